# Optimizing an MI355X kernel written in HIP

```python
import jax
import jax.numpy as jnp
from jax import lax
import numpy as np

D_MODEL = 1024
BATCH = 4
SEQ = 4096
DEPTH = 1

GRID_W = 64
CTX_LEN = 256
MIX_W = D_MODEL
NA_W = MIX_W // 2
NA_HEADS = 8
NA_HEAD_DIM = NA_W // NA_HEADS
NA_WIN_ROWS = 8
NA_WIN_COLS = 16
GLA_HEADS = 4
GLA_VAL_W = MIX_W - NA_W
GLA_DV = GLA_VAL_W // GLA_HEADS
GLA_DK = GLA_DV // 2
GLA_KEY_W = GLA_HEADS * GLA_DK
GLA_GATE_RANK = 16
GLA_GATE_TAU = 16.0
GLA_CHUNK = 16
ROPE_BASE = 10000.0
N_EXPERTS = 16
EC_CAPACITY_FACTOR = 2
D_EXPERT = 2816
NORM_EPS = 1e-6

KV_SIZES = (NA_W, NA_W, GLA_KEY_W, GLA_VAL_W, 2 * GLA_GATE_RANK)
Q_SIZES = (NA_W, GLA_KEY_W, GLA_VAL_W)
IN_SIZES = KV_SIZES + Q_SIZES
KV_COLS = sum(KV_SIZES)
IN_COLS = sum(IN_SIZES)

kernel_name = 'hybrid_na_gla_ec_diffusion_block'


def _split(t, sizes):
    cuts = [sum(sizes[:i + 1]) for i in range(len(sizes) - 1)]
    return jnp.split(t, cuts, axis=-1)


def _to_heads(t, n_heads):
    b, n, _ = t.shape
    return t.reshape(b, n, n_heads, -1).transpose(0, 2, 1, 3)


def _merge_heads(t):
    b, h, n, d = t.shape
    return t.transpose(0, 2, 1, 3).reshape(b, n, h * d)


def _rms_norm(x, g):
    xf = x.astype(jnp.float32)
    y = xf * lax.rsqrt(jnp.mean(xf * xf, axis=-1, keepdims=True) + NORM_EPS)
    return (y * g.astype(jnp.float32)).astype(x.dtype)


def _modulate(x, g, shift, scale):
    return _rms_norm(x, g) * (1 + scale) + shift


def _rope_1d(x, pos):
    half = x.shape[-1] // 2
    freqs = ROPE_BASE ** (-jnp.arange(half, dtype=jnp.float32) / half)
    ang = pos.astype(jnp.float32)[:, None] * freqs
    cos, sin = jnp.cos(ang).astype(x.dtype), jnp.sin(ang).astype(x.dtype)
    x1, x2 = x[..., :half], x[..., half:]
    return jnp.concatenate([x1 * cos - x2 * sin, x1 * sin + x2 * cos], axis=-1)


def _axial_rope(x, pos_row, pos_col):
    half = x.shape[-1] // 2
    return jnp.concatenate([_rope_1d(x[..., :half], pos_row), _rope_1d(x[..., half:], pos_col)], axis=-1)


def _neighbourhood_attention(q, k, v, k_ctx, v_ctx, rpb):
    b, h, n, dh = q.shape
    rows = n // GRID_W
    kr = min(NA_WIN_ROWS, rows)
    qg = q.reshape(b, h, rows, GRID_W, dh)
    kg = k.reshape(b, h, rows, GRID_W, dh)
    vg = v.reshape(b, h, rows, GRID_W, dh)
    r = jnp.arange(rows)
    row_start = jnp.clip(r - kr // 2, 0, rows - kr)
    key_rows = row_start[:, None] + jnp.arange(kr)
    k_blk = kg[:, :, key_rows]
    v_blk = vg[:, :, key_rows]
    col = jnp.arange(GRID_W)
    col_start = jnp.clip(col - NA_WIN_COLS // 2, 0, GRID_W - NA_WIN_COLS)
    in_win = (col[None, :] >= col_start[:, None]) & (col[None, :] < col_start[:, None] + NA_WIN_COLS)
    dr = key_rows - r[:, None] + NA_WIN_ROWS - 1
    dc = jnp.clip(col[None, :] - col[:, None] + NA_WIN_COLS - 1, 0, 2 * NA_WIN_COLS - 2)
    bias = rpb[:, dr[:, None, :, None], dc[None, :, None, :]]
    scale = dh ** -0.5
    s_win = jnp.einsum('bhrqd,bhrkwd->bhrqkw', qg, k_blk).astype(jnp.float32) * scale + bias.astype(jnp.float32)
    s_win = jnp.where(in_win[:, None, :], s_win, -jnp.inf)
    s_ctx = jnp.einsum('bhrqd,bhcd->bhrqc', qg, k_ctx).astype(jnp.float32) * scale
    scores = jnp.concatenate([s_win.reshape(b, h, rows, GRID_W, kr * GRID_W), s_ctx], axis=-1)
    p = jax.nn.softmax(scores, axis=-1).astype(v.dtype)
    p_win = p[..., :kr * GRID_W].reshape(b, h, rows, GRID_W, kr, GRID_W)
    p_ctx = p[..., kr * GRID_W:]
    o = jnp.einsum('bhrqkw,bhrkwd->bhrqd', p_win, v_blk) + jnp.einsum('bhrqc,bhcd->bhrqd', p_ctx, v_ctx)
    return o.reshape(b, h, n, dh)


def _context_attention(q, k, v):
    s = jnp.einsum('bhqd,bhkd->bhqk', q, k).astype(jnp.float32) * q.shape[-1] ** -0.5
    p = jax.nn.softmax(s, axis=-1).astype(v.dtype)
    return jnp.einsum('bhqk,bhkd->bhqd', p, v)


def _gla_log_decay(a_down, a_up, a_bias, direction):
    z = a_down[..., direction * GLA_GATE_RANK:(direction + 1) * GLA_GATE_RANK] @ a_up[direction] + a_bias[direction]
    return _to_heads(jax.nn.log_sigmoid(z.astype(jnp.float32)) / GLA_GATE_TAU, GLA_HEADS)


def _chunk(t):
    b, h, n, d = t.shape
    return t.reshape(b, h, n // GLA_CHUNK, GLA_CHUNK, d)


def _gla_states(kc, vc, lam, s0, keep_states):
    lam_last = lam[:, :, :, -1:, :]
    u = jnp.einsum('bhcld,bhcle->bhcde', kc * jnp.exp(lam_last - lam), vc)
    a_tot = jnp.exp(lam_last[:, :, :, 0, :])

    def step(s, xs):
        a_c, u_c = xs
        return a_c[..., None] * s + u_c, (s if keep_states else None)

    s_final, s_before = lax.scan(step, s0, (jnp.moveaxis(a_tot, 2, 0), jnp.moveaxis(u, 2, 0)))
    if keep_states:
        s_before = jnp.moveaxis(s_before, 0, 2)
    return s_before, s_final


def _gla_readout(qc, kc, vc, lam, s_before):
    ln = qc.shape[3]
    causal = jnp.tril(jnp.ones((ln, ln), dtype=bool))[:, :, None]
    diff = lam[:, :, :, :, None, :] - lam[:, :, :, None, :, :]
    decay = jnp.where(causal, jnp.exp(jnp.where(causal, diff, 0.0)), 0.0)
    scores = jnp.einsum('bhcid,bhcjd,bhcijd->bhcij', qc, kc, decay)
    o_intra = jnp.einsum('bhcij,bhcje->bhcie', scores, vc)
    o_inter = jnp.einsum('bhcid,bhcde->bhcie', qc * jnp.exp(lam), s_before)
    return o_intra + o_inter


def _gla_direction(q, k, v, log_a, s0, reverse):
    if reverse:
        q, k, v, log_a = (jnp.flip(t, axis=2) for t in (q, k, v, log_a))
    b, h, n, _ = v.shape
    qc, kc, vc = _chunk(q), _chunk(k), _chunk(v)
    lam = jnp.cumsum(_chunk(log_a), axis=3)
    s_before, s_final = _gla_states(kc, vc, lam, s0, True)
    o = _gla_readout(qc, kc, vc, lam, s_before).reshape(b, h, n, -1)
    return (jnp.flip(o, axis=2) if reverse else o), s_final


def _gla_final_state(k, v, log_a, s0, reverse):
    if reverse:
        k, v, log_a = (jnp.flip(t, axis=2) for t in (k, v, log_a))
    lam = jnp.cumsum(_chunk(log_a), axis=3)
    return _gla_states(_chunk(k), _chunk(v), lam, s0, False)[1]


def _gla_merge(o, g_norm, gate):
    o = _rms_norm(o, g_norm)
    return _merge_heads(o).astype(gate.dtype) * jax.nn.silu(gate)


def _expert_choice_ffn(h, router, w_gate, w_up, w_down):
    b, n, d = h.shape
    cap = EC_CAPACITY_FACTOR * n // N_EXPERTS
    affinity = jax.nn.softmax((h @ router).astype(jnp.float32), axis=-1)
    gates, idx = lax.top_k(jnp.swapaxes(affinity, 1, 2), cap)
    xs = jax.vmap(lambda hb, ib: hb[ib])(h, idx)
    hid = jax.nn.silu(jnp.einsum('becd,edf->becf', xs, w_gate)) * jnp.einsum('becd,edf->becf', xs, w_up)
    y = jnp.einsum('becf,efd->becd', hid, w_down) * gates[..., None].astype(h.dtype)
    return jax.vmap(lambda yb, ib: jnp.zeros((n, d), h.dtype).at[ib.reshape(-1)].add(yb.reshape(-1, d)))(y, idx)


def _normal(key, shape, scale):
    return jax.random.normal(key, shape, jnp.float32) * scale


def setup_inputs(seed: int = 0) -> dict:
    key = jax.random.key(seed)
    ks = jax.random.split(key, 20)
    D, L = D_MODEL, DEPTH
    return {
        'x': _normal(ks[0], (BATCH, SEQ, D), 1.0),
        'c': _normal(ks[1], (BATCH, D), 1.0),
        'ctx': _normal(ks[2], (BATCH, CTX_LEN, D), 1.0),
        'c_ctx': _normal(ks[3], (D,), 1.0),
        'w_mod': _normal(ks[4], (L, D, 6 * D), 0.5 * D ** -0.5),
        'b_mod': _normal(ks[5], (L, 6 * D), 0.01),
        'norm_mix_pre': 1.0 + _normal(ks[6], (L, D), 0.02),
        'norm_mix_post': 1.0 + _normal(ks[7], (L, D), 0.02),
        'norm_ffn_pre': 1.0 + _normal(ks[8], (L, D), 0.02),
        'norm_ffn_post': 1.0 + _normal(ks[9], (L, D), 0.02),
        'w_in': _normal(ks[10], (L, D, IN_COLS), D ** -0.5),
        'na_rpb': _normal(ks[11], (L, NA_HEADS, 2 * NA_WIN_ROWS - 1, 2 * NA_WIN_COLS - 1), 0.1),
        'gla_a_up': _normal(ks[12], (L, 2, GLA_GATE_RANK, GLA_KEY_W), GLA_GATE_RANK ** -0.5),
        'gla_a_bias': _normal(ks[13], (L, 2, GLA_KEY_W), 0.1),
        'gla_norm': 1.0 + _normal(ks[14], (L, GLA_DV), 0.02),
        'w_out': _normal(ks[15], (L, MIX_W, D), MIX_W ** -0.5),
        'router': _normal(ks[16], (L, D, N_EXPERTS), D ** -0.5),
        'w_gate': _normal(ks[17], (L, N_EXPERTS, D, D_EXPERT), D ** -0.5),
        'w_up': _normal(ks[18], (L, N_EXPERTS, D, D_EXPERT), D ** -0.5),
        'w_down': _normal(ks[19], (L, N_EXPERTS, D_EXPERT, D), D_EXPERT ** -0.5),
    }


def reference(x, c, ctx, c_ctx, w_mod, b_mod, norm_mix_pre, norm_mix_post, norm_ffn_pre, norm_ffn_post,
              w_in, na_rpb, gla_a_up, gla_a_bias, gla_norm, w_out, router, w_gate, w_up, w_down):
    b, n, d = x.shape
    t = jnp.arange(n)
    pos_row, pos_col = t // GRID_W, t % GRID_W
    s_zero = jnp.zeros((b, GLA_HEADS, GLA_DK, GLA_DV), jnp.float32)
    for layer in range(DEPTH):
        last = layer == DEPTH - 1
        mod = jax.nn.silu(c) @ w_mod[layer] + b_mod[layer]
        sh_m, sc_m, g_m, sh_f, sc_f, g_f = jnp.split(mod[:, None, :], 6, axis=-1)
        n_ctx_mods = 2 if last else 6
        mod_ctx = jax.nn.silu(c_ctx) @ w_mod[layer][:, :n_ctx_mods * d] + b_mod[layer][:n_ctx_mods * d]
        ctx_mods = jnp.split(mod_ctx, n_ctx_mods, axis=-1)

        h = _modulate(x, norm_mix_pre[layer], sh_m, sc_m)
        h_ctx = _modulate(ctx, norm_mix_pre[layer], ctx_mods[0], ctx_mods[1])
        na_k, na_v, gla_k, gla_v, a_down, na_q, gla_q, gla_g = _split(h @ w_in[layer], IN_SIZES)
        parts_ctx = _split(h_ctx @ w_in[layer][:, :(KV_COLS if last else IN_COLS)], KV_SIZES if last else IN_SIZES)
        c_na_k, c_na_v, c_gla_k, c_gla_v, c_a_down = parts_ctx[:5]
        c_na_k, c_na_v = _to_heads(c_na_k, NA_HEADS), _to_heads(c_na_v, NA_HEADS)

        o_na = _neighbourhood_attention(_to_heads(na_q, NA_HEADS), _to_heads(na_k, NA_HEADS),
                                        _to_heads(na_v, NA_HEADS), c_na_k, c_na_v, na_rpb[layer])

        c_k = _to_heads(c_gla_k, GLA_HEADS).astype(jnp.float32)
        c_v = _to_heads(c_gla_v, GLA_HEADS).astype(jnp.float32)
        c_la_f = _gla_log_decay(c_a_down, gla_a_up[layer], gla_a_bias[layer], 0)
        c_la_b = _gla_log_decay(c_a_down, gla_a_up[layer], gla_a_bias[layer], 1)
        if last:
            s_ctx_f = _gla_final_state(c_k, c_v, c_la_f, s_zero, False)
            s_ctx_b = _gla_final_state(c_k, c_v, c_la_b, s_zero, True)
        else:
            c_na_q, c_gla_q, c_gla_g = parts_ctx[5:]
            c_q = _to_heads(c_gla_q, GLA_HEADS).astype(jnp.float32) * GLA_DK ** -0.5
            oc_f, s_ctx_f = _gla_direction(c_q, c_k, c_v, c_la_f, s_zero, False)
            oc_b, s_ctx_b = _gla_direction(c_q, c_k, c_v, c_la_b, s_zero, True)
        q_l = _axial_rope(_to_heads(gla_q, GLA_HEADS).astype(jnp.float32), pos_row, pos_col) * GLA_DK ** -0.5
        k_l = _axial_rope(_to_heads(gla_k, GLA_HEADS).astype(jnp.float32), pos_row, pos_col)
        v_l = _to_heads(gla_v, GLA_HEADS).astype(jnp.float32)
        la_f = _gla_log_decay(a_down, gla_a_up[layer], gla_a_bias[layer], 0)
        la_b = _gla_log_decay(a_down, gla_a_up[layer], gla_a_bias[layer], 1)
        o_f, _ = _gla_direction(q_l, k_l, v_l, la_f, s_ctx_f, False)
        o_b, _ = _gla_direction(q_l, k_l, v_l, la_b, s_ctx_b, True)
        o_gla = _gla_merge(o_f + o_b, gla_norm[layer], gla_g)

        mix = jnp.concatenate([_merge_heads(o_na), o_gla], axis=-1) @ w_out[layer]
        x_new = x + g_m * _rms_norm(mix, norm_mix_post[layer])

        hf = _modulate(x_new, norm_ffn_pre[layer], sh_f, sc_f)
        y = _expert_choice_ffn(hf, router[layer], w_gate[layer], w_up[layer], w_down[layer])
        x_new = x_new + g_f * _rms_norm(y, norm_ffn_post[layer])

        if not last:
            o_na_c = _context_attention(_to_heads(c_na_q, NA_HEADS), c_na_k, c_na_v)
            o_gla_c = _gla_merge(oc_f + oc_b, gla_norm[layer], c_gla_g)
            mix_c = jnp.concatenate([_merge_heads(o_na_c), o_gla_c], axis=-1) @ w_out[layer]
            ctx = ctx + ctx_mods[2] * _rms_norm(mix_c, norm_mix_post[layer])
            hc = _modulate(ctx, norm_ffn_pre[layer], ctx_mods[3], ctx_mods[4])
            yc = _expert_choice_ffn(hc, router[layer], w_gate[layer], w_up[layer], w_down[layer])
            ctx = ctx + ctx_mods[5] * _rms_norm(yc, norm_ffn_post[layer])
        x = x_new
    return x
```

```cpp
#include <hip/hip_runtime.h>
#include <hip/hip_cooperative_groups.h>
#include <cstdio>
#include <cstdint>
namespace pg8 {
#define PG8_LAS __attribute__((address_space(3)))
typedef unsigned short bf16_t;
typedef short bf16x8 __attribute__((ext_vector_type(8)));
typedef float f32x4 __attribute__((ext_vector_type(4)));
typedef unsigned u32x4 __attribute__((ext_vector_type(4)));
constexpr int BM = 256, BK = 64, HALF = 128, HTB = HALF * BK * 2  , STAGE_BYTES = 8 * HTB, NXCD = 8, WGM = 8;

__host__ __device__ __forceinline__ int lds_byte(int r, int c) { const int st = (r >> 4) * 2 + (c >> 5), rr = r & 15, cc = c & 31, ob = rr * 64 + cc * 2; return st * 1024 + (ob ^ (((ob >> 9) & 1) << 5)); }
__host__ __device__ __forceinline__ void stage_rc(int b, int& R, int& C) { const int st = b / 1024, sb = b % 1024, swz = sb ^ (((sb >> 9) & 1) << 5); R = (st >> 1) * 16 + swz / 64; C = (st & 1) * 32 + (swz % 64) / 2; }
__host__ __device__ __forceinline__ int perm32(int rho) { const int n = rho >> 4, i = rho & 15; return 8 * (i >> 2) + 4 * n + (i & 3); }

struct Unit { int pm, pn, bt; };
struct Gemm { const bf16_t* A; const bf16_t* Bt; int M, N, K; };

struct StaticOrder {
    int nM, nN, nwg, G, c;
    __host__ __device__ void init(int M, int N, int G_, int c_) { nM = M / BM; nN = N / BM; nwg = nM * nN; G = G_; c = c_; }
    __host__ __device__ bool next(int i, Unit& u) const {
        const long L = (long)i * G + c; if (L >= nwg) return false;
        int wgid = (int)L; { const int q = nwg / NXCD, r = nwg % NXCD, xcd = wgid % NXCD, off = wgid / NXCD; wgid = (xcd < r ? xcd * (q + 1) : r * (q + 1) + (xcd - r) * q) + off; }
        const int nig = WGM * nN, gid = wgid / nig, fm = gid * WGM, gsz = (nM - fm) < WGM ? (nM - fm) : WGM;
        u.pm = fm + ((wgid % nig) % gsz); u.pn = (wgid % nig) / gsz; u.bt = u.pn; return true;
    }
    __device__ __forceinline__ void a_ready(const Unit&) const {}
    __device__ __forceinline__ void done(const Unit&) const {}
};

__device__ __forceinline__ unsigned cvt_pk_bf16(float lo, float hi) { unsigned r; asm volatile("v_cvt_pk_bf16_f32 %0, %1, %2" : "=v"(r) : "v"(lo), "v"(hi)); return r; }
typedef float f32x2 __attribute__((ext_vector_type(2)));
__device__ __forceinline__ f32x2 gelu_pk(f32x2 v) {
    const f32x2 av = __builtin_elementwise_abs(v), d = av * 0.2316418882f + 1.0f;
    f32x2 t; t.x = __builtin_amdgcn_rcpf(d.x); t.y = __builtin_amdgcn_rcpf(d.y);
    f32x2 q = t * 0.5307027145f + (-0.7265760135f); q = q * t + 0.7107068705f; q = q * t + (-0.142248368f); q = q * t + 0.127414796f; q = q * t;
    const f32x2 s = (v * v) * (-0.72134752044f);
    f32x2 e; e.x = __builtin_amdgcn_exp2f(s.x); e.y = __builtin_amdgcn_exp2f(s.y);
    const f32x2 m = v * (q * e), r = v - m;
    f32x2 o; o.x = v.x < 0.f ? m.x : r.x; o.y = v.y < 0.f ? m.y : r.y; return o;
}

template <int ACT  > struct EpiBf16 {
    static constexpr bool PERM = true, AFTER_DRAIN = false; static_assert(ACT == 0 || ACT == 1, "EpiBf16: ACT is 0 (none) or 1 (gelu_pk)");
    bf16_t* O; int ldc; const float* bias; int split_cols; size_t split_stride; float scale0;
    __device__ __forceinline__ void operator()(const f32x4 (&acc)[2][2][4][2], const Unit& u, int wr, int wc, int fr, int fq) const {
        const int row0 = u.pm * BM + wr * 64 + fr; int colt = u.pn * BM; bf16_t* base = O;
        float sc = 1.f; if (split_cols) { const int t = colt / split_cols; base += (size_t)t * split_stride; colt -= t * split_cols; if (t == 0) sc = scale0; }
        const int col0 = colt + wc * 32 + 8 * fq, bcol0 = u.pn * BM + wc * 32 + 8 * fq;
        f32x4 bv[2][2];
#pragma unroll
        for (int bj = 0; bj < 2; ++bj)
#pragma unroll
            for (int n = 0; n < 2; ++n) bv[bj][n] = bias ? *(const f32x4*)(bias + bcol0 + bj * HALF + 4 * n) : (f32x4){0.f, 0.f, 0.f, 0.f};
#pragma unroll
        for (int ai = 0; ai < 2; ++ai)
#pragma unroll
            for (int m = 0; m < 4; ++m) { bf16_t* rowp = base + (size_t)(row0 + ai * HALF + m * 16) * ldc + col0;
#pragma unroll
                for (int bj = 0; bj < 2; ++bj) { f32x4 v0 = acc[ai][bj][m][0] + bv[bj][0], v1 = acc[ai][bj][m][1] + bv[bj][1];
                    if (ACT == 1) { f32x2 a = gelu_pk((f32x2){v0[0], v0[1]}), b = gelu_pk((f32x2){v0[2], v0[3]}), c = gelu_pk((f32x2){v1[0], v1[1]}), d = gelu_pk((f32x2){v1[2], v1[3]});
                        v0 = (f32x4){a.x, a.y, b.x, b.y}; v1 = (f32x4){c.x, c.y, d.x, d.y}; }
                    v0 = v0 * sc; v1 = v1 * sc; u32x4 w; w.x = cvt_pk_bf16(v0[0], v0[1]); w.y = cvt_pk_bf16(v0[2], v0[3]); w.z = cvt_pk_bf16(v1[0], v1[1]); w.w = cvt_pk_bf16(v1[2], v1[3]);
                    *(u32x4*)(rowp + bj * HALF) = w; } }
    }
};
template <class Epi, class Sched, bool ALIGN_EPI = false, bool SP2 = false>
__device__ __forceinline__ void gemm_phase(PG8_LAS unsigned char* lds, const Gemm g, const Sched& S, const Epi& E) {
    const int tid = threadIdx.x, wid = __builtin_amdgcn_readfirstlane(tid >> 6), lane = tid & 63, wr = wid >> 2, wc = wid & 3, fr = lane & 15, fq = lane >> 4;
    const int K = g.K, nt = K / BK;
    unsigned voffA[2], voffB[2];
#pragma unroll
    for (int i = 0; i < 2; ++i) { int R, C; stage_rc(tid * 16 + i * 8192, R, C); const int Rb = Epi::PERM ? ((R & ~31) + perm32(R & 31)) : R;
        voffA[i] = (unsigned)(R * K + C) * 2u; voffB[i] = (unsigned)(Rb * K + C) * 2u; }
    const size_t kstep = (size_t)(BK * 2);
    const size_t hstep = (size_t)HALF * K * 2;
    const size_t tstep = 2 * hstep;
    const unsigned ldsw = (unsigned)wid * 1024u;
    const int aoff = lds_byte(wr * 64 + fr, fq * 8), boff = lds_byte(wc * 32 + fr, fq * 8);
#define PG8_SA(b, h) (((b) * 2 + (h)) * HTB)
#define PG8_SB(b, h) ((4 + (b) * 2 + (h)) * HTB)
#define PG8_STAGE(bufoff, gbase, voff) do { _Pragma("unroll") for (int _i = 0; _i < 2; ++_i) \
        __builtin_amdgcn_global_load_lds((const unsigned*)((const char*)(gbase) + (voff)[_i]), (PG8_LAS unsigned*)(lds + (bufoff) + ldsw + _i * 8192), 16, 0, 0); } while (0)
#define PG8_LDA(dst, b, h) do { _Pragma("unroll") for (int m = 0; m < 4; ++m) _Pragma("unroll") for (int k = 0; k < 2; ++k) dst[m][k] = *(const PG8_LAS bf16x8*)(lds + PG8_SA(b, h) + aoff + m * 2048 + k * 1024); } while (0)
#define PG8_LDB(dst, b, h) do { _Pragma("unroll") for (int n = 0; n < 2; ++n) _Pragma("unroll") for (int k = 0; k < 2; ++k) dst[n][k] = *(const PG8_LAS bf16x8*)(lds + PG8_SB(b, h) + boff + n * 2048 + k * 1024); } while (0)
#define PG8_MMA(ai, bj, At, Bt) do { __builtin_amdgcn_s_setprio(1); _Pragma("unroll") for (int m = 0; m < 4; ++m) _Pragma("unroll") for (int n = 0; n < 2; ++n) _Pragma("unroll") for (int k = 0; k < 2; ++k) \
        acc[ai][bj][m][n] = __builtin_amdgcn_mfma_f32_16x16x32_bf16(Bt[n][k], At[m][k], acc[ai][bj][m][n], 0, 0, 0); __builtin_amdgcn_s_setprio(0); } while (0)
#define PG8_WAIT_V(n) asm volatile("s_waitcnt vmcnt(" #n ")" ::: "memory")
#define PG8_WAIT_L(n) asm volatile("s_waitcnt lgkmcnt(" #n ")" ::: "memory")
#define PG8_BAR __builtin_amdgcn_s_barrier()
#define PG8_SCHED __builtin_amdgcn_sched_barrier(0)
    Unit cur, nxt; int ui = 0;
    if (!S.next(0, cur)) return;
    f32x4 acc[2][2][4][2];
#pragma unroll
    for (int a = 0; a < 2; ++a)
#pragma unroll
        for (int b = 0; b < 2; ++b)
#pragma unroll
            for (int m = 0; m < 4; ++m)
#pragma unroll
                for (int n = 0; n < 2; ++n) acc[a][b][m][n] = (f32x4){0.f, 0.f, 0.f, 0.f};
    bf16x8 At[4][2], B0[2][2], B1[2][2];
    const char* cA = (const char*)g.A + (size_t)cur.pm * tstep; const char* cB = (const char*)g.Bt + (size_t)cur.bt * tstep;
    S.a_ready(cur);
    if constexpr (SP2) {
        PG8_STAGE(PG8_SB(0, 0), cB, voffB); PG8_STAGE(PG8_SB(0, 1), cB + hstep, voffB); PG8_STAGE(PG8_SA(0, 0), cA, voffA); PG8_STAGE(PG8_SA(0, 1), cA + hstep, voffA);
        if (wr == 1) PG8_BAR;
        PG8_WAIT_V(2); PG8_BAR;
        PG8_STAGE(PG8_SB(1, 0), cB + kstep, voffB); PG8_STAGE(PG8_SA(1, 0), cA + kstep, voffA); PG8_STAGE(PG8_SB(1, 1), cB + hstep + kstep, voffB);
        PG8_WAIT_V(6); PG8_BAR;
    } else {
        PG8_STAGE(PG8_SB(0, 0), cB, voffB); PG8_STAGE(PG8_SA(0, 0), cA, voffA); PG8_STAGE(PG8_SB(0, 1), cB + hstep, voffB); PG8_STAGE(PG8_SA(0, 1), cA + hstep, voffA);
        if (wr == 1) PG8_BAR;
        PG8_WAIT_V(4); PG8_BAR;
        PG8_STAGE(PG8_SB(1, 0), cB + kstep, voffB); PG8_STAGE(PG8_SA(1, 0), cA + kstep, voffA); PG8_STAGE(PG8_SB(1, 1), cB + hstep + kstep, voffB);
        PG8_WAIT_V(6); PG8_BAR;
    }
    for (;;) {
        const bool has_next = S.next(ui + 1, nxt);
        const char* nA = has_next ? (const char*)g.A + (size_t)nxt.pm * tstep : cA; const char* nB = has_next ? (const char*)g.Bt + (size_t)nxt.bt * tstep : cB;
        for (int t = 0; t < nt; t += 2) {
            const bool last = (t == nt - 2);
            const char* a1 = cA + (size_t)(t + 1) * kstep;
            const char* a2 = last ? nA : cA + (size_t)(t + 2) * kstep; const char* b2 = last ? nB : cB + (size_t)(t + 2) * kstep;
            const char* a3 = a2 + kstep; const char* b3 = b2 + kstep;
            if (last && has_next) S.a_ready(nxt);
            if constexpr (SP2) {
            PG8_LDB(B0, 0, 0); PG8_LDB(B1, 0, 1); PG8_SCHED; PG8_LDA(At, 0, 0); PG8_STAGE(PG8_SA(1, 1), a1 + hstep, voffA);
            PG8_WAIT_V(8); PG8_WAIT_L(0); PG8_BAR; PG8_MMA(0, 0, At, B0); PG8_MMA(0, 1, At, B1); PG8_BAR; PG8_SCHED;
            PG8_LDA(At, 0, 1); PG8_STAGE(PG8_SB(0, 0), b2, voffB); PG8_STAGE(PG8_SB(0, 1), b2 + hstep, voffB); PG8_STAGE(PG8_SA(0, 0), a2, voffA);
            PG8_WAIT_V(8); PG8_WAIT_L(0); PG8_BAR; PG8_MMA(1, 0, At, B0); PG8_MMA(1, 1, At, B1); PG8_BAR; PG8_SCHED;
            PG8_LDB(B0, 1, 0); PG8_LDB(B1, 1, 1); PG8_SCHED; PG8_LDA(At, 1, 0); PG8_STAGE(PG8_SA(0, 1), a2 + hstep, voffA);
            PG8_WAIT_V(8); PG8_WAIT_L(0); PG8_BAR; PG8_MMA(0, 0, At, B0); PG8_MMA(0, 1, At, B1); PG8_BAR; PG8_SCHED;
            PG8_LDA(At, 1, 1); PG8_STAGE(PG8_SB(1, 0), b3, voffB); PG8_STAGE(PG8_SB(1, 1), b3 + hstep, voffB); PG8_STAGE(PG8_SA(1, 0), a3, voffA);
            PG8_WAIT_V(8); PG8_WAIT_L(0); PG8_BAR; PG8_MMA(1, 0, At, B0); PG8_MMA(1, 1, At, B1); PG8_BAR; PG8_SCHED;
            } else {
            PG8_LDB(B0, 0, 0); PG8_SCHED; PG8_LDA(At, 0, 0); PG8_STAGE(PG8_SA(1, 1), a1 + hstep, voffA);
            PG8_WAIT_L(8); PG8_BAR; PG8_WAIT_L(0); PG8_MMA(0, 0, At, B0); PG8_BAR; PG8_SCHED;
            PG8_LDB(B1, 0, 1); PG8_STAGE(PG8_SB(0, 0), b2, voffB);
            PG8_BAR; PG8_WAIT_L(0); PG8_MMA(0, 1, At, B1); PG8_BAR;
            PG8_LDA(At, 0, 1); PG8_STAGE(PG8_SA(0, 0), a2, voffA);
            PG8_BAR; PG8_WAIT_L(0); PG8_MMA(1, 0, At, B0); PG8_BAR; PG8_SCHED;
            PG8_STAGE(PG8_SB(0, 1), b2 + hstep, voffB);
            PG8_WAIT_V(6); PG8_BAR; PG8_MMA(1, 1, At, B1); PG8_BAR;
            PG8_LDB(B0, 1, 0); PG8_SCHED; PG8_LDA(At, 1, 0); PG8_STAGE(PG8_SA(0, 1), a2 + hstep, voffA);
            PG8_WAIT_L(8); PG8_BAR; PG8_WAIT_L(0); PG8_MMA(0, 0, At, B0); PG8_BAR; PG8_SCHED;
            PG8_LDB(B1, 1, 1); PG8_STAGE(PG8_SB(1, 0), b3, voffB);
            PG8_BAR; PG8_WAIT_L(0); PG8_MMA(0, 1, At, B1); PG8_BAR;
            PG8_LDA(At, 1, 1); PG8_STAGE(PG8_SA(1, 0), a3, voffA);
            PG8_BAR; PG8_WAIT_L(0); PG8_MMA(1, 0, At, B0); PG8_BAR; PG8_SCHED;
            PG8_STAGE(PG8_SB(1, 1), b3 + hstep, voffB);
            PG8_WAIT_V(6); PG8_BAR; PG8_MMA(1, 1, At, B1); PG8_BAR;
            }
        }
        if constexpr (ALIGN_EPI) { if (wr == 0) PG8_BAR; }
        if constexpr (!Epi::AFTER_DRAIN) { E(acc, cur, wr, wc, fr, fq); S.done(cur); }
        if (!has_next) break;
#pragma unroll
        for (int a = 0; a < 2; ++a)
#pragma unroll
            for (int b = 0; b < 2; ++b)
#pragma unroll
                for (int m = 0; m < 4; ++m)
#pragma unroll
                    for (int n = 0; n < 2; ++n) acc[a][b][m][n] = (f32x4){0.f, 0.f, 0.f, 0.f};
        cur = nxt; cA = nA; cB = nB; ++ui;
        if constexpr (ALIGN_EPI) { if (wr == 1) PG8_BAR; }
    }
    PG8_WAIT_V(0);
    if constexpr (!ALIGN_EPI) { if (wr == 0) PG8_BAR; }
    PG8_BAR;
    if constexpr (Epi::AFTER_DRAIN) { E.fused(acc, cur, wr, wc, fr, fq, lds, wid, lane); S.done(cur); }
#undef PG8_SA
#undef PG8_SB
#undef PG8_STAGE
#undef PG8_LDA
#undef PG8_LDB
#undef PG8_MMA
#undef PG8_WAIT_V
#undef PG8_WAIT_L
#undef PG8_BAR
#undef PG8_SCHED
}
}
namespace hy {
using pg8::bf16_t; using pg8::f32x4; using pg8::u32x4; using pg8::bf16x8;
#define LAS __attribute__((address_space(3)))
constexpr int NB = 4, SEQ = 4096, DM = 1024, CTXL = 256;
constexpr int M_LAT = NB * SEQ, M_CTX = NB * CTXL, M_ALL = M_LAT + M_CTX;
constexpr int IN_COLS = 3104, NE = 16, CAP = 512, DE = 2816, NSLOT = NE * NB * CAP;
constexpr int PROJ_LD = 2304, PC_NAK = 0, PC_GK = 512, PC_NAQ = 768, PC_GQ = 1280, PC_GG = 1536, PC_AD = 2048;
constexpr int VT_LD = M_ALL;
constexpr float EPS = 1e-6f;
constexpr size_t MiB = 1u << 20;
constexpr size_t WS_MODP = 1 * MiB, WS_MOD = 3 * MiB, WS_WTIN = 4 * MiB, WS_WTV = 9 * MiB, WS_WTOUT = 11 * MiB, WS_AFF = 13 * MiB, WS_IDX = 14 * MiB, WS_GATE = 14 * MiB + 256 * 1024, WS_INV = 15 * MiB;
constexpr size_t WS_WTGU = 16 * MiB, WS_WTDN = 192 * MiB, WS_H = 280 * MiB, WS_PROJ = 314 * MiB, WS_VT = 391 * MiB, WS_OMIX = 425 * MiB, WS_MIX = 457 * MiB, WS_HID = 280 * MiB;
constexpr size_t WS_HF = 489 * MiB, WS_XS = 521 * MiB, WS_GLAT = 590 * MiB, WS_END = 660 * MiB;
static_assert(WS_WTIN + (size_t)PROJ_LD * DM * 2 <= WS_WTV && WS_WTGU + (size_t)NE * 2 * DE * DM * 2 <= WS_WTDN && WS_WTDN + (size_t)NE * DM * DE * 2 <= WS_H, "ws map 1");
static_assert(WS_H + (size_t)M_ALL * DM * 2 <= WS_PROJ && WS_PROJ + (size_t)M_ALL * PROJ_LD * 2 <= WS_VT && WS_VT + (size_t)1024 * VT_LD * 2 <= WS_OMIX, "ws map 2");
static_assert(WS_HID + (size_t)NSLOT * DE * 2 <= WS_MIX && WS_XS + (size_t)NSLOT * DM * 2 <= WS_GLAT && WS_GLAT + (size_t)4 * M_ALL * 256 * 4 <= WS_END, "ws map 3");

__device__ __forceinline__ float bf2f(bf16_t x) { return __uint_as_float((unsigned)x << 16); }
__device__ __forceinline__ unsigned f2bf(float f) { unsigned u = __float_as_uint(f); return (u + 0x7fffu + ((u >> 16) & 1u)) >> 16; }
__device__ __forceinline__ unsigned pk2(float lo, float hi) { return f2bf(lo) | (f2bf(hi) << 16); }
__device__ __forceinline__ float wave_sum(float v) {
#pragma unroll
    for (int o = 1; o < 64; o <<= 1) v += __shfl_xor(v, o);
    return v;
}
__device__ __forceinline__ float silu_f(float x) { return x / (1.f + __expf(-x)); }

__global__ void __launch_bounds__(256) k_mod_partial(const float* __restrict__ c, const float* __restrict__ c_ctx, const float* __restrict__ w_mod, float* __restrict__ part) {
    __shared__ float s[5][64];
    const int ks = blockIdx.y, j = blockIdx.x * 256 + threadIdx.x;
    for (int i = threadIdx.x; i < 5 * 64; i += 256) { const int v = i / 64, k = ks * 64 + (i % 64); const float x = v < 4 ? c[v * 1024 + k] : c_ctx[k]; s[v][i % 64] = x / (1.f + expf(-x)); }
    __syncthreads();
    float acc[5] = {0.f, 0.f, 0.f, 0.f, 0.f};
#pragma unroll 8
    for (int k = 0; k < 64; ++k) { const float w = w_mod[(size_t)(ks * 64 + k) * 6144 + j];
#pragma unroll
        for (int v = 0; v < 5; ++v) acc[v] += s[v][k] * w; }
#pragma unroll
    for (int v = 0; v < 5; ++v) part[(size_t)(ks * 5 + v) * 6144 + j] = acc[v];
}
__global__ void __launch_bounds__(256) k_mod_final(const float* __restrict__ part, const float* __restrict__ b_mod, float* __restrict__ mod) {
    const int i = blockIdx.x * 256 + threadIdx.x; if (i >= 5 * 6144) return; const int v = i / 6144, j = i % 6144;
    float a = b_mod[j];
    for (int ks = 0; ks < 16; ++ks) a += part[(size_t)(ks * 5 + v) * 6144 + j];
    mod[i] = a;
}

__device__ __forceinline__ void transpose_item(const float* __restrict__ W, int N, int k0, int n0, bf16_t* dst, int K, float scale, LAS float* scr, int lane) {
#pragma unroll 8
    for (int i = 0; i < 32; ++i) { const int kk = 2 * i + (lane >> 5); scr[kk * 33 + (lane & 31)] = W[(size_t)(k0 + kk) * N + n0 + (lane & 31)]; }
    asm volatile("s_waitcnt lgkmcnt(0)" ::: "memory");
    const int c = lane & 7;
#pragma unroll
    for (int j = 0; j < 4; ++j) { const int n = (lane >> 3) + 8 * j; const LAS float* s = scr + (8 * c) * 33 + n;
        u32x4 o; o.x = pk2(s[0 * 33] * scale, s[1 * 33] * scale); o.y = pk2(s[2 * 33] * scale, s[3 * 33] * scale); o.z = pk2(s[4 * 33] * scale, s[5 * 33] * scale); o.w = pk2(s[6 * 33] * scale, s[7 * 33] * scale);
        *(u32x4*)(dst + (size_t)n * K + k0 + 8 * c) = o; }
    asm volatile("s_waitcnt lgkmcnt(0)" ::: "memory");
}
struct PrepArgs { const float *x, *ctx, *g_pre, *mod, *w_in, *w_out, *w_gate, *w_up, *w_down; bf16_t *WTIN, *WTV, *WTOUT, *WTGU, *WTDN, *H; };
constexpr int IT_IN = 16 * 97, IT_OUT = 16 * 32, IT_GU1 = 16 * 16 * 88, IT_DN = 16 * 44 * 32, IT_ALL = IT_IN + IT_OUT + 2 * IT_GU1 + IT_DN;
__global__ void __launch_bounds__(512) k_prep(PrepArgs a) {
    extern __shared__ __attribute__((aligned(16))) unsigned char lds_raw[];
    const int tid = threadIdx.x, lane = tid & 63, wave = tid >> 6;
    LAS float* scr = (LAS float*)((LAS unsigned char*)lds_raw + wave * 8448);
    const int gw = blockIdx.x * 8 + wave, NGW = gridDim.x * 8;
    { u32x4* z = (u32x4*)(a.WTIN + (size_t)(PC_AD + 32) * DM); const int nz = (PROJ_LD - PC_AD - 32) * DM * 2 / 16;
      for (int i = blockIdx.x * 512 + tid; i < nz; i += gridDim.x * 512) z[i] = (u32x4){0u, 0u, 0u, 0u}; }
    for (int m = gw; m < M_ALL; m += NGW) {
        const float* src; int v;
        if (m < M_LAT) { src = a.x + (size_t)m * DM; v = m / SEQ; } else { src = a.ctx + (size_t)(m - M_LAT) * DM; v = 4; }
        const f32x4* xr = (const f32x4*)src + lane; f32x4 xv[4]; float ss = 0.f;
#pragma unroll
        for (int j = 0; j < 4; ++j) { xv[j] = xr[64 * j]; ss += (xv[j].x * xv[j].x + xv[j].y * xv[j].y) + (xv[j].z * xv[j].z + xv[j].w * xv[j].w); }
        const float rstd = rsqrtf(wave_sum(ss) * (1.f / DM) + EPS);
        const float* mv = a.mod + (size_t)v * 6144;
        unsigned long long* o8 = (unsigned long long*)(a.H + (size_t)m * DM) + lane;
#pragma unroll
        for (int j = 0; j < 4; ++j) { const int col = 4 * lane + 256 * j;
            const f32x4 g = *(const f32x4*)(a.g_pre + col), sh = *(const f32x4*)(mv + col), sc = *(const f32x4*)(mv + 1024 + col);
            const f32x4 hv = xv[j] * rstd * g * (sc + 1.f) + sh;
            o8[64 * j] = (unsigned long long)pk2(hv.x, hv.y) | ((unsigned long long)pk2(hv.z, hv.w) << 32); }
    }
    for (int it = gw; it < IT_ALL; it += NGW) {
        int r = it;
        if (r < IT_IN) { const int kb = r / 97, n0 = (r % 97) * 32; bf16_t* dst; float sc = 1.f;
            if (n0 < 512) dst = a.WTIN + (size_t)(PC_NAK + n0) * DM;
            else if (n0 < 1024) dst = a.WTV + (size_t)(n0 - 512) * DM;
            else if (n0 < 1280) dst = a.WTIN + (size_t)(PC_GK + n0 - 1024) * DM;
            else if (n0 < 1792) dst = a.WTV + (size_t)(512 + n0 - 1280) * DM;
            else if (n0 < 1824) dst = a.WTIN + (size_t)(PC_AD + n0 - 1792) * DM;
            else if (n0 < 2336) { dst = a.WTIN + (size_t)(PC_NAQ + n0 - 1824) * DM; sc = 0.125f; }
            else if (n0 < 2592) { dst = a.WTIN + (size_t)(PC_GQ + n0 - 2336) * DM; sc = 0.125f; }
            else dst = a.WTIN + (size_t)(PC_GG + n0 - 2592) * DM;
            transpose_item(a.w_in, IN_COLS, kb * 64, n0, dst, DM, sc, scr, lane); continue; }
        r -= IT_IN;
        if (r < IT_OUT) { const int kb = r / 32, n0 = (r % 32) * 32; transpose_item(a.w_out, DM, kb * 64, n0, a.WTOUT + (size_t)n0 * DM, DM, 1.f, scr, lane); continue; }
        r -= IT_OUT;
        if (r < 2 * IT_GU1) { const int which = r / IT_GU1; r %= IT_GU1; const int e = r / (16 * 88); r %= (16 * 88); const int kb = r / 88, n0 = (r % 88) * 32;
            const float* W = (which ? a.w_up : a.w_gate) + (size_t)e * DM * DE;
            bf16_t* dst = a.WTGU + ((size_t)e * 2 * DE + (n0 / 128) * 256 + (n0 % 128) + which * 128) * DM;
            transpose_item(W, DE, kb * 64, n0, dst, DM, 1.f, scr, lane); continue; }
        r -= 2 * IT_GU1;
        { const int e = r / (44 * 32); r %= (44 * 32); const int kb = r / 32, n0 = (r % 32) * 32;
          transpose_item(a.w_down + (size_t)e * DE * DM, DM, kb * 64, n0, a.WTDN + ((size_t)e * DM + n0) * DE, DE, 1.f, scr, lane); }
    }
}

struct EpiSwiGLU {
    static constexpr bool PERM = true, AFTER_DRAIN = false;
    bf16_t* O; int ldc;
    __device__ __forceinline__ void operator()(const f32x4 (&acc)[2][2][4][2], const pg8::Unit& u, int wr, int wc, int fr, int fq) const {
        const int row0 = u.pm * 256 + wr * 64 + fr, col0 = u.pn * 128 + wc * 32 + 8 * fq;
#pragma unroll
        for (int ai = 0; ai < 2; ++ai)
#pragma unroll
            for (int m = 0; m < 4; ++m) { bf16_t* rowp = O + (size_t)(row0 + ai * 128 + m * 16) * ldc + col0;
                const f32x4 g0 = acc[ai][0][m][0], g1 = acc[ai][0][m][1], u0 = acc[ai][1][m][0], u1 = acc[ai][1][m][1];
                u32x4 w; w.x = pg8::cvt_pk_bf16(silu_f(g0[0]) * u0[0], silu_f(g0[1]) * u0[1]); w.y = pg8::cvt_pk_bf16(silu_f(g0[2]) * u0[2], silu_f(g0[3]) * u0[3]);
                w.z = pg8::cvt_pk_bf16(silu_f(g1[0]) * u1[0], silu_f(g1[1]) * u1[1]); w.w = pg8::cvt_pk_bf16(silu_f(g1[2]) * u1[2], silu_f(g1[3]) * u1[3]);
                *(u32x4*)rowp = w; }
    }
};
struct EpiRowScale {
    static constexpr bool PERM = true, AFTER_DRAIN = false;
    bf16_t* O; int ldc; const float* rowscale;
    __device__ __forceinline__ void operator()(const f32x4 (&acc)[2][2][4][2], const pg8::Unit& u, int wr, int wc, int fr, int fq) const {
        const int row0 = u.pm * 256 + wr * 64 + fr, col0 = u.pn * 256 + wc * 32 + 8 * fq;
#pragma unroll
        for (int ai = 0; ai < 2; ++ai)
#pragma unroll
            for (int m = 0; m < 4; ++m) { const int row = row0 + ai * 128 + m * 16; const float sc = rowscale[row]; bf16_t* rowp = O + (size_t)row * ldc + col0;
#pragma unroll
                for (int bj = 0; bj < 2; ++bj) { const f32x4 v0 = acc[ai][bj][m][0] * sc, v1 = acc[ai][bj][m][1] * sc;
                    u32x4 w; w.x = pg8::cvt_pk_bf16(v0[0], v0[1]); w.y = pg8::cvt_pk_bf16(v0[2], v0[3]); w.z = pg8::cvt_pk_bf16(v1[0], v1[1]); w.w = pg8::cvt_pk_bf16(v1[2], v1[3]);
                    *(u32x4*)(rowp + bj * 128) = w; } }
    }
};
struct ExpertOrder {
    int nT, G, c;
    __device__ __forceinline__ bool next(int i, pg8::Unit& u) const {
        if (G == 256) { if (2 * i >= nT) return false; const int x = c & 7, j = c >> 3, e = 2 * x + (j >> 4), mt = j & 7, pn = 2 * i + ((j >> 3) & 1);
            u.pm = e * 8 + mt; u.pn = pn; u.bt = e * nT + pn; return true; }
        const long L = (long)i * G + c; if (L >= (long)128 * nT) return false;
        const int e = (int)(L / (8 * nT)), r = (int)(L % (8 * nT)); u.pm = e * 8 + (r % 8); u.pn = r / 8; u.bt = e * nT + u.pn; return true;
    }
    __device__ __forceinline__ void a_ready(const pg8::Unit&) const {}
    __device__ __forceinline__ void done(const pg8::Unit&) const {}
};
template <class Epi> __global__ void __launch_bounds__(512, 2) k_gemm_static(pg8::Gemm g, Epi E) {
    extern __shared__ __attribute__((aligned(16))) unsigned char lds_raw[];
    pg8::StaticOrder S; S.init(g.M, g.N, (int)gridDim.x, (int)blockIdx.x);
    pg8::gemm_phase<Epi, pg8::StaticOrder, true, true>((PG8_LAS unsigned char*)lds_raw, g, S, E);
}
template <class Epi> __global__ void __launch_bounds__(512, 2) k_gemm_expert(pg8::Gemm g, int nT, Epi E) {
    extern __shared__ __attribute__((aligned(16))) unsigned char lds_raw[];
    ExpertOrder S; S.nT = nT; S.G = (int)gridDim.x; S.c = (int)blockIdx.x;
    pg8::gemm_phase<Epi, ExpertOrder, true, true>((PG8_LAS unsigned char*)lds_raw, g, S, E);
}

__global__ void __launch_bounds__(64) k_na_naive(const bf16_t* __restrict__ PROJ, const bf16_t* __restrict__ VT, const float* __restrict__ rpb, bf16_t* __restrict__ OMIX) {
    const int bid = blockIdx.x, r = bid % 64, h = (bid / 64) % 8, b = bid / 512, c = threadIdx.x;
    const size_t mq = (size_t)b * SEQ + r * 64 + c;
    float q[64], acc[64];
    { const u32x4* qp = (const u32x4*)(PROJ + mq * PROJ_LD + PC_NAQ + h * 64);
#pragma unroll
      for (int i = 0; i < 8; ++i) { const u32x4 w = qp[i]; q[8 * i + 0] = __uint_as_float(w.x << 16); q[8 * i + 1] = __uint_as_float(w.x & 0xffff0000u); q[8 * i + 2] = __uint_as_float(w.y << 16); q[8 * i + 3] = __uint_as_float(w.y & 0xffff0000u);
          q[8 * i + 4] = __uint_as_float(w.z << 16); q[8 * i + 5] = __uint_as_float(w.z & 0xffff0000u); q[8 * i + 6] = __uint_as_float(w.w << 16); q[8 * i + 7] = __uint_as_float(w.w & 0xffff0000u); } }
#pragma unroll
    for (int d = 0; d < 64; ++d) acc[d] = 0.f;
    float mx = -INFINITY, l = 0.f;
    const int rs = min(max(r - 4, 0), 56), cs = min(max(c - 8, 0), 48);
    for (int kk = 0; kk < 128 + CTXL; ++kk) {
        size_t mk; float bias = 0.f;
        if (kk < 128) { const int krow = rs + (kk >> 4), kcol = cs + (kk & 15); mk = (size_t)b * SEQ + krow * 64 + kcol; bias = rpb[(h * 15 + (krow - r + 7)) * 31 + (kcol - c + 15)]; }
        else mk = (size_t)M_LAT + b * CTXL + (kk - 128);
        const u32x4* kp = (const u32x4*)(PROJ + mk * PROJ_LD + PC_NAK + h * 64);
        float s = 0.f;
#pragma unroll
        for (int i = 0; i < 8; ++i) { const u32x4 w = kp[i];
            s += q[8 * i + 0] * __uint_as_float(w.x << 16) + q[8 * i + 1] * __uint_as_float(w.x & 0xffff0000u) + q[8 * i + 2] * __uint_as_float(w.y << 16) + q[8 * i + 3] * __uint_as_float(w.y & 0xffff0000u)
               + q[8 * i + 4] * __uint_as_float(w.z << 16) + q[8 * i + 5] * __uint_as_float(w.z & 0xffff0000u) + q[8 * i + 6] * __uint_as_float(w.w << 16) + q[8 * i + 7] * __uint_as_float(w.w & 0xffff0000u); }
        s += bias;
        const float mn = fmaxf(mx, s), al = __expf(mx - mn), p = __expf(s - mn);
        l = l * al + p; mx = mn;
        const bf16_t* vp = VT + (size_t)(h * 64) * VT_LD + mk;
#pragma unroll
        for (int d = 0; d < 64; ++d) acc[d] = acc[d] * al + p * bf2f(vp[(size_t)d * VT_LD]);
    }
    const float inv = 1.f / l;
    unsigned* op = (unsigned*)(OMIX + mq * DM + h * 64);
#pragma unroll
    for (int i = 0; i < 32; ++i) op[i] = pk2(acc[2 * i] * inv, acc[2 * i + 1] * inv);
}

__global__ void __launch_bounds__(256) k_gla_prep(const bf16_t* __restrict__ PROJ, const float* __restrict__ a_up, const float* __restrict__ a_bias, float* __restrict__ qr, float* __restrict__ kr, float* __restrict__ laf, float* __restrict__ lab) {
    const int m = blockIdx.x, j = threadIdx.x, d = j & 63;
    const bf16_t* row = PROJ + (size_t)m * PROJ_LD;
    float kv = bf2f(row[PC_GK + j]);
    if (m < M_LAT) {
        const int t = m % SEQ, pr = t / 64, pc = t % 64;
        const int seg = d >> 5, dd = d & 31, i = dd & 15; const float pos = (float)(seg ? pc : pr);
        const float ang = pos * powf(10000.f, -(float)i / 16.f), cs = cosf(ang), sn = sinf(ang);
        const float qv = bf2f(row[PC_GQ + j]);
        const int jp = (dd < 16) ? j + 16 : j - 16;
        const float kp = bf2f(row[PC_GK + jp]), qp = bf2f(row[PC_GQ + jp]);
        float ko, qo;
        if (dd < 16) { ko = kv * cs - kp * sn; qo = qv * cs - qp * sn; } else { ko = kp * sn + kv * cs; qo = qp * sn + qv * cs; }
        kv = ko; qr[(size_t)m * 256 + j] = qo;
    }
    kr[(size_t)m * 256 + j] = kv;
    float zf = a_bias[j], zb = a_bias[256 + j];
#pragma unroll
    for (int r = 0; r < 16; ++r) { zf += bf2f(row[PC_AD + r]) * a_up[r * 256 + j]; zb += bf2f(row[PC_AD + 16 + r]) * a_up[(16 + r) * 256 + j]; }
    laf[(size_t)m * 256 + j] = (fminf(zf, 0.f) - log1pf(expf(-fabsf(zf)))) * (1.f / 16.f);
    lab[(size_t)m * 256 + j] = (fminf(zb, 0.f) - log1pf(expf(-fabsf(zb)))) * (1.f / 16.f);
}
__global__ void __launch_bounds__(512) k_gla_scan(const float* __restrict__ qr, const float* __restrict__ kr, const float* __restrict__ laf, const float* __restrict__ lab, const bf16_t* __restrict__ VT, float* __restrict__ of) {
    const int bid = blockIdx.x, es = bid & 7, dir = (bid >> 3) & 1, h = (bid >> 4) & 3, b = bid >> 6;
    const int lane = threadIdx.x & 63, w = threadIdx.x >> 6, e0 = es * 16 + 2 * w;
    const float* la = dir ? lab : laf;
    const bf16_t* v0p = VT + (size_t)(512 + h * 128 + e0) * VT_LD; const bf16_t* v1p = v0p + VT_LD;
    float S0 = 0.f, S1 = 0.f;
    for (int s = 0; s < CTXL; ++s) { const int jj = dir ? (CTXL - 1 - s) : s; const size_t m = (size_t)M_LAT + b * CTXL + jj;
        const float a = __expf(la[m * 256 + h * 64 + lane]), k = kr[m * 256 + h * 64 + lane];
        S0 = a * S0 + k * bf2f(v0p[m]); S1 = a * S1 + k * bf2f(v1p[m]); }
#pragma unroll 4
    for (int s = 0; s < SEQ; ++s) { const int t = dir ? (SEQ - 1 - s) : s; const size_t m = (size_t)b * SEQ + t;
        const float a = __expf(la[m * 256 + h * 64 + lane]), k = kr[m * 256 + h * 64 + lane], q = qr[m * 256 + h * 64 + lane];
        S0 = a * S0 + k * bf2f(v0p[m]); S1 = a * S1 + k * bf2f(v1p[m]);
        const float o0 = wave_sum(q * S0), o1 = wave_sum(q * S1);
        if (lane == 0) { float* o = of + ((size_t)dir * M_LAT + m) * 512 + h * 128 + e0; o[0] = o0; o[1] = o1; } }
}
__global__ void __launch_bounds__(256) k_gla_merge(const float* __restrict__ of, const bf16_t* __restrict__ PROJ, const float* __restrict__ gnorm, bf16_t* __restrict__ OMIX) {
    const int lane = threadIdx.x & 63, gwv = blockIdx.x * 4 + (threadIdx.x >> 6), m = gwv >> 2, h = gwv & 3;
    float o[2]; float ss = 0.f;
#pragma unroll
    for (int i = 0; i < 2; ++i) { const int e = lane + 64 * i; o[i] = of[(size_t)m * 512 + h * 128 + e] + of[((size_t)M_LAT + m) * 512 + h * 128 + e]; ss += o[i] * o[i]; }
    const float rstd = rsqrtf(wave_sum(ss) * (1.f / 128.f) + EPS);
#pragma unroll
    for (int i = 0; i < 2; ++i) { const int e = lane + 64 * i; const float g = bf2f(PROJ[(size_t)m * PROJ_LD + PC_GG + h * 128 + e]);
        OMIX[(size_t)m * DM + 512 + h * 128 + e] = (bf16_t)f2bf(o[i] * rstd * gnorm[e] * silu_f(g)); }
}

__global__ void __launch_bounds__(512) k_post_mix(const float* __restrict__ x, const bf16_t* __restrict__ MIX, const float* __restrict__ mod, const float* __restrict__ g_post, const float* __restrict__ g_fpre, const float* __restrict__ router,
                                                  float* __restrict__ xnew, bf16_t* __restrict__ HF, float* __restrict__ aff) {
    __shared__ float rt[DM * NE];
    for (int i = threadIdx.x; i < DM * NE; i += 512) rt[(i % NE) * DM + (i / NE)] = router[i];
    __syncthreads();
    const int lane = threadIdx.x & 63, wave = threadIdx.x >> 6;
    for (int m = blockIdx.x * 8 + wave; m < M_LAT; m += gridDim.x * 8) {
        const int b = m / SEQ, t = m % SEQ; const float* mv = mod + (size_t)b * 6144;
        f32x4 mx[4]; float ss = 0.f;
        const unsigned long long* mp = (const unsigned long long*)(MIX + (size_t)m * DM) + lane;
#pragma unroll
        for (int j = 0; j < 4; ++j) { const unsigned long long w = mp[64 * j]; const unsigned lo = (unsigned)w, hi = (unsigned)(w >> 32);
            mx[j] = (f32x4){__uint_as_float(lo << 16), __uint_as_float(lo & 0xffff0000u), __uint_as_float(hi << 16), __uint_as_float(hi & 0xffff0000u)};
            ss += (mx[j].x * mx[j].x + mx[j].y * mx[j].y) + (mx[j].z * mx[j].z + mx[j].w * mx[j].w); }
        const float rstd = rsqrtf(wave_sum(ss) * (1.f / DM) + EPS);
        f32x4 xn[4]; float s2 = 0.f;
#pragma unroll
        for (int j = 0; j < 4; ++j) { const int col = 4 * lane + 256 * j;
            const f32x4 xv = *(const f32x4*)(x + (size_t)m * DM + col), gp = *(const f32x4*)(g_post + col), gm = *(const f32x4*)(mv + 2048 + col);
            xn[j] = xv + gm * (mx[j] * rstd * gp);
            *(f32x4*)(xnew + (size_t)m * DM + col) = xn[j];
            s2 += (xn[j].x * xn[j].x + xn[j].y * xn[j].y) + (xn[j].z * xn[j].z + xn[j].w * xn[j].w); }
        const float rstd2 = rsqrtf(wave_sum(s2) * (1.f / DM) + EPS);
        f32x4 hv4[4];
        unsigned long long* hp = (unsigned long long*)(HF + (size_t)m * DM) + lane;
#pragma unroll
        for (int j = 0; j < 4; ++j) { const int col = 4 * lane + 256 * j;
            const f32x4 gf = *(const f32x4*)(g_fpre + col), sh = *(const f32x4*)(mv + 3072 + col), sc = *(const f32x4*)(mv + 4096 + col);
            hv4[j] = xn[j] * rstd2 * gf * (sc + 1.f) + sh;
            hp[64 * j] = (unsigned long long)pk2(hv4[j].x, hv4[j].y) | ((unsigned long long)pk2(hv4[j].z, hv4[j].w) << 32); }
        float lg[NE]; float mxl = -INFINITY;
#pragma unroll
        for (int e = 0; e < NE; ++e) { float sacc = 0.f;
#pragma unroll
            for (int j = 0; j < 4; ++j) { const f32x4 rv = *(const f32x4*)(rt + e * DM + 4 * lane + 256 * j); sacc += (hv4[j].x * rv.x + hv4[j].y * rv.y) + (hv4[j].z * rv.z + hv4[j].w * rv.w); }
            lg[e] = wave_sum(sacc); mxl = fmaxf(mxl, lg[e]); asm volatile("" ::: "memory"); }
        float den = 0.f;
#pragma unroll
        for (int e = 0; e < NE; ++e) { lg[e] = expf(lg[e] - mxl); den += lg[e]; }
        const float rden = 1.f / den;
#pragma unroll
        for (int e = 0; e < NE; ++e) if (lane == e) aff[((size_t)b * NE + e) * SEQ + t] = lg[e] * rden;
    }
}

__device__ __forceinline__ int block_excl_scan(int v, int* sm  , int& total) {
    const int lane = threadIdx.x & 63, w = threadIdx.x >> 6; int x = v;
#pragma unroll
    for (int o = 1; o < 64; o <<= 1) { const int y = __shfl_up(x, o); if (lane >= o) x += y; }
    __syncthreads();
    if (lane == 63) sm[w] = x;
    __syncthreads();
    int base = 0, tot = 0;
#pragma unroll
    for (int i = 0; i < 8; ++i) { const int s = sm[i]; if (i < w) base += s; tot += s; }
    total = tot;
    return base + x - v;
}
__global__ void __launch_bounds__(512) k_topk(const float* __restrict__ aff, const bf16_t* __restrict__ HF, int* __restrict__ idx, float* __restrict__ gate, int* __restrict__ inv, bf16_t* __restrict__ XS) {
    __shared__ int hist[256]; __shared__ int sm[16]; __shared__ unsigned s_prefix; __shared__ int s_remain; __shared__ int s_list[CAP];
    const int be = blockIdx.x, b = be / NE, e = be % NE, tid = threadIdx.x;
    const float* av = aff + ((size_t)b * NE + e) * SEQ;
    unsigned key[8];
#pragma unroll
    for (int j = 0; j < 8; ++j) key[j] = __float_as_uint(av[tid * 8 + j]);
    if (tid == 0) { s_prefix = 0u; s_remain = CAP; }
    for (int pass = 3; pass >= 0; --pass) {
        if (tid < 256) hist[tid] = 0;
        __syncthreads();
        const unsigned prefix = s_prefix; const int shift = pass * 8; const unsigned himask = pass == 3 ? 0u : (0xffffffffu << (shift + 8));
#pragma unroll
        for (int j = 0; j < 8; ++j) if ((key[j] & himask) == prefix) atomicAdd(&hist[(key[j] >> shift) & 255u], 1);
        __syncthreads();
        if (tid == 0) { int rem = s_remain, bin = 255; for (; bin > 0; --bin) { const int cnt = hist[bin]; if (cnt >= rem) break; rem -= cnt; } s_remain = rem; s_prefix = prefix | ((unsigned)bin << shift); }
        __syncthreads();
    }
    const unsigned T = s_prefix; const int remain = s_remain;
    int neq = 0;
#pragma unroll
    for (int j = 0; j < 8; ++j) neq += (key[j] == T);
    int tot; int eqbase = block_excl_scan(neq, sm, tot);
    int flags = 0, nsel = 0;
#pragma unroll
    for (int j = 0; j < 8; ++j) { bool sel = key[j] > T; if (key[j] == T) { sel = eqbase < remain; ++eqbase; } if (sel) { flags |= 1 << j; ++nsel; } }
    int slot = block_excl_scan(nsel, sm, tot);
    const int rowbase = (e * NB + b) * CAP;
#pragma unroll
    for (int j = 0; j < 8; ++j) { const int t = tid * 8 + j; int sl = -1;
        if (flags & (1 << j)) { sl = slot++; idx[rowbase + sl] = t; gate[rowbase + sl] = __uint_as_float(key[j]); s_list[sl] = t; }
        inv[((size_t)b * SEQ + t) * NE + e] = sl; }
    __syncthreads();
    const int lane = tid & 63, wave = tid >> 6;
    for (int s = wave; s < CAP; s += 8) { const u32x4* src = (const u32x4*)(HF + ((size_t)b * SEQ + s_list[s]) * DM); u32x4* dst = (u32x4*)(XS + (size_t)(rowbase + s) * DM);
        dst[lane] = src[lane]; dst[lane + 64] = src[lane + 64]; }
}

__global__ void __launch_bounds__(512) k_combine(const bf16_t* __restrict__ Y, const int* __restrict__ inv, const float* __restrict__ mod, const float* __restrict__ g_fpost, float* __restrict__ out) {
    const int lane = threadIdx.x & 63, wave = threadIdx.x >> 6;
    for (int m = blockIdx.x * 8 + wave; m < M_LAT; m += gridDim.x * 8) {
        const int b = m / SEQ; const float* mv = mod + (size_t)b * 6144;
        f32x4 y[4];
#pragma unroll
        for (int j = 0; j < 4; ++j) y[j] = (f32x4){0.f, 0.f, 0.f, 0.f};
        for (int e = 0; e < NE; ++e) { const int sl = inv[(size_t)m * NE + e]; if (sl < 0) continue;
            const unsigned long long* yp = (const unsigned long long*)(Y + (size_t)((e * NB + b) * CAP + sl) * DM) + lane;
#pragma unroll
            for (int j = 0; j < 4; ++j) { const unsigned long long w = yp[64 * j]; const unsigned lo = (unsigned)w, hi = (unsigned)(w >> 32);
                y[j] += (f32x4){__uint_as_float(lo << 16), __uint_as_float(lo & 0xffff0000u), __uint_as_float(hi << 16), __uint_as_float(hi & 0xffff0000u)}; } }
        float ss = 0.f;
#pragma unroll
        for (int j = 0; j < 4; ++j) ss += (y[j].x * y[j].x + y[j].y * y[j].y) + (y[j].z * y[j].z + y[j].w * y[j].w);
        const float rstd = rsqrtf(wave_sum(ss) * (1.f / DM) + EPS);
#pragma unroll
        for (int j = 0; j < 4; ++j) { const int col = 4 * lane + 256 * j; float* op = out + (size_t)m * DM + col;
            const f32x4 xn = *(const f32x4*)op, gp = *(const f32x4*)(g_fpost + col), gf = *(const f32x4*)(mv + 5120 + col);
            *(f32x4*)op = xn + gf * (y[j] * rstd * gp); }
    }
}
}

extern "C" void kernel_launch(void* const* d_in, const int* in_sizes, int n_in, void* d_out, int out_size, void* d_ws, size_t ws_size, hipStream_t stream) {
    using namespace hy;
    static int ok = 0;
    if (ok == 0) {
        if (n_in != 20 || in_sizes[0] != M_LAT * DM || out_size != M_LAT * DM || ws_size < WS_END) { fprintf(stderr, "kernel_launch: unexpected shapes / workspace (n_in %d, ws %zu)\n", n_in, ws_size); ok = -1; return; }
        hipFuncSetAttribute((const void*)k_prep, hipFuncAttributeMaxDynamicSharedMemorySize, 8 * 8448);
        hipFuncSetAttribute((const void*)k_gemm_static<pg8::EpiBf16<0>>, hipFuncAttributeMaxDynamicSharedMemorySize, pg8::STAGE_BYTES);
        hipFuncSetAttribute((const void*)k_gemm_expert<EpiSwiGLU>, hipFuncAttributeMaxDynamicSharedMemorySize, pg8::STAGE_BYTES);
        hipFuncSetAttribute((const void*)k_gemm_expert<EpiRowScale>, hipFuncAttributeMaxDynamicSharedMemorySize, pg8::STAGE_BYTES);
        ok = 1;
    }
    if (ok < 0) return;
    const float* x = (const float*)d_in[0]; const float* c = (const float*)d_in[1]; const float* ctx = (const float*)d_in[2]; const float* c_ctx = (const float*)d_in[3];
    const float* w_mod = (const float*)d_in[4]; const float* b_mod = (const float*)d_in[5]; const float* g_pre = (const float*)d_in[6]; const float* g_post = (const float*)d_in[7];
    const float* g_fpre = (const float*)d_in[8]; const float* g_fpost = (const float*)d_in[9]; const float* w_in = (const float*)d_in[10]; const float* rpb = (const float*)d_in[11];
    const float* a_up = (const float*)d_in[12]; const float* a_bias = (const float*)d_in[13]; const float* gnorm = (const float*)d_in[14]; const float* w_out = (const float*)d_in[15];
    const float* router = (const float*)d_in[16]; const float* w_gate = (const float*)d_in[17]; const float* w_up = (const float*)d_in[18]; const float* w_down = (const float*)d_in[19];
    unsigned char* ws = (unsigned char*)d_ws; float* out = (float*)d_out;
    float* modp = (float*)(ws + WS_MODP); float* mod = (float*)(ws + WS_MOD);
    bf16_t* WTIN = (bf16_t*)(ws + WS_WTIN); bf16_t* WTV = (bf16_t*)(ws + WS_WTV); bf16_t* WTOUT = (bf16_t*)(ws + WS_WTOUT); bf16_t* WTGU = (bf16_t*)(ws + WS_WTGU); bf16_t* WTDN = (bf16_t*)(ws + WS_WTDN);
    bf16_t* H = (bf16_t*)(ws + WS_H); bf16_t* PROJ = (bf16_t*)(ws + WS_PROJ); bf16_t* VT = (bf16_t*)(ws + WS_VT); bf16_t* OMIX = (bf16_t*)(ws + WS_OMIX); bf16_t* MIX = (bf16_t*)(ws + WS_MIX);
    bf16_t* HID = (bf16_t*)(ws + WS_HID); bf16_t* HF = (bf16_t*)(ws + WS_HF); bf16_t* XS = (bf16_t*)(ws + WS_XS); bf16_t* Y = XS;
    float* aff = (float*)(ws + WS_AFF); int* idx = (int*)(ws + WS_IDX); float* gate = (float*)(ws + WS_GATE); int* inv = (int*)(ws + WS_INV);
    float* qr = (float*)(ws + WS_GLAT); float* kr = qr + (size_t)M_ALL * 256; float* laf = kr + (size_t)M_ALL * 256; float* lab = laf + (size_t)M_ALL * 256;
    const int G = 256;
    hipLaunchKernelGGL(k_mod_partial, dim3(24, 16), dim3(256), 0, stream, c, c_ctx, w_mod, modp);
    hipLaunchKernelGGL(k_mod_final, dim3(120), dim3(256), 0, stream, modp, b_mod, mod);
    { PrepArgs a{}; a.x = x; a.ctx = ctx; a.g_pre = g_pre; a.mod = mod; a.w_in = w_in; a.w_out = w_out; a.w_gate = w_gate; a.w_up = w_up; a.w_down = w_down;
      a.WTIN = WTIN; a.WTV = WTV; a.WTOUT = WTOUT; a.WTGU = WTGU; a.WTDN = WTDN; a.H = H;
      hipLaunchKernelGGL(k_prep, dim3(G), dim3(512), 8 * 8448, stream, a); }
    { pg8::Gemm g{}; g.A = H; g.Bt = WTIN; g.M = M_ALL; g.N = PROJ_LD; g.K = DM; pg8::EpiBf16<0> E{}; E.O = PROJ; E.ldc = PROJ_LD; E.bias = nullptr; E.split_cols = 0; E.split_stride = 0; E.scale0 = 1.f;
      hipLaunchKernelGGL(k_gemm_static<pg8::EpiBf16<0>>, dim3(G), dim3(512), pg8::STAGE_BYTES, stream, g, E); }
    { pg8::Gemm g{}; g.A = WTV; g.Bt = H; g.M = 1024; g.N = M_ALL; g.K = DM; pg8::EpiBf16<0> E{}; E.O = VT; E.ldc = VT_LD; E.bias = nullptr; E.split_cols = 0; E.split_stride = 0; E.scale0 = 1.f;
      hipLaunchKernelGGL(k_gemm_static<pg8::EpiBf16<0>>, dim3(G), dim3(512), pg8::STAGE_BYTES, stream, g, E); }
    hipLaunchKernelGGL(k_na_naive, dim3(NB * 8 * 64), dim3(64), 0, stream, PROJ, VT, rpb, OMIX);
    hipLaunchKernelGGL(k_gla_prep, dim3(M_ALL), dim3(256), 0, stream, PROJ, a_up, a_bias, qr, kr, laf, lab);
    hipLaunchKernelGGL(k_gla_scan, dim3(NB * 4 * 2 * 8), dim3(512), 0, stream, qr, kr, laf, lab, VT, out  );
    hipLaunchKernelGGL(k_gla_merge, dim3(M_LAT), dim3(256), 0, stream, out, PROJ, gnorm, OMIX);
    { pg8::Gemm g{}; g.A = OMIX; g.Bt = WTOUT; g.M = M_LAT; g.N = DM; g.K = DM; pg8::EpiBf16<0> E{}; E.O = MIX; E.ldc = DM; E.bias = nullptr; E.split_cols = 0; E.split_stride = 0; E.scale0 = 1.f;
      hipLaunchKernelGGL(k_gemm_static<pg8::EpiBf16<0>>, dim3(G), dim3(512), pg8::STAGE_BYTES, stream, g, E); }
    hipLaunchKernelGGL(k_post_mix, dim3(G), dim3(512), 0, stream, x, MIX, mod, g_post, g_fpre, router, out, HF, aff);
    hipLaunchKernelGGL(k_topk, dim3(NB * NE), dim3(512), 0, stream, aff, HF, idx, gate, inv, XS);
    { pg8::Gemm g{}; g.A = XS; g.Bt = WTGU; g.M = NSLOT; g.N = 2 * DE; g.K = DM; EpiSwiGLU E{}; E.O = HID; E.ldc = DE;
      hipLaunchKernelGGL(k_gemm_expert<EpiSwiGLU>, dim3(G), dim3(512), pg8::STAGE_BYTES, stream, g, 22, E); }
    { pg8::Gemm g{}; g.A = HID; g.Bt = WTDN; g.M = NSLOT; g.N = DM; g.K = DE; EpiRowScale E{}; E.O = Y; E.ldc = DM; E.rowscale = gate;
      hipLaunchKernelGGL(k_gemm_expert<EpiRowScale>, dim3(G), dim3(512), pg8::STAGE_BYTES, stream, g, 4, E); }
    hipLaunchKernelGGL(k_combine, dim3(G), dim3(512), 0, stream, Y, inv, mod, g_fpost, out);
}
```

```cpp
#include <hip/hip_runtime.h>
#include <hip/hip_cooperative_groups.h>
#include <cstdio>
#include <cstdint>
namespace pg8 {
#define PG8_LAS __attribute__((address_space(3)))
typedef unsigned short bf16_t;
typedef short bf16x8 __attribute__((ext_vector_type(8)));
typedef float f32x4 __attribute__((ext_vector_type(4)));
typedef unsigned u32x4 __attribute__((ext_vector_type(4)));
constexpr int BM = 256, BK = 64, HALF = 128, HTB = HALF * BK * 2  , STAGE_BYTES = 8 * HTB, NXCD = 8, WGM = 8;

__host__ __device__ __forceinline__ int lds_byte(int r, int c) { const int st = (r >> 4) * 2 + (c >> 5), rr = r & 15, cc = c & 31, ob = rr * 64 + cc * 2; return st * 1024 + (ob ^ (((ob >> 9) & 1) << 5)); }
__host__ __device__ __forceinline__ void stage_rc(int b, int& R, int& C) { const int st = b / 1024, sb = b % 1024, swz = sb ^ (((sb >> 9) & 1) << 5); R = (st >> 1) * 16 + swz / 64; C = (st & 1) * 32 + (swz % 64) / 2; }
__host__ __device__ __forceinline__ int perm32(int rho) { const int n = rho >> 4, i = rho & 15; return 8 * (i >> 2) + 4 * n + (i & 3); }

struct Unit { int pm, pn, bt; };
struct Gemm { const bf16_t* A; const bf16_t* Bt; int M, N, K; };

struct StaticOrder {
    int nM, nN, nwg, G, c;
    __host__ __device__ void init(int M, int N, int G_, int c_) { nM = M / BM; nN = N / BM; nwg = nM * nN; G = G_; c = c_; }
    __host__ __device__ bool next(int i, Unit& u) const {
        const long L = (long)i * G + c; if (L >= nwg) return false;
        int wgid = (int)L; { const int q = nwg / NXCD, r = nwg % NXCD, xcd = wgid % NXCD, off = wgid / NXCD; wgid = (xcd < r ? xcd * (q + 1) : r * (q + 1) + (xcd - r) * q) + off; }
        const int nig = WGM * nN, gid = wgid / nig, fm = gid * WGM, gsz = (nM - fm) < WGM ? (nM - fm) : WGM;
        u.pm = fm + ((wgid % nig) % gsz); u.pn = (wgid % nig) / gsz; u.bt = u.pn; return true;
    }
    __device__ __forceinline__ void a_ready(const Unit&) const {}
    __device__ __forceinline__ void done(const Unit&) const {}
};

__device__ __forceinline__ unsigned cvt_pk_bf16(float lo, float hi) { unsigned r; asm volatile("v_cvt_pk_bf16_f32 %0, %1, %2" : "=v"(r) : "v"(lo), "v"(hi)); return r; }
typedef float f32x2 __attribute__((ext_vector_type(2)));
__device__ __forceinline__ f32x2 gelu_pk(f32x2 v) {
    const f32x2 av = __builtin_elementwise_abs(v), d = av * 0.2316418882f + 1.0f;
    f32x2 t; t.x = __builtin_amdgcn_rcpf(d.x); t.y = __builtin_amdgcn_rcpf(d.y);
    f32x2 q = t * 0.5307027145f + (-0.7265760135f); q = q * t + 0.7107068705f; q = q * t + (-0.142248368f); q = q * t + 0.127414796f; q = q * t;
    const f32x2 s = (v * v) * (-0.72134752044f);
    f32x2 e; e.x = __builtin_amdgcn_exp2f(s.x); e.y = __builtin_amdgcn_exp2f(s.y);
    const f32x2 m = v * (q * e), r = v - m;
    f32x2 o; o.x = v.x < 0.f ? m.x : r.x; o.y = v.y < 0.f ? m.y : r.y; return o;
}

template <int ACT  > struct EpiBf16 {
    static constexpr bool PERM = true, AFTER_DRAIN = false; static_assert(ACT == 0 || ACT == 1, "EpiBf16: ACT is 0 (none) or 1 (gelu_pk)");
    bf16_t* O; int ldc; const float* bias; int split_cols; size_t split_stride; float scale0;
    __device__ __forceinline__ void operator()(const f32x4 (&acc)[2][2][4][2], const Unit& u, int wr, int wc, int fr, int fq) const {
        const int row0 = u.pm * BM + wr * 64 + fr; int colt = u.pn * BM; bf16_t* base = O;
        float sc = 1.f; if (split_cols) { const int t = colt / split_cols; base += (size_t)t * split_stride; colt -= t * split_cols; if (t == 0) sc = scale0; }
        const int col0 = colt + wc * 32 + 8 * fq, bcol0 = u.pn * BM + wc * 32 + 8 * fq;
        f32x4 bv[2][2];
#pragma unroll
        for (int bj = 0; bj < 2; ++bj)
#pragma unroll
            for (int n = 0; n < 2; ++n) bv[bj][n] = bias ? *(const f32x4*)(bias + bcol0 + bj * HALF + 4 * n) : (f32x4){0.f, 0.f, 0.f, 0.f};
#pragma unroll
        for (int ai = 0; ai < 2; ++ai)
#pragma unroll
            for (int m = 0; m < 4; ++m) { bf16_t* rowp = base + (size_t)(row0 + ai * HALF + m * 16) * ldc + col0;
#pragma unroll
                for (int bj = 0; bj < 2; ++bj) { f32x4 v0 = acc[ai][bj][m][0] + bv[bj][0], v1 = acc[ai][bj][m][1] + bv[bj][1];
                    if (ACT == 1) { f32x2 a = gelu_pk((f32x2){v0[0], v0[1]}), b = gelu_pk((f32x2){v0[2], v0[3]}), c = gelu_pk((f32x2){v1[0], v1[1]}), d = gelu_pk((f32x2){v1[2], v1[3]});
                        v0 = (f32x4){a.x, a.y, b.x, b.y}; v1 = (f32x4){c.x, c.y, d.x, d.y}; }
                    v0 = v0 * sc; v1 = v1 * sc; u32x4 w; w.x = cvt_pk_bf16(v0[0], v0[1]); w.y = cvt_pk_bf16(v0[2], v0[3]); w.z = cvt_pk_bf16(v1[0], v1[1]); w.w = cvt_pk_bf16(v1[2], v1[3]);
                    *(u32x4*)(rowp + bj * HALF) = w; } }
    }
};
template <class Epi, class Sched, bool ALIGN_EPI = false, bool SP2 = false>
__device__ __forceinline__ void gemm_phase(PG8_LAS unsigned char* lds, const Gemm g, const Sched& S, const Epi& E) {
    const int tid = threadIdx.x, wid = __builtin_amdgcn_readfirstlane(tid >> 6), lane = tid & 63, wr = wid >> 2, wc = wid & 3, fr = lane & 15, fq = lane >> 4;
    const int K = g.K, nt = K / BK;
    unsigned voffA[2], voffB[2];
#pragma unroll
    for (int i = 0; i < 2; ++i) { int R, C; stage_rc(tid * 16 + i * 8192, R, C); const int Rb = Epi::PERM ? ((R & ~31) + perm32(R & 31)) : R;
        voffA[i] = (unsigned)(R * K + C) * 2u; voffB[i] = (unsigned)(Rb * K + C) * 2u; }
    const size_t kstep = (size_t)(BK * 2);
    const size_t hstep = (size_t)HALF * K * 2;
    const size_t tstep = 2 * hstep;
    const unsigned ldsw = (unsigned)wid * 1024u;
    const int aoff = lds_byte(wr * 64 + fr, fq * 8), boff = lds_byte(wc * 32 + fr, fq * 8);
#define PG8_SA(b, h) (((b) * 2 + (h)) * HTB)
#define PG8_SB(b, h) ((4 + (b) * 2 + (h)) * HTB)
#define PG8_STAGE(bufoff, gbase, voff) do { _Pragma("unroll") for (int _i = 0; _i < 2; ++_i) \
        __builtin_amdgcn_global_load_lds((const unsigned*)((const char*)(gbase) + (voff)[_i]), (PG8_LAS unsigned*)(lds + (bufoff) + ldsw + _i * 8192), 16, 0, 0); } while (0)
#define PG8_LDA(dst, b, h) do { _Pragma("unroll") for (int m = 0; m < 4; ++m) _Pragma("unroll") for (int k = 0; k < 2; ++k) dst[m][k] = *(const PG8_LAS bf16x8*)(lds + PG8_SA(b, h) + aoff + m * 2048 + k * 1024); } while (0)
#define PG8_LDB(dst, b, h) do { _Pragma("unroll") for (int n = 0; n < 2; ++n) _Pragma("unroll") for (int k = 0; k < 2; ++k) dst[n][k] = *(const PG8_LAS bf16x8*)(lds + PG8_SB(b, h) + boff + n * 2048 + k * 1024); } while (0)
#define PG8_MMA(ai, bj, At, Bt) do { __builtin_amdgcn_s_setprio(1); _Pragma("unroll") for (int m = 0; m < 4; ++m) _Pragma("unroll") for (int n = 0; n < 2; ++n) _Pragma("unroll") for (int k = 0; k < 2; ++k) \
        acc[ai][bj][m][n] = __builtin_amdgcn_mfma_f32_16x16x32_bf16(Bt[n][k], At[m][k], acc[ai][bj][m][n], 0, 0, 0); __builtin_amdgcn_s_setprio(0); } while (0)
#define PG8_WAIT_V(n) asm volatile("s_waitcnt vmcnt(" #n ")" ::: "memory")
#define PG8_WAIT_L(n) asm volatile("s_waitcnt lgkmcnt(" #n ")" ::: "memory")
#define PG8_BAR __builtin_amdgcn_s_barrier()
#define PG8_SCHED __builtin_amdgcn_sched_barrier(0)
    Unit cur, nxt; int ui = 0;
    if (!S.next(0, cur)) return;
    f32x4 acc[2][2][4][2];
#pragma unroll
    for (int a = 0; a < 2; ++a)
#pragma unroll
        for (int b = 0; b < 2; ++b)
#pragma unroll
            for (int m = 0; m < 4; ++m)
#pragma unroll
                for (int n = 0; n < 2; ++n) acc[a][b][m][n] = (f32x4){0.f, 0.f, 0.f, 0.f};
    bf16x8 At[4][2], B0[2][2], B1[2][2];
    const char* cA = (const char*)g.A + (size_t)cur.pm * tstep; const char* cB = (const char*)g.Bt + (size_t)cur.bt * tstep;
    S.a_ready(cur);
    if constexpr (SP2) {
        PG8_STAGE(PG8_SB(0, 0), cB, voffB); PG8_STAGE(PG8_SB(0, 1), cB + hstep, voffB); PG8_STAGE(PG8_SA(0, 0), cA, voffA); PG8_STAGE(PG8_SA(0, 1), cA + hstep, voffA);
        if (wr == 1) PG8_BAR;
        PG8_WAIT_V(2); PG8_BAR;
        PG8_STAGE(PG8_SB(1, 0), cB + kstep, voffB); PG8_STAGE(PG8_SA(1, 0), cA + kstep, voffA); PG8_STAGE(PG8_SB(1, 1), cB + hstep + kstep, voffB);
        PG8_WAIT_V(6); PG8_BAR;
    } else {
        PG8_STAGE(PG8_SB(0, 0), cB, voffB); PG8_STAGE(PG8_SA(0, 0), cA, voffA); PG8_STAGE(PG8_SB(0, 1), cB + hstep, voffB); PG8_STAGE(PG8_SA(0, 1), cA + hstep, voffA);
        if (wr == 1) PG8_BAR;
        PG8_WAIT_V(4); PG8_BAR;
        PG8_STAGE(PG8_SB(1, 0), cB + kstep, voffB); PG8_STAGE(PG8_SA(1, 0), cA + kstep, voffA); PG8_STAGE(PG8_SB(1, 1), cB + hstep + kstep, voffB);
        PG8_WAIT_V(6); PG8_BAR;
    }
    for (;;) {
        const bool has_next = S.next(ui + 1, nxt);
        const char* nA = has_next ? (const char*)g.A + (size_t)nxt.pm * tstep : cA; const char* nB = has_next ? (const char*)g.Bt + (size_t)nxt.bt * tstep : cB;
        for (int t = 0; t < nt; t += 2) {
            const bool last = (t == nt - 2);
            const char* a1 = cA + (size_t)(t + 1) * kstep;
            const char* a2 = last ? nA : cA + (size_t)(t + 2) * kstep; const char* b2 = last ? nB : cB + (size_t)(t + 2) * kstep;
            const char* a3 = a2 + kstep; const char* b3 = b2 + kstep;
            if (last && has_next) S.a_ready(nxt);
            if constexpr (SP2) {
            PG8_LDB(B0, 0, 0); PG8_LDB(B1, 0, 1); PG8_SCHED; PG8_LDA(At, 0, 0); PG8_STAGE(PG8_SA(1, 1), a1 + hstep, voffA);
            PG8_WAIT_V(8); PG8_WAIT_L(0); PG8_BAR; PG8_MMA(0, 0, At, B0); PG8_MMA(0, 1, At, B1); PG8_BAR; PG8_SCHED;
            PG8_LDA(At, 0, 1); PG8_STAGE(PG8_SB(0, 0), b2, voffB); PG8_STAGE(PG8_SB(0, 1), b2 + hstep, voffB); PG8_STAGE(PG8_SA(0, 0), a2, voffA);
            PG8_WAIT_V(8); PG8_WAIT_L(0); PG8_BAR; PG8_MMA(1, 0, At, B0); PG8_MMA(1, 1, At, B1); PG8_BAR; PG8_SCHED;
            PG8_LDB(B0, 1, 0); PG8_LDB(B1, 1, 1); PG8_SCHED; PG8_LDA(At, 1, 0); PG8_STAGE(PG8_SA(0, 1), a2 + hstep, voffA);
            PG8_WAIT_V(8); PG8_WAIT_L(0); PG8_BAR; PG8_MMA(0, 0, At, B0); PG8_MMA(0, 1, At, B1); PG8_BAR; PG8_SCHED;
            PG8_LDA(At, 1, 1); PG8_STAGE(PG8_SB(1, 0), b3, voffB); PG8_STAGE(PG8_SB(1, 1), b3 + hstep, voffB); PG8_STAGE(PG8_SA(1, 0), a3, voffA);
            PG8_WAIT_V(8); PG8_WAIT_L(0); PG8_BAR; PG8_MMA(1, 0, At, B0); PG8_MMA(1, 1, At, B1); PG8_BAR; PG8_SCHED;
            } else {
            PG8_LDB(B0, 0, 0); PG8_SCHED; PG8_LDA(At, 0, 0); PG8_STAGE(PG8_SA(1, 1), a1 + hstep, voffA);
            PG8_WAIT_L(8); PG8_BAR; PG8_WAIT_L(0); PG8_MMA(0, 0, At, B0); PG8_BAR; PG8_SCHED;
            PG8_LDB(B1, 0, 1); PG8_STAGE(PG8_SB(0, 0), b2, voffB);
            PG8_BAR; PG8_WAIT_L(0); PG8_MMA(0, 1, At, B1); PG8_BAR;
            PG8_LDA(At, 0, 1); PG8_STAGE(PG8_SA(0, 0), a2, voffA);
            PG8_BAR; PG8_WAIT_L(0); PG8_MMA(1, 0, At, B0); PG8_BAR; PG8_SCHED;
            PG8_STAGE(PG8_SB(0, 1), b2 + hstep, voffB);
            PG8_WAIT_V(6); PG8_BAR; PG8_MMA(1, 1, At, B1); PG8_BAR;
            PG8_LDB(B0, 1, 0); PG8_SCHED; PG8_LDA(At, 1, 0); PG8_STAGE(PG8_SA(0, 1), a2 + hstep, voffA);
            PG8_WAIT_L(8); PG8_BAR; PG8_WAIT_L(0); PG8_MMA(0, 0, At, B0); PG8_BAR; PG8_SCHED;
            PG8_LDB(B1, 1, 1); PG8_STAGE(PG8_SB(1, 0), b3, voffB);
            PG8_BAR; PG8_WAIT_L(0); PG8_MMA(0, 1, At, B1); PG8_BAR;
            PG8_LDA(At, 1, 1); PG8_STAGE(PG8_SA(1, 0), a3, voffA);
            PG8_BAR; PG8_WAIT_L(0); PG8_MMA(1, 0, At, B0); PG8_BAR; PG8_SCHED;
            PG8_STAGE(PG8_SB(1, 1), b3 + hstep, voffB);
            PG8_WAIT_V(6); PG8_BAR; PG8_MMA(1, 1, At, B1); PG8_BAR;
            }
        }
        if constexpr (ALIGN_EPI) { if (wr == 0) PG8_BAR; }
        if constexpr (!Epi::AFTER_DRAIN) { E(acc, cur, wr, wc, fr, fq); S.done(cur); }
        if (!has_next) break;
#pragma unroll
        for (int a = 0; a < 2; ++a)
#pragma unroll
            for (int b = 0; b < 2; ++b)
#pragma unroll
                for (int m = 0; m < 4; ++m)
#pragma unroll
                    for (int n = 0; n < 2; ++n) acc[a][b][m][n] = (f32x4){0.f, 0.f, 0.f, 0.f};
        cur = nxt; cA = nA; cB = nB; ++ui;
        if constexpr (ALIGN_EPI) { if (wr == 1) PG8_BAR; }
    }
    PG8_WAIT_V(0);
    if constexpr (!ALIGN_EPI) { if (wr == 0) PG8_BAR; }
    PG8_BAR;
    if constexpr (Epi::AFTER_DRAIN) { E.fused(acc, cur, wr, wc, fr, fq, lds, wid, lane); S.done(cur); }
#undef PG8_SA
#undef PG8_SB
#undef PG8_STAGE
#undef PG8_LDA
#undef PG8_LDB
#undef PG8_MMA
#undef PG8_WAIT_V
#undef PG8_WAIT_L
#undef PG8_BAR
#undef PG8_SCHED
}
}
namespace hy {
using pg8::bf16_t; using pg8::f32x4; using pg8::u32x4; using pg8::bf16x8;
#define LAS __attribute__((address_space(3)))
constexpr int NB = 4, SEQ = 4096, DM = 1024, CTXL = 256;
constexpr int M_LAT = NB * SEQ, M_CTX = NB * CTXL, M_ALL = M_LAT + M_CTX;
constexpr int IN_COLS = 3104, NE = 16, CAP = 512, DE = 2816, NSLOT = NE * NB * CAP;
constexpr int PROJ_LD = 2304, PC_NAK = 0, PC_GK = 512, PC_NAQ = 768, PC_GQ = 1280, PC_GG = 1536, PC_AD = 2048;
constexpr int VT_LD = M_ALL;
constexpr float EPS = 1e-6f;
constexpr size_t MiB = 1u << 20;
constexpr size_t WS_MODP = 1 * MiB, WS_MOD = 3 * MiB, WS_WTIN = 4 * MiB, WS_WTV = 9 * MiB, WS_WTOUT = 11 * MiB, WS_AFF = 13 * MiB, WS_IDX = 14 * MiB, WS_GATE = 14 * MiB + 256 * 1024, WS_INV = 15 * MiB;
constexpr size_t WS_WTGU = 16 * MiB, WS_WTDN = 192 * MiB, WS_H = 280 * MiB, WS_PROJ = 314 * MiB, WS_VT = 391 * MiB, WS_OMIX = 425 * MiB, WS_MIX = 457 * MiB, WS_HID = 280 * MiB;
constexpr size_t WS_HF = 489 * MiB, WS_XS = 521 * MiB, WS_GLAT = 590 * MiB, WS_END = 660 * MiB;
static_assert(WS_WTIN + (size_t)PROJ_LD * DM * 2 <= WS_WTV && WS_WTGU + (size_t)NE * 2 * DE * DM * 2 <= WS_WTDN && WS_WTDN + (size_t)NE * DM * DE * 2 <= WS_H, "ws map 1");
static_assert(WS_H + (size_t)M_ALL * DM * 2 <= WS_PROJ && WS_PROJ + (size_t)M_ALL * PROJ_LD * 2 <= WS_VT && WS_VT + (size_t)1024 * VT_LD * 2 <= WS_OMIX, "ws map 2");
static_assert(WS_HID + (size_t)NSLOT * DE * 2 <= WS_MIX && WS_XS + (size_t)NSLOT * DM * 2 <= WS_GLAT && WS_GLAT + (size_t)4 * M_ALL * 256 * 4 <= WS_END, "ws map 3");

__device__ __forceinline__ float bf2f(bf16_t x) { return __uint_as_float((unsigned)x << 16); }
__device__ __forceinline__ unsigned f2bf(float f) { unsigned u = __float_as_uint(f); return (u + 0x7fffu + ((u >> 16) & 1u)) >> 16; }
__device__ __forceinline__ unsigned pk2(float lo, float hi) { return f2bf(lo) | (f2bf(hi) << 16); }
__device__ __forceinline__ float wave_sum(float v) {
#pragma unroll
    for (int o = 1; o < 64; o <<= 1) v += __shfl_xor(v, o);
    return v;
}
__device__ __forceinline__ float silu_f(float x) { return x / (1.f + __expf(-x)); }

__device__ __forceinline__ void ph_mod_partial(const float* __restrict__ c, const float* __restrict__ c_ctx, const float* __restrict__ w_mod, float* __restrict__ part, LAS unsigned char* lds, int bid, int G) {
  const int half = threadIdx.x >> 8, tx = threadIdx.x & 255;
  LAS float (*s)[64] = (LAS float (*)[64])(lds + half * 5 * 64 * 4);
  for (int vb0 = bid * 2; vb0 < 384; vb0 += 2 * G) {
    const int vb = vb0 + half; const bool act = vb < 384;
    const int ks = vb / 24, j = (vb % 24) * 256 + tx;
    __syncthreads();
    if (act) for (int i = tx; i < 5 * 64; i += 256) { const int v = i / 64, k = ks * 64 + (i % 64); const float x = v < 4 ? c[v * 1024 + k] : c_ctx[k]; s[v][i % 64] = x / (1.f + expf(-x)); }
    __syncthreads();
    if (!act) continue;
    float acc[5] = {0.f, 0.f, 0.f, 0.f, 0.f};
#pragma unroll 8
    for (int k = 0; k < 64; ++k) { const float w = w_mod[(size_t)(ks * 64 + k) * 6144 + j];
#pragma unroll
        for (int v = 0; v < 5; ++v) acc[v] += s[v][k] * w; }
#pragma unroll
    for (int v = 0; v < 5; ++v) part[(size_t)(ks * 5 + v) * 6144 + j] = acc[v];
  }
}
__device__ __forceinline__ void ph_mod_final(const float* __restrict__ part, const float* __restrict__ b_mod, float* __restrict__ mod, int bid, int G) {
  for (int i = bid * 512 + threadIdx.x; i < 5 * 6144; i += G * 512) { const int v = i / 6144, j = i % 6144;
    float a = b_mod[j];
    for (int ks = 0; ks < 16; ++ks) a += part[(size_t)(ks * 5 + v) * 6144 + j];
    mod[i] = a; }
}

__device__ __forceinline__ void transpose_item(const float* __restrict__ W, int N, int k0, int n0, bf16_t* dst, int K, float scale, LAS float* scr, int lane) {
#pragma unroll 8
    for (int i = 0; i < 32; ++i) { const int kk = 2 * i + (lane >> 5); scr[kk * 33 + (lane & 31)] = W[(size_t)(k0 + kk) * N + n0 + (lane & 31)]; }
    asm volatile("s_waitcnt lgkmcnt(0)" ::: "memory");
    const int c = lane & 7;
#pragma unroll
    for (int j = 0; j < 4; ++j) { const int n = (lane >> 3) + 8 * j; const LAS float* s = scr + (8 * c) * 33 + n;
        u32x4 o; o.x = pk2(s[0 * 33] * scale, s[1 * 33] * scale); o.y = pk2(s[2 * 33] * scale, s[3 * 33] * scale); o.z = pk2(s[4 * 33] * scale, s[5 * 33] * scale); o.w = pk2(s[6 * 33] * scale, s[7 * 33] * scale);
        *(u32x4*)(dst + (size_t)n * K + k0 + 8 * c) = o; }
    asm volatile("s_waitcnt lgkmcnt(0)" ::: "memory");
}
struct PrepArgs { const float *x, *ctx, *g_pre, *mod, *w_in, *w_out, *w_gate, *w_up, *w_down; bf16_t *WTIN, *WTV, *WTOUT, *WTGU, *WTDN, *H; };
constexpr int IT_IN = 16 * 97, IT_OUT = 16 * 32, IT_GU1 = 16 * 16 * 88, IT_DN = 16 * 44 * 32, IT_ALL = IT_IN + IT_OUT + 2 * IT_GU1 + IT_DN;
__device__ __forceinline__ void ph_prep(const PrepArgs& a, LAS unsigned char* lds, int bid, int G) {
    const int tid = threadIdx.x, lane = tid & 63, wave = tid >> 6;
    LAS float* scr = (LAS float*)(lds + wave * 8448);
    const int gw = bid * 8 + wave, NGW = G * 8;
    { u32x4* z = (u32x4*)(a.WTIN + (size_t)(PC_AD + 32) * DM); const int nz = (PROJ_LD - PC_AD - 32) * DM * 2 / 16;
      for (int i = bid * 512 + tid; i < nz; i += G * 512) z[i] = (u32x4){0u, 0u, 0u, 0u}; }
    for (int m = gw; m < M_ALL; m += NGW) {
        const float* src; int v;
        if (m < M_LAT) { src = a.x + (size_t)m * DM; v = m / SEQ; } else { src = a.ctx + (size_t)(m - M_LAT) * DM; v = 4; }
        const f32x4* xr = (const f32x4*)src + lane; f32x4 xv[4]; float ss = 0.f;
#pragma unroll
        for (int j = 0; j < 4; ++j) { xv[j] = xr[64 * j]; ss += (xv[j].x * xv[j].x + xv[j].y * xv[j].y) + (xv[j].z * xv[j].z + xv[j].w * xv[j].w); }
        const float rstd = rsqrtf(wave_sum(ss) * (1.f / DM) + EPS);
        const float* mv = a.mod + (size_t)v * 6144;
        unsigned long long* o8 = (unsigned long long*)(a.H + (size_t)m * DM) + lane;
#pragma unroll
        for (int j = 0; j < 4; ++j) { const int col = 4 * lane + 256 * j;
            const f32x4 g = *(const f32x4*)(a.g_pre + col), sh = *(const f32x4*)(mv + col), sc = *(const f32x4*)(mv + 1024 + col);
            const f32x4 hv = xv[j] * rstd * g * (sc + 1.f) + sh;
            o8[64 * j] = (unsigned long long)pk2(hv.x, hv.y) | ((unsigned long long)pk2(hv.z, hv.w) << 32); }
    }
    for (int it = gw; it < IT_ALL; it += NGW) {
        int r = it;
        if (r < IT_IN) { const int kb = r / 97, n0 = (r % 97) * 32; bf16_t* dst; float sc = 1.f;
            if (n0 < 512) dst = a.WTIN + (size_t)(PC_NAK + n0) * DM;
            else if (n0 < 1024) dst = a.WTV + (size_t)(n0 - 512) * DM;
            else if (n0 < 1280) dst = a.WTIN + (size_t)(PC_GK + n0 - 1024) * DM;
            else if (n0 < 1792) dst = a.WTV + (size_t)(512 + n0 - 1280) * DM;
            else if (n0 < 1824) dst = a.WTIN + (size_t)(PC_AD + n0 - 1792) * DM;
            else if (n0 < 2336) { dst = a.WTIN + (size_t)(PC_NAQ + n0 - 1824) * DM; sc = 0.125f; }
            else if (n0 < 2592) { dst = a.WTIN + (size_t)(PC_GQ + n0 - 2336) * DM; sc = 0.125f; }
            else dst = a.WTIN + (size_t)(PC_GG + n0 - 2592) * DM;
            transpose_item(a.w_in, IN_COLS, kb * 64, n0, dst, DM, sc, scr, lane); continue; }
        r -= IT_IN;
        if (r < IT_OUT) { const int kb = r / 32, n0 = (r % 32) * 32; transpose_item(a.w_out, DM, kb * 64, n0, a.WTOUT + (size_t)n0 * DM, DM, 1.f, scr, lane); continue; }
        r -= IT_OUT;
        if (r < 2 * IT_GU1) { const int which = r / IT_GU1; r %= IT_GU1; const int e = r / (16 * 88); r %= (16 * 88); const int kb = r / 88, n0 = (r % 88) * 32;
            const float* W = (which ? a.w_up : a.w_gate) + (size_t)e * DM * DE;
            bf16_t* dst = a.WTGU + ((size_t)e * 2 * DE + (n0 / 128) * 256 + (n0 % 128) + which * 128) * DM;
            transpose_item(W, DE, kb * 64, n0, dst, DM, 1.f, scr, lane); continue; }
        r -= 2 * IT_GU1;
        { const int e = r / (44 * 32); r %= (44 * 32); const int kb = r / 32, n0 = (r % 32) * 32;
          transpose_item(a.w_down + (size_t)e * DE * DM, DM, kb * 64, n0, a.WTDN + ((size_t)e * DM + n0) * DE, DE, 1.f, scr, lane); }
    }
}

struct EpiSwiGLU {
    static constexpr bool PERM = true, AFTER_DRAIN = false;
    bf16_t* O; int ldc;
    __device__ __forceinline__ void operator()(const f32x4 (&acc)[2][2][4][2], const pg8::Unit& u, int wr, int wc, int fr, int fq) const {
        const int row0 = u.pm * 256 + wr * 64 + fr, col0 = u.pn * 128 + wc * 32 + 8 * fq;
#pragma unroll
        for (int ai = 0; ai < 2; ++ai)
#pragma unroll
            for (int m = 0; m < 4; ++m) { bf16_t* rowp = O + (size_t)(row0 + ai * 128 + m * 16) * ldc + col0;
                const f32x4 g0 = acc[ai][0][m][0], g1 = acc[ai][0][m][1], u0 = acc[ai][1][m][0], u1 = acc[ai][1][m][1];
                u32x4 w; w.x = pg8::cvt_pk_bf16(silu_f(g0[0]) * u0[0], silu_f(g0[1]) * u0[1]); w.y = pg8::cvt_pk_bf16(silu_f(g0[2]) * u0[2], silu_f(g0[3]) * u0[3]);
                w.z = pg8::cvt_pk_bf16(silu_f(g1[0]) * u1[0], silu_f(g1[1]) * u1[1]); w.w = pg8::cvt_pk_bf16(silu_f(g1[2]) * u1[2], silu_f(g1[3]) * u1[3]);
                *(u32x4*)rowp = w; }
    }
};
struct EpiRowScale {
    static constexpr bool PERM = true, AFTER_DRAIN = false;
    bf16_t* O; int ldc; const float* rowscale;
    __device__ __forceinline__ void operator()(const f32x4 (&acc)[2][2][4][2], const pg8::Unit& u, int wr, int wc, int fr, int fq) const {
        const int row0 = u.pm * 256 + wr * 64 + fr, col0 = u.pn * 256 + wc * 32 + 8 * fq;
#pragma unroll
        for (int ai = 0; ai < 2; ++ai)
#pragma unroll
            for (int m = 0; m < 4; ++m) { const int row = row0 + ai * 128 + m * 16; const float sc = rowscale[row]; bf16_t* rowp = O + (size_t)row * ldc + col0;
#pragma unroll
                for (int bj = 0; bj < 2; ++bj) { const f32x4 v0 = acc[ai][bj][m][0] * sc, v1 = acc[ai][bj][m][1] * sc;
                    u32x4 w; w.x = pg8::cvt_pk_bf16(v0[0], v0[1]); w.y = pg8::cvt_pk_bf16(v0[2], v0[3]); w.z = pg8::cvt_pk_bf16(v1[0], v1[1]); w.w = pg8::cvt_pk_bf16(v1[2], v1[3]);
                    *(u32x4*)(rowp + bj * 128) = w; } }
    }
};
struct ExpertOrder {
    int nT, G, c;
    __device__ __forceinline__ bool next(int i, pg8::Unit& u) const {
        if (G == 256) { if (2 * i >= nT) return false; const int x = c & 7, j = c >> 3, e = 2 * x + (j >> 4), mt = j & 7, pn = 2 * i + ((j >> 3) & 1);
            u.pm = e * 8 + mt; u.pn = pn; u.bt = e * nT + pn; return true; }
        const long L = (long)i * G + c; if (L >= (long)128 * nT) return false;
        const int e = (int)(L / (8 * nT)), r = (int)(L % (8 * nT)); u.pm = e * 8 + (r % 8); u.pn = r / 8; u.bt = e * nT + u.pn; return true;
    }
    __device__ __forceinline__ void a_ready(const pg8::Unit&) const {}
    __device__ __forceinline__ void done(const pg8::Unit&) const {}
};
__device__ __forceinline__ void ph_na_naive(const bf16_t* __restrict__ PROJ, const bf16_t* __restrict__ VT, const float* __restrict__ rpb, bf16_t* __restrict__ OMIX, int bid, int G) {
  for (int vb = bid * 8 + (threadIdx.x >> 6); vb < NB * 8 * 64; vb += G * 8) {
    const int r = vb % 64, h = (vb / 64) % 8, b = vb / 512, c = threadIdx.x & 63;
    const size_t mq = (size_t)b * SEQ + r * 64 + c;
    float q[64], acc[64];
    { const u32x4* qp = (const u32x4*)(PROJ + mq * PROJ_LD + PC_NAQ + h * 64);
#pragma unroll
      for (int i = 0; i < 8; ++i) { const u32x4 w = qp[i]; q[8 * i + 0] = __uint_as_float(w.x << 16); q[8 * i + 1] = __uint_as_float(w.x & 0xffff0000u); q[8 * i + 2] = __uint_as_float(w.y << 16); q[8 * i + 3] = __uint_as_float(w.y & 0xffff0000u);
          q[8 * i + 4] = __uint_as_float(w.z << 16); q[8 * i + 5] = __uint_as_float(w.z & 0xffff0000u); q[8 * i + 6] = __uint_as_float(w.w << 16); q[8 * i + 7] = __uint_as_float(w.w & 0xffff0000u); } }
#pragma unroll
    for (int d = 0; d < 64; ++d) acc[d] = 0.f;
    float mx = -INFINITY, l = 0.f;
    const int rs = min(max(r - 4, 0), 56), cs = min(max(c - 8, 0), 48);
    for (int kk = 0; kk < 128 + CTXL; ++kk) {
        size_t mk; float bias = 0.f;
        if (kk < 128) { const int krow = rs + (kk >> 4), kcol = cs + (kk & 15); mk = (size_t)b * SEQ + krow * 64 + kcol; bias = rpb[(h * 15 + (krow - r + 7)) * 31 + (kcol - c + 15)]; }
        else mk = (size_t)M_LAT + b * CTXL + (kk - 128);
        const u32x4* kp = (const u32x4*)(PROJ + mk * PROJ_LD + PC_NAK + h * 64);
        float s = 0.f;
#pragma unroll
        for (int i = 0; i < 8; ++i) { const u32x4 w = kp[i];
            s += q[8 * i + 0] * __uint_as_float(w.x << 16) + q[8 * i + 1] * __uint_as_float(w.x & 0xffff0000u) + q[8 * i + 2] * __uint_as_float(w.y << 16) + q[8 * i + 3] * __uint_as_float(w.y & 0xffff0000u)
               + q[8 * i + 4] * __uint_as_float(w.z << 16) + q[8 * i + 5] * __uint_as_float(w.z & 0xffff0000u) + q[8 * i + 6] * __uint_as_float(w.w << 16) + q[8 * i + 7] * __uint_as_float(w.w & 0xffff0000u); }
        s += bias;
        const float mn = fmaxf(mx, s), al = __expf(mx - mn), p = __expf(s - mn);
        l = l * al + p; mx = mn;
        const bf16_t* vp = VT + (size_t)(h * 64) * VT_LD + mk;
#pragma unroll
        for (int d = 0; d < 64; ++d) acc[d] = acc[d] * al + p * bf2f(vp[(size_t)d * VT_LD]);
    }
    const float inv = 1.f / l;
    unsigned* op = (unsigned*)(OMIX + mq * DM + h * 64);
#pragma unroll
    for (int i = 0; i < 32; ++i) op[i] = pk2(acc[2 * i] * inv, acc[2 * i + 1] * inv);
  }
}

__device__ __forceinline__ void ph_gla_prep(const bf16_t* __restrict__ PROJ, const float* __restrict__ a_up, const float* __restrict__ a_bias, float* __restrict__ qr, float* __restrict__ kr, float* __restrict__ laf, float* __restrict__ lab, int bid, int G) {
  for (int m = bid * 2 + (threadIdx.x >> 8); m < M_ALL; m += 2 * G) {
    const int j = threadIdx.x & 255, d = j & 63;
    const bf16_t* row = PROJ + (size_t)m * PROJ_LD;
    float kv = bf2f(row[PC_GK + j]);
    if (m < M_LAT) {
        const int t = m % SEQ, pr = t / 64, pc = t % 64;
        const int seg = d >> 5, dd = d & 31, i = dd & 15; const float pos = (float)(seg ? pc : pr);
        const float ang = pos * powf(10000.f, -(float)i / 16.f), cs = cosf(ang), sn = sinf(ang);
        const float qv = bf2f(row[PC_GQ + j]);
        const int jp = (dd < 16) ? j + 16 : j - 16;
        const float kp = bf2f(row[PC_GK + jp]), qp = bf2f(row[PC_GQ + jp]);
        float ko, qo;
        if (dd < 16) { ko = kv * cs - kp * sn; qo = qv * cs - qp * sn; } else { ko = kp * sn + kv * cs; qo = qp * sn + qv * cs; }
        kv = ko; qr[(size_t)m * 256 + j] = qo;
    }
    kr[(size_t)m * 256 + j] = kv;
    float zf = a_bias[j], zb = a_bias[256 + j];
#pragma unroll
    for (int r = 0; r < 16; ++r) { zf += bf2f(row[PC_AD + r]) * a_up[r * 256 + j]; zb += bf2f(row[PC_AD + 16 + r]) * a_up[(16 + r) * 256 + j]; }
    laf[(size_t)m * 256 + j] = (fminf(zf, 0.f) - log1pf(expf(-fabsf(zf)))) * (1.f / 16.f);
    lab[(size_t)m * 256 + j] = (fminf(zb, 0.f) - log1pf(expf(-fabsf(zb)))) * (1.f / 16.f);
  }
}
__device__ __forceinline__ void ph_gla_scan(const float* __restrict__ qr, const float* __restrict__ kr, const float* __restrict__ laf, const float* __restrict__ lab, const bf16_t* __restrict__ VT, float* __restrict__ of, int bid, int G) {
  for (int vb = bid; vb < NB * 4 * 2 * 8; vb += G) {
    const int es = vb & 7, dir = (vb >> 3) & 1, h = (vb >> 4) & 3, b = vb >> 6;
    const int lane = threadIdx.x & 63, w = threadIdx.x >> 6, e0 = es * 16 + 2 * w;
    const float* la = dir ? lab : laf;
    const bf16_t* v0p = VT + (size_t)(512 + h * 128 + e0) * VT_LD; const bf16_t* v1p = v0p + VT_LD;
    float S0 = 0.f, S1 = 0.f;
    for (int s = 0; s < CTXL; ++s) { const int jj = dir ? (CTXL - 1 - s) : s; const size_t m = (size_t)M_LAT + b * CTXL + jj;
        const float a = __expf(la[m * 256 + h * 64 + lane]), k = kr[m * 256 + h * 64 + lane];
        S0 = a * S0 + k * bf2f(v0p[m]); S1 = a * S1 + k * bf2f(v1p[m]); }
#pragma unroll 4
    for (int s = 0; s < SEQ; ++s) { const int t = dir ? (SEQ - 1 - s) : s; const size_t m = (size_t)b * SEQ + t;
        const float a = __expf(la[m * 256 + h * 64 + lane]), k = kr[m * 256 + h * 64 + lane], q = qr[m * 256 + h * 64 + lane];
        S0 = a * S0 + k * bf2f(v0p[m]); S1 = a * S1 + k * bf2f(v1p[m]);
        const float o0 = wave_sum(q * S0), o1 = wave_sum(q * S1);
        if (lane == 0) { float* o = of + ((size_t)dir * M_LAT + m) * 512 + h * 128 + e0; o[0] = o0; o[1] = o1; } }
  }
}
__device__ __forceinline__ void ph_gla_merge(const float* __restrict__ of, const bf16_t* __restrict__ PROJ, const float* __restrict__ gnorm, bf16_t* __restrict__ OMIX, int bid, int G) {
  for (int gwv = bid * 8 + (threadIdx.x >> 6); gwv < M_LAT * 4; gwv += G * 8) {
    const int lane = threadIdx.x & 63, m = gwv >> 2, h = gwv & 3;
    float o[2]; float ss = 0.f;
#pragma unroll
    for (int i = 0; i < 2; ++i) { const int e = lane + 64 * i; o[i] = of[(size_t)m * 512 + h * 128 + e] + of[((size_t)M_LAT + m) * 512 + h * 128 + e]; ss += o[i] * o[i]; }
    const float rstd = rsqrtf(wave_sum(ss) * (1.f / 128.f) + EPS);
#pragma unroll
    for (int i = 0; i < 2; ++i) { const int e = lane + 64 * i; const float g = bf2f(PROJ[(size_t)m * PROJ_LD + PC_GG + h * 128 + e]);
        OMIX[(size_t)m * DM + 512 + h * 128 + e] = (bf16_t)f2bf(o[i] * rstd * gnorm[e] * silu_f(g)); }
  }
}

__device__ __forceinline__ void ph_post_mix(const float* __restrict__ x, const bf16_t* __restrict__ MIX, const float* __restrict__ mod, const float* __restrict__ g_post, const float* __restrict__ g_fpre, const float* __restrict__ router,
                                                  float* __restrict__ xnew, bf16_t* __restrict__ HF, float* __restrict__ aff, LAS unsigned char* lds, int bid, int G) {
    LAS float* rt = (LAS float*)lds;
    __syncthreads();
    for (int i = threadIdx.x; i < DM * NE; i += 512) rt[(i % NE) * DM + (i / NE)] = router[i];
    __syncthreads();
    const int lane = threadIdx.x & 63, wave = threadIdx.x >> 6;
    for (int m = bid * 8 + wave; m < M_LAT; m += G * 8) {
        const int b = m / SEQ, t = m % SEQ; const float* mv = mod + (size_t)b * 6144;
        f32x4 mx[4]; float ss = 0.f;
        const unsigned long long* mp = (const unsigned long long*)(MIX + (size_t)m * DM) + lane;
#pragma unroll
        for (int j = 0; j < 4; ++j) { const unsigned long long w = mp[64 * j]; const unsigned lo = (unsigned)w, hi = (unsigned)(w >> 32);
            mx[j] = (f32x4){__uint_as_float(lo << 16), __uint_as_float(lo & 0xffff0000u), __uint_as_float(hi << 16), __uint_as_float(hi & 0xffff0000u)};
            ss += (mx[j].x * mx[j].x + mx[j].y * mx[j].y) + (mx[j].z * mx[j].z + mx[j].w * mx[j].w); }
        const float rstd = rsqrtf(wave_sum(ss) * (1.f / DM) + EPS);
        f32x4 xn[4]; float s2 = 0.f;
#pragma unroll
        for (int j = 0; j < 4; ++j) { const int col = 4 * lane + 256 * j;
            const f32x4 xv = *(const f32x4*)(x + (size_t)m * DM + col), gp = *(const f32x4*)(g_post + col), gm = *(const f32x4*)(mv + 2048 + col);
            xn[j] = xv + gm * (mx[j] * rstd * gp);
            *(f32x4*)(xnew + (size_t)m * DM + col) = xn[j];
            s2 += (xn[j].x * xn[j].x + xn[j].y * xn[j].y) + (xn[j].z * xn[j].z + xn[j].w * xn[j].w); }
        const float rstd2 = rsqrtf(wave_sum(s2) * (1.f / DM) + EPS);
        f32x4 hv4[4];
        unsigned long long* hp = (unsigned long long*)(HF + (size_t)m * DM) + lane;
#pragma unroll
        for (int j = 0; j < 4; ++j) { const int col = 4 * lane + 256 * j;
            const f32x4 gf = *(const f32x4*)(g_fpre + col), sh = *(const f32x4*)(mv + 3072 + col), sc = *(const f32x4*)(mv + 4096 + col);
            hv4[j] = xn[j] * rstd2 * gf * (sc + 1.f) + sh;
            hp[64 * j] = (unsigned long long)pk2(hv4[j].x, hv4[j].y) | ((unsigned long long)pk2(hv4[j].z, hv4[j].w) << 32); }
        float lg[NE]; float mxl = -INFINITY;
#pragma unroll
        for (int e = 0; e < NE; ++e) { float sacc = 0.f;
#pragma unroll
            for (int j = 0; j < 4; ++j) { const f32x4 rv = *(const LAS f32x4*)(rt + e * DM + 4 * lane + 256 * j); sacc += (hv4[j].x * rv.x + hv4[j].y * rv.y) + (hv4[j].z * rv.z + hv4[j].w * rv.w); }
            lg[e] = wave_sum(sacc); mxl = fmaxf(mxl, lg[e]); asm volatile("" ::: "memory"); }
        float den = 0.f;
#pragma unroll
        for (int e = 0; e < NE; ++e) { lg[e] = expf(lg[e] - mxl); den += lg[e]; }
        const float rden = 1.f / den;
#pragma unroll
        for (int e = 0; e < NE; ++e) if (lane == e) aff[((size_t)b * NE + e) * SEQ + t] = lg[e] * rden;
    }
}

__device__ __forceinline__ int block_excl_scan(int v, LAS int* sm  , int& total) {
    const int lane = threadIdx.x & 63, w = threadIdx.x >> 6; int x = v;
#pragma unroll
    for (int o = 1; o < 64; o <<= 1) { const int y = __shfl_up(x, o); if (lane >= o) x += y; }
    __syncthreads();
    if (lane == 63) sm[w] = x;
    __syncthreads();
    int base = 0, tot = 0;
#pragma unroll
    for (int i = 0; i < 8; ++i) { const int s = sm[i]; if (i < w) base += s; tot += s; }
    total = tot;
    return base + x - v;
}
__device__ __forceinline__ void ph_topk(const float* __restrict__ aff, const bf16_t* __restrict__ HF, int* __restrict__ idx, float* __restrict__ gate, int* __restrict__ inv, bf16_t* __restrict__ XS, LAS unsigned char* lds, int bid, int G) {
  LAS int* hist = (LAS int*)lds; LAS int* sm = hist + 256; LAS unsigned* sp = (LAS unsigned*)(sm + 16); LAS int* srm = (LAS int*)(sp + 1); LAS int* s_list = srm + 1;
#define s_prefix (*sp)
#define s_remain (*srm)
  for (int be = bid; be < NB * NE; be += G) {
    const int b = be / NE, e = be % NE, tid = threadIdx.x;
    __syncthreads();
    const float* av = aff + ((size_t)b * NE + e) * SEQ;
    unsigned key[8];
#pragma unroll
    for (int j = 0; j < 8; ++j) key[j] = __float_as_uint(av[tid * 8 + j]);
    if (tid == 0) { s_prefix = 0u; s_remain = CAP; }
    for (int pass = 3; pass >= 0; --pass) {
        if (tid < 256) hist[tid] = 0;
        __syncthreads();
        const unsigned prefix = s_prefix; const int shift = pass * 8; const unsigned himask = pass == 3 ? 0u : (0xffffffffu << (shift + 8));
#pragma unroll
        for (int j = 0; j < 8; ++j) if ((key[j] & himask) == prefix) atomicAdd((int*)(hist + ((key[j] >> shift) & 255u)), 1);
        __syncthreads();
        if (tid == 0) { int rem = s_remain, bin = 255; for (; bin > 0; --bin) { const int cnt = hist[bin]; if (cnt >= rem) break; rem -= cnt; } s_remain = rem; s_prefix = prefix | ((unsigned)bin << shift); }
        __syncthreads();
    }
    const unsigned T = s_prefix; const int remain = s_remain;
    int neq = 0;
#pragma unroll
    for (int j = 0; j < 8; ++j) neq += (key[j] == T);
    int tot; int eqbase = block_excl_scan(neq, sm, tot);
    int flags = 0, nsel = 0;
#pragma unroll
    for (int j = 0; j < 8; ++j) { bool sel = key[j] > T; if (key[j] == T) { sel = eqbase < remain; ++eqbase; } if (sel) { flags |= 1 << j; ++nsel; } }
    int slot = block_excl_scan(nsel, sm, tot);
    const int rowbase = (e * NB + b) * CAP;
#pragma unroll
    for (int j = 0; j < 8; ++j) { const int t = tid * 8 + j; int sl = -1;
        if (flags & (1 << j)) { sl = slot++; idx[rowbase + sl] = t; gate[rowbase + sl] = __uint_as_float(key[j]); s_list[sl] = t; }
        inv[((size_t)b * SEQ + t) * NE + e] = sl; }
    __syncthreads();
    const int lane = tid & 63, wave = tid >> 6;
    for (int s = wave; s < CAP; s += 8) { const u32x4* src = (const u32x4*)(HF + ((size_t)b * SEQ + s_list[s]) * DM); u32x4* dst = (u32x4*)(XS + (size_t)(rowbase + s) * DM);
        dst[lane] = src[lane]; dst[lane + 64] = src[lane + 64]; }
  }
#undef s_prefix
#undef s_remain
}

__device__ __forceinline__ void ph_combine(const bf16_t* __restrict__ Y, const int* __restrict__ inv, const float* __restrict__ mod, const float* __restrict__ g_fpost, float* __restrict__ out, int bid, int G) {
    const int lane = threadIdx.x & 63, wave = threadIdx.x >> 6;
    for (int m = bid * 8 + wave; m < M_LAT; m += G * 8) {
        const int b = m / SEQ; const float* mv = mod + (size_t)b * 6144;
        f32x4 y[4];
#pragma unroll
        for (int j = 0; j < 4; ++j) y[j] = (f32x4){0.f, 0.f, 0.f, 0.f};
        for (int e = 0; e < NE; ++e) { const int sl = inv[(size_t)m * NE + e]; if (sl < 0) continue;
            const unsigned long long* yp = (const unsigned long long*)(Y + (size_t)((e * NB + b) * CAP + sl) * DM) + lane;
#pragma unroll
            for (int j = 0; j < 4; ++j) { const unsigned long long w = yp[64 * j]; const unsigned lo = (unsigned)w, hi = (unsigned)(w >> 32);
                y[j] += (f32x4){__uint_as_float(lo << 16), __uint_as_float(lo & 0xffff0000u), __uint_as_float(hi << 16), __uint_as_float(hi & 0xffff0000u)}; } }
        float ss = 0.f;
#pragma unroll
        for (int j = 0; j < 4; ++j) ss += (y[j].x * y[j].x + y[j].y * y[j].y) + (y[j].z * y[j].z + y[j].w * y[j].w);
        const float rstd = rsqrtf(wave_sum(ss) * (1.f / DM) + EPS);
#pragma unroll
        for (int j = 0; j < 4; ++j) { const int col = 4 * lane + 256 * j; float* op = out + (size_t)m * DM + col;
            const f32x4 xn = *(const f32x4*)op, gp = *(const f32x4*)(g_fpost + col), gf = *(const f32x4*)(mv + 5120 + col);
            *(f32x4*)op = xn + gf * (y[j] * rstd * gp); }
    }
}

namespace cg = cooperative_groups;
constexpr int LDS_BYTES = 147456;
constexpr int N_PHASES = 13;
struct MegaArgs { const float* in[20]; float* out; unsigned char* ws; int ph_lo, ph_hi; };
__global__ void __launch_bounds__(512, 2) hy_mega(MegaArgs a) {
    extern __shared__ __attribute__((aligned(16))) unsigned char lds_raw[];
    LAS unsigned char* lds = (LAS unsigned char*)lds_raw;
    cg::grid_group grid = cg::this_grid();
    const int bid = blockIdx.x, G = gridDim.x;
    const float* x = a.in[0]; const float* c = a.in[1]; const float* ctx = a.in[2]; const float* c_ctx = a.in[3];
    const float* w_mod = a.in[4]; const float* b_mod = a.in[5]; const float* g_pre = a.in[6]; const float* g_post = a.in[7];
    const float* g_fpre = a.in[8]; const float* g_fpost = a.in[9]; const float* w_in = a.in[10]; const float* rpb = a.in[11];
    const float* a_up = a.in[12]; const float* a_bias = a.in[13]; const float* gnorm = a.in[14]; const float* w_out = a.in[15];
    const float* router = a.in[16]; const float* w_gate = a.in[17]; const float* w_up = a.in[18]; const float* w_down = a.in[19];
    unsigned char* ws = a.ws; float* out = a.out;
    float* modp = (float*)(ws + WS_MODP); float* mod = (float*)(ws + WS_MOD);
    bf16_t* WTIN = (bf16_t*)(ws + WS_WTIN); bf16_t* WTV = (bf16_t*)(ws + WS_WTV); bf16_t* WTOUT = (bf16_t*)(ws + WS_WTOUT); bf16_t* WTGU = (bf16_t*)(ws + WS_WTGU); bf16_t* WTDN = (bf16_t*)(ws + WS_WTDN);
    bf16_t* H = (bf16_t*)(ws + WS_H); bf16_t* PROJ = (bf16_t*)(ws + WS_PROJ); bf16_t* VT = (bf16_t*)(ws + WS_VT); bf16_t* OMIX = (bf16_t*)(ws + WS_OMIX); bf16_t* MIX = (bf16_t*)(ws + WS_MIX);
    bf16_t* HID = (bf16_t*)(ws + WS_HID); bf16_t* HF = (bf16_t*)(ws + WS_HF); bf16_t* XS = (bf16_t*)(ws + WS_XS); bf16_t* Y = XS;
    float* aff = (float*)(ws + WS_AFF); int* idx = (int*)(ws + WS_IDX); float* gate = (float*)(ws + WS_GATE); int* inv = (int*)(ws + WS_INV);
    float* qr = (float*)(ws + WS_GLAT); float* kr = qr + (size_t)M_ALL * 256; float* laf = kr + (size_t)M_ALL * 256; float* lab = laf + (size_t)M_ALL * 256;
    const int lo = a.ph_lo, hi = a.ph_hi;
#define IN(k) (lo <= (k) && (k) < hi)
#define SEAM(k) do { if (IN(k) && IN((k) + 1)) grid.sync(); } while (0)
    if (IN(0)) ph_mod_partial(c, c_ctx, w_mod, modp, lds, bid, G);
    SEAM(0);
    if (IN(1)) ph_mod_final(modp, b_mod, mod, bid, G);
    SEAM(1);
    if (IN(2)) { PrepArgs p; p.x = x; p.ctx = ctx; p.g_pre = g_pre; p.mod = mod; p.w_in = w_in; p.w_out = w_out; p.w_gate = w_gate; p.w_up = w_up; p.w_down = w_down;
        p.WTIN = WTIN; p.WTV = WTV; p.WTOUT = WTOUT; p.WTGU = WTGU; p.WTDN = WTDN; p.H = H; ph_prep(p, lds, bid, G); }
    SEAM(2);
    if (IN(3)) {
        { pg8::Gemm g{H, WTIN, M_ALL, PROJ_LD, DM}; pg8::StaticOrder S; S.init(g.M, g.N, G, bid); pg8::EpiBf16<0> E{PROJ, PROJ_LD, nullptr, 0, 0, 1.f};
          pg8::gemm_phase<pg8::EpiBf16<0>, pg8::StaticOrder, true, true>(lds, g, S, E); }
        { pg8::Gemm g{WTV, H, 1024, M_ALL, DM}; pg8::StaticOrder S; S.init(g.M, g.N, G, bid); pg8::EpiBf16<0> E{VT, VT_LD, nullptr, 0, 0, 1.f};
          pg8::gemm_phase<pg8::EpiBf16<0>, pg8::StaticOrder, true, true>(lds, g, S, E); }
    }
    SEAM(3);
    if (IN(4)) { ph_na_naive(PROJ, VT, rpb, OMIX, bid, G); ph_gla_prep(PROJ, a_up, a_bias, qr, kr, laf, lab, bid, G); }
    SEAM(4);
    if (IN(5)) ph_gla_scan(qr, kr, laf, lab, VT, out, bid, G);
    SEAM(5);
    if (IN(6)) ph_gla_merge(out, PROJ, gnorm, OMIX, bid, G);
    SEAM(6);
    if (IN(7)) { pg8::Gemm g{OMIX, WTOUT, M_LAT, DM, DM}; pg8::StaticOrder S; S.init(g.M, g.N, G, bid); pg8::EpiBf16<0> E{MIX, DM, nullptr, 0, 0, 1.f};
        pg8::gemm_phase<pg8::EpiBf16<0>, pg8::StaticOrder, true, true>(lds, g, S, E); }
    SEAM(7);
    if (IN(8)) ph_post_mix(x, MIX, mod, g_post, g_fpre, router, out, HF, aff, lds, bid, G);
    SEAM(8);
    if (IN(9)) ph_topk(aff, HF, idx, gate, inv, XS, lds, bid, G);
    SEAM(9);
    if (IN(10)) { pg8::Gemm g{XS, WTGU, NSLOT, 2 * DE, DM}; ExpertOrder S{22, G, bid}; EpiSwiGLU E{HID, DE};
        pg8::gemm_phase<EpiSwiGLU, ExpertOrder, true, true>(lds, g, S, E); }
    SEAM(10);
    if (IN(11)) { pg8::Gemm g{HID, WTDN, NSLOT, DM, DE}; ExpertOrder S{4, G, bid}; EpiRowScale E{Y, DM, gate};
        pg8::gemm_phase<EpiRowScale, ExpertOrder, true, true>(lds, g, S, E); }
    SEAM(11);
    if (IN(12)) ph_combine(Y, inv, mod, g_fpost, out, bid, G);
#undef IN
#undef SEAM
}
}

#ifndef MK_SPLIT
#define MK_SPLIT 0
#endif
extern "C" void kernel_launch(void* const* d_in, const int* in_sizes, int n_in, void* d_out, int out_size, void* d_ws, size_t ws_size, hipStream_t stream) {
    using namespace hy;
    static int grid = 0;
    if (grid == 0) {
        if (n_in != 20 || in_sizes[0] != M_LAT * DM || out_size != M_LAT * DM || ws_size < WS_END) { fprintf(stderr, "kernel_launch: unexpected shapes / workspace (n_in %d, ws %zu)\n", n_in, ws_size); grid = -1; return; }
        int dev = 0, cus = 0, per_cu = 0;
        if (hipGetDevice(&dev) != hipSuccess || hipDeviceGetAttribute(&cus, hipDeviceAttributeMultiprocessorCount, dev) != hipSuccess) { grid = -1; return; }
        if (hipFuncSetAttribute((const void*)hy_mega, hipFuncAttributeMaxDynamicSharedMemorySize, LDS_BYTES) != hipSuccess) { fprintf(stderr, "kernel_launch: hipFuncSetAttribute failed\n"); grid = -1; return; }
        if (hipOccupancyMaxActiveBlocksPerMultiprocessor(&per_cu, (const void*)hy_mega, 512, LDS_BYTES) != hipSuccess || per_cu < 1) { fprintf(stderr, "kernel_launch: occupancy query says %d\n", per_cu); per_cu = 1; }
        (void)hipGetLastError();
        grid = cus;
    }
    if (grid < 0) return;
    MegaArgs a{};
    for (int i = 0; i < 20; ++i) a.in[i] = (const float*)d_in[i];
    a.out = (float*)d_out; a.ws = (unsigned char*)d_ws;
#if MK_SPLIT
    for (int p = 0; p < N_PHASES; ++p) { a.ph_lo = p; a.ph_hi = p + 1; hipLaunchKernelGGL(hy_mega, dim3(grid), dim3(512), LDS_BYTES, stream, a); }
#else
    a.ph_lo = 0; a.ph_hi = N_PHASES;
    void* args[] = {&a};
    hipError_t e = hipLaunchCooperativeKernel((const void*)hy_mega, dim3(grid), dim3(512), args, LDS_BYTES, stream);
    if (e != hipSuccess) fprintf(stderr, "cooperative launch failed: %s (grid %d)\n", hipGetErrorString(e), grid);
#endif
}
```

```cpp
#include <hip/hip_runtime.h>
#include <hip/hip_cooperative_groups.h>
#include <cstdio>
#include <cstdint>
namespace pg8 {
#define PG8_LAS __attribute__((address_space(3)))
typedef unsigned short bf16_t;
typedef short bf16x8 __attribute__((ext_vector_type(8)));
typedef float f32x4 __attribute__((ext_vector_type(4)));
typedef unsigned u32x4 __attribute__((ext_vector_type(4)));
constexpr int BM = 256, BK = 64, HALF = 128, HTB = HALF * BK * 2  , STAGE_BYTES = 8 * HTB, NXCD = 8, WGM = 8;

__host__ __device__ __forceinline__ int lds_byte(int r, int c) { const int st = (r >> 4) * 2 + (c >> 5), rr = r & 15, cc = c & 31, ob = rr * 64 + cc * 2; return st * 1024 + (ob ^ (((ob >> 9) & 1) << 5)); }
__host__ __device__ __forceinline__ void stage_rc(int b, int& R, int& C) { const int st = b / 1024, sb = b % 1024, swz = sb ^ (((sb >> 9) & 1) << 5); R = (st >> 1) * 16 + swz / 64; C = (st & 1) * 32 + (swz % 64) / 2; }
__host__ __device__ __forceinline__ int perm32(int rho) { const int n = rho >> 4, i = rho & 15; return 8 * (i >> 2) + 4 * n + (i & 3); }

struct Unit { int pm, pn, bt; };
struct Gemm { const bf16_t* A; const bf16_t* Bt; int M, N, K; };

struct StaticOrder {
    int nM, nN, nwg, G, c;
    __host__ __device__ void init(int M, int N, int G_, int c_) { nM = M / BM; nN = N / BM; nwg = nM * nN; G = G_; c = c_; }
    __host__ __device__ bool next(int i, Unit& u) const {
        const long L = (long)i * G + c; if (L >= nwg) return false;
        int wgid = (int)L; { const int q = nwg / NXCD, r = nwg % NXCD, xcd = wgid % NXCD, off = wgid / NXCD; wgid = (xcd < r ? xcd * (q + 1) : r * (q + 1) + (xcd - r) * q) + off; }
        const int nig = WGM * nN, gid = wgid / nig, fm = gid * WGM, gsz = (nM - fm) < WGM ? (nM - fm) : WGM;
        u.pm = fm + ((wgid % nig) % gsz); u.pn = (wgid % nig) / gsz; u.bt = u.pn; return true;
    }
    __device__ __forceinline__ void a_ready(const Unit&) const {}
    __device__ __forceinline__ void done(const Unit&) const {}
};

__device__ __forceinline__ unsigned cvt_pk_bf16(float lo, float hi) { unsigned r; asm volatile("v_cvt_pk_bf16_f32 %0, %1, %2" : "=v"(r) : "v"(lo), "v"(hi)); return r; }
typedef float f32x2 __attribute__((ext_vector_type(2)));
__device__ __forceinline__ f32x2 gelu_pk(f32x2 v) {
    const f32x2 av = __builtin_elementwise_abs(v), d = av * 0.2316418882f + 1.0f;
    f32x2 t; t.x = __builtin_amdgcn_rcpf(d.x); t.y = __builtin_amdgcn_rcpf(d.y);
    f32x2 q = t * 0.5307027145f + (-0.7265760135f); q = q * t + 0.7107068705f; q = q * t + (-0.142248368f); q = q * t + 0.127414796f; q = q * t;
    const f32x2 s = (v * v) * (-0.72134752044f);
    f32x2 e; e.x = __builtin_amdgcn_exp2f(s.x); e.y = __builtin_amdgcn_exp2f(s.y);
    const f32x2 m = v * (q * e), r = v - m;
    f32x2 o; o.x = v.x < 0.f ? m.x : r.x; o.y = v.y < 0.f ? m.y : r.y; return o;
}

template <int ACT  > struct EpiBf16 {
    static constexpr bool PERM = true, AFTER_DRAIN = false; static_assert(ACT == 0 || ACT == 1, "EpiBf16: ACT is 0 (none) or 1 (gelu_pk)");
    bf16_t* O; int ldc; const float* bias; int split_cols; size_t split_stride; float scale0;
    __device__ __forceinline__ void operator()(const f32x4 (&acc)[2][2][4][2], const Unit& u, int wr, int wc, int fr, int fq) const {
        const int row0 = u.pm * BM + wr * 64 + fr; int colt = u.pn * BM; bf16_t* base = O;
        float sc = 1.f; if (split_cols) { const int t = colt / split_cols; base += (size_t)t * split_stride; colt -= t * split_cols; if (t == 0) sc = scale0; }
        const int col0 = colt + wc * 32 + 8 * fq, bcol0 = u.pn * BM + wc * 32 + 8 * fq;
        f32x4 bv[2][2];
#pragma unroll
        for (int bj = 0; bj < 2; ++bj)
#pragma unroll
            for (int n = 0; n < 2; ++n) bv[bj][n] = bias ? *(const f32x4*)(bias + bcol0 + bj * HALF + 4 * n) : (f32x4){0.f, 0.f, 0.f, 0.f};
#pragma unroll
        for (int ai = 0; ai < 2; ++ai)
#pragma unroll
            for (int m = 0; m < 4; ++m) { bf16_t* rowp = base + (size_t)(row0 + ai * HALF + m * 16) * ldc + col0;
#pragma unroll
                for (int bj = 0; bj < 2; ++bj) { f32x4 v0 = acc[ai][bj][m][0] + bv[bj][0], v1 = acc[ai][bj][m][1] + bv[bj][1];
                    if (ACT == 1) { f32x2 a = gelu_pk((f32x2){v0[0], v0[1]}), b = gelu_pk((f32x2){v0[2], v0[3]}), c = gelu_pk((f32x2){v1[0], v1[1]}), d = gelu_pk((f32x2){v1[2], v1[3]});
                        v0 = (f32x4){a.x, a.y, b.x, b.y}; v1 = (f32x4){c.x, c.y, d.x, d.y}; }
                    v0 = v0 * sc; v1 = v1 * sc; u32x4 w; w.x = cvt_pk_bf16(v0[0], v0[1]); w.y = cvt_pk_bf16(v0[2], v0[3]); w.z = cvt_pk_bf16(v1[0], v1[1]); w.w = cvt_pk_bf16(v1[2], v1[3]);
                    *(u32x4*)(rowp + bj * HALF) = w; } }
    }
};
template <class Epi, class Sched, bool ALIGN_EPI = false, bool SP2 = false>
__device__ __forceinline__ void gemm_phase(PG8_LAS unsigned char* lds, const Gemm g, const Sched& S, const Epi& E) {
    const int tid = threadIdx.x, wid = __builtin_amdgcn_readfirstlane(tid >> 6), lane = tid & 63, wr = wid >> 2, wc = wid & 3, fr = lane & 15, fq = lane >> 4;
    const int K = g.K, nt = K / BK;
    unsigned voffA[2], voffB[2];
#pragma unroll
    for (int i = 0; i < 2; ++i) { int R, C; stage_rc(tid * 16 + i * 8192, R, C); const int Rb = Epi::PERM ? ((R & ~31) + perm32(R & 31)) : R;
        voffA[i] = (unsigned)(R * K + C) * 2u; voffB[i] = (unsigned)(Rb * K + C) * 2u; }
    const size_t kstep = (size_t)(BK * 2);
    const size_t hstep = (size_t)HALF * K * 2;
    const size_t tstep = 2 * hstep;
    const unsigned ldsw = (unsigned)wid * 1024u;
    const int aoff = lds_byte(wr * 64 + fr, fq * 8), boff = lds_byte(wc * 32 + fr, fq * 8);
#define PG8_SA(b, h) (((b) * 2 + (h)) * HTB)
#define PG8_SB(b, h) ((4 + (b) * 2 + (h)) * HTB)
#define PG8_STAGE(bufoff, gbase, voff) do { _Pragma("unroll") for (int _i = 0; _i < 2; ++_i) \
        __builtin_amdgcn_global_load_lds((const unsigned*)((const char*)(gbase) + (voff)[_i]), (PG8_LAS unsigned*)(lds + (bufoff) + ldsw + _i * 8192), 16, 0, 0); } while (0)
#define PG8_LDA(dst, b, h) do { _Pragma("unroll") for (int m = 0; m < 4; ++m) _Pragma("unroll") for (int k = 0; k < 2; ++k) dst[m][k] = *(const PG8_LAS bf16x8*)(lds + PG8_SA(b, h) + aoff + m * 2048 + k * 1024); } while (0)
#define PG8_LDB(dst, b, h) do { _Pragma("unroll") for (int n = 0; n < 2; ++n) _Pragma("unroll") for (int k = 0; k < 2; ++k) dst[n][k] = *(const PG8_LAS bf16x8*)(lds + PG8_SB(b, h) + boff + n * 2048 + k * 1024); } while (0)
#define PG8_MMA(ai, bj, At, Bt) do { __builtin_amdgcn_s_setprio(1); _Pragma("unroll") for (int m = 0; m < 4; ++m) _Pragma("unroll") for (int n = 0; n < 2; ++n) _Pragma("unroll") for (int k = 0; k < 2; ++k) \
        acc[ai][bj][m][n] = __builtin_amdgcn_mfma_f32_16x16x32_bf16(Bt[n][k], At[m][k], acc[ai][bj][m][n], 0, 0, 0); __builtin_amdgcn_s_setprio(0); } while (0)
#define PG8_WAIT_V(n) asm volatile("s_waitcnt vmcnt(" #n ")" ::: "memory")
#define PG8_WAIT_L(n) asm volatile("s_waitcnt lgkmcnt(" #n ")" ::: "memory")
#define PG8_BAR __builtin_amdgcn_s_barrier()
#define PG8_SCHED __builtin_amdgcn_sched_barrier(0)
    Unit cur, nxt; int ui = 0;
    if (!S.next(0, cur)) return;
    f32x4 acc[2][2][4][2];
#pragma unroll
    for (int a = 0; a < 2; ++a)
#pragma unroll
        for (int b = 0; b < 2; ++b)
#pragma unroll
            for (int m = 0; m < 4; ++m)
#pragma unroll
                for (int n = 0; n < 2; ++n) acc[a][b][m][n] = (f32x4){0.f, 0.f, 0.f, 0.f};
    bf16x8 At[4][2], B0[2][2], B1[2][2];
    const char* cA = (const char*)g.A + (size_t)cur.pm * tstep; const char* cB = (const char*)g.Bt + (size_t)cur.bt * tstep;
    S.a_ready(cur);
    if constexpr (SP2) {
        PG8_STAGE(PG8_SB(0, 0), cB, voffB); PG8_STAGE(PG8_SB(0, 1), cB + hstep, voffB); PG8_STAGE(PG8_SA(0, 0), cA, voffA); PG8_STAGE(PG8_SA(0, 1), cA + hstep, voffA);
        if (wr == 1) PG8_BAR;
        PG8_WAIT_V(2); PG8_BAR;
        PG8_STAGE(PG8_SB(1, 0), cB + kstep, voffB); PG8_STAGE(PG8_SA(1, 0), cA + kstep, voffA); PG8_STAGE(PG8_SB(1, 1), cB + hstep + kstep, voffB);
        PG8_WAIT_V(6); PG8_BAR;
    } else {
        PG8_STAGE(PG8_SB(0, 0), cB, voffB); PG8_STAGE(PG8_SA(0, 0), cA, voffA); PG8_STAGE(PG8_SB(0, 1), cB + hstep, voffB); PG8_STAGE(PG8_SA(0, 1), cA + hstep, voffA);
        if (wr == 1) PG8_BAR;
        PG8_WAIT_V(4); PG8_BAR;
        PG8_STAGE(PG8_SB(1, 0), cB + kstep, voffB); PG8_STAGE(PG8_SA(1, 0), cA + kstep, voffA); PG8_STAGE(PG8_SB(1, 1), cB + hstep + kstep, voffB);
        PG8_WAIT_V(6); PG8_BAR;
    }
    for (;;) {
        const bool has_next = S.next(ui + 1, nxt);
        const char* nA = has_next ? (const char*)g.A + (size_t)nxt.pm * tstep : cA; const char* nB = has_next ? (const char*)g.Bt + (size_t)nxt.bt * tstep : cB;
        for (int t = 0; t < nt; t += 2) {
            const bool last = (t == nt - 2);
            const char* a1 = cA + (size_t)(t + 1) * kstep;
            const char* a2 = last ? nA : cA + (size_t)(t + 2) * kstep; const char* b2 = last ? nB : cB + (size_t)(t + 2) * kstep;
            const char* a3 = a2 + kstep; const char* b3 = b2 + kstep;
            if (last && has_next) S.a_ready(nxt);
            if constexpr (SP2) {
            PG8_LDB(B0, 0, 0); PG8_LDB(B1, 0, 1); PG8_SCHED; PG8_LDA(At, 0, 0); PG8_STAGE(PG8_SA(1, 1), a1 + hstep, voffA);
            PG8_WAIT_V(8); PG8_WAIT_L(0); PG8_BAR; PG8_MMA(0, 0, At, B0); PG8_MMA(0, 1, At, B1); PG8_BAR; PG8_SCHED;
            PG8_LDA(At, 0, 1); PG8_STAGE(PG8_SB(0, 0), b2, voffB); PG8_STAGE(PG8_SB(0, 1), b2 + hstep, voffB); PG8_STAGE(PG8_SA(0, 0), a2, voffA);
            PG8_WAIT_V(8); PG8_WAIT_L(0); PG8_BAR; PG8_MMA(1, 0, At, B0); PG8_MMA(1, 1, At, B1); PG8_BAR; PG8_SCHED;
            PG8_LDB(B0, 1, 0); PG8_LDB(B1, 1, 1); PG8_SCHED; PG8_LDA(At, 1, 0); PG8_STAGE(PG8_SA(0, 1), a2 + hstep, voffA);
            PG8_WAIT_V(8); PG8_WAIT_L(0); PG8_BAR; PG8_MMA(0, 0, At, B0); PG8_MMA(0, 1, At, B1); PG8_BAR; PG8_SCHED;
            PG8_LDA(At, 1, 1); PG8_STAGE(PG8_SB(1, 0), b3, voffB); PG8_STAGE(PG8_SB(1, 1), b3 + hstep, voffB); PG8_STAGE(PG8_SA(1, 0), a3, voffA);
            PG8_WAIT_V(8); PG8_WAIT_L(0); PG8_BAR; PG8_MMA(1, 0, At, B0); PG8_MMA(1, 1, At, B1); PG8_BAR; PG8_SCHED;
            } else {
            PG8_LDB(B0, 0, 0); PG8_SCHED; PG8_LDA(At, 0, 0); PG8_STAGE(PG8_SA(1, 1), a1 + hstep, voffA);
            PG8_WAIT_L(8); PG8_BAR; PG8_WAIT_L(0); PG8_MMA(0, 0, At, B0); PG8_BAR; PG8_SCHED;
            PG8_LDB(B1, 0, 1); PG8_STAGE(PG8_SB(0, 0), b2, voffB);
            PG8_BAR; PG8_WAIT_L(0); PG8_MMA(0, 1, At, B1); PG8_BAR;
            PG8_LDA(At, 0, 1); PG8_STAGE(PG8_SA(0, 0), a2, voffA);
            PG8_BAR; PG8_WAIT_L(0); PG8_MMA(1, 0, At, B0); PG8_BAR; PG8_SCHED;
            PG8_STAGE(PG8_SB(0, 1), b2 + hstep, voffB);
            PG8_WAIT_V(6); PG8_BAR; PG8_MMA(1, 1, At, B1); PG8_BAR;
            PG8_LDB(B0, 1, 0); PG8_SCHED; PG8_LDA(At, 1, 0); PG8_STAGE(PG8_SA(0, 1), a2 + hstep, voffA);
            PG8_WAIT_L(8); PG8_BAR; PG8_WAIT_L(0); PG8_MMA(0, 0, At, B0); PG8_BAR; PG8_SCHED;
            PG8_LDB(B1, 1, 1); PG8_STAGE(PG8_SB(1, 0), b3, voffB);
            PG8_BAR; PG8_WAIT_L(0); PG8_MMA(0, 1, At, B1); PG8_BAR;
            PG8_LDA(At, 1, 1); PG8_STAGE(PG8_SA(1, 0), a3, voffA);
            PG8_BAR; PG8_WAIT_L(0); PG8_MMA(1, 0, At, B0); PG8_BAR; PG8_SCHED;
            PG8_STAGE(PG8_SB(1, 1), b3 + hstep, voffB);
            PG8_WAIT_V(6); PG8_BAR; PG8_MMA(1, 1, At, B1); PG8_BAR;
            }
        }
        if constexpr (ALIGN_EPI) { if (wr == 0) PG8_BAR; }
        if constexpr (!Epi::AFTER_DRAIN) { E(acc, cur, wr, wc, fr, fq); S.done(cur); }
        if (!has_next) break;
#pragma unroll
        for (int a = 0; a < 2; ++a)
#pragma unroll
            for (int b = 0; b < 2; ++b)
#pragma unroll
                for (int m = 0; m < 4; ++m)
#pragma unroll
                    for (int n = 0; n < 2; ++n) acc[a][b][m][n] = (f32x4){0.f, 0.f, 0.f, 0.f};
        cur = nxt; cA = nA; cB = nB; ++ui;
        if constexpr (ALIGN_EPI) { if (wr == 1) PG8_BAR; }
    }
    PG8_WAIT_V(0);
    if constexpr (!ALIGN_EPI) { if (wr == 0) PG8_BAR; }
    PG8_BAR;
    if constexpr (Epi::AFTER_DRAIN) { E.fused(acc, cur, wr, wc, fr, fq, lds, wid, lane); S.done(cur); }
#undef PG8_SA
#undef PG8_SB
#undef PG8_STAGE
#undef PG8_LDA
#undef PG8_LDB
#undef PG8_MMA
#undef PG8_WAIT_V
#undef PG8_WAIT_L
#undef PG8_BAR
#undef PG8_SCHED
}
}
namespace hy {
using pg8::bf16_t; using pg8::f32x4; using pg8::u32x4; using pg8::bf16x8;
#define LAS __attribute__((address_space(3)))
constexpr int NB = 4, SEQ = 4096, DM = 1024, CTXL = 256;
constexpr int M_LAT = NB * SEQ, M_CTX = NB * CTXL, M_ALL = M_LAT + M_CTX;
constexpr int IN_COLS = 3104, NE = 16, CAP = 512, DE = 2816, NSLOT = NE * NB * CAP;
constexpr int PROJ_LD = 2304, PC_NAK = 0, PC_GK = 512, PC_NAQ = 768, PC_GQ = 1280, PC_GG = 1536, PC_AD = 2048;
constexpr int VT_LD = M_ALL;
constexpr float EPS = 1e-6f;
constexpr size_t MiB = 1u << 20;
constexpr size_t WS_MODP = 1 * MiB, WS_MOD = 3 * MiB, WS_WTIN = 4 * MiB, WS_WTV = 9 * MiB, WS_WTOUT = 11 * MiB, WS_AFF = 13 * MiB, WS_IDX = 14 * MiB, WS_GATE = 14 * MiB + 256 * 1024, WS_INV = 15 * MiB;
constexpr size_t WS_WTGU = 16 * MiB, WS_WTDN = 192 * MiB, WS_H = 280 * MiB, WS_PROJ = 314 * MiB, WS_VT = 391 * MiB, WS_OMIX = 425 * MiB, WS_MIX = 457 * MiB, WS_HID = 280 * MiB;
constexpr size_t WS_HF = 489 * MiB, WS_XS = 521 * MiB, WS_GLAT = 590 * MiB, WS_QF = 590 * MiB, WS_KF = 606 * MiB, WS_KFT = 622 * MiB, WS_AT = 639 * MiB, WS_SB = 640 * MiB, WS_END = 680 * MiB;
static_assert(WS_WTIN + (size_t)PROJ_LD * DM * 2 <= WS_WTV && WS_WTGU + (size_t)NE * 2 * DE * DM * 2 <= WS_WTDN && WS_WTDN + (size_t)NE * DM * DE * 2 <= WS_H, "ws map 1");
static_assert(WS_H + (size_t)M_ALL * DM * 2 <= WS_PROJ && WS_PROJ + (size_t)M_ALL * PROJ_LD * 2 <= WS_VT && WS_VT + (size_t)1024 * VT_LD * 2 <= WS_OMIX, "ws map 2");
static_assert(WS_HID + (size_t)NSLOT * DE * 2 <= WS_MIX && WS_XS + (size_t)NSLOT * DM * 2 <= WS_GLAT && WS_SB + (size_t)2 * NB * 4 * 64 * 128 * 64 * 2 <= WS_END && WS_KFT + (size_t)2 * 256 * M_ALL * 2 <= WS_AT, "ws map 3");

__device__ __forceinline__ float bf2f(bf16_t x) { return __uint_as_float((unsigned)x << 16); }
__device__ __forceinline__ unsigned f2bf(float f) { unsigned u = __float_as_uint(f); return (u + 0x7fffu + ((u >> 16) & 1u)) >> 16; }
__device__ __forceinline__ unsigned pk2(float lo, float hi) { return f2bf(lo) | (f2bf(hi) << 16); }
__device__ __forceinline__ float wave_sum(float v) {
#pragma unroll
    for (int o = 1; o < 64; o <<= 1) v += __shfl_xor(v, o);
    return v;
}
__device__ __forceinline__ float silu_f(float x) { return x / (1.f + __expf(-x)); }

__device__ __forceinline__ void ph_mod_partial(const float* __restrict__ c, const float* __restrict__ c_ctx, const float* __restrict__ w_mod, float* __restrict__ part, LAS unsigned char* lds, int bid, int G) {
  const int half = threadIdx.x >> 8, tx = threadIdx.x & 255;
  LAS float (*s)[64] = (LAS float (*)[64])(lds + half * 5 * 64 * 4);
  for (int vb0 = bid * 2; vb0 < 384; vb0 += 2 * G) {
    const int vb = vb0 + half; const bool act = vb < 384;
    const int ks = vb / 24, j = (vb % 24) * 256 + tx;
    __syncthreads();
    if (act) for (int i = tx; i < 5 * 64; i += 256) { const int v = i / 64, k = ks * 64 + (i % 64); const float x = v < 4 ? c[v * 1024 + k] : c_ctx[k]; s[v][i % 64] = x / (1.f + expf(-x)); }
    __syncthreads();
    if (!act) continue;
    float acc[5] = {0.f, 0.f, 0.f, 0.f, 0.f};
#pragma unroll 8
    for (int k = 0; k < 64; ++k) { const float w = w_mod[(size_t)(ks * 64 + k) * 6144 + j];
#pragma unroll
        for (int v = 0; v < 5; ++v) acc[v] += s[v][k] * w; }
#pragma unroll
    for (int v = 0; v < 5; ++v) part[(size_t)(ks * 5 + v) * 6144 + j] = acc[v];
  }
}
__device__ __forceinline__ void ph_mod_final(const float* __restrict__ part, const float* __restrict__ b_mod, float* __restrict__ mod, int bid, int G) {
  for (int i = bid * 512 + threadIdx.x; i < 5 * 6144; i += G * 512) { const int v = i / 6144, j = i % 6144;
    float a = b_mod[j];
    for (int ks = 0; ks < 16; ++ks) a += part[(size_t)(ks * 5 + v) * 6144 + j];
    mod[i] = a; }
}

__device__ __forceinline__ void transpose_item(const float* __restrict__ W, int N, int k0, int n0, bf16_t* dst, int K, float scale, LAS float* scr, int lane) {
#pragma unroll 8
    for (int i = 0; i < 32; ++i) { const int kk = 2 * i + (lane >> 5); scr[kk * 33 + (lane & 31)] = W[(size_t)(k0 + kk) * N + n0 + (lane & 31)]; }
    asm volatile("s_waitcnt lgkmcnt(0)" ::: "memory");
    const int c = lane & 7;
#pragma unroll
    for (int j = 0; j < 4; ++j) { const int n = (lane >> 3) + 8 * j; const LAS float* s = scr + (8 * c) * 33 + n;
        u32x4 o; o.x = pk2(s[0 * 33] * scale, s[1 * 33] * scale); o.y = pk2(s[2 * 33] * scale, s[3 * 33] * scale); o.z = pk2(s[4 * 33] * scale, s[5 * 33] * scale); o.w = pk2(s[6 * 33] * scale, s[7 * 33] * scale);
        *(u32x4*)(dst + (size_t)n * K + k0 + 8 * c) = o; }
    asm volatile("s_waitcnt lgkmcnt(0)" ::: "memory");
}
struct PrepArgs { const float *x, *ctx, *g_pre, *mod, *w_in, *w_out, *w_gate, *w_up, *w_down; bf16_t *WTIN, *WTV, *WTOUT, *WTGU, *WTDN, *H; };
constexpr int IT_IN = 16 * 97, IT_OUT = 16 * 32, IT_GU1 = 16 * 16 * 88, IT_DN = 16 * 44 * 32, IT_ALL = IT_IN + IT_OUT + 2 * IT_GU1 + IT_DN;
__device__ __forceinline__ void ph_prep(const PrepArgs& a, LAS unsigned char* lds, int bid, int G) {
    const int tid = threadIdx.x, lane = tid & 63, wave = tid >> 6;
    LAS float* scr = (LAS float*)(lds + wave * 8448);
    const int gw = bid * 8 + wave, NGW = G * 8;
    { u32x4* z = (u32x4*)(a.WTIN + (size_t)(PC_AD + 32) * DM); const int nz = (PROJ_LD - PC_AD - 32) * DM * 2 / 16;
      for (int i = bid * 512 + tid; i < nz; i += G * 512) z[i] = (u32x4){0u, 0u, 0u, 0u}; }
    for (int m = gw; m < M_ALL; m += NGW) {
        const float* src; int v;
        if (m < M_LAT) { src = a.x + (size_t)m * DM; v = m / SEQ; } else { src = a.ctx + (size_t)(m - M_LAT) * DM; v = 4; }
        const f32x4* xr = (const f32x4*)src + lane; f32x4 xv[4]; float ss = 0.f;
#pragma unroll
        for (int j = 0; j < 4; ++j) { xv[j] = xr[64 * j]; ss += (xv[j].x * xv[j].x + xv[j].y * xv[j].y) + (xv[j].z * xv[j].z + xv[j].w * xv[j].w); }
        const float rstd = rsqrtf(wave_sum(ss) * (1.f / DM) + EPS);
        const float* mv = a.mod + (size_t)v * 6144;
        unsigned long long* o8 = (unsigned long long*)(a.H + (size_t)m * DM) + lane;
#pragma unroll
        for (int j = 0; j < 4; ++j) { const int col = 4 * lane + 256 * j;
            const f32x4 g = *(const f32x4*)(a.g_pre + col), sh = *(const f32x4*)(mv + col), sc = *(const f32x4*)(mv + 1024 + col);
            const f32x4 hv = xv[j] * rstd * g * (sc + 1.f) + sh;
            o8[64 * j] = (unsigned long long)pk2(hv.x, hv.y) | ((unsigned long long)pk2(hv.z, hv.w) << 32); }
    }
    for (int it = gw; it < IT_ALL; it += NGW) {
        int r = it;
        if (r < IT_IN) { const int kb = r / 97, n0 = (r % 97) * 32; bf16_t* dst; float sc = 1.f;
            if (n0 < 512) dst = a.WTIN + (size_t)(PC_NAK + n0) * DM;
            else if (n0 < 1024) dst = a.WTV + (size_t)(n0 - 512) * DM;
            else if (n0 < 1280) dst = a.WTIN + (size_t)(PC_GK + n0 - 1024) * DM;
            else if (n0 < 1792) dst = a.WTV + (size_t)(512 + n0 - 1280) * DM;
            else if (n0 < 1824) dst = a.WTIN + (size_t)(PC_AD + n0 - 1792) * DM;
            else if (n0 < 2336) { dst = a.WTIN + (size_t)(PC_NAQ + n0 - 1824) * DM; sc = 0.125f; }
            else if (n0 < 2592) { dst = a.WTIN + (size_t)(PC_GQ + n0 - 2336) * DM; sc = 0.125f; }
            else dst = a.WTIN + (size_t)(PC_GG + n0 - 2592) * DM;
            transpose_item(a.w_in, IN_COLS, kb * 64, n0, dst, DM, sc, scr, lane); continue; }
        r -= IT_IN;
        if (r < IT_OUT) { const int kb = r / 32, n0 = (r % 32) * 32; transpose_item(a.w_out, DM, kb * 64, n0, a.WTOUT + (size_t)n0 * DM, DM, 1.f, scr, lane); continue; }
        r -= IT_OUT;
        if (r < 2 * IT_GU1) { const int which = r / IT_GU1; r %= IT_GU1; const int e = r / (16 * 88); r %= (16 * 88); const int kb = r / 88, n0 = (r % 88) * 32;
            const float* W = (which ? a.w_up : a.w_gate) + (size_t)e * DM * DE;
            bf16_t* dst = a.WTGU + ((size_t)e * 2 * DE + (n0 / 128) * 256 + (n0 % 128) + which * 128) * DM;
            transpose_item(W, DE, kb * 64, n0, dst, DM, 1.f, scr, lane); continue; }
        r -= 2 * IT_GU1;
        { const int e = r / (44 * 32); r %= (44 * 32); const int kb = r / 32, n0 = (r % 32) * 32;
          transpose_item(a.w_down + (size_t)e * DE * DM, DM, kb * 64, n0, a.WTDN + ((size_t)e * DM + n0) * DE, DE, 1.f, scr, lane); }
    }
}

struct EpiSwiGLU {
    static constexpr bool PERM = true, AFTER_DRAIN = false;
    bf16_t* O; int ldc;
    __device__ __forceinline__ void operator()(const f32x4 (&acc)[2][2][4][2], const pg8::Unit& u, int wr, int wc, int fr, int fq) const {
        const int row0 = u.pm * 256 + wr * 64 + fr, col0 = u.pn * 128 + wc * 32 + 8 * fq;
#pragma unroll
        for (int ai = 0; ai < 2; ++ai)
#pragma unroll
            for (int m = 0; m < 4; ++m) { bf16_t* rowp = O + (size_t)(row0 + ai * 128 + m * 16) * ldc + col0;
                const f32x4 g0 = acc[ai][0][m][0], g1 = acc[ai][0][m][1], u0 = acc[ai][1][m][0], u1 = acc[ai][1][m][1];
                u32x4 w; w.x = pg8::cvt_pk_bf16(silu_f(g0[0]) * u0[0], silu_f(g0[1]) * u0[1]); w.y = pg8::cvt_pk_bf16(silu_f(g0[2]) * u0[2], silu_f(g0[3]) * u0[3]);
                w.z = pg8::cvt_pk_bf16(silu_f(g1[0]) * u1[0], silu_f(g1[1]) * u1[1]); w.w = pg8::cvt_pk_bf16(silu_f(g1[2]) * u1[2], silu_f(g1[3]) * u1[3]);
                *(u32x4*)rowp = w; }
    }
};
struct EpiRowScale {
    static constexpr bool PERM = true, AFTER_DRAIN = false;
    bf16_t* O; int ldc; const float* rowscale;
    __device__ __forceinline__ void operator()(const f32x4 (&acc)[2][2][4][2], const pg8::Unit& u, int wr, int wc, int fr, int fq) const {
        const int row0 = u.pm * 256 + wr * 64 + fr, col0 = u.pn * 256 + wc * 32 + 8 * fq;
#pragma unroll
        for (int ai = 0; ai < 2; ++ai)
#pragma unroll
            for (int m = 0; m < 4; ++m) { const int row = row0 + ai * 128 + m * 16; const float sc = rowscale[row]; bf16_t* rowp = O + (size_t)row * ldc + col0;
#pragma unroll
                for (int bj = 0; bj < 2; ++bj) { const f32x4 v0 = acc[ai][bj][m][0] * sc, v1 = acc[ai][bj][m][1] * sc;
                    u32x4 w; w.x = pg8::cvt_pk_bf16(v0[0], v0[1]); w.y = pg8::cvt_pk_bf16(v0[2], v0[3]); w.z = pg8::cvt_pk_bf16(v1[0], v1[1]); w.w = pg8::cvt_pk_bf16(v1[2], v1[3]);
                    *(u32x4*)(rowp + bj * 128) = w; } }
    }
};
struct ExpertOrder {
    int nT, G, c;
    __device__ __forceinline__ bool next(int i, pg8::Unit& u) const {
        if (G == 256) { if (2 * i >= nT) return false; const int x = c & 7, j = c >> 3, e = 2 * x + (j >> 4), mt = j & 7, pn = 2 * i + ((j >> 3) & 1);
            u.pm = e * 8 + mt; u.pn = pn; u.bt = e * nT + pn; return true; }
        const long L = (long)i * G + c; if (L >= (long)128 * nT) return false;
        const int e = (int)(L / (8 * nT)), r = (int)(L % (8 * nT)); u.pm = e * 8 + (r % 8); u.pn = r / 8; u.bt = e * nT + u.pn; return true;
    }
    __device__ __forceinline__ void a_ready(const pg8::Unit&) const {}
    __device__ __forceinline__ void done(const pg8::Unit&) const {}
};
__device__ __forceinline__ void ph_na_naive(const bf16_t* __restrict__ PROJ, const bf16_t* __restrict__ VT, const float* __restrict__ rpb, bf16_t* __restrict__ OMIX, int bid, int G) {
  for (int vb = bid * 8 + (threadIdx.x >> 6); vb < NB * 8 * 64; vb += G * 8) {
    const int r = vb % 64, h = (vb / 64) % 8, b = vb / 512, c = threadIdx.x & 63;
    const size_t mq = (size_t)b * SEQ + r * 64 + c;
    float q[64], acc[64];
    { const u32x4* qp = (const u32x4*)(PROJ + mq * PROJ_LD + PC_NAQ + h * 64);
#pragma unroll
      for (int i = 0; i < 8; ++i) { const u32x4 w = qp[i]; q[8 * i + 0] = __uint_as_float(w.x << 16); q[8 * i + 1] = __uint_as_float(w.x & 0xffff0000u); q[8 * i + 2] = __uint_as_float(w.y << 16); q[8 * i + 3] = __uint_as_float(w.y & 0xffff0000u);
          q[8 * i + 4] = __uint_as_float(w.z << 16); q[8 * i + 5] = __uint_as_float(w.z & 0xffff0000u); q[8 * i + 6] = __uint_as_float(w.w << 16); q[8 * i + 7] = __uint_as_float(w.w & 0xffff0000u); } }
#pragma unroll
    for (int d = 0; d < 64; ++d) acc[d] = 0.f;
    float mx = -INFINITY, l = 0.f;
    const int rs = min(max(r - 4, 0), 56), cs = min(max(c - 8, 0), 48);
    for (int kk = 0; kk < 128 + CTXL; ++kk) {
        size_t mk; float bias = 0.f;
        if (kk < 128) { const int krow = rs + (kk >> 4), kcol = cs + (kk & 15); mk = (size_t)b * SEQ + krow * 64 + kcol; bias = rpb[(h * 15 + (krow - r + 7)) * 31 + (kcol - c + 15)]; }
        else mk = (size_t)M_LAT + b * CTXL + (kk - 128);
        const u32x4* kp = (const u32x4*)(PROJ + mk * PROJ_LD + PC_NAK + h * 64);
        float s = 0.f;
#pragma unroll
        for (int i = 0; i < 8; ++i) { const u32x4 w = kp[i];
            s += q[8 * i + 0] * __uint_as_float(w.x << 16) + q[8 * i + 1] * __uint_as_float(w.x & 0xffff0000u) + q[8 * i + 2] * __uint_as_float(w.y << 16) + q[8 * i + 3] * __uint_as_float(w.y & 0xffff0000u)
               + q[8 * i + 4] * __uint_as_float(w.z << 16) + q[8 * i + 5] * __uint_as_float(w.z & 0xffff0000u) + q[8 * i + 6] * __uint_as_float(w.w << 16) + q[8 * i + 7] * __uint_as_float(w.w & 0xffff0000u); }
        s += bias;
        const float mn = fmaxf(mx, s), al = __expf(mx - mn), p = __expf(s - mn);
        l = l * al + p; mx = mn;
        const bf16_t* vp = VT + (size_t)(h * 64) * VT_LD + mk;
#pragma unroll
        for (int d = 0; d < 64; ++d) acc[d] = acc[d] * al + p * bf2f(vp[(size_t)d * VT_LD]);
    }
    const float inv = 1.f / l;
    unsigned* op = (unsigned*)(OMIX + mq * DM + h * 64);
#pragma unroll
    for (int i = 0; i < 32; ++i) op[i] = pk2(acc[2 * i] * inv, acc[2 * i + 1] * inv);
  }
}

__device__ __forceinline__ f32x4 mfma16(bf16x8 a, bf16x8 b, f32x4 c) { return __builtin_amdgcn_mfma_f32_16x16x32_bf16(a, b, c, 0, 0, 0); }
__device__ __forceinline__ void na_unit(int u, const bf16_t* __restrict__ PROJ, const bf16_t* __restrict__ VT, const LAS float* rb, bf16_t* __restrict__ OMIX, int lane) {
    const int q = lane & 15, g = lane >> 4;
    const int bh = u >> 8, b = bh >> 3, h = bh & 7, r = (u & 255) >> 2, qt = u & 3;
    const int c0 = (qt == 0) ? 0 : (qt == 3 ? 32 : 16 * qt - 8);
    const int rs = min(max(r - 4, 0), 56);
    const int cq = 16 * qt + q, cs = min(max(cq - 8, 0), 48);
    const size_t mq = (size_t)b * SEQ + r * 64 + cq;
    const bf16_t* qp = PROJ + mq * PROJ_LD + PC_NAQ + h * 64 + 8 * g;
    const bf16x8 qf0 = *(const bf16x8*)qp, qf1 = *(const bf16x8*)(qp + 32);
    const bf16_t* kbase = PROJ + PC_NAK + h * 64 + 8 * g;
    f32x4 S[32];
#pragma unroll
    for (int T = 0; T < 16; ++T) {
        const int kr = T >> 1, ct = T & 1;
        const bf16_t* kp = kbase + ((size_t)b * SEQ + (rs + kr) * 64 + c0 + 16 * ct + q) * PROJ_LD;
        f32x4 acc = (f32x4){0.f, 0.f, 0.f, 0.f};
        acc = mfma16(*(const bf16x8*)kp, qf0, acc); acc = mfma16(*(const bf16x8*)(kp + 32), qf1, acc);
        const LAS float* rbr = rb + (h * 15 + (rs + kr - r + 7)) * 31;
#pragma unroll
        for (int i = 0; i < 4; ++i) { const int kcol = c0 + 16 * ct + 4 * g + i; const bool valid = (kcol >= cs) && (kcol < cs + 16);
            const float bias = rbr[min(max(kcol - cq + 15, 0), 30)];
            acc[i] = valid ? acc[i] + bias : -INFINITY; }
        S[T] = acc;
    }
#pragma unroll
    for (int T = 0; T < 16; ++T) {
        const bf16_t* kp = kbase + ((size_t)M_LAT + b * CTXL + 16 * T + q) * PROJ_LD;
        f32x4 acc = (f32x4){0.f, 0.f, 0.f, 0.f};
        acc = mfma16(*(const bf16x8*)kp, qf0, acc); acc = mfma16(*(const bf16x8*)(kp + 32), qf1, acc);
        S[16 + T] = acc;
    }
    float mx = -INFINITY;
#pragma unroll
    for (int T = 0; T < 32; ++T) mx = fmaxf(fmaxf(mx, fmaxf(S[T][0], S[T][1])), fmaxf(S[T][2], S[T][3]));
    mx = fmaxf(mx, __shfl_xor(mx, 16)); mx = fmaxf(mx, __shfl_xor(mx, 32));
    float l = 0.f;
#pragma unroll
    for (int T = 0; T < 32; ++T) {
#pragma unroll
        for (int i = 0; i < 4; ++i) { const float p = __expf(S[T][i] - mx); S[T][i] = p; l += p; } }
    l += __shfl_xor(l, 16); l += __shfl_xor(l, 32);
    f32x4 O[4];
#pragma unroll
    for (int dt = 0; dt < 4; ++dt) O[dt] = (f32x4){0.f, 0.f, 0.f, 0.f};
#pragma unroll
    for (int p = 0; p < 16; ++p) {
        u32x4 pw; pw.x = pg8::cvt_pk_bf16(S[2 * p][0], S[2 * p][1]); pw.y = pg8::cvt_pk_bf16(S[2 * p][2], S[2 * p][3]); pw.z = pg8::cvt_pk_bf16(S[2 * p + 1][0], S[2 * p + 1][1]); pw.w = pg8::cvt_pk_bf16(S[2 * p + 1][2], S[2 * p + 1][3]);
        const bf16x8 pb = __builtin_bit_cast(bf16x8, pw);
        const size_t mb = (p < 8) ? ((size_t)b * SEQ + (rs + p) * 64 + c0) : ((size_t)M_LAT + b * CTXL + 32 * (p - 8));
#pragma unroll
        for (int dt = 0; dt < 4; ++dt) {
            const bf16_t* vp = VT + (size_t)(h * 64 + dt * 16 + q) * VT_LD + mb + 4 * g;
            const uint2 lo = *(const uint2*)vp, hi = *(const uint2*)(vp + 16);
            const u32x4 vw = (u32x4){lo.x, lo.y, hi.x, hi.y};
            O[dt] = mfma16(__builtin_bit_cast(bf16x8, vw), pb, O[dt]); }
    }
    const float inv = 1.f / l;
    bf16_t* op = OMIX + mq * DM + h * 64 + 4 * g;
#pragma unroll
    for (int dt = 0; dt < 4; ++dt) { uint2 w; w.x = pg8::cvt_pk_bf16(O[dt][0] * inv, O[dt][1] * inv); w.y = pg8::cvt_pk_bf16(O[dt][2] * inv, O[dt][3] * inv); *(uint2*)(op + dt * 16) = w; }
}
__device__ __forceinline__ void ph_na(const bf16_t* __restrict__ PROJ, const bf16_t* __restrict__ VT, const float* __restrict__ rpb, bf16_t* __restrict__ OMIX, LAS unsigned char* lds, int bid, int G) {
    LAS float* rb = (LAS float*)lds;
    __syncthreads();
    for (int i = threadIdx.x; i < 8 * 15 * 31; i += 512) rb[i] = rpb[i];
    __syncthreads();
    const int lane = threadIdx.x & 63, wave = threadIdx.x >> 6;
    for (int u = bid * 8 + wave; u < NB * 8 * 64 * 4; u += G * 8) na_unit(u, PROJ, VT, rb, OMIX, lane);
}

typedef float f32x16 __attribute__((ext_vector_type(16)));
__device__ __forceinline__ f32x16 mfma32(bf16x8 a, bf16x8 b, f32x16 c) { return __builtin_amdgcn_mfma_f32_32x32x16_bf16(a, b, c, 0, 0, 0); }
constexpr int NCHUNK = 272;
__device__ __forceinline__ float logsig16(float z) { return (fminf(z, 0.f) - log1pf(__expf(-fabsf(z)))) * (1.f / 16.f); }
__device__ __forceinline__ void ph_gla_prep2(const bf16_t* __restrict__ PROJ, const float* __restrict__ a_up, const float* __restrict__ a_bias, bf16_t* __restrict__ QF, bf16_t* __restrict__ KF, bf16_t* __restrict__ KFT, float* __restrict__ AT,
                                             LAS unsigned char* lds, int bid, int G) {
    LAS float* tab = (LAS float*)lds;
    __syncthreads();
    for (int i = threadIdx.x; i < 1024; i += 512) { const int pos = i >> 4, fi = i & 15; const float ang = (float)pos * powf(10000.f, -(float)fi / 16.f); tab[2 * i] = cosf(ang); tab[2 * i + 1] = sinf(ang); }
    __syncthreads();
    const int lane = threadIdx.x & 63, wave = threadIdx.x >> 6, d = lane;
    for (int u = bid * 8 + wave; u < NCHUNK * 4 * 2; u += G * 8) {
        const int uu = __builtin_amdgcn_readfirstlane(u);
        const int dir = uu & 1, h = (uu >> 1) & 3, ci = uu >> 3;
        const bool lat = ci < 256;
        const int crow = ci & 63;
        const int m0 = lat ? ((ci >> 6) * SEQ + crow * 64) : (M_LAT + (ci - 256) * 64);
        float up[16];
#pragma unroll
        for (int r = 0; r < 16; ++r) up[r] = a_up[(dir * 16 + r) * 256 + h * 64 + d];
        const float zb = a_bias[dir * 256 + h * 64 + d];
        float tot = 0.f;
        for (int t = 0; t < 64; ++t) {
            const unsigned* ad = (const unsigned*)(PROJ + (size_t)(m0 + t) * PROJ_LD + PC_AD + dir * 16);
            float z = zb;
#pragma unroll
            for (int r = 0; r < 8; ++r) { const unsigned w = ad[r]; z += __uint_as_float(w << 16) * up[2 * r] + __uint_as_float(w & 0xffff0000u) * up[2 * r + 1]; }
            tot += logsig16(z);
        }
        AT[((size_t)dir * NCHUNK + ci) * 256 + h * 64 + d] = __expf(tot);
        const int seg = d >> 5, fi = d & 15; const bool lower = (d & 31) < 16;
        float run = 0.f;
        unsigned pk[4];
        for (int t8 = 0; t8 < 8; ++t8) {
#pragma unroll
            for (int tt = 0; tt < 8; ++tt) {
                const int t = t8 * 8 + tt; const size_t m = (size_t)(m0 + t);
                const unsigned* ad = (const unsigned*)(PROJ + m * PROJ_LD + PC_AD + dir * 16);
                float z = zb;
#pragma unroll
                for (int r = 0; r < 8; ++r) { const unsigned w = ad[r]; z += __uint_as_float(w << 16) * up[2 * r] + __uint_as_float(w & 0xffff0000u) * up[2 * r + 1]; }
                const float la = logsig16(z);
                const float lam = dir ? (tot - run) : (run + la);
                run += la;
                float kv = bf2f(PROJ[m * PROJ_LD + PC_GK + h * 64 + d]);
                if (lat) {
                    float qv = bf2f(PROJ[m * PROJ_LD + PC_GQ + h * 64 + d]);
                    const int pos = seg ? t : crow; const float cs = tab[2 * (pos * 16 + fi)], sn = tab[2 * (pos * 16 + fi) + 1];
                    const float kp = __shfl_xor(kv, 16), qp = __shfl_xor(qv, 16);
                    if (lower) { kv = kv * cs - kp * sn; qv = qv * cs - qp * sn; } else { kv = kp * sn + kv * cs; qv = qp * sn + qv * cs; }
                    QF[((size_t)dir * M_LAT + m) * 256 + h * 64 + d] = (bf16_t)f2bf(qv * __expf(lam));
                }
                const float kf = kv * __expf(-lam);
                const unsigned kb = f2bf(kf);
                if (lat) KF[((size_t)dir * M_LAT + m) * 256 + h * 64 + d] = (bf16_t)kb;
                if (tt & 1) pk[tt >> 1] |= kb << 16; else pk[tt >> 1] = kb;
            }
            *(u32x4*)(KFT + ((size_t)dir * 256 + h * 64 + d) * M_ALL + m0 + t8 * 8) = (u32x4){pk[0], pk[1], pk[2], pk[3]};
        }
    }
}
constexpr size_t SB_CH = 128 * 64;
__device__ __forceinline__ void gla_state_unit(int u, const bf16_t* __restrict__ KFT, const bf16_t* __restrict__ VT, const float* __restrict__ AT, bf16_t* __restrict__ SB, int lane) {
    const int es = u & 3, dir = (u >> 2) & 1, h = (u >> 3) & 3, b = u >> 5;
    const int l31 = lane & 31, hh = lane >> 5;
    f32x16 acc[2];
#pragma unroll
    for (int dt = 0; dt < 2; ++dt)
#pragma unroll
        for (int i = 0; i < 16; ++i) acc[dt][i] = 0.f;
    const bf16_t* kft0 = KFT + ((size_t)dir * 256 + h * 64 + l31) * M_ALL + 8 * hh;
    const bf16_t* vt0 = VT + (size_t)(512 + h * 128 + es * 32 + l31) * VT_LD + 8 * hh;
    bf16_t* sb0 = SB + ((size_t)((dir * NB + b) * 4 + h) * 64) * SB_CH + (size_t)(es * 32 + l31) * 64 + 4 * hh;
    for (int s = 0; s < 68; ++s) {
        int ci, m0, c = 0;
        if (s < 4) { const int cc = dir ? 3 - s : s; ci = 256 + b * 4 + cc; m0 = M_LAT + b * CTXL + cc * 64; }
        else { c = dir ? 67 - s : s - 4; ci = b * 64 + c; m0 = b * SEQ + c * 64; }
        bf16x8 af[2][4], bfr[4]; f32x4 av[2][4];
#pragma unroll
        for (int ks = 0; ks < 4; ++ks) { bfr[ks] = *(const bf16x8*)(vt0 + m0 + 16 * ks);
#pragma unroll
            for (int dt = 0; dt < 2; ++dt) af[dt][ks] = *(const bf16x8*)(kft0 + (size_t)dt * 32 * M_ALL + m0 + 16 * ks); }
#pragma unroll
        for (int dt = 0; dt < 2; ++dt)
#pragma unroll
            for (int rr = 0; rr < 4; ++rr) av[dt][rr] = *(const f32x4*)(AT + ((size_t)dir * NCHUNK + ci) * 256 + h * 64 + dt * 32 + 8 * rr + 4 * hh);
        if (s >= 4) {
            bf16_t* sp = sb0 + (size_t)c * SB_CH;
#pragma unroll
            for (int dt = 0; dt < 2; ++dt)
#pragma unroll
                for (int rr = 0; rr < 4; ++rr) { uint2 w; w.x = pg8::cvt_pk_bf16(acc[dt][4 * rr], acc[dt][4 * rr + 1]); w.y = pg8::cvt_pk_bf16(acc[dt][4 * rr + 2], acc[dt][4 * rr + 3]); *(uint2*)(sp + dt * 32 + 8 * rr) = w; }
        }
#pragma unroll
        for (int dt = 0; dt < 2; ++dt) {
#pragma unroll
            for (int ks = 0; ks < 4; ++ks) acc[dt] = mfma32(af[dt][ks], bfr[ks], acc[dt]);
#pragma unroll
            for (int rr = 0; rr < 4; ++rr) { acc[dt][4 * rr] *= av[dt][rr][0]; acc[dt][4 * rr + 1] *= av[dt][rr][1]; acc[dt][4 * rr + 2] *= av[dt][rr][2]; acc[dt][4 * rr + 3] *= av[dt][rr][3]; }
        }
    }
}
__device__ __forceinline__ void gla_out_unit(int u, const bf16_t* __restrict__ PROJ, const bf16_t* __restrict__ QF, const bf16_t* __restrict__ KF, const bf16_t* __restrict__ VT, const bf16_t* __restrict__ SB, const float* __restrict__ gnorm,
                                             bf16_t* __restrict__ OMIX, int lane) {
    const int it = u & 1, c = (u >> 1) & 63, h = (u >> 7) & 3, b = u >> 9;
    const int l31 = lane & 31, hh = lane >> 5;
    const int m0 = b * SEQ + c * 64;
    f32x16 o[4];
#pragma unroll
    for (int et = 0; et < 4; ++et)
#pragma unroll
        for (int i = 0; i < 16; ++i) o[et][i] = 0.f;
#pragma unroll
    for (int dir = 0; dir < 2; ++dir) {
        bf16x8 qf[4];
        const bf16_t* qp = QF + ((size_t)dir * M_LAT + m0 + 32 * it + l31) * 256 + h * 64 + 8 * hh;
#pragma unroll
        for (int ks = 0; ks < 4; ++ks) qf[ks] = *(const bf16x8*)(qp + 16 * ks);
#pragma unroll
        for (int jt = 0; jt < 2; ++jt) {
            const bool need = dir ? (jt >= it) : (jt <= it);
            if (!need) continue;
            f32x16 X;
#pragma unroll
            for (int i = 0; i < 16; ++i) X[i] = 0.f;
            const bf16_t* kp = KF + ((size_t)dir * M_LAT + m0 + 32 * jt + l31) * 256 + h * 64 + 8 * hh;
#pragma unroll
            for (int ks = 0; ks < 4; ++ks) X = mfma32(*(const bf16x8*)(kp + 16 * ks), qf[ks], X);
            if (jt == it) {
#pragma unroll
                for (int i = 0; i < 16; ++i) { const int jr = (i & 3) + 8 * (i >> 2) + 4 * hh; const bool keep = dir ? (jr >= l31) : (jr <= l31); X[i] = keep ? X[i] : 0.f; }
            }
#pragma unroll
            for (int s = 0; s < 2; ++s) {
                u32x4 xw; xw.x = pg8::cvt_pk_bf16(X[8 * s], X[8 * s + 1]); xw.y = pg8::cvt_pk_bf16(X[8 * s + 2], X[8 * s + 3]); xw.z = pg8::cvt_pk_bf16(X[8 * s + 4], X[8 * s + 5]); xw.w = pg8::cvt_pk_bf16(X[8 * s + 6], X[8 * s + 7]);
                const bf16x8 xa = __builtin_bit_cast(bf16x8, xw);
#pragma unroll
                for (int et = 0; et < 4; ++et) {
                    const bf16_t* vp = VT + (size_t)(512 + h * 128 + et * 32 + l31) * VT_LD + m0 + 32 * jt + 16 * s + 4 * hh;
                    const uint2 lo = *(const uint2*)vp, hi = *(const uint2*)(vp + 8);
                    const u32x4 vw = (u32x4){lo.x, lo.y, hi.x, hi.y};
                    o[et] = mfma32(xa, __builtin_bit_cast(bf16x8, vw), o[et]); }
            }
        }
        const bf16_t* sp = SB + ((size_t)(((dir * NB + b) * 4 + h) * 64 + c)) * SB_CH + (size_t)l31 * 64 + 8 * hh;
#pragma unroll
        for (int et = 0; et < 4; ++et)
#pragma unroll
            for (int ks = 0; ks < 4; ++ks) o[et] = mfma32(qf[ks], *(const bf16x8*)(sp + (size_t)et * 32 * 64 + 16 * ks), o[et]);
    }
    float ss[16];
#pragma unroll
    for (int i = 0; i < 16; ++i) { float a = 0.f;
#pragma unroll
        for (int et = 0; et < 4; ++et) a += o[et][i] * o[et][i];
        a += __shfl_xor(a, 1); a += __shfl_xor(a, 2); a += __shfl_xor(a, 4); a += __shfl_xor(a, 8); a += __shfl_xor(a, 16);
        ss[i] = rsqrtf(a * (1.f / 128.f) + EPS); }
#pragma unroll
    for (int et = 0; et < 4; ++et) { const float gn = gnorm[et * 32 + l31];
#pragma unroll
        for (int i = 0; i < 16; ++i) { const size_t m = (size_t)(m0 + 32 * it + (i & 3) + 8 * (i >> 2) + 4 * hh);
            const float g = bf2f(PROJ[m * PROJ_LD + PC_GG + h * 128 + et * 32 + l31]);
            OMIX[m * DM + 512 + h * 128 + et * 32 + l31] = (bf16_t)f2bf(o[et][i] * ss[i] * gn * silu_f(g)); } }
}
__device__ __forceinline__ void ph_gla_state(const bf16_t* KFT, const bf16_t* VT, const float* AT, bf16_t* SB, int bid, int G) {
    const int lane = threadIdx.x & 63, wave = threadIdx.x >> 6;
    for (int u = wave * G + bid; u < NB * 4 * 2 * 4; u += 8 * G) gla_state_unit(u, KFT, VT, AT, SB, lane);
}
__device__ __forceinline__ void ph_gla_out(const bf16_t* PROJ, const bf16_t* QF, const bf16_t* KF, const bf16_t* VT, const bf16_t* SB, const float* gnorm, bf16_t* OMIX, int bid, int G) {
    const int lane = threadIdx.x & 63, wave = threadIdx.x >> 6;
    for (int u = bid * 8 + wave; u < NB * 4 * 64 * 2; u += G * 8) gla_out_unit(u, PROJ, QF, KF, VT, SB, gnorm, OMIX, lane);
}

__device__ __forceinline__ void ph_post_mix(const float* __restrict__ x, const bf16_t* __restrict__ MIX, const float* __restrict__ mod, const float* __restrict__ g_post, const float* __restrict__ g_fpre, const float* __restrict__ router,
                                                  float* __restrict__ xnew, bf16_t* __restrict__ HF, float* __restrict__ aff, LAS unsigned char* lds, int bid, int G) {
    LAS float* rt = (LAS float*)lds;
    __syncthreads();
    for (int i = threadIdx.x; i < DM * NE; i += 512) rt[(i % NE) * DM + (i / NE)] = router[i];
    __syncthreads();
    const int lane = threadIdx.x & 63, wave = threadIdx.x >> 6;
    for (int m = bid * 8 + wave; m < M_LAT; m += G * 8) {
        const int b = m / SEQ, t = m % SEQ; const float* mv = mod + (size_t)b * 6144;
        f32x4 mx[4]; float ss = 0.f;
        const unsigned long long* mp = (const unsigned long long*)(MIX + (size_t)m * DM) + lane;
#pragma unroll
        for (int j = 0; j < 4; ++j) { const unsigned long long w = mp[64 * j]; const unsigned lo = (unsigned)w, hi = (unsigned)(w >> 32);
            mx[j] = (f32x4){__uint_as_float(lo << 16), __uint_as_float(lo & 0xffff0000u), __uint_as_float(hi << 16), __uint_as_float(hi & 0xffff0000u)};
            ss += (mx[j].x * mx[j].x + mx[j].y * mx[j].y) + (mx[j].z * mx[j].z + mx[j].w * mx[j].w); }
        const float rstd = rsqrtf(wave_sum(ss) * (1.f / DM) + EPS);
        f32x4 xn[4]; float s2 = 0.f;
#pragma unroll
        for (int j = 0; j < 4; ++j) { const int col = 4 * lane + 256 * j;
            const f32x4 xv = *(const f32x4*)(x + (size_t)m * DM + col), gp = *(const f32x4*)(g_post + col), gm = *(const f32x4*)(mv + 2048 + col);
            xn[j] = xv + gm * (mx[j] * rstd * gp);
            *(f32x4*)(xnew + (size_t)m * DM + col) = xn[j];
            s2 += (xn[j].x * xn[j].x + xn[j].y * xn[j].y) + (xn[j].z * xn[j].z + xn[j].w * xn[j].w); }
        const float rstd2 = rsqrtf(wave_sum(s2) * (1.f / DM) + EPS);
        f32x4 hv4[4];
        unsigned long long* hp = (unsigned long long*)(HF + (size_t)m * DM) + lane;
#pragma unroll
        for (int j = 0; j < 4; ++j) { const int col = 4 * lane + 256 * j;
            const f32x4 gf = *(const f32x4*)(g_fpre + col), sh = *(const f32x4*)(mv + 3072 + col), sc = *(const f32x4*)(mv + 4096 + col);
            hv4[j] = xn[j] * rstd2 * gf * (sc + 1.f) + sh;
            hp[64 * j] = (unsigned long long)pk2(hv4[j].x, hv4[j].y) | ((unsigned long long)pk2(hv4[j].z, hv4[j].w) << 32); }
        float lg[NE]; float mxl = -INFINITY;
#pragma unroll
        for (int e = 0; e < NE; ++e) { float sacc = 0.f;
#pragma unroll
            for (int j = 0; j < 4; ++j) { const f32x4 rv = *(const LAS f32x4*)(rt + e * DM + 4 * lane + 256 * j); sacc += (hv4[j].x * rv.x + hv4[j].y * rv.y) + (hv4[j].z * rv.z + hv4[j].w * rv.w); }
            lg[e] = wave_sum(sacc); mxl = fmaxf(mxl, lg[e]); asm volatile("" ::: "memory"); }
        float den = 0.f;
#pragma unroll
        for (int e = 0; e < NE; ++e) { lg[e] = expf(lg[e] - mxl); den += lg[e]; }
        const float rden = 1.f / den;
#pragma unroll
        for (int e = 0; e < NE; ++e) if (lane == e) aff[((size_t)b * NE + e) * SEQ + t] = lg[e] * rden;
    }
}

__device__ __forceinline__ int block_excl_scan(int v, LAS int* sm  , int& total) {
    const int lane = threadIdx.x & 63, w = threadIdx.x >> 6; int x = v;
#pragma unroll
    for (int o = 1; o < 64; o <<= 1) { const int y = __shfl_up(x, o); if (lane >= o) x += y; }
    __syncthreads();
    if (lane == 63) sm[w] = x;
    __syncthreads();
    int base = 0, tot = 0;
#pragma unroll
    for (int i = 0; i < 8; ++i) { const int s = sm[i]; if (i < w) base += s; tot += s; }
    total = tot;
    return base + x - v;
}
__device__ __forceinline__ void ph_topk(const float* __restrict__ aff, const bf16_t* __restrict__ HF, int* __restrict__ idx, float* __restrict__ gate, int* __restrict__ inv, bf16_t* __restrict__ XS, LAS unsigned char* lds, int bid, int G) {
  LAS int* hist = (LAS int*)lds; LAS int* sm = hist + 256; LAS unsigned* sp = (LAS unsigned*)(sm + 16); LAS int* srm = (LAS int*)(sp + 1); LAS int* s_list = srm + 1;
#define s_prefix (*sp)
#define s_remain (*srm)
  for (int be = bid; be < NB * NE; be += G) {
    const int b = be / NE, e = be % NE, tid = threadIdx.x;
    __syncthreads();
    const float* av = aff + ((size_t)b * NE + e) * SEQ;
    unsigned key[8];
#pragma unroll
    for (int j = 0; j < 8; ++j) key[j] = __float_as_uint(av[tid * 8 + j]);
    if (tid == 0) { s_prefix = 0u; s_remain = CAP; }
    for (int pass = 3; pass >= 0; --pass) {
        if (tid < 256) hist[tid] = 0;
        __syncthreads();
        const unsigned prefix = s_prefix; const int shift = pass * 8; const unsigned himask = pass == 3 ? 0u : (0xffffffffu << (shift + 8));
#pragma unroll
        for (int j = 0; j < 8; ++j) if ((key[j] & himask) == prefix) atomicAdd((int*)(hist + ((key[j] >> shift) & 255u)), 1);
        __syncthreads();
        if (tid == 0) { int rem = s_remain, bin = 255; for (; bin > 0; --bin) { const int cnt = hist[bin]; if (cnt >= rem) break; rem -= cnt; } s_remain = rem; s_prefix = prefix | ((unsigned)bin << shift); }
        __syncthreads();
    }
    const unsigned T = s_prefix; const int remain = s_remain;
    int neq = 0;
#pragma unroll
    for (int j = 0; j < 8; ++j) neq += (key[j] == T);
    int tot; int eqbase = block_excl_scan(neq, sm, tot);
    int flags = 0, nsel = 0;
#pragma unroll
    for (int j = 0; j < 8; ++j) { bool sel = key[j] > T; if (key[j] == T) { sel = eqbase < remain; ++eqbase; } if (sel) { flags |= 1 << j; ++nsel; } }
    int slot = block_excl_scan(nsel, sm, tot);
    const int rowbase = (e * NB + b) * CAP;
#pragma unroll
    for (int j = 0; j < 8; ++j) { const int t = tid * 8 + j; int sl = -1;
        if (flags & (1 << j)) { sl = slot++; idx[rowbase + sl] = t; gate[rowbase + sl] = __uint_as_float(key[j]); s_list[sl] = t; }
        inv[((size_t)b * SEQ + t) * NE + e] = sl; }
    __syncthreads();
    const int lane = tid & 63, wave = tid >> 6;
    for (int s = wave; s < CAP; s += 8) { const u32x4* src = (const u32x4*)(HF + ((size_t)b * SEQ + s_list[s]) * DM); u32x4* dst = (u32x4*)(XS + (size_t)(rowbase + s) * DM);
        dst[lane] = src[lane]; dst[lane + 64] = src[lane + 64]; }
  }
#undef s_prefix
#undef s_remain
}

__device__ __forceinline__ void ph_combine(const bf16_t* __restrict__ Y, const int* __restrict__ inv, const float* __restrict__ mod, const float* __restrict__ g_fpost, float* __restrict__ out, int bid, int G) {
    const int lane = threadIdx.x & 63, wave = threadIdx.x >> 6;
    for (int m = bid * 8 + wave; m < M_LAT; m += G * 8) {
        const int b = m / SEQ; const float* mv = mod + (size_t)b * 6144;
        f32x4 y[4];
#pragma unroll
        for (int j = 0; j < 4; ++j) y[j] = (f32x4){0.f, 0.f, 0.f, 0.f};
        for (int e = 0; e < NE; ++e) { const int sl = inv[(size_t)m * NE + e]; if (sl < 0) continue;
            const unsigned long long* yp = (const unsigned long long*)(Y + (size_t)((e * NB + b) * CAP + sl) * DM) + lane;
#pragma unroll
            for (int j = 0; j < 4; ++j) { const unsigned long long w = yp[64 * j]; const unsigned lo = (unsigned)w, hi = (unsigned)(w >> 32);
                y[j] += (f32x4){__uint_as_float(lo << 16), __uint_as_float(lo & 0xffff0000u), __uint_as_float(hi << 16), __uint_as_float(hi & 0xffff0000u)}; } }
        float ss = 0.f;
#pragma unroll
        for (int j = 0; j < 4; ++j) ss += (y[j].x * y[j].x + y[j].y * y[j].y) + (y[j].z * y[j].z + y[j].w * y[j].w);
        const float rstd = rsqrtf(wave_sum(ss) * (1.f / DM) + EPS);
#pragma unroll
        for (int j = 0; j < 4; ++j) { const int col = 4 * lane + 256 * j; float* op = out + (size_t)m * DM + col;
            const f32x4 xn = *(const f32x4*)op, gp = *(const f32x4*)(g_fpost + col), gf = *(const f32x4*)(mv + 5120 + col);
            *(f32x4*)op = xn + gf * (y[j] * rstd * gp); }
    }
}

namespace cg = cooperative_groups;
constexpr int LDS_BYTES = 147456;
constexpr int N_PHASES = 13;
struct MegaArgs { const float* in[20]; float* out; unsigned char* ws; int ph_lo, ph_hi; };
__global__ void __launch_bounds__(512, 2) hy_mega(MegaArgs a) {
    extern __shared__ __attribute__((aligned(16))) unsigned char lds_raw[];
    LAS unsigned char* lds = (LAS unsigned char*)lds_raw;
    cg::grid_group grid = cg::this_grid();
    const int bid = blockIdx.x, G = gridDim.x;
    const float* x = a.in[0]; const float* c = a.in[1]; const float* ctx = a.in[2]; const float* c_ctx = a.in[3];
    const float* w_mod = a.in[4]; const float* b_mod = a.in[5]; const float* g_pre = a.in[6]; const float* g_post = a.in[7];
    const float* g_fpre = a.in[8]; const float* g_fpost = a.in[9]; const float* w_in = a.in[10]; const float* rpb = a.in[11];
    const float* a_up = a.in[12]; const float* a_bias = a.in[13]; const float* gnorm = a.in[14]; const float* w_out = a.in[15];
    const float* router = a.in[16]; const float* w_gate = a.in[17]; const float* w_up = a.in[18]; const float* w_down = a.in[19];
    unsigned char* ws = a.ws; float* out = a.out;
    float* modp = (float*)(ws + WS_MODP); float* mod = (float*)(ws + WS_MOD);
    bf16_t* WTIN = (bf16_t*)(ws + WS_WTIN); bf16_t* WTV = (bf16_t*)(ws + WS_WTV); bf16_t* WTOUT = (bf16_t*)(ws + WS_WTOUT); bf16_t* WTGU = (bf16_t*)(ws + WS_WTGU); bf16_t* WTDN = (bf16_t*)(ws + WS_WTDN);
    bf16_t* H = (bf16_t*)(ws + WS_H); bf16_t* PROJ = (bf16_t*)(ws + WS_PROJ); bf16_t* VT = (bf16_t*)(ws + WS_VT); bf16_t* OMIX = (bf16_t*)(ws + WS_OMIX); bf16_t* MIX = (bf16_t*)(ws + WS_MIX);
    bf16_t* HID = (bf16_t*)(ws + WS_HID); bf16_t* HF = (bf16_t*)(ws + WS_HF); bf16_t* XS = (bf16_t*)(ws + WS_XS); bf16_t* Y = XS;
    float* aff = (float*)(ws + WS_AFF); int* idx = (int*)(ws + WS_IDX); float* gate = (float*)(ws + WS_GATE); int* inv = (int*)(ws + WS_INV);
    bf16_t* QF = (bf16_t*)(ws + WS_QF); bf16_t* KF = (bf16_t*)(ws + WS_KF); bf16_t* KFT = (bf16_t*)(ws + WS_KFT); float* AT = (float*)(ws + WS_AT); bf16_t* SB = (bf16_t*)(ws + WS_SB);
    const int lo = a.ph_lo, hi = a.ph_hi;
#define IN(k) (lo <= (k) && (k) < hi)
#define SEAM(k) do { if (IN(k) && IN((k) + 1)) grid.sync(); } while (0)
    if (IN(0)) ph_mod_partial(c, c_ctx, w_mod, modp, lds, bid, G);
    SEAM(0);
    if (IN(1)) ph_mod_final(modp, b_mod, mod, bid, G);
    SEAM(1);
    if (IN(2)) { PrepArgs p; p.x = x; p.ctx = ctx; p.g_pre = g_pre; p.mod = mod; p.w_in = w_in; p.w_out = w_out; p.w_gate = w_gate; p.w_up = w_up; p.w_down = w_down;
        p.WTIN = WTIN; p.WTV = WTV; p.WTOUT = WTOUT; p.WTGU = WTGU; p.WTDN = WTDN; p.H = H; ph_prep(p, lds, bid, G); }
    SEAM(2);
    if (IN(3)) {
        { pg8::Gemm g{H, WTIN, M_ALL, PROJ_LD, DM}; pg8::StaticOrder S; S.init(g.M, g.N, G, bid); pg8::EpiBf16<0> E{PROJ, PROJ_LD, nullptr, 0, 0, 1.f};
          pg8::gemm_phase<pg8::EpiBf16<0>, pg8::StaticOrder, true, true>(lds, g, S, E); }
        { pg8::Gemm g{WTV, H, 1024, M_ALL, DM}; pg8::StaticOrder S; S.init(g.M, g.N, G, bid); pg8::EpiBf16<0> E{VT, VT_LD, nullptr, 0, 0, 1.f};
          pg8::gemm_phase<pg8::EpiBf16<0>, pg8::StaticOrder, true, true>(lds, g, S, E); }
    }
    SEAM(3);
    if (IN(4)) { ph_gla_prep2(PROJ, a_up, a_bias, QF, KF, KFT, AT, lds, bid, G); ph_na(PROJ, VT, rpb, OMIX, lds, bid, G); }
    SEAM(4);
    if (IN(5)) ph_gla_state(KFT, VT, AT, SB, bid, G);
    SEAM(5);
    if (IN(6)) ph_gla_out(PROJ, QF, KF, VT, SB, gnorm, OMIX, bid, G);
    SEAM(6);
    if (IN(7)) { pg8::Gemm g{OMIX, WTOUT, M_LAT, DM, DM}; pg8::StaticOrder S; S.init(g.M, g.N, G, bid); pg8::EpiBf16<0> E{MIX, DM, nullptr, 0, 0, 1.f};
        pg8::gemm_phase<pg8::EpiBf16<0>, pg8::StaticOrder, true, true>(lds, g, S, E); }
    SEAM(7);
    if (IN(8)) ph_post_mix(x, MIX, mod, g_post, g_fpre, router, out, HF, aff, lds, bid, G);
    SEAM(8);
    if (IN(9)) ph_topk(aff, HF, idx, gate, inv, XS, lds, bid, G);
    SEAM(9);
    if (IN(10)) { pg8::Gemm g{XS, WTGU, NSLOT, 2 * DE, DM}; ExpertOrder S{22, G, bid}; EpiSwiGLU E{HID, DE};
        pg8::gemm_phase<EpiSwiGLU, ExpertOrder, true, true>(lds, g, S, E); }
    SEAM(10);
    if (IN(11)) { pg8::Gemm g{HID, WTDN, NSLOT, DM, DE}; ExpertOrder S{4, G, bid}; EpiRowScale E{Y, DM, gate};
        pg8::gemm_phase<EpiRowScale, ExpertOrder, true, true>(lds, g, S, E); }
    SEAM(11);
    if (IN(12)) ph_combine(Y, inv, mod, g_fpost, out, bid, G);
#undef IN
#undef SEAM
}
}

#ifndef MK_SPLIT
#define MK_SPLIT 0
#endif
extern "C" void kernel_launch(void* const* d_in, const int* in_sizes, int n_in, void* d_out, int out_size, void* d_ws, size_t ws_size, hipStream_t stream) {
    using namespace hy;
    static int grid = 0;
    if (grid == 0) {
        if (n_in != 20 || in_sizes[0] != M_LAT * DM || out_size != M_LAT * DM || ws_size < WS_END) { fprintf(stderr, "kernel_launch: unexpected shapes / workspace (n_in %d, ws %zu)\n", n_in, ws_size); grid = -1; return; }
        int dev = 0, cus = 0, per_cu = 0;
        if (hipGetDevice(&dev) != hipSuccess || hipDeviceGetAttribute(&cus, hipDeviceAttributeMultiprocessorCount, dev) != hipSuccess) { grid = -1; return; }
        if (hipFuncSetAttribute((const void*)hy_mega, hipFuncAttributeMaxDynamicSharedMemorySize, LDS_BYTES) != hipSuccess) { fprintf(stderr, "kernel_launch: hipFuncSetAttribute failed\n"); grid = -1; return; }
        if (hipOccupancyMaxActiveBlocksPerMultiprocessor(&per_cu, (const void*)hy_mega, 512, LDS_BYTES) != hipSuccess || per_cu < 1) { fprintf(stderr, "kernel_launch: occupancy query says %d\n", per_cu); per_cu = 1; }
        (void)hipGetLastError();
        grid = cus;
    }
    if (grid < 0) return;
    MegaArgs a{};
    for (int i = 0; i < 20; ++i) a.in[i] = (const float*)d_in[i];
    a.out = (float*)d_out; a.ws = (unsigned char*)d_ws;
#if MK_SPLIT
    for (int p = 0; p < N_PHASES; ++p) { a.ph_lo = p; a.ph_hi = p + 1; hipLaunchKernelGGL(hy_mega, dim3(grid), dim3(512), LDS_BYTES, stream, a); }
#else
    a.ph_lo = 0; a.ph_hi = N_PHASES;
    void* args[] = {&a};
    hipError_t e = hipLaunchCooperativeKernel((const void*)hy_mega, dim3(grid), dim3(512), args, LDS_BYTES, stream);
    if (e != hipSuccess) fprintf(stderr, "cooperative launch failed: %s (grid %d)\n", hipGetErrorString(e), grid);
#endif
}
```

```cpp
#include <hip/hip_runtime.h>
#include <hip/hip_cooperative_groups.h>
#include <cstdio>
#include <cstdint>
namespace pg8 {
#define PG8_LAS __attribute__((address_space(3)))
typedef unsigned short bf16_t;
typedef short bf16x8 __attribute__((ext_vector_type(8)));
typedef float f32x4 __attribute__((ext_vector_type(4)));
typedef unsigned u32x4 __attribute__((ext_vector_type(4)));
constexpr int BM = 256, BK = 64, HALF = 128, HTB = HALF * BK * 2  , STAGE_BYTES = 8 * HTB, NXCD = 8, WGM = 8;

__host__ __device__ __forceinline__ int lds_byte(int r, int c) { const int st = (r >> 4) * 2 + (c >> 5), rr = r & 15, cc = c & 31, ob = rr * 64 + cc * 2; return st * 1024 + (ob ^ (((ob >> 9) & 1) << 5)); }
__host__ __device__ __forceinline__ void stage_rc(int b, int& R, int& C) { const int st = b / 1024, sb = b % 1024, swz = sb ^ (((sb >> 9) & 1) << 5); R = (st >> 1) * 16 + swz / 64; C = (st & 1) * 32 + (swz % 64) / 2; }
__host__ __device__ __forceinline__ int perm32(int rho) { const int n = rho >> 4, i = rho & 15; return 8 * (i >> 2) + 4 * n + (i & 3); }

struct Unit { int pm, pn, bt; };
struct Gemm { const bf16_t* A; const bf16_t* Bt; int M, N, K; };

struct StaticOrder {
    int nM, nN, nwg, G, c;
    __host__ __device__ void init(int M, int N, int G_, int c_) { nM = M / BM; nN = N / BM; nwg = nM * nN; G = G_; c = c_; }
    __host__ __device__ bool next(int i, Unit& u) const {
        const long L = (long)i * G + c; if (L >= nwg) return false;
        int wgid = (int)L; { const int q = nwg / NXCD, r = nwg % NXCD, xcd = wgid % NXCD, off = wgid / NXCD; wgid = (xcd < r ? xcd * (q + 1) : r * (q + 1) + (xcd - r) * q) + off; }
        const int nig = WGM * nN, gid = wgid / nig, fm = gid * WGM, gsz = (nM - fm) < WGM ? (nM - fm) : WGM;
        u.pm = fm + ((wgid % nig) % gsz); u.pn = (wgid % nig) / gsz; u.bt = u.pn; return true;
    }
    __device__ __forceinline__ void a_ready(const Unit&) const {}
    __device__ __forceinline__ void done(const Unit&) const {}
};

__device__ __forceinline__ unsigned cvt_pk_bf16(float lo, float hi) { unsigned r; asm volatile("v_cvt_pk_bf16_f32 %0, %1, %2" : "=v"(r) : "v"(lo), "v"(hi)); return r; }
typedef float f32x2 __attribute__((ext_vector_type(2)));
__device__ __forceinline__ f32x2 gelu_pk(f32x2 v) {
    const f32x2 av = __builtin_elementwise_abs(v), d = av * 0.2316418882f + 1.0f;
    f32x2 t; t.x = __builtin_amdgcn_rcpf(d.x); t.y = __builtin_amdgcn_rcpf(d.y);
    f32x2 q = t * 0.5307027145f + (-0.7265760135f); q = q * t + 0.7107068705f; q = q * t + (-0.142248368f); q = q * t + 0.127414796f; q = q * t;
    const f32x2 s = (v * v) * (-0.72134752044f);
    f32x2 e; e.x = __builtin_amdgcn_exp2f(s.x); e.y = __builtin_amdgcn_exp2f(s.y);
    const f32x2 m = v * (q * e), r = v - m;
    f32x2 o; o.x = v.x < 0.f ? m.x : r.x; o.y = v.y < 0.f ? m.y : r.y; return o;
}

template <int ACT  > struct EpiBf16 {
    static constexpr bool PERM = true, AFTER_DRAIN = false; static_assert(ACT == 0 || ACT == 1, "EpiBf16: ACT is 0 (none) or 1 (gelu_pk)");
    bf16_t* O; int ldc; const float* bias; int split_cols; size_t split_stride; float scale0;
    __device__ __forceinline__ void operator()(const f32x4 (&acc)[2][2][4][2], const Unit& u, int wr, int wc, int fr, int fq) const {
        const int row0 = u.pm * BM + wr * 64 + fr; int colt = u.pn * BM; bf16_t* base = O;
        float sc = 1.f; if (split_cols) { const int t = colt / split_cols; base += (size_t)t * split_stride; colt -= t * split_cols; if (t == 0) sc = scale0; }
        const int col0 = colt + wc * 32 + 8 * fq, bcol0 = u.pn * BM + wc * 32 + 8 * fq;
        f32x4 bv[2][2];
#pragma unroll
        for (int bj = 0; bj < 2; ++bj)
#pragma unroll
            for (int n = 0; n < 2; ++n) bv[bj][n] = bias ? *(const f32x4*)(bias + bcol0 + bj * HALF + 4 * n) : (f32x4){0.f, 0.f, 0.f, 0.f};
#pragma unroll
        for (int ai = 0; ai < 2; ++ai)
#pragma unroll
            for (int m = 0; m < 4; ++m) { bf16_t* rowp = base + (size_t)(row0 + ai * HALF + m * 16) * ldc + col0;
#pragma unroll
                for (int bj = 0; bj < 2; ++bj) { f32x4 v0 = acc[ai][bj][m][0] + bv[bj][0], v1 = acc[ai][bj][m][1] + bv[bj][1];
                    if (ACT == 1) { f32x2 a = gelu_pk((f32x2){v0[0], v0[1]}), b = gelu_pk((f32x2){v0[2], v0[3]}), c = gelu_pk((f32x2){v1[0], v1[1]}), d = gelu_pk((f32x2){v1[2], v1[3]});
                        v0 = (f32x4){a.x, a.y, b.x, b.y}; v1 = (f32x4){c.x, c.y, d.x, d.y}; }
                    v0 = v0 * sc; v1 = v1 * sc; u32x4 w; w.x = cvt_pk_bf16(v0[0], v0[1]); w.y = cvt_pk_bf16(v0[2], v0[3]); w.z = cvt_pk_bf16(v1[0], v1[1]); w.w = cvt_pk_bf16(v1[2], v1[3]);
                    *(u32x4*)(rowp + bj * HALF) = w; } }
    }
};
template <class Epi, class Sched, bool ALIGN_EPI = false, bool SP2 = false>
__device__ __forceinline__ void gemm_phase(PG8_LAS unsigned char* lds, const Gemm g, const Sched& S, const Epi& E) {
    const int tid = threadIdx.x, wid = __builtin_amdgcn_readfirstlane(tid >> 6), lane = tid & 63, wr = wid >> 2, wc = wid & 3, fr = lane & 15, fq = lane >> 4;
    const int K = g.K, nt = K / BK;
    unsigned voffA[2], voffB[2];
#pragma unroll
    for (int i = 0; i < 2; ++i) { int R, C; stage_rc(tid * 16 + i * 8192, R, C); const int Rb = Epi::PERM ? ((R & ~31) + perm32(R & 31)) : R;
        voffA[i] = (unsigned)(R * K + C) * 2u; voffB[i] = (unsigned)(Rb * K + C) * 2u; }
    const size_t kstep = (size_t)(BK * 2);
    const size_t hstep = (size_t)HALF * K * 2;
    const size_t tstep = 2 * hstep;
    const unsigned ldsw = (unsigned)wid * 1024u;
    const int aoff = lds_byte(wr * 64 + fr, fq * 8), boff = lds_byte(wc * 32 + fr, fq * 8);
#define PG8_SA(b, h) (((b) * 2 + (h)) * HTB)
#define PG8_SB(b, h) ((4 + (b) * 2 + (h)) * HTB)
#define PG8_STAGE(bufoff, gbase, voff) do { _Pragma("unroll") for (int _i = 0; _i < 2; ++_i) \
        __builtin_amdgcn_global_load_lds((const unsigned*)((const char*)(gbase) + (voff)[_i]), (PG8_LAS unsigned*)(lds + (bufoff) + ldsw + _i * 8192), 16, 0, 0); } while (0)
#define PG8_LDA(dst, b, h) do { _Pragma("unroll") for (int m = 0; m < 4; ++m) _Pragma("unroll") for (int k = 0; k < 2; ++k) dst[m][k] = *(const PG8_LAS bf16x8*)(lds + PG8_SA(b, h) + aoff + m * 2048 + k * 1024); } while (0)
#define PG8_LDB(dst, b, h) do { _Pragma("unroll") for (int n = 0; n < 2; ++n) _Pragma("unroll") for (int k = 0; k < 2; ++k) dst[n][k] = *(const PG8_LAS bf16x8*)(lds + PG8_SB(b, h) + boff + n * 2048 + k * 1024); } while (0)
#define PG8_MMA(ai, bj, At, Bt) do { __builtin_amdgcn_s_setprio(1); _Pragma("unroll") for (int m = 0; m < 4; ++m) _Pragma("unroll") for (int n = 0; n < 2; ++n) _Pragma("unroll") for (int k = 0; k < 2; ++k) \
        acc[ai][bj][m][n] = __builtin_amdgcn_mfma_f32_16x16x32_bf16(Bt[n][k], At[m][k], acc[ai][bj][m][n], 0, 0, 0); __builtin_amdgcn_s_setprio(0); } while (0)
#define PG8_WAIT_V(n) asm volatile("s_waitcnt vmcnt(" #n ")" ::: "memory")
#define PG8_WAIT_L(n) asm volatile("s_waitcnt lgkmcnt(" #n ")" ::: "memory")
#define PG8_BAR __builtin_amdgcn_s_barrier()
#define PG8_SCHED __builtin_amdgcn_sched_barrier(0)
    Unit cur, nxt; int ui = 0;
    if (!S.next(0, cur)) return;
    f32x4 acc[2][2][4][2];
#pragma unroll
    for (int a = 0; a < 2; ++a)
#pragma unroll
        for (int b = 0; b < 2; ++b)
#pragma unroll
            for (int m = 0; m < 4; ++m)
#pragma unroll
                for (int n = 0; n < 2; ++n) acc[a][b][m][n] = (f32x4){0.f, 0.f, 0.f, 0.f};
    bf16x8 At[4][2], B0[2][2], B1[2][2];
    const char* cA = (const char*)g.A + (size_t)cur.pm * tstep; const char* cB = (const char*)g.Bt + (size_t)cur.bt * tstep;
    S.a_ready(cur);
    if constexpr (SP2) {
        PG8_STAGE(PG8_SB(0, 0), cB, voffB); PG8_STAGE(PG8_SB(0, 1), cB + hstep, voffB); PG8_STAGE(PG8_SA(0, 0), cA, voffA); PG8_STAGE(PG8_SA(0, 1), cA + hstep, voffA);
        if (wr == 1) PG8_BAR;
        PG8_WAIT_V(2); PG8_BAR;
        PG8_STAGE(PG8_SB(1, 0), cB + kstep, voffB); PG8_STAGE(PG8_SA(1, 0), cA + kstep, voffA); PG8_STAGE(PG8_SB(1, 1), cB + hstep + kstep, voffB);
        PG8_WAIT_V(6); PG8_BAR;
    } else {
        PG8_STAGE(PG8_SB(0, 0), cB, voffB); PG8_STAGE(PG8_SA(0, 0), cA, voffA); PG8_STAGE(PG8_SB(0, 1), cB + hstep, voffB); PG8_STAGE(PG8_SA(0, 1), cA + hstep, voffA);
        if (wr == 1) PG8_BAR;
        PG8_WAIT_V(4); PG8_BAR;
        PG8_STAGE(PG8_SB(1, 0), cB + kstep, voffB); PG8_STAGE(PG8_SA(1, 0), cA + kstep, voffA); PG8_STAGE(PG8_SB(1, 1), cB + hstep + kstep, voffB);
        PG8_WAIT_V(6); PG8_BAR;
    }
    for (;;) {
        const bool has_next = S.next(ui + 1, nxt);
        const char* nA = has_next ? (const char*)g.A + (size_t)nxt.pm * tstep : cA; const char* nB = has_next ? (const char*)g.Bt + (size_t)nxt.bt * tstep : cB;
        for (int t = 0; t < nt; t += 2) {
            const bool last = (t == nt - 2);
            const char* a1 = cA + (size_t)(t + 1) * kstep;
            const char* a2 = last ? nA : cA + (size_t)(t + 2) * kstep; const char* b2 = last ? nB : cB + (size_t)(t + 2) * kstep;
            const char* a3 = a2 + kstep; const char* b3 = b2 + kstep;
            if (last && has_next) S.a_ready(nxt);
            if constexpr (SP2) {
            PG8_LDB(B0, 0, 0); PG8_LDB(B1, 0, 1); PG8_SCHED; PG8_LDA(At, 0, 0); PG8_STAGE(PG8_SA(1, 1), a1 + hstep, voffA);
            PG8_WAIT_V(8); PG8_WAIT_L(0); PG8_BAR; PG8_MMA(0, 0, At, B0); PG8_MMA(0, 1, At, B1); PG8_BAR; PG8_SCHED;
            PG8_LDA(At, 0, 1); PG8_STAGE(PG8_SB(0, 0), b2, voffB); PG8_STAGE(PG8_SB(0, 1), b2 + hstep, voffB); PG8_STAGE(PG8_SA(0, 0), a2, voffA);
            PG8_WAIT_V(8); PG8_WAIT_L(0); PG8_BAR; PG8_MMA(1, 0, At, B0); PG8_MMA(1, 1, At, B1); PG8_BAR; PG8_SCHED;
            PG8_LDB(B0, 1, 0); PG8_LDB(B1, 1, 1); PG8_SCHED; PG8_LDA(At, 1, 0); PG8_STAGE(PG8_SA(0, 1), a2 + hstep, voffA);
            PG8_WAIT_V(8); PG8_WAIT_L(0); PG8_BAR; PG8_MMA(0, 0, At, B0); PG8_MMA(0, 1, At, B1); PG8_BAR; PG8_SCHED;
            PG8_LDA(At, 1, 1); PG8_STAGE(PG8_SB(1, 0), b3, voffB); PG8_STAGE(PG8_SB(1, 1), b3 + hstep, voffB); PG8_STAGE(PG8_SA(1, 0), a3, voffA);
            PG8_WAIT_V(8); PG8_WAIT_L(0); PG8_BAR; PG8_MMA(1, 0, At, B0); PG8_MMA(1, 1, At, B1); PG8_BAR; PG8_SCHED;
            } else {
            PG8_LDB(B0, 0, 0); PG8_SCHED; PG8_LDA(At, 0, 0); PG8_STAGE(PG8_SA(1, 1), a1 + hstep, voffA);
            PG8_WAIT_L(8); PG8_BAR; PG8_WAIT_L(0); PG8_MMA(0, 0, At, B0); PG8_BAR; PG8_SCHED;
            PG8_LDB(B1, 0, 1); PG8_STAGE(PG8_SB(0, 0), b2, voffB);
            PG8_BAR; PG8_WAIT_L(0); PG8_MMA(0, 1, At, B1); PG8_BAR;
            PG8_LDA(At, 0, 1); PG8_STAGE(PG8_SA(0, 0), a2, voffA);
            PG8_BAR; PG8_WAIT_L(0); PG8_MMA(1, 0, At, B0); PG8_BAR; PG8_SCHED;
            PG8_STAGE(PG8_SB(0, 1), b2 + hstep, voffB);
            PG8_WAIT_V(6); PG8_BAR; PG8_MMA(1, 1, At, B1); PG8_BAR;
            PG8_LDB(B0, 1, 0); PG8_SCHED; PG8_LDA(At, 1, 0); PG8_STAGE(PG8_SA(0, 1), a2 + hstep, voffA);
            PG8_WAIT_L(8); PG8_BAR; PG8_WAIT_L(0); PG8_MMA(0, 0, At, B0); PG8_BAR; PG8_SCHED;
            PG8_LDB(B1, 1, 1); PG8_STAGE(PG8_SB(1, 0), b3, voffB);
            PG8_BAR; PG8_WAIT_L(0); PG8_MMA(0, 1, At, B1); PG8_BAR;
            PG8_LDA(At, 1, 1); PG8_STAGE(PG8_SA(1, 0), a3, voffA);
            PG8_BAR; PG8_WAIT_L(0); PG8_MMA(1, 0, At, B0); PG8_BAR; PG8_SCHED;
            PG8_STAGE(PG8_SB(1, 1), b3 + hstep, voffB);
            PG8_WAIT_V(6); PG8_BAR; PG8_MMA(1, 1, At, B1); PG8_BAR;
            }
        }
        if constexpr (ALIGN_EPI) { if (wr == 0) PG8_BAR; }
        if constexpr (!Epi::AFTER_DRAIN) { E(acc, cur, wr, wc, fr, fq); S.done(cur); }
        if (!has_next) break;
#pragma unroll
        for (int a = 0; a < 2; ++a)
#pragma unroll
            for (int b = 0; b < 2; ++b)
#pragma unroll
                for (int m = 0; m < 4; ++m)
#pragma unroll
                    for (int n = 0; n < 2; ++n) acc[a][b][m][n] = (f32x4){0.f, 0.f, 0.f, 0.f};
        cur = nxt; cA = nA; cB = nB; ++ui;
        if constexpr (ALIGN_EPI) { if (wr == 1) PG8_BAR; }
    }
    PG8_WAIT_V(0);
    if constexpr (!ALIGN_EPI) { if (wr == 0) PG8_BAR; }
    PG8_BAR;
    if constexpr (Epi::AFTER_DRAIN) { E.fused(acc, cur, wr, wc, fr, fq, lds, wid, lane); S.done(cur); }
#undef PG8_SA
#undef PG8_SB
#undef PG8_STAGE
#undef PG8_LDA
#undef PG8_LDB
#undef PG8_MMA
#undef PG8_WAIT_V
#undef PG8_WAIT_L
#undef PG8_BAR
#undef PG8_SCHED
}
}
namespace hy {
using pg8::bf16_t; using pg8::f32x4; using pg8::u32x4; using pg8::bf16x8;
#define LAS __attribute__((address_space(3)))
constexpr int NB = 4, SEQ = 4096, DM = 1024, CTXL = 256;
constexpr int M_LAT = NB * SEQ, M_CTX = NB * CTXL, M_ALL = M_LAT + M_CTX;
constexpr int IN_COLS = 3104, NE = 16, CAP = 512, DE = 2816, NSLOT = NE * NB * CAP;
constexpr int PROJ_LD = 2304, PC_NAK = 0, PC_GK = 512, PC_NAQ = 768, PC_GQ = 1280, PC_GG = 1536, PC_AD = 2048;
constexpr int VT_LD = M_ALL;
constexpr float EPS = 1e-6f;
constexpr int TKB = SEQ + CTXL;
constexpr size_t MiB = 1u << 20;
constexpr size_t WS_MODP = 1 * MiB, WS_MOD = 3 * MiB, WS_WTIN = 4 * MiB, WS_WTV = 9 * MiB, WS_WTOUT = 11 * MiB, WS_AFF = 13 * MiB, WS_IDX = 14 * MiB, WS_GATE = 14 * MiB + 256 * 1024, WS_INV = 15 * MiB;
constexpr size_t WS_WTGU = 16 * MiB, WS_WTDN = 192 * MiB, WS_H = 280 * MiB, WS_PROJ = 314 * MiB, WS_VT = 391 * MiB, WS_OMIX = 425 * MiB, WS_MIX = 457 * MiB, WS_HID = 280 * MiB;
constexpr size_t WS_HF = 489 * MiB, WS_XS = 521 * MiB, WS_GLAT = 590 * MiB, WS_QF = 590 * MiB, WS_KF = 606 * MiB, WS_KFT = 622 * MiB, WS_AT = 639 * MiB, WS_SB = 640 * MiB, WS_KH = 521 * MiB, WS_VB = 538 * MiB, WS_END = 672 * MiB;
static_assert(WS_WTIN + (size_t)PROJ_LD * DM * 2 <= WS_WTV && WS_WTGU + (size_t)NE * 2 * DE * DM * 2 <= WS_WTDN && WS_WTDN + (size_t)NE * DM * DE * 2 <= WS_H, "ws map 1");
static_assert(WS_H + (size_t)M_ALL * DM * 2 <= WS_PROJ && WS_PROJ + (size_t)M_ALL * PROJ_LD * 2 <= WS_VT && WS_VT + (size_t)1024 * VT_LD * 2 <= WS_OMIX, "ws map 2");
static_assert(WS_HID + (size_t)NSLOT * DE * 2 <= WS_MIX && WS_XS + (size_t)NSLOT * DM * 2 <= WS_GLAT && WS_SB + (size_t)2 * NB * 4 * 64 * 128 * 64 * 2 <= WS_END && WS_KFT + (size_t)2 * 256 * M_ALL * 2 <= WS_AT, "ws map 3");

__device__ __forceinline__ float bf2f(bf16_t x) { return __uint_as_float((unsigned)x << 16); }
__device__ __forceinline__ unsigned f2bf(float f) { unsigned u = __float_as_uint(f); return (u + 0x7fffu + ((u >> 16) & 1u)) >> 16; }
__device__ __forceinline__ unsigned pk2(float lo, float hi) { return f2bf(lo) | (f2bf(hi) << 16); }
__device__ __forceinline__ float wave_sum(float v) {
#pragma unroll
    for (int o = 1; o < 64; o <<= 1) v += __shfl_xor(v, o);
    return v;
}
__device__ __forceinline__ float silu_f(float x) { return x / (1.f + __expf(-x)); }

__device__ __forceinline__ void ph_mod(const float* __restrict__ c, const float* __restrict__ c_ctx, const float* __restrict__ w_mod, const float* __restrict__ b_mod, float* __restrict__ mod, LAS unsigned char* lds, int bid, int G) {
    LAS float* s = (LAS float*)lds;
    LAS float* red = s + 5 * 1024;
    const int tid = threadIdx.x;
    __syncthreads();
    for (int i = tid; i < 5 * 1024; i += 512) { const int v = i >> 10, k = i & 1023; const float x = v < 4 ? c[v * 1024 + k] : c_ctx[k]; s[i] = x / (1.f + expf(-x)); }
    __syncthreads();
    for (int cg = bid; cg < 256; cg += G) {
        const int ks = tid / 24, cj = tid % 24, j = cg * 24 + cj;
        if (tid < 504) {
            float acc[5] = {0.f, 0.f, 0.f, 0.f, 0.f};
            const int k0 = ks * 49, k1 = min(k0 + 49, 1024);
#pragma unroll 7
            for (int k = k0; k < k1; ++k) { const float w = w_mod[(size_t)k * 6144 + j];
#pragma unroll
                for (int v = 0; v < 5; ++v) acc[v] += s[v * 1024 + k] * w; }
#pragma unroll
            for (int v = 0; v < 5; ++v) red[(v * 21 + ks) * 24 + cj] = acc[v];
        }
        __syncthreads();
        if (tid < 120) { const int v = tid / 24, cc = tid % 24; float a = b_mod[cg * 24 + cc];
            for (int q = 0; q < 21; ++q) a += red[(v * 21 + q) * 24 + cc];
            mod[(size_t)v * 6144 + cg * 24 + cc] = a; }
        __syncthreads();
    }
}

__device__ __forceinline__ void transpose_item(const float* __restrict__ W, int N, int k0, int n0, bf16_t* dst, int K, float scale, LAS float* scr, int lane) {
    float wv[32];
#pragma unroll
    for (int i = 0; i < 32; ++i) wv[i] = W[(size_t)(k0 + 2 * i + (lane >> 5)) * N + n0 + (lane & 31)];
#pragma unroll
    for (int i = 0; i < 32; ++i) scr[(2 * i + (lane >> 5)) * 33 + (lane & 31)] = wv[i];
    asm volatile("s_waitcnt lgkmcnt(0)" ::: "memory");
    const int c = lane & 7;
#pragma unroll
    for (int j = 0; j < 4; ++j) { const int n = (lane >> 3) + 8 * j; const LAS float* s = scr + (8 * c) * 33 + n;
        u32x4 o; o.x = pk2(s[0 * 33] * scale, s[1 * 33] * scale); o.y = pk2(s[2 * 33] * scale, s[3 * 33] * scale); o.z = pk2(s[4 * 33] * scale, s[5 * 33] * scale); o.w = pk2(s[6 * 33] * scale, s[7 * 33] * scale);
        *(u32x4*)(dst + (size_t)n * K + k0 + 8 * c) = o; }
    asm volatile("s_waitcnt lgkmcnt(0)" ::: "memory");
}
struct PrepArgs { const float *x, *ctx, *g_pre, *mod, *w_in, *w_out, *w_gate, *w_up, *w_down; bf16_t *WTIN, *WTV, *WTOUT, *WTGU, *WTDN, *H; };
constexpr int IT_IN = 16 * 97, IT_OUT = 16 * 32, IT_GU1 = 16 * 16 * 88, IT_DN = 16 * 44 * 32, IT_ALL = IT_IN + IT_OUT + 2 * IT_GU1 + IT_DN;
__device__ __forceinline__ void ph_convert(const PrepArgs& a, LAS unsigned char* lds, int bid, int G) {
    const int tid = threadIdx.x, lane = tid & 63, wave = tid >> 6;
    LAS float* scr = (LAS float*)(lds + wave * 8448);
    const int gw = bid * 8 + wave, NGW = G * 8;
    { u32x4* z = (u32x4*)(a.WTIN + (size_t)(PC_AD + 32) * DM); const int nz = (PROJ_LD - PC_AD - 32) * DM * 2 / 16;
      for (int i = bid * 512 + tid; i < nz; i += G * 512) z[i] = (u32x4){0u, 0u, 0u, 0u}; }
    for (int it = gw; it < IT_ALL; it += NGW) {
        int r = it;
        if (r < IT_IN) { const int kb = r / 97, n0 = (r % 97) * 32; bf16_t* dst; float sc = 1.f;
            if (n0 < 512) dst = a.WTIN + (size_t)(PC_NAK + n0) * DM;
            else if (n0 < 1024) dst = a.WTV + (size_t)(n0 - 512) * DM;
            else if (n0 < 1280) dst = a.WTIN + (size_t)(PC_GK + n0 - 1024) * DM;
            else if (n0 < 1792) dst = a.WTV + (size_t)(512 + n0 - 1280) * DM;
            else if (n0 < 1824) dst = a.WTIN + (size_t)(PC_AD + n0 - 1792) * DM;
            else if (n0 < 2336) { dst = a.WTIN + (size_t)(PC_NAQ + n0 - 1824) * DM; sc = 0.125f; }
            else if (n0 < 2592) { dst = a.WTIN + (size_t)(PC_GQ + n0 - 2336) * DM; sc = 0.125f; }
            else dst = a.WTIN + (size_t)(PC_GG + n0 - 2592) * DM;
            transpose_item(a.w_in, IN_COLS, kb * 64, n0, dst, DM, sc, scr, lane); continue; }
        r -= IT_IN;
        if (r < IT_OUT) { const int kb = r / 32, n0 = (r % 32) * 32; transpose_item(a.w_out, DM, kb * 64, n0, a.WTOUT + (size_t)n0 * DM, DM, 1.f, scr, lane); continue; }
        r -= IT_OUT;
        if (r < 2 * IT_GU1) { const int which = r / IT_GU1; r %= IT_GU1; const int e = r / (16 * 88); r %= (16 * 88); const int kb = r / 88, n0 = (r % 88) * 32;
            const float* W = (which ? a.w_up : a.w_gate) + (size_t)e * DM * DE;
            bf16_t* dst = a.WTGU + ((size_t)e * 2 * DE + (n0 / 128) * 256 + (n0 % 128) + which * 128) * DM;
            transpose_item(W, DE, kb * 64, n0, dst, DM, 1.f, scr, lane); continue; }
        r -= 2 * IT_GU1;
        { const int e = r / (44 * 32); r %= (44 * 32); const int kb = r / 32, n0 = (r % 32) * 32;
          transpose_item(a.w_down + (size_t)e * DE * DM, DM, kb * 64, n0, a.WTDN + ((size_t)e * DM + n0) * DE, DE, 1.f, scr, lane); }
    }
}
__device__ __forceinline__ void ph_modulate(const PrepArgs& a, int bid, int G) {
    const int tid = threadIdx.x, lane = tid & 63, wave = tid >> 6;
    const int gw = bid * 8 + wave, NGW = G * 8;
    for (int m = gw; m < M_ALL; m += NGW) {
        const float* src; int v;
        if (m < M_LAT) { src = a.x + (size_t)m * DM; v = m / SEQ; } else { src = a.ctx + (size_t)(m - M_LAT) * DM; v = 4; }
        const f32x4* xr = (const f32x4*)src + lane; f32x4 xv[4]; float ss = 0.f;
#pragma unroll
        for (int j = 0; j < 4; ++j) { xv[j] = xr[64 * j]; ss += (xv[j].x * xv[j].x + xv[j].y * xv[j].y) + (xv[j].z * xv[j].z + xv[j].w * xv[j].w); }
        const float rstd = rsqrtf(wave_sum(ss) * (1.f / DM) + EPS);
        const float* mv = a.mod + (size_t)v * 6144;
        unsigned long long* o8 = (unsigned long long*)(a.H + (size_t)m * DM) + lane;
#pragma unroll
        for (int j = 0; j < 4; ++j) { const int col = 4 * lane + 256 * j;
            const f32x4 g = *(const f32x4*)(a.g_pre + col), sh = *(const f32x4*)(mv + col), sc = *(const f32x4*)(mv + 1024 + col);
            const f32x4 hv = xv[j] * rstd * g * (sc + 1.f) + sh;
            o8[64 * j] = (unsigned long long)pk2(hv.x, hv.y) | ((unsigned long long)pk2(hv.z, hv.w) << 32); }
    }
}


__device__ __forceinline__ void tok_of_row(int row, int& bb, int& tk) { if (row < M_LAT) { bb = row >> 12; tk = row & (SEQ - 1); } else { const int r2 = row - M_LAT; bb = r2 >> 8; tk = SEQ + (r2 & (CTXL - 1)); } }
struct EpiProj {
    static constexpr bool PERM = true, AFTER_DRAIN = false;
    bf16_t* O; int ldc; bf16_t* KH;
    __device__ __forceinline__ void operator()(const f32x4 (&acc)[2][2][4][2], const pg8::Unit& u, int wr, int wc, int fr, int fq) const {
        const int row0 = u.pm * 256 + wr * 64 + fr, col0 = u.pn * 256 + wc * 32 + 8 * fq;
#pragma unroll
        for (int ai = 0; ai < 2; ++ai)
#pragma unroll
            for (int m = 0; m < 4; ++m) { const int row = row0 + ai * 128 + m * 16; int bb, tk; tok_of_row(row, bb, tk);
#pragma unroll
                for (int bj = 0; bj < 2; ++bj) { const f32x4 v0 = acc[ai][bj][m][0], v1 = acc[ai][bj][m][1];
                    u32x4 w; w.x = pg8::cvt_pk_bf16(v0[0], v0[1]); w.y = pg8::cvt_pk_bf16(v0[2], v0[3]); w.z = pg8::cvt_pk_bf16(v1[0], v1[1]); w.w = pg8::cvt_pk_bf16(v1[2], v1[3]);
                    const int col = col0 + bj * 128;
                    if (u.pn < 2) { const int hh = col >> 6, ks = (col >> 5) & 1; *(u32x4*)(KH + ((size_t)((bb * 8 + hh) * 2 + ks) * TKB + tk) * 32 + (col & 31)) = w; }
                    else *(u32x4*)(O + (size_t)row * ldc + col) = w; } }
    }
};
struct EpiVal {
    static constexpr bool PERM = true, AFTER_DRAIN = false;
    bf16_t* VT; int ldc; bf16_t* VB;
    __device__ __forceinline__ void operator()(const f32x4 (&acc)[2][2][4][2], const pg8::Unit& u, int wr, int wc, int fr, int fq) const {
        const int row0 = u.pm * 256 + wr * 64 + fr, col0 = u.pn * 256 + wc * 32 + 8 * fq;
#pragma unroll
        for (int ai = 0; ai < 2; ++ai)
#pragma unroll
            for (int m = 0; m < 4; ++m) { const int vr = row0 + ai * 128 + m * 16;
#pragma unroll
                for (int bj = 0; bj < 2; ++bj) { const f32x4 v0 = acc[ai][bj][m][0], v1 = acc[ai][bj][m][1];
                    u32x4 w; w.x = pg8::cvt_pk_bf16(v0[0], v0[1]); w.y = pg8::cvt_pk_bf16(v0[2], v0[3]); w.z = pg8::cvt_pk_bf16(v1[0], v1[1]); w.w = pg8::cvt_pk_bf16(v1[2], v1[3]);
                    const int col = col0 + bj * 128;
                    if (u.pm < 2) { int bb, tk; tok_of_row(col, bb, tk); const int hh = vr >> 6, dt = (vr >> 4) & 3, dd = vr & 15;
                        *(u32x4*)(VB + ((size_t)(((bb * 8 + hh) * 4 + dt) * (TKB / 8) + (tk >> 3)) * 16 + dd) * 8) = w; }
                    else *(u32x4*)(VT + (size_t)vr * ldc + col) = w; } }
    }
};
struct EpiSwiGLU {
    static constexpr bool PERM = true, AFTER_DRAIN = false;
    bf16_t* O; int ldc;
    __device__ __forceinline__ void operator()(const f32x4 (&acc)[2][2][4][2], const pg8::Unit& u, int wr, int wc, int fr, int fq) const {
        const int row0 = u.pm * 256 + wr * 64 + fr, col0 = u.pn * 128 + wc * 32 + 8 * fq;
#pragma unroll
        for (int ai = 0; ai < 2; ++ai)
#pragma unroll
            for (int m = 0; m < 4; ++m) { bf16_t* rowp = O + (size_t)(row0 + ai * 128 + m * 16) * ldc + col0;
                const f32x4 g0 = acc[ai][0][m][0], g1 = acc[ai][0][m][1], u0 = acc[ai][1][m][0], u1 = acc[ai][1][m][1];
                u32x4 w; w.x = pg8::cvt_pk_bf16(silu_f(g0[0]) * u0[0], silu_f(g0[1]) * u0[1]); w.y = pg8::cvt_pk_bf16(silu_f(g0[2]) * u0[2], silu_f(g0[3]) * u0[3]);
                w.z = pg8::cvt_pk_bf16(silu_f(g1[0]) * u1[0], silu_f(g1[1]) * u1[1]); w.w = pg8::cvt_pk_bf16(silu_f(g1[2]) * u1[2], silu_f(g1[3]) * u1[3]);
                *(u32x4*)rowp = w; }
    }
};
struct EpiRowScale {
    static constexpr bool PERM = true, AFTER_DRAIN = false;
    bf16_t* O; int ldc; const float* rowscale;
    __device__ __forceinline__ void operator()(const f32x4 (&acc)[2][2][4][2], const pg8::Unit& u, int wr, int wc, int fr, int fq) const {
        const int row0 = u.pm * 256 + wr * 64 + fr, col0 = u.pn * 256 + wc * 32 + 8 * fq;
#pragma unroll
        for (int ai = 0; ai < 2; ++ai)
#pragma unroll
            for (int m = 0; m < 4; ++m) { const int row = row0 + ai * 128 + m * 16; const float sc = rowscale[row]; bf16_t* rowp = O + (size_t)row * ldc + col0;
#pragma unroll
                for (int bj = 0; bj < 2; ++bj) { const f32x4 v0 = acc[ai][bj][m][0] * sc, v1 = acc[ai][bj][m][1] * sc;
                    u32x4 w; w.x = pg8::cvt_pk_bf16(v0[0], v0[1]); w.y = pg8::cvt_pk_bf16(v0[2], v0[3]); w.z = pg8::cvt_pk_bf16(v1[0], v1[1]); w.w = pg8::cvt_pk_bf16(v1[2], v1[3]);
                    *(u32x4*)(rowp + bj * 128) = w; } }
    }
};
struct ExpertOrder {
    int nT, G, c;
    __device__ __forceinline__ bool next(int i, pg8::Unit& u) const {
        if (G == 256) { if (2 * i >= nT) return false; const int x = c & 7, j = c >> 3, e = 2 * x + (j >> 4), mt = j & 7, pn = 2 * i + ((j >> 3) & 1);
            u.pm = e * 8 + mt; u.pn = pn; u.bt = e * nT + pn; return true; }
        const long L = (long)i * G + c; if (L >= (long)128 * nT) return false;
        const int e = (int)(L / (8 * nT)), r = (int)(L % (8 * nT)); u.pm = e * 8 + (r % 8); u.pn = r / 8; u.bt = e * nT + u.pn; return true;
    }
    __device__ __forceinline__ void a_ready(const pg8::Unit&) const {}
    __device__ __forceinline__ void done(const pg8::Unit&) const {}
};
__device__ __forceinline__ void ph_na_naive(const bf16_t* __restrict__ PROJ, const bf16_t* __restrict__ VT, const float* __restrict__ rpb, bf16_t* __restrict__ OMIX, int bid, int G) {
  for (int vb = bid * 8 + (threadIdx.x >> 6); vb < NB * 8 * 64; vb += G * 8) {
    const int r = vb % 64, h = (vb / 64) % 8, b = vb / 512, c = threadIdx.x & 63;
    const size_t mq = (size_t)b * SEQ + r * 64 + c;
    float q[64], acc[64];
    { const u32x4* qp = (const u32x4*)(PROJ + mq * PROJ_LD + PC_NAQ + h * 64);
#pragma unroll
      for (int i = 0; i < 8; ++i) { const u32x4 w = qp[i]; q[8 * i + 0] = __uint_as_float(w.x << 16); q[8 * i + 1] = __uint_as_float(w.x & 0xffff0000u); q[8 * i + 2] = __uint_as_float(w.y << 16); q[8 * i + 3] = __uint_as_float(w.y & 0xffff0000u);
          q[8 * i + 4] = __uint_as_float(w.z << 16); q[8 * i + 5] = __uint_as_float(w.z & 0xffff0000u); q[8 * i + 6] = __uint_as_float(w.w << 16); q[8 * i + 7] = __uint_as_float(w.w & 0xffff0000u); } }
#pragma unroll
    for (int d = 0; d < 64; ++d) acc[d] = 0.f;
    float mx = -INFINITY, l = 0.f;
    const int rs = min(max(r - 4, 0), 56), cs = min(max(c - 8, 0), 48);
    for (int kk = 0; kk < 128 + CTXL; ++kk) {
        size_t mk; float bias = 0.f;
        if (kk < 128) { const int krow = rs + (kk >> 4), kcol = cs + (kk & 15); mk = (size_t)b * SEQ + krow * 64 + kcol; bias = rpb[(h * 15 + (krow - r + 7)) * 31 + (kcol - c + 15)]; }
        else mk = (size_t)M_LAT + b * CTXL + (kk - 128);
        const u32x4* kp = (const u32x4*)(PROJ + mk * PROJ_LD + PC_NAK + h * 64);
        float s = 0.f;
#pragma unroll
        for (int i = 0; i < 8; ++i) { const u32x4 w = kp[i];
            s += q[8 * i + 0] * __uint_as_float(w.x << 16) + q[8 * i + 1] * __uint_as_float(w.x & 0xffff0000u) + q[8 * i + 2] * __uint_as_float(w.y << 16) + q[8 * i + 3] * __uint_as_float(w.y & 0xffff0000u)
               + q[8 * i + 4] * __uint_as_float(w.z << 16) + q[8 * i + 5] * __uint_as_float(w.z & 0xffff0000u) + q[8 * i + 6] * __uint_as_float(w.w << 16) + q[8 * i + 7] * __uint_as_float(w.w & 0xffff0000u); }
        s += bias;
        const float mn = fmaxf(mx, s), al = __expf(mx - mn), p = __expf(s - mn);
        l = l * al + p; mx = mn;
        const bf16_t* vp = VT + (size_t)(h * 64) * VT_LD + mk;
#pragma unroll
        for (int d = 0; d < 64; ++d) acc[d] = acc[d] * al + p * bf2f(vp[(size_t)d * VT_LD]);
    }
    const float inv = 1.f / l;
    unsigned* op = (unsigned*)(OMIX + mq * DM + h * 64);
#pragma unroll
    for (int i = 0; i < 32; ++i) op[i] = pk2(acc[2 * i] * inv, acc[2 * i + 1] * inv);
  }
}

__device__ __forceinline__ f32x4 mfma16(bf16x8 a, bf16x8 b, f32x4 c) { return __builtin_amdgcn_mfma_f32_16x16x32_bf16(a, b, c, 0, 0, 0); }
__device__ __forceinline__ void na_unit(int u, const bf16_t* __restrict__ PROJ, const bf16_t* __restrict__ KH, const bf16_t* __restrict__ VB, const LAS float* rb, bf16_t* __restrict__ OMIX, int lane) {
    const int q = lane & 15, g = lane >> 4;
    const int bh = u >> 8, b = bh >> 3, h = bh & 7, r = (u & 255) >> 2, qt = u & 3;
    const int c0 = (qt == 0) ? 0 : (qt == 3 ? 32 : 16 * qt - 8);
    const int rs = min(max(r - 4, 0), 56);
    const int cq = 16 * qt + q, cs = min(max(cq - 8, 0), 48);
    const size_t mq = (size_t)b * SEQ + r * 64 + cq;
    const bf16_t* qp = PROJ + mq * PROJ_LD + PC_NAQ + h * 64 + 8 * g;
    const bf16x8 qf0 = *(const bf16x8*)qp, qf1 = *(const bf16x8*)(qp + 32);
    const bf16_t* kb0 = KH + ((size_t)(bh * 2) * TKB + 8 * (q >> 2) + (q & 3)) * 32 + 8 * g;
    const bf16_t* kb1 = kb0 + (size_t)TKB * 32;
    f32x4 S[32];
#pragma unroll
    for (int p = 0; p < 16; ++p) {
        const int s = (p < 8) ? ((rs + p) * 64 + c0) : (SEQ + 32 * (p - 8));
#pragma unroll
        for (int half = 0; half < 2; ++half) {
            const size_t off = (size_t)(s + 4 * half) * 32;
            f32x4 acc = (f32x4){0.f, 0.f, 0.f, 0.f};
            acc = mfma16(*(const bf16x8*)(kb0 + off), qf0, acc); acc = mfma16(*(const bf16x8*)(kb1 + off), qf1, acc);
            if (p < 8) {
                const LAS float* rbr = rb + (h * 15 + (rs + p - r + 7)) * 31;
#pragma unroll
                for (int i = 0; i < 4; ++i) { const int kcol = c0 + 8 * g + 4 * half + i; const bool valid = (kcol >= cs) && (kcol < cs + 16);
                    const float bias = rbr[min(max(kcol - cq + 15, 0), 30)];
                    acc[i] = valid ? acc[i] + bias : -INFINITY; }
            }
            S[2 * p + half] = acc;
        }
    }
    float mx = -INFINITY;
#pragma unroll
    for (int T = 0; T < 32; ++T) mx = fmaxf(fmaxf(mx, fmaxf(S[T][0], S[T][1])), fmaxf(S[T][2], S[T][3]));
    mx = fmaxf(mx, __shfl_xor(mx, 16)); mx = fmaxf(mx, __shfl_xor(mx, 32));
    float l = 0.f;
#pragma unroll
    for (int T = 0; T < 32; ++T) {
#pragma unroll
        for (int i = 0; i < 4; ++i) { const float p = __expf(S[T][i] - mx); S[T][i] = p; l += p; } }
    l += __shfl_xor(l, 16); l += __shfl_xor(l, 32);
    f32x4 O[4];
#pragma unroll
    for (int dt = 0; dt < 4; ++dt) O[dt] = (f32x4){0.f, 0.f, 0.f, 0.f};
    const bf16_t* vb0 = VB + ((size_t)(bh * 4) * (TKB / 8) * 16 + (size_t)g * 16 + q) * 8;
#pragma unroll
    for (int p = 0; p < 16; ++p) {
        u32x4 pw; pw.x = pg8::cvt_pk_bf16(S[2 * p][0], S[2 * p][1]); pw.y = pg8::cvt_pk_bf16(S[2 * p][2], S[2 * p][3]); pw.z = pg8::cvt_pk_bf16(S[2 * p + 1][0], S[2 * p + 1][1]); pw.w = pg8::cvt_pk_bf16(S[2 * p + 1][2], S[2 * p + 1][3]);
        const bf16x8 pb = __builtin_bit_cast(bf16x8, pw);
        const int s = (p < 8) ? ((rs + p) * 64 + c0) : (SEQ + 32 * (p - 8));
#pragma unroll
        for (int dt = 0; dt < 4; ++dt) O[dt] = mfma16(*(const bf16x8*)(vb0 + ((size_t)dt * (TKB / 8) + (s >> 3)) * 128), pb, O[dt]);
    }
    const float inv = 1.f / l;
    bf16_t* op = OMIX + mq * DM + h * 64 + 4 * g;
#pragma unroll
    for (int dt = 0; dt < 4; ++dt) { uint2 w; w.x = pg8::cvt_pk_bf16(O[dt][0] * inv, O[dt][1] * inv); w.y = pg8::cvt_pk_bf16(O[dt][2] * inv, O[dt][3] * inv); *(uint2*)(op + dt * 16) = w; }
}
__device__ __forceinline__ void ph_na(const bf16_t* __restrict__ PROJ, const bf16_t* __restrict__ KH, const bf16_t* __restrict__ VB, const float* __restrict__ rpb, bf16_t* __restrict__ OMIX, LAS unsigned char* lds, int bid, int G) {
    LAS float* rb = (LAS float*)lds;
    __syncthreads();
    for (int i = threadIdx.x; i < 8 * 15 * 31; i += 512) rb[i] = rpb[i];
    __syncthreads();
    const int lane = threadIdx.x & 63, wave = threadIdx.x >> 6;
#ifndef REP_NA
#define REP_NA 1
#endif
    for (int rep_ = 0; rep_ < REP_NA; ++rep_)
    for (int u = bid * 8 + wave; u < NB * 8 * 64 * 4; u += G * 8) na_unit(u, PROJ, KH, VB, rb, OMIX, lane);
}

typedef float f32x16 __attribute__((ext_vector_type(16)));
__device__ __forceinline__ f32x16 mfma32(bf16x8 a, bf16x8 b, f32x16 c) { return __builtin_amdgcn_mfma_f32_32x32x16_bf16(a, b, c, 0, 0, 0); }
constexpr int NCHUNK = 272;
__device__ __forceinline__ float logsig16(float z) { return (fminf(z, 0.f) - log1pf(__expf(-fabsf(z)))) * (1.f / 16.f); }
__device__ __forceinline__ float wave_incl_prefix(float v, int lane) {
#pragma unroll
    for (int o = 1; o < 64; o <<= 1) { const float y = __shfl_up(v, o); if (lane >= o) v += y; }
    return v;
}
__device__ __forceinline__ float wave_incl_suffix(float v, int lane) {
#pragma unroll
    for (int o = 1; o < 64; o <<= 1) { const float y = __shfl_down(v, o); if (lane + o < 64) v += y; }
    return v;
}
__device__ __forceinline__ void gla_prep_unit(int uu, const bf16_t* __restrict__ PROJ, const float* __restrict__ a_up, const float* __restrict__ a_bias, bf16_t* __restrict__ QF, bf16_t* __restrict__ KF, bf16_t* __restrict__ KFT, float* __restrict__ AT,
                                              const LAS float* tab, int lane) {
    const int dir = uu & 1, h = (uu >> 1) & 3, ci = uu >> 3;
    const bool lat = ci < 256;
    const int crow = ci & 63;
    const int m0 = lat ? ((ci >> 6) * SEQ + crow * 64) : (M_LAT + (ci - 256) * 64);
    const size_t m = (size_t)(m0 + lane);
    const bf16_t* prow = PROJ + m * PROJ_LD;
    float adv[16];
    { const u32x4 w0 = *(const u32x4*)(prow + PC_AD + dir * 16), w1 = *(const u32x4*)(prow + PC_AD + dir * 16 + 8);
      const unsigned ww[8] = {w0.x, w0.y, w0.z, w0.w, w1.x, w1.y, w1.z, w1.w};
#pragma unroll
      for (int r = 0; r < 8; ++r) { adv[2 * r] = __uint_as_float(ww[r] << 16); adv[2 * r + 1] = __uint_as_float(ww[r] & 0xffff0000u); } }
    unsigned kw[32], qw[32];
#pragma unroll
    for (int i = 0; i < 8; ++i) { const u32x4 w = *(const u32x4*)(prow + PC_GK + h * 64 + 8 * i); kw[4 * i] = w.x; kw[4 * i + 1] = w.y; kw[4 * i + 2] = w.z; kw[4 * i + 3] = w.w; }
    if (lat) {
#pragma unroll
        for (int i = 0; i < 8; ++i) { const u32x4 w = *(const u32x4*)(prow + PC_GQ + h * 64 + 8 * i); qw[4 * i] = w.x; qw[4 * i + 1] = w.y; qw[4 * i + 2] = w.z; qw[4 * i + 3] = w.w; }
    } else {
#pragma unroll
        for (int i = 0; i < 32; ++i) qw[i] = 0u;
    }
    unsigned qo[32], ko[32];
    const float* upb = a_up + (size_t)(dir * 16) * 256 + h * 64;
    const float* bib = a_bias + dir * 256 + h * 64;
    bf16_t* kft = KFT + ((size_t)dir * 256 + h * 64) * M_ALL + m;
    float* at = AT + ((size_t)dir * NCHUNK + ci) * 256 + h * 64;
    const int totlane = dir ? 0 : 63;
#pragma unroll
    for (int seg = 0; seg < 2; ++seg)
#pragma unroll
        for (int i = 0; i < 16; ++i) {
            const int d1 = seg * 32 + i, d2 = d1 + 16;
            float z1 = bib[d1], z2 = bib[d2];
#pragma unroll
            for (int r = 0; r < 16; ++r) { z1 += adv[r] * upb[r * 256 + d1]; z2 += adv[r] * upb[r * 256 + d2]; }
            const float la1 = logsig16(z1), la2 = logsig16(z2);
            const float lam1 = dir ? wave_incl_suffix(la1, lane) : wave_incl_prefix(la1, lane);
            const float lam2 = dir ? wave_incl_suffix(la2, lane) : wave_incl_prefix(la2, lane);
            if (lane == totlane) { at[d1] = __expf(lam1); at[d2] = __expf(lam2); }
            const unsigned kw1 = kw[d1 >> 1], kw2 = kw[d2 >> 1];
            float k1 = (d1 & 1) ? __uint_as_float(kw1 & 0xffff0000u) : __uint_as_float(kw1 << 16);
            float k2 = (d2 & 1) ? __uint_as_float(kw2 & 0xffff0000u) : __uint_as_float(kw2 << 16);
            if (lat) {
                const unsigned qw1 = qw[d1 >> 1], qw2 = qw[d2 >> 1];
                float q1 = (d1 & 1) ? __uint_as_float(qw1 & 0xffff0000u) : __uint_as_float(qw1 << 16);
                float q2 = (d2 & 1) ? __uint_as_float(qw2 & 0xffff0000u) : __uint_as_float(qw2 << 16);
                const int pos = seg ? lane : crow; const float cs = tab[2 * (pos * 16 + i)], sn = tab[2 * (pos * 16 + i) + 1];
                const float k1r = k1 * cs - k2 * sn, k2r = k1 * sn + k2 * cs, q1r = q1 * cs - q2 * sn, q2r = q1 * sn + q2 * cs;
                k1 = k1r; k2 = k2r;
                const unsigned qb1 = f2bf(q1r * __expf(lam1)), qb2 = f2bf(q2r * __expf(lam2));
                if (d1 & 1) qo[d1 >> 1] |= qb1 << 16; else qo[d1 >> 1] = qb1;
                if (d2 & 1) qo[d2 >> 1] |= qb2 << 16; else qo[d2 >> 1] = qb2;
            }
            const unsigned kb1 = f2bf(k1 * __expf(-lam1)), kb2 = f2bf(k2 * __expf(-lam2));
            if (d1 & 1) ko[d1 >> 1] |= kb1 << 16; else ko[d1 >> 1] = kb1;
            if (d2 & 1) ko[d2 >> 1] |= kb2 << 16; else ko[d2 >> 1] = kb2;
            kft[(size_t)d1 * M_ALL] = (bf16_t)kb1; kft[(size_t)d2 * M_ALL] = (bf16_t)kb2;
            asm volatile("" ::: "memory");
        }
    if (lat) {
        u32x4* qd = (u32x4*)(QF + ((size_t)dir * M_LAT + m) * 256 + h * 64); u32x4* kd = (u32x4*)(KF + ((size_t)dir * M_LAT + m) * 256 + h * 64);
#pragma unroll
        for (int i = 0; i < 8; ++i) { qd[i] = (u32x4){qo[4 * i], qo[4 * i + 1], qo[4 * i + 2], qo[4 * i + 3]}; kd[i] = (u32x4){ko[4 * i], ko[4 * i + 1], ko[4 * i + 2], ko[4 * i + 3]}; }
    }
}
__device__ __forceinline__ void ph_gla_prep2(const bf16_t* __restrict__ PROJ, const float* __restrict__ a_up, const float* __restrict__ a_bias, bf16_t* __restrict__ QF, bf16_t* __restrict__ KF, bf16_t* __restrict__ KFT, float* __restrict__ AT,
                                             LAS unsigned char* lds, int bid, int G) {
    LAS float* tab = (LAS float*)(lds + 16384);
    __syncthreads();
    for (int i = threadIdx.x; i < 1024; i += 512) { const int pos = i >> 4, fi = i & 15; const float ang = (float)pos * powf(10000.f, -(float)fi / 16.f); tab[2 * i] = cosf(ang); tab[2 * i + 1] = sinf(ang); }
    __syncthreads();
    const int lane = threadIdx.x & 63, wave = threadIdx.x >> 6;
#ifndef REP_GP
#define REP_GP 1
#endif
    for (int rep_ = 0; rep_ < REP_GP; ++rep_)
    for (int u = bid * 8 + wave; u < NCHUNK * 4 * 2; u += G * 8) gla_prep_unit(__builtin_amdgcn_readfirstlane(u), PROJ, a_up, a_bias, QF, KF, KFT, AT, tab, lane);
}
constexpr size_t SB_CH = 128 * 64;
__device__ __forceinline__ void gla_state_unit(int u, const bf16_t* __restrict__ KFT, const bf16_t* __restrict__ VT, const float* __restrict__ AT, bf16_t* __restrict__ SB, int lane) {
    const int es = u & 3, dir = (u >> 2) & 1, h = (u >> 3) & 3, b = u >> 5;
    const int l31 = lane & 31, hh = lane >> 5;
    f32x16 acc[2];
#pragma unroll
    for (int dt = 0; dt < 2; ++dt)
#pragma unroll
        for (int i = 0; i < 16; ++i) acc[dt][i] = 0.f;
    const bf16_t* kft0 = KFT + ((size_t)dir * 256 + h * 64 + l31) * M_ALL + 8 * hh;
    const bf16_t* vt0 = VT + (size_t)(512 + h * 128 + es * 32 + l31) * VT_LD + 8 * hh;
    bf16_t* sb0 = SB + ((size_t)((dir * NB + b) * 4 + h) * 64) * SB_CH + (size_t)(es * 32 + l31) * 64 + 4 * hh;
    for (int s = 0; s < 68; ++s) {
        int ci, m0, c = 0;
        if (s < 4) { const int cc = dir ? 3 - s : s; ci = 256 + b * 4 + cc; m0 = M_LAT + b * CTXL + cc * 64; }
        else { c = dir ? 67 - s : s - 4; ci = b * 64 + c; m0 = b * SEQ + c * 64; }
        bf16x8 af[2][4], bfr[4]; f32x4 av[2][4];
#pragma unroll
        for (int ks = 0; ks < 4; ++ks) { bfr[ks] = *(const bf16x8*)(vt0 + m0 + 16 * ks);
#pragma unroll
            for (int dt = 0; dt < 2; ++dt) af[dt][ks] = *(const bf16x8*)(kft0 + (size_t)dt * 32 * M_ALL + m0 + 16 * ks); }
#pragma unroll
        for (int dt = 0; dt < 2; ++dt)
#pragma unroll
            for (int rr = 0; rr < 4; ++rr) av[dt][rr] = *(const f32x4*)(AT + ((size_t)dir * NCHUNK + ci) * 256 + h * 64 + dt * 32 + 8 * rr + 4 * hh);
        if (s >= 4) {
            bf16_t* sp = sb0 + (size_t)c * SB_CH;
#pragma unroll
            for (int dt = 0; dt < 2; ++dt)
#pragma unroll
                for (int rr = 0; rr < 4; ++rr) { uint2 w; w.x = pg8::cvt_pk_bf16(acc[dt][4 * rr], acc[dt][4 * rr + 1]); w.y = pg8::cvt_pk_bf16(acc[dt][4 * rr + 2], acc[dt][4 * rr + 3]); *(uint2*)(sp + dt * 32 + 8 * rr) = w; }
        }
#pragma unroll
        for (int dt = 0; dt < 2; ++dt) {
#pragma unroll
            for (int ks = 0; ks < 4; ++ks) acc[dt] = mfma32(af[dt][ks], bfr[ks], acc[dt]);
#pragma unroll
            for (int rr = 0; rr < 4; ++rr) { acc[dt][4 * rr] *= av[dt][rr][0]; acc[dt][4 * rr + 1] *= av[dt][rr][1]; acc[dt][4 * rr + 2] *= av[dt][rr][2]; acc[dt][4 * rr + 3] *= av[dt][rr][3]; }
        }
    }
}
__device__ __forceinline__ void gla_out_unit(int u, const bf16_t* __restrict__ PROJ, const bf16_t* __restrict__ QF, const bf16_t* __restrict__ KF, const bf16_t* __restrict__ VT, const bf16_t* __restrict__ SB, const float* __restrict__ gnorm,
                                             bf16_t* __restrict__ OMIX, int lane) {
    const int it = u & 1, c = (u >> 1) & 63, h = (u >> 7) & 3, b = u >> 9;
    const int l31 = lane & 31, hh = lane >> 5;
    const int m0 = b * SEQ + c * 64;
    f32x16 o[4];
#pragma unroll
    for (int et = 0; et < 4; ++et)
#pragma unroll
        for (int i = 0; i < 16; ++i) o[et][i] = 0.f;
#pragma unroll
    for (int dir = 0; dir < 2; ++dir) {
        bf16x8 qf[4];
        const bf16_t* qp = QF + ((size_t)dir * M_LAT + m0 + 32 * it + l31) * 256 + h * 64 + 8 * hh;
#pragma unroll
        for (int ks = 0; ks < 4; ++ks) qf[ks] = *(const bf16x8*)(qp + 16 * ks);
#pragma unroll
        for (int jt = 0; jt < 2; ++jt) {
            const bool need = dir ? (jt >= it) : (jt <= it);
            if (!need) continue;
            f32x16 X;
#pragma unroll
            for (int i = 0; i < 16; ++i) X[i] = 0.f;
            const bf16_t* kp = KF + ((size_t)dir * M_LAT + m0 + 32 * jt + l31) * 256 + h * 64 + 8 * hh;
#pragma unroll
            for (int ks = 0; ks < 4; ++ks) X = mfma32(*(const bf16x8*)(kp + 16 * ks), qf[ks], X);
            if (jt == it) {
#pragma unroll
                for (int i = 0; i < 16; ++i) { const int jr = (i & 3) + 8 * (i >> 2) + 4 * hh; const bool keep = dir ? (jr >= l31) : (jr <= l31); X[i] = keep ? X[i] : 0.f; }
            }
#pragma unroll
            for (int s = 0; s < 2; ++s) {
                u32x4 xw; xw.x = pg8::cvt_pk_bf16(X[8 * s], X[8 * s + 1]); xw.y = pg8::cvt_pk_bf16(X[8 * s + 2], X[8 * s + 3]); xw.z = pg8::cvt_pk_bf16(X[8 * s + 4], X[8 * s + 5]); xw.w = pg8::cvt_pk_bf16(X[8 * s + 6], X[8 * s + 7]);
                const bf16x8 xa = __builtin_bit_cast(bf16x8, xw);
#pragma unroll
                for (int et = 0; et < 4; ++et) {
                    const bf16_t* vp = VT + (size_t)(512 + h * 128 + et * 32 + l31) * VT_LD + m0 + 32 * jt + 16 * s + 4 * hh;
                    const uint2 lo = *(const uint2*)vp, hi = *(const uint2*)(vp + 8);
                    const u32x4 vw = (u32x4){lo.x, lo.y, hi.x, hi.y};
                    o[et] = mfma32(xa, __builtin_bit_cast(bf16x8, vw), o[et]); }
            }
        }
        const bf16_t* sp = SB + ((size_t)(((dir * NB + b) * 4 + h) * 64 + c)) * SB_CH + (size_t)l31 * 64 + 8 * hh;
#pragma unroll
        for (int et = 0; et < 4; ++et)
#pragma unroll
            for (int ks = 0; ks < 4; ++ks) o[et] = mfma32(qf[ks], *(const bf16x8*)(sp + (size_t)et * 32 * 64 + 16 * ks), o[et]);
    }
    float ss[16];
#pragma unroll
    for (int i = 0; i < 16; ++i) { float a = 0.f;
#pragma unroll
        for (int et = 0; et < 4; ++et) a += o[et][i] * o[et][i];
        a += __shfl_xor(a, 1); a += __shfl_xor(a, 2); a += __shfl_xor(a, 4); a += __shfl_xor(a, 8); a += __shfl_xor(a, 16);
        ss[i] = rsqrtf(a * (1.f / 128.f) + EPS); }
#pragma unroll
    for (int et = 0; et < 4; ++et) { const float gn = gnorm[et * 32 + l31];
#pragma unroll
        for (int i = 0; i < 16; ++i) { const size_t m = (size_t)(m0 + 32 * it + (i & 3) + 8 * (i >> 2) + 4 * hh);
            const float g = bf2f(PROJ[m * PROJ_LD + PC_GG + h * 128 + et * 32 + l31]);
            OMIX[m * DM + 512 + h * 128 + et * 32 + l31] = (bf16_t)f2bf(o[et][i] * ss[i] * gn * silu_f(g)); } }
}
__device__ __forceinline__ void ph_gla_state(const bf16_t* KFT, const bf16_t* VT, const float* AT, bf16_t* SB, int bid, int G) {
    const int lane = threadIdx.x & 63, wave = threadIdx.x >> 6;
    for (int u = wave * G + bid; u < NB * 4 * 2 * 4; u += 8 * G) gla_state_unit(u, KFT, VT, AT, SB, lane);
}
__device__ __forceinline__ void ph_gla_out(const bf16_t* PROJ, const bf16_t* QF, const bf16_t* KF, const bf16_t* VT, const bf16_t* SB, const float* gnorm, bf16_t* OMIX, int bid, int G) {
    const int lane = threadIdx.x & 63, wave = threadIdx.x >> 6;
    for (int u = bid * 8 + wave; u < NB * 4 * 64 * 2; u += G * 8) gla_out_unit(u, PROJ, QF, KF, VT, SB, gnorm, OMIX, lane);
}

__device__ __forceinline__ void ph_post_mix(const float* __restrict__ x, const bf16_t* __restrict__ MIX, const float* __restrict__ mod, const float* __restrict__ g_post, const float* __restrict__ g_fpre, const float* __restrict__ router,
                                                  float* __restrict__ xnew, bf16_t* __restrict__ HF, float* __restrict__ aff, LAS unsigned char* lds, int bid, int G) {
    LAS float* rt = (LAS float*)lds;
    __syncthreads();
    for (int i = threadIdx.x; i < DM * NE; i += 512) rt[(i % NE) * DM + (i / NE)] = router[i];
    __syncthreads();
    const int lane = threadIdx.x & 63, wave = threadIdx.x >> 6;
    for (int m = bid * 8 + wave; m < M_LAT; m += G * 8) {
        const int b = m / SEQ, t = m % SEQ; const float* mv = mod + (size_t)b * 6144;
        f32x4 mx[4]; float ss = 0.f;
        const unsigned long long* mp = (const unsigned long long*)(MIX + (size_t)m * DM) + lane;
#pragma unroll
        for (int j = 0; j < 4; ++j) { const unsigned long long w = mp[64 * j]; const unsigned lo = (unsigned)w, hi = (unsigned)(w >> 32);
            mx[j] = (f32x4){__uint_as_float(lo << 16), __uint_as_float(lo & 0xffff0000u), __uint_as_float(hi << 16), __uint_as_float(hi & 0xffff0000u)};
            ss += (mx[j].x * mx[j].x + mx[j].y * mx[j].y) + (mx[j].z * mx[j].z + mx[j].w * mx[j].w); }
        const float rstd = rsqrtf(wave_sum(ss) * (1.f / DM) + EPS);
        f32x4 xn[4]; float s2 = 0.f;
#pragma unroll
        for (int j = 0; j < 4; ++j) { const int col = 4 * lane + 256 * j;
            const f32x4 xv = *(const f32x4*)(x + (size_t)m * DM + col), gp = *(const f32x4*)(g_post + col), gm = *(const f32x4*)(mv + 2048 + col);
            xn[j] = xv + gm * (mx[j] * rstd * gp);
            *(f32x4*)(xnew + (size_t)m * DM + col) = xn[j];
            s2 += (xn[j].x * xn[j].x + xn[j].y * xn[j].y) + (xn[j].z * xn[j].z + xn[j].w * xn[j].w); }
        const float rstd2 = rsqrtf(wave_sum(s2) * (1.f / DM) + EPS);
        f32x4 hv4[4];
        unsigned long long* hp = (unsigned long long*)(HF + (size_t)m * DM) + lane;
#pragma unroll
        for (int j = 0; j < 4; ++j) { const int col = 4 * lane + 256 * j;
            const f32x4 gf = *(const f32x4*)(g_fpre + col), sh = *(const f32x4*)(mv + 3072 + col), sc = *(const f32x4*)(mv + 4096 + col);
            hv4[j] = xn[j] * rstd2 * gf * (sc + 1.f) + sh;
            hp[64 * j] = (unsigned long long)pk2(hv4[j].x, hv4[j].y) | ((unsigned long long)pk2(hv4[j].z, hv4[j].w) << 32); }
        float lg[NE]; float mxl = -INFINITY;
#pragma unroll
        for (int e = 0; e < NE; ++e) { float sacc = 0.f;
#pragma unroll
            for (int j = 0; j < 4; ++j) { const f32x4 rv = *(const LAS f32x4*)(rt + e * DM + 4 * lane + 256 * j); sacc += (hv4[j].x * rv.x + hv4[j].y * rv.y) + (hv4[j].z * rv.z + hv4[j].w * rv.w); }
            lg[e] = wave_sum(sacc); mxl = fmaxf(mxl, lg[e]); asm volatile("" ::: "memory"); }
        float den = 0.f;
#pragma unroll
        for (int e = 0; e < NE; ++e) { lg[e] = expf(lg[e] - mxl); den += lg[e]; }
        const float rden = 1.f / den;
#pragma unroll
        for (int e = 0; e < NE; ++e) if (lane == e) aff[((size_t)b * NE + e) * SEQ + t] = lg[e] * rden;
    }
}

__device__ __forceinline__ int block_excl_scan(int v, LAS int* sm  , int& total) {
    const int lane = threadIdx.x & 63, w = threadIdx.x >> 6; int x = v;
#pragma unroll
    for (int o = 1; o < 64; o <<= 1) { const int y = __shfl_up(x, o); if (lane >= o) x += y; }
    __syncthreads();
    if (lane == 63) sm[w] = x;
    __syncthreads();
    int base = 0, tot = 0;
#pragma unroll
    for (int i = 0; i < 8; ++i) { const int s = sm[i]; if (i < w) base += s; tot += s; }
    total = tot;
    return base + x - v;
}
__device__ __forceinline__ void ph_topk(const float* __restrict__ aff, const bf16_t* __restrict__ HF, int* __restrict__ idx, float* __restrict__ gate, int* __restrict__ inv, bf16_t* __restrict__ XS, LAS unsigned char* lds, int bid, int G) {
  LAS int* hist = (LAS int*)lds; LAS int* sm = hist + 256; LAS unsigned* sp = (LAS unsigned*)(sm + 16); LAS int* srm = (LAS int*)(sp + 1); LAS int* s_list = srm + 1;
#define s_prefix (*sp)
#define s_remain (*srm)
  for (int be = bid; be < NB * NE; be += G) {
    const int b = be / NE, e = be % NE, tid = threadIdx.x;
    __syncthreads();
    const float* av = aff + ((size_t)b * NE + e) * SEQ;
    unsigned key[8];
#pragma unroll
    for (int j = 0; j < 8; ++j) key[j] = __float_as_uint(av[tid * 8 + j]);
    if (tid == 0) { s_prefix = 0u; s_remain = CAP; }
    for (int pass = 3; pass >= 0; --pass) {
        if (tid < 256) hist[tid] = 0;
        __syncthreads();
        const unsigned prefix = s_prefix; const int shift = pass * 8; const unsigned himask = pass == 3 ? 0u : (0xffffffffu << (shift + 8));
#pragma unroll
        for (int j = 0; j < 8; ++j) if ((key[j] & himask) == prefix) atomicAdd((int*)(hist + ((key[j] >> shift) & 255u)), 1);
        __syncthreads();
        if (tid == 0) { int rem = s_remain, bin = 255; for (; bin > 0; --bin) { const int cnt = hist[bin]; if (cnt >= rem) break; rem -= cnt; } s_remain = rem; s_prefix = prefix | ((unsigned)bin << shift); }
        __syncthreads();
    }
    const unsigned T = s_prefix; const int remain = s_remain;
    int neq = 0;
#pragma unroll
    for (int j = 0; j < 8; ++j) neq += (key[j] == T);
    int tot; int eqbase = block_excl_scan(neq, sm, tot);
    int flags = 0, nsel = 0;
#pragma unroll
    for (int j = 0; j < 8; ++j) { bool sel = key[j] > T; if (key[j] == T) { sel = eqbase < remain; ++eqbase; } if (sel) { flags |= 1 << j; ++nsel; } }
    int slot = block_excl_scan(nsel, sm, tot);
    const int rowbase = (e * NB + b) * CAP;
#pragma unroll
    for (int j = 0; j < 8; ++j) { const int t = tid * 8 + j; int sl = -1;
        if (flags & (1 << j)) { sl = slot++; idx[rowbase + sl] = t; gate[rowbase + sl] = __uint_as_float(key[j]); s_list[sl] = t; }
        inv[((size_t)b * SEQ + t) * NE + e] = sl; }
    __syncthreads();
    const int lane = tid & 63, wave = tid >> 6;
    for (int s = wave; s < CAP; s += 8) { const u32x4* src = (const u32x4*)(HF + ((size_t)b * SEQ + s_list[s]) * DM); u32x4* dst = (u32x4*)(XS + (size_t)(rowbase + s) * DM);
        dst[lane] = src[lane]; dst[lane + 64] = src[lane + 64]; }
  }
#undef s_prefix
#undef s_remain
}

__device__ __forceinline__ void ph_combine(const bf16_t* __restrict__ Y, const int* __restrict__ inv, const float* __restrict__ mod, const float* __restrict__ g_fpost, float* __restrict__ out, int bid, int G) {
    const int lane = threadIdx.x & 63, wave = threadIdx.x >> 6;
    for (int m = bid * 8 + wave; m < M_LAT; m += G * 8) {
        const int b = m / SEQ; const float* mv = mod + (size_t)b * 6144;
        f32x4 y[4];
#pragma unroll
        for (int j = 0; j < 4; ++j) y[j] = (f32x4){0.f, 0.f, 0.f, 0.f};
        for (int e = 0; e < NE; ++e) { const int sl = inv[(size_t)m * NE + e]; if (sl < 0) continue;
            const unsigned long long* yp = (const unsigned long long*)(Y + (size_t)((e * NB + b) * CAP + sl) * DM) + lane;
#pragma unroll
            for (int j = 0; j < 4; ++j) { const unsigned long long w = yp[64 * j]; const unsigned lo = (unsigned)w, hi = (unsigned)(w >> 32);
                y[j] += (f32x4){__uint_as_float(lo << 16), __uint_as_float(lo & 0xffff0000u), __uint_as_float(hi << 16), __uint_as_float(hi & 0xffff0000u)}; } }
        float ss = 0.f;
#pragma unroll
        for (int j = 0; j < 4; ++j) ss += (y[j].x * y[j].x + y[j].y * y[j].y) + (y[j].z * y[j].z + y[j].w * y[j].w);
        const float rstd = rsqrtf(wave_sum(ss) * (1.f / DM) + EPS);
#pragma unroll
        for (int j = 0; j < 4; ++j) { const int col = 4 * lane + 256 * j; float* op = out + (size_t)m * DM + col;
            const f32x4 xn = *(const f32x4*)op, gp = *(const f32x4*)(g_fpost + col), gf = *(const f32x4*)(mv + 5120 + col);
            *(f32x4*)op = xn + gf * (y[j] * rstd * gp); }
    }
}

#define GAS __attribute__((address_space(1)))
#define XB_TMO      128
#define XB_XCNT(j)  (256  + 64 * (j))
#define XB_XSUB(j)  (1280 + 64 * (j))
#define XB_XGEN(j)  (2304 + 64 * (j))
#define XB_TOP      3328
#define XB_TOPGEN   3392
#define XCD_BAR_WORDS 3456
#define XB_SPIN_CAP (1u << 18)

__device__ __forceinline__ unsigned xb_ld(unsigned* p)              { return __hip_atomic_load(p, __ATOMIC_RELAXED, __HIP_MEMORY_SCOPE_AGENT); }
__device__ __forceinline__ unsigned xb_add(unsigned* p, unsigned v) { return __hip_atomic_fetch_add(p, v, __ATOMIC_RELAXED, __HIP_MEMORY_SCOPE_AGENT); }
__device__ __forceinline__ unsigned xb_xcc_id() { return (unsigned)__builtin_amdgcn_s_getreg((3 << 11) | 20) & 0xFu; }
#define XB_SPIN(cond, bar) do { unsigned _sp = 0; while (cond) { __builtin_amdgcn_s_sleep(1); \
    if ((++_sp & 255u) == 0u) { if (xb_ld(&(bar)[XB_TMO])) break; if (_sp > XB_SPIN_CAP) { atomicAdd(&(bar)[XB_TMO], 1u); break; } } } } while (0)

struct XcdBarrier {
    unsigned* bar; unsigned x;
    volatile LAS unsigned* st;
};

__device__ __forceinline__ XcdBarrier xcd_barrier_post(unsigned* bar, volatile LAS unsigned* st) {
    XcdBarrier b; b.bar = bar; b.x = xb_xcc_id(); b.st = st;
    if (threadIdx.x == 0) (void)xb_add(&bar[XB_XCNT(b.x)], 1u);
    return b;
}
__device__ __forceinline__ void xcd_barrier_complete(unsigned* bar, unsigned x, unsigned& nloc, unsigned& nx) {
    const unsigned G = gridDim.x * gridDim.y * gridDim.z;
    unsigned sum, cnt, mine, sp = 0u;
    for (;;) {
        sum = 0u; cnt = 0u; mine = 0u;
#pragma unroll
        for (unsigned j = 0; j < 16; ++j) { const unsigned c = xb_ld(&bar[XB_XCNT(j)]); sum += c; cnt += (c > 0u) ? 1u : 0u; mine = (j == x) ? c : mine; }
        if (sum == G) break;
        __builtin_amdgcn_s_sleep(1);
        if ((++sp & 255u) == 0u) { if (xb_ld(&bar[XB_TMO])) break; if (sp > XB_SPIN_CAP) { atomicAdd(&bar[XB_TMO], 1u); break; } }
    }
    nloc = mine > 0u ? mine : 1u; nx = cnt > 0u ? cnt : 1u;
}

__device__ __forceinline__ void xcd_barrier(const XcdBarrier& b) {
    asm volatile("s_waitcnt vmcnt(0)" ::: "memory");
    __syncthreads();
    if (threadIdx.x == 0) {
        unsigned* bar = b.bar;
        __builtin_amdgcn_s_waitcnt(0);
        unsigned nloc = b.st[0], nx = b.st[1];
        if (nloc == 0u) { xcd_barrier_complete(bar, b.x, nloc, nx); b.st[0] = nloc; b.st[1] = nx; }
        const unsigned old = xb_add(&bar[XB_XSUB(b.x)], 1u);
        const unsigned gen = old / nloc;
        if (old + 1u == (gen + 1u) * nloc) {
            __builtin_amdgcn_fence(__ATOMIC_RELEASE, "agent");
            asm volatile("s_waitcnt vmcnt(0)" ::: "memory");
            const unsigned og = xb_add(&bar[XB_TOP], 1u);
            const unsigned tg = og / nx;
            if (og + 1u == (tg + 1u) * nx) xb_add(&bar[XB_TOPGEN], 1u);
            else XB_SPIN(xb_ld(&bar[XB_TOPGEN]) == tg, bar);
            __builtin_amdgcn_fence(__ATOMIC_ACQUIRE, "agent");
            xb_add(&bar[XB_XGEN(b.x)], 1u);
            asm volatile("s_waitcnt vmcnt(0)" ::: "memory");
        } else {
            XB_SPIN(xb_ld(&bar[XB_XGEN(b.x)]) == gen, bar);
            __builtin_amdgcn_fence(__ATOMIC_ACQUIRE, "agent");
            asm volatile("s_waitcnt vmcnt(0)" ::: "memory");
        }
    }
    __syncthreads();
}


namespace cg = cooperative_groups;
constexpr int LDS_BYTES = 147456;
constexpr int N_PHASES = 12;
constexpr size_t CTL_BYTES = 65536;
#ifndef REP_PH
#define REP_PH -1
#endif
#ifndef REP_SYNC
#define REP_SYNC 0
#endif
struct MegaArgs { const float* in[20]; float* out; unsigned char* ws; int ph_lo, ph_hi; };
__global__ void __launch_bounds__(512, 2) hy_mega(MegaArgs a) {
    extern __shared__ __attribute__((aligned(16))) unsigned char lds_raw[];
    LAS unsigned char* lds = (LAS unsigned char*)lds_raw;
    const int bid = blockIdx.x, G = gridDim.x;
    const float* x = a.in[0]; const float* c = a.in[1]; const float* ctx = a.in[2]; const float* c_ctx = a.in[3];
    const float* w_mod = a.in[4]; const float* b_mod = a.in[5]; const float* g_pre = a.in[6]; const float* g_post = a.in[7];
    const float* g_fpre = a.in[8]; const float* g_fpost = a.in[9]; const float* w_in = a.in[10]; const float* rpb = a.in[11];
    const float* a_up = a.in[12]; const float* a_bias = a.in[13]; const float* gnorm = a.in[14]; const float* w_out = a.in[15];
    const float* router = a.in[16]; const float* w_gate = a.in[17]; const float* w_up = a.in[18]; const float* w_down = a.in[19];
    unsigned char* ws = a.ws; float* out = a.out;
    float* mod = (float*)(ws + WS_MOD);
    bf16_t* WTIN = (bf16_t*)(ws + WS_WTIN); bf16_t* WTV = (bf16_t*)(ws + WS_WTV); bf16_t* WTOUT = (bf16_t*)(ws + WS_WTOUT); bf16_t* WTGU = (bf16_t*)(ws + WS_WTGU); bf16_t* WTDN = (bf16_t*)(ws + WS_WTDN);
    bf16_t* H = (bf16_t*)(ws + WS_H); bf16_t* PROJ = (bf16_t*)(ws + WS_PROJ); bf16_t* VT = (bf16_t*)(ws + WS_VT); bf16_t* OMIX = (bf16_t*)(ws + WS_OMIX); bf16_t* MIX = (bf16_t*)(ws + WS_MIX);
    bf16_t* HID = (bf16_t*)(ws + WS_HID); bf16_t* HF = (bf16_t*)(ws + WS_HF); bf16_t* XS = (bf16_t*)(ws + WS_XS); bf16_t* Y = XS;
    float* aff = (float*)(ws + WS_AFF); int* idx = (int*)(ws + WS_IDX); float* gate = (float*)(ws + WS_GATE); int* inv = (int*)(ws + WS_INV);
    bf16_t* QF = (bf16_t*)(ws + WS_QF); bf16_t* KF = (bf16_t*)(ws + WS_KF); bf16_t* KFT = (bf16_t*)(ws + WS_KFT); float* AT = (float*)(ws + WS_AT); bf16_t* SB = (bf16_t*)(ws + WS_SB); bf16_t* KH = (bf16_t*)(ws + WS_KH); bf16_t* VB = (bf16_t*)(ws + WS_VB);
    volatile LAS unsigned* bst = (volatile LAS unsigned*)(lds + LDS_BYTES - 64);
    if (threadIdx.x < 16) bst[threadIdx.x] = 0u;
    __syncthreads();
    XcdBarrier bar = xcd_barrier_post((unsigned*)ws, bst);
    if (a.ph_hi < 0) cg::this_grid().sync();
    const int lo = a.ph_lo, hi = a.ph_hi;
#define IN(k) (lo <= (k) && (k) < hi)
#define SEAM(k) do { if (IN(k) && IN((k) + 1)) xcd_barrier(bar); } while (0)
    PrepArgs p; p.x = x; p.ctx = ctx; p.g_pre = g_pre; p.mod = mod; p.w_in = w_in; p.w_out = w_out; p.w_gate = w_gate; p.w_up = w_up; p.w_down = w_down;
    p.WTIN = WTIN; p.WTV = WTV; p.WTOUT = WTOUT; p.WTGU = WTGU; p.WTDN = WTDN; p.H = H;
#define PH0 if (IN(0)) { ph_mod(c, c_ctx, w_mod, b_mod, mod, lds, bid, G); ph_convert(p, lds, bid, G); }
#define PH1 if (IN(1)) ph_modulate(p, bid, G);
#define PH2 if (IN(2)) { \
        { pg8::Gemm g{H, WTIN, M_ALL, PROJ_LD, DM}; pg8::StaticOrder S; S.init(g.M, g.N, G, bid); EpiProj E{PROJ, PROJ_LD, KH}; \
          pg8::gemm_phase<EpiProj, pg8::StaticOrder, true, true>(lds, g, S, E); } \
        { pg8::Gemm g{WTV, H, 1024, M_ALL, DM}; pg8::StaticOrder S; S.init(g.M, g.N, G, bid); EpiVal E{VT, VT_LD, VB}; \
          pg8::gemm_phase<EpiVal, pg8::StaticOrder, true, true>(lds, g, S, E); } }
#define PH3 if (IN(3)) { ph_gla_prep2(PROJ, a_up, a_bias, QF, KF, KFT, AT, lds, bid, G); ph_na(PROJ, KH, VB, rpb, OMIX, lds, bid, G); }
#define PH4 if (IN(4)) ph_gla_state(KFT, VT, AT, SB, bid, G);
#define PH5 if (IN(5)) ph_gla_out(PROJ, QF, KF, VT, SB, gnorm, OMIX, bid, G);
#define PH6 if (IN(6)) { pg8::Gemm g{OMIX, WTOUT, M_LAT, DM, DM}; pg8::StaticOrder S; S.init(g.M, g.N, G, bid); pg8::EpiBf16<0> E{MIX, DM, nullptr, 0, 0, 1.f}; \
        pg8::gemm_phase<pg8::EpiBf16<0>, pg8::StaticOrder, true, true>(lds, g, S, E); }
#define PH7 if (IN(7)) ph_post_mix(x, MIX, mod, g_post, g_fpre, router, out, HF, aff, lds, bid, G);
#define PH8 if (IN(8)) ph_topk(aff, HF, idx, gate, inv, XS, lds, bid, G);
#define PH9 if (IN(9)) { pg8::Gemm g{XS, WTGU, NSLOT, 2 * DE, DM}; ExpertOrder S{22, G, bid}; EpiSwiGLU E{HID, DE}; \
        pg8::gemm_phase<EpiSwiGLU, ExpertOrder, true, true>(lds, g, S, E); }
#define PH10 if (IN(10)) { pg8::Gemm g{HID, WTDN, NSLOT, DM, DE}; ExpertOrder S{4, G, bid}; EpiRowScale E{Y, DM, gate}; \
        pg8::gemm_phase<EpiRowScale, ExpertOrder, true, true>(lds, g, S, E); }
#define PH11 if (IN(11)) ph_combine(Y, inv, mod, g_fpost, out, bid, G);
#define RUN(k, PH) PH
    PH0
#if REP_PH == 0
    PH0
#endif
    SEAM(0);
    for (int rs_ = 0; rs_ < REP_SYNC; ++rs_) xcd_barrier(bar);
    PH1
#if REP_PH == 1
    PH1
#endif
    SEAM(1);
    PH2
#if REP_PH == 2
    PH2
#endif
    SEAM(2);
    PH3
#if REP_PH == 3
    PH3
#endif
    SEAM(3);
    PH4
#if REP_PH == 4
    PH4
#endif
    SEAM(4);
    PH5
#if REP_PH == 5
    PH5
#endif
    SEAM(5);
    PH6
#if REP_PH == 6
    PH6
#endif
    SEAM(6);
    PH7
#if REP_PH == 7
    PH7
#endif
    SEAM(7);
    PH8
#if REP_PH == 8
    PH8
#endif
    SEAM(8);
    PH9
#if REP_PH == 9
    PH9
#endif
    SEAM(9);
    PH10
#if REP_PH == 10
    PH10
#endif
    SEAM(10);
    PH11
#undef IN
#undef SEAM
}
}

extern "C" void kernel_launch(void* const* d_in, const int* in_sizes, int n_in, void* d_out, int out_size, void* d_ws, size_t ws_size, hipStream_t stream) {
    using namespace hy;
    static int grid = 0;
    if (grid == 0) {
        if (n_in != 20 || in_sizes[0] != M_LAT * DM || out_size != M_LAT * DM || ws_size < WS_END) { fprintf(stderr, "kernel_launch: unexpected shapes / workspace (n_in %d, ws %zu)\n", n_in, ws_size); grid = -1; return; }
        int dev = 0, cus = 0, per_cu = 0;
        if (hipGetDevice(&dev) != hipSuccess || hipDeviceGetAttribute(&cus, hipDeviceAttributeMultiprocessorCount, dev) != hipSuccess) { grid = -1; return; }
        if (hipFuncSetAttribute((const void*)hy_mega, hipFuncAttributeMaxDynamicSharedMemorySize, LDS_BYTES) != hipSuccess) { fprintf(stderr, "kernel_launch: hipFuncSetAttribute failed\n"); grid = -1; return; }
        if (hipOccupancyMaxActiveBlocksPerMultiprocessor(&per_cu, (const void*)hy_mega, 512, LDS_BYTES) != hipSuccess || per_cu < 1) { fprintf(stderr, "kernel_launch: occupancy query says %d\n", per_cu); per_cu = 1; }
        (void)hipGetLastError();
        grid = cus;
    }
    if (grid < 0) return;
    (void)hipMemsetAsync(d_ws, 0, CTL_BYTES, stream);
    MegaArgs a{};
    for (int i = 0; i < 20; ++i) a.in[i] = (const float*)d_in[i];
    a.out = (float*)d_out; a.ws = (unsigned char*)d_ws;
    a.ph_lo = 0; a.ph_hi = N_PHASES;
    void* args[] = {&a};
    hipError_t e = hipLaunchCooperativeKernel((const void*)hy_mega, dim3(grid), dim3(512), args, LDS_BYTES, stream);
    if (e != hipSuccess) fprintf(stderr, "cooperative launch failed: %s (grid %d)\n", hipGetErrorString(e), grid);
}
```

```cpp
#include <hip/hip_runtime.h>
#include <hip/hip_cooperative_groups.h>
#include <cstdio>
#include <cstdint>
namespace pg8 {
#define PG8_LAS __attribute__((address_space(3)))
typedef unsigned short bf16_t;
typedef short bf16x8 __attribute__((ext_vector_type(8)));
typedef float f32x4 __attribute__((ext_vector_type(4)));
typedef unsigned u32x4 __attribute__((ext_vector_type(4)));
constexpr int BM = 256, BK = 64, HALF = 128, HTB = HALF * BK * 2  , STAGE_BYTES = 8 * HTB, NXCD = 8, WGM = 8;

__host__ __device__ __forceinline__ int lds_byte(int r, int c) { const int st = (r >> 4) * 2 + (c >> 5), rr = r & 15, cc = c & 31, ob = rr * 64 + cc * 2; return st * 1024 + (ob ^ (((ob >> 9) & 1) << 5)); }
__host__ __device__ __forceinline__ void stage_rc(int b, int& R, int& C) { const int st = b / 1024, sb = b % 1024, swz = sb ^ (((sb >> 9) & 1) << 5); R = (st >> 1) * 16 + swz / 64; C = (st & 1) * 32 + (swz % 64) / 2; }
__host__ __device__ __forceinline__ int perm32(int rho) { const int n = rho >> 4, i = rho & 15; return 8 * (i >> 2) + 4 * n + (i & 3); }

struct Unit { int pm, pn, bt; };
struct Gemm { const bf16_t* A; const bf16_t* Bt; int M, N, K; };

struct StaticOrder {
    int nM, nN, nwg, G, c;
    __host__ __device__ void init(int M, int N, int G_, int c_) { nM = M / BM; nN = N / BM; nwg = nM * nN; G = G_; c = c_; }
    __host__ __device__ bool next(int i, Unit& u) const {
        const long L = (long)i * G + c; if (L >= nwg) return false;
        int wgid = (int)L; { const int q = nwg / NXCD, r = nwg % NXCD, xcd = wgid % NXCD, off = wgid / NXCD; wgid = (xcd < r ? xcd * (q + 1) : r * (q + 1) + (xcd - r) * q) + off; }
        const int nig = WGM * nN, gid = wgid / nig, fm = gid * WGM, gsz = (nM - fm) < WGM ? (nM - fm) : WGM;
        u.pm = fm + ((wgid % nig) % gsz); u.pn = (wgid % nig) / gsz; u.bt = u.pn; return true;
    }
    __device__ __forceinline__ void a_ready(const Unit&) const {}
    __device__ __forceinline__ void done(const Unit&) const {}
};

__device__ __forceinline__ unsigned cvt_pk_bf16(float lo, float hi) { unsigned r; asm volatile("v_cvt_pk_bf16_f32 %0, %1, %2" : "=v"(r) : "v"(lo), "v"(hi)); return r; }
typedef float f32x2 __attribute__((ext_vector_type(2)));
__device__ __forceinline__ f32x2 gelu_pk(f32x2 v) {
    const f32x2 av = __builtin_elementwise_abs(v), d = av * 0.2316418882f + 1.0f;
    f32x2 t; t.x = __builtin_amdgcn_rcpf(d.x); t.y = __builtin_amdgcn_rcpf(d.y);
    f32x2 q = t * 0.5307027145f + (-0.7265760135f); q = q * t + 0.7107068705f; q = q * t + (-0.142248368f); q = q * t + 0.127414796f; q = q * t;
    const f32x2 s = (v * v) * (-0.72134752044f);
    f32x2 e; e.x = __builtin_amdgcn_exp2f(s.x); e.y = __builtin_amdgcn_exp2f(s.y);
    const f32x2 m = v * (q * e), r = v - m;
    f32x2 o; o.x = v.x < 0.f ? m.x : r.x; o.y = v.y < 0.f ? m.y : r.y; return o;
}

template <int ACT  > struct EpiBf16 {
    static constexpr bool PERM = true, AFTER_DRAIN = false; static_assert(ACT == 0 || ACT == 1, "EpiBf16: ACT is 0 (none) or 1 (gelu_pk)");
    bf16_t* O; int ldc; const float* bias; int split_cols; size_t split_stride; float scale0;
    __device__ __forceinline__ void operator()(const f32x4 (&acc)[2][2][4][2], const Unit& u, int wr, int wc, int fr, int fq) const {
        const int row0 = u.pm * BM + wr * 64 + fr; int colt = u.pn * BM; bf16_t* base = O;
        float sc = 1.f; if (split_cols) { const int t = colt / split_cols; base += (size_t)t * split_stride; colt -= t * split_cols; if (t == 0) sc = scale0; }
        const int col0 = colt + wc * 32 + 8 * fq, bcol0 = u.pn * BM + wc * 32 + 8 * fq;
        f32x4 bv[2][2];
#pragma unroll
        for (int bj = 0; bj < 2; ++bj)
#pragma unroll
            for (int n = 0; n < 2; ++n) bv[bj][n] = bias ? *(const f32x4*)(bias + bcol0 + bj * HALF + 4 * n) : (f32x4){0.f, 0.f, 0.f, 0.f};
#pragma unroll
        for (int ai = 0; ai < 2; ++ai)
#pragma unroll
            for (int m = 0; m < 4; ++m) { bf16_t* rowp = base + (size_t)(row0 + ai * HALF + m * 16) * ldc + col0;
#pragma unroll
                for (int bj = 0; bj < 2; ++bj) { f32x4 v0 = acc[ai][bj][m][0] + bv[bj][0], v1 = acc[ai][bj][m][1] + bv[bj][1];
                    if (ACT == 1) { f32x2 a = gelu_pk((f32x2){v0[0], v0[1]}), b = gelu_pk((f32x2){v0[2], v0[3]}), c = gelu_pk((f32x2){v1[0], v1[1]}), d = gelu_pk((f32x2){v1[2], v1[3]});
                        v0 = (f32x4){a.x, a.y, b.x, b.y}; v1 = (f32x4){c.x, c.y, d.x, d.y}; }
                    v0 = v0 * sc; v1 = v1 * sc; u32x4 w; w.x = cvt_pk_bf16(v0[0], v0[1]); w.y = cvt_pk_bf16(v0[2], v0[3]); w.z = cvt_pk_bf16(v1[0], v1[1]); w.w = cvt_pk_bf16(v1[2], v1[3]);
                    *(u32x4*)(rowp + bj * HALF) = w; } }
    }
};
typedef int i32x8 __attribute__((ext_vector_type(8)));
typedef int i32x4v __attribute__((ext_vector_type(4)));
__device__ __forceinline__ f32x4 mfma_f8(bf16x8 b0, bf16x8 b1, bf16x8 a0, bf16x8 a1, f32x4 c) {
    const i32x8 bv = __builtin_shufflevector(__builtin_bit_cast(i32x4v, b0), __builtin_bit_cast(i32x4v, b1), 0, 1, 2, 3, 4, 5, 6, 7);
    const i32x8 av = __builtin_shufflevector(__builtin_bit_cast(i32x4v, a0), __builtin_bit_cast(i32x4v, a1), 0, 1, 2, 3, 4, 5, 6, 7);
    return __builtin_amdgcn_mfma_scale_f32_16x16x128_f8f6f4(bv, av, c, 0, 0, 0, 0x7f7f7f7f, 0, 0x7f7f7f7f);
}
struct Frag16 { bf16x8 k[2]; };
template <bool F8> struct FragSel { typedef Frag16 A; };
template <> struct FragSel<true> { typedef i32x8 A; };
__device__ __forceinline__ void frag_load(Frag16& d, const PG8_LAS unsigned char* p) { d.k[0] = *(const PG8_LAS bf16x8*)p; d.k[1] = *(const PG8_LAS bf16x8*)(p + 1024); }
__device__ __forceinline__ void frag_load(i32x8& d, const PG8_LAS unsigned char* p) { const i32x4v lo = *(const PG8_LAS i32x4v*)p, hi = *(const PG8_LAS i32x4v*)(p + 1024); d = __builtin_shufflevector(lo, hi, 0, 1, 2, 3, 4, 5, 6, 7); }
__device__ __forceinline__ f32x4 frag_mma(const Frag16& b, const Frag16& a, f32x4 c) { c = __builtin_amdgcn_mfma_f32_16x16x32_bf16(b.k[0], a.k[0], c, 0, 0, 0); return __builtin_amdgcn_mfma_f32_16x16x32_bf16(b.k[1], a.k[1], c, 0, 0, 0); }
__device__ __forceinline__ f32x4 frag_mma(const i32x8& b, const i32x8& a, f32x4 c) {
    const int sc = 0x7f7f7f7f;
    asm volatile("s_nop 1\n\tv_mfma_scale_f32_16x16x128_f8f6f4 %0, %1, %2, %0, %3, %3 op_sel_hi:[0,0,0]" : "+v"(c) : "v"(b), "v"(a), "v"(sc));
    return c; }
template <class Epi, class Sched, bool ALIGN_EPI = false, bool SP2 = false, bool F8 = false>
__device__ __forceinline__ void gemm_phase(PG8_LAS unsigned char* lds, const Gemm g, const Sched& S, const Epi& E) {
    const int tid = threadIdx.x, wid = __builtin_amdgcn_readfirstlane(tid >> 6), lane = tid & 63, wr = wid >> 2, wc = wid & 3, fr = lane & 15, fq = lane >> 4;
    const int K = g.K, nt = K / BK;
    unsigned voffA[2], voffB[2];
#pragma unroll
    for (int i = 0; i < 2; ++i) { int R, C; stage_rc(tid * 16 + i * 8192, R, C); const int Rb = Epi::PERM ? ((R & ~31) + perm32(R & 31)) : R;
        voffA[i] = (unsigned)(R * K + C) * 2u; voffB[i] = (unsigned)(Rb * K + C) * 2u; }
    const size_t kstep = (size_t)(BK * 2);
    const size_t hstep = (size_t)HALF * K * 2;
    const size_t tstep = 2 * hstep;
    const unsigned ldsw = (unsigned)wid * 1024u;
    const int aoff = lds_byte(wr * 64 + fr, fq * 8), boff = lds_byte(wc * 32 + fr, fq * 8);
#define PG8_SA(b, h) (((b) * 2 + (h)) * HTB)
#define PG8_SB(b, h) ((4 + (b) * 2 + (h)) * HTB)
#define PG8_STAGE(bufoff, gbase, voff) do { _Pragma("unroll") for (int _i = 0; _i < 2; ++_i) \
        __builtin_amdgcn_global_load_lds((const unsigned*)((const char*)(gbase) + (voff)[_i]), (PG8_LAS unsigned*)(lds + (bufoff) + ldsw + _i * 8192), 16, 0, 0); } while (0)
#define PG8_LDA(dst, b, h) do { _Pragma("unroll") for (int m = 0; m < 4; ++m) frag_load(dst[m], lds + PG8_SA(b, h) + aoff + m * 2048); } while (0)
#define PG8_LDB(dst, b, h) do { _Pragma("unroll") for (int n = 0; n < 2; ++n) frag_load(dst[n], lds + PG8_SB(b, h) + boff + n * 2048); } while (0)
#define PG8_MMA(ai, bj, At, Bt) do { __builtin_amdgcn_s_setprio(1); _Pragma("unroll") for (int m = 0; m < 4; ++m) _Pragma("unroll") for (int n = 0; n < 2; ++n) \
        acc[ai][bj][m][n] = frag_mma(Bt[n], At[m], acc[ai][bj][m][n]); __builtin_amdgcn_s_setprio(0); } while (0)
#define PG8_WAIT_V(n) asm volatile("s_waitcnt vmcnt(" #n ")" ::: "memory")
#define PG8_WAIT_L(n) asm volatile("s_waitcnt lgkmcnt(" #n ")" ::: "memory")
#define PG8_BAR __builtin_amdgcn_s_barrier()
#define PG8_SCHED __builtin_amdgcn_sched_barrier(0)
    Unit cur, nxt; int ui = 0;
    if (!S.next(0, cur)) return;
    f32x4 acc[2][2][4][2];
#pragma unroll
    for (int a = 0; a < 2; ++a)
#pragma unroll
        for (int b = 0; b < 2; ++b)
#pragma unroll
            for (int m = 0; m < 4; ++m)
#pragma unroll
                for (int n = 0; n < 2; ++n) acc[a][b][m][n] = (f32x4){0.f, 0.f, 0.f, 0.f};
    typename FragSel<F8>::A At[4]; typename FragSel<F8>::A B0[2], B1[2];
    const char* cA = (const char*)g.A + (size_t)cur.pm * tstep; const char* cB = (const char*)g.Bt + (size_t)cur.bt * tstep;
    S.a_ready(cur);
    if constexpr (SP2) {
        PG8_STAGE(PG8_SB(0, 0), cB, voffB); PG8_STAGE(PG8_SB(0, 1), cB + hstep, voffB); PG8_STAGE(PG8_SA(0, 0), cA, voffA); PG8_STAGE(PG8_SA(0, 1), cA + hstep, voffA);
        if (wr == 1) PG8_BAR;
        PG8_WAIT_V(2); PG8_BAR;
        PG8_STAGE(PG8_SB(1, 0), cB + kstep, voffB); PG8_STAGE(PG8_SA(1, 0), cA + kstep, voffA); PG8_STAGE(PG8_SB(1, 1), cB + hstep + kstep, voffB);
        PG8_WAIT_V(6); PG8_BAR;
    } else {
        PG8_STAGE(PG8_SB(0, 0), cB, voffB); PG8_STAGE(PG8_SA(0, 0), cA, voffA); PG8_STAGE(PG8_SB(0, 1), cB + hstep, voffB); PG8_STAGE(PG8_SA(0, 1), cA + hstep, voffA);
        if (wr == 1) PG8_BAR;
        PG8_WAIT_V(4); PG8_BAR;
        PG8_STAGE(PG8_SB(1, 0), cB + kstep, voffB); PG8_STAGE(PG8_SA(1, 0), cA + kstep, voffA); PG8_STAGE(PG8_SB(1, 1), cB + hstep + kstep, voffB);
        PG8_WAIT_V(6); PG8_BAR;
    }
    for (;;) {
        const bool has_next = S.next(ui + 1, nxt);
        const char* nA = has_next ? (const char*)g.A + (size_t)nxt.pm * tstep : cA; const char* nB = has_next ? (const char*)g.Bt + (size_t)nxt.bt * tstep : cB;
        for (int t = 0; t < nt; t += 2) {
            const bool last = (t == nt - 2);
            const char* a1 = cA + (size_t)(t + 1) * kstep;
            const char* a2 = last ? nA : cA + (size_t)(t + 2) * kstep; const char* b2 = last ? nB : cB + (size_t)(t + 2) * kstep;
            const char* a3 = a2 + kstep; const char* b3 = b2 + kstep;
            if (last && has_next) S.a_ready(nxt);
            if constexpr (SP2) {
            PG8_LDB(B0, 0, 0); PG8_LDB(B1, 0, 1); PG8_SCHED; PG8_LDA(At, 0, 0); PG8_STAGE(PG8_SA(1, 1), a1 + hstep, voffA);
            PG8_WAIT_V(8); PG8_WAIT_L(0); PG8_BAR; PG8_MMA(0, 0, At, B0); PG8_MMA(0, 1, At, B1); PG8_BAR; PG8_SCHED;
            PG8_LDA(At, 0, 1); PG8_STAGE(PG8_SB(0, 0), b2, voffB); PG8_STAGE(PG8_SB(0, 1), b2 + hstep, voffB); PG8_STAGE(PG8_SA(0, 0), a2, voffA);
            PG8_WAIT_V(8); PG8_WAIT_L(0); PG8_BAR; PG8_MMA(1, 0, At, B0); PG8_MMA(1, 1, At, B1); PG8_BAR; PG8_SCHED;
            PG8_LDB(B0, 1, 0); PG8_LDB(B1, 1, 1); PG8_SCHED; PG8_LDA(At, 1, 0); PG8_STAGE(PG8_SA(0, 1), a2 + hstep, voffA);
            PG8_WAIT_V(8); PG8_WAIT_L(0); PG8_BAR; PG8_MMA(0, 0, At, B0); PG8_MMA(0, 1, At, B1); PG8_BAR; PG8_SCHED;
            PG8_LDA(At, 1, 1); PG8_STAGE(PG8_SB(1, 0), b3, voffB); PG8_STAGE(PG8_SB(1, 1), b3 + hstep, voffB); PG8_STAGE(PG8_SA(1, 0), a3, voffA);
            PG8_WAIT_V(8); PG8_WAIT_L(0); PG8_BAR; PG8_MMA(1, 0, At, B0); PG8_MMA(1, 1, At, B1); PG8_BAR; PG8_SCHED;
            } else {
            PG8_LDB(B0, 0, 0); PG8_SCHED; PG8_LDA(At, 0, 0); PG8_STAGE(PG8_SA(1, 1), a1 + hstep, voffA);
            PG8_WAIT_L(8); PG8_BAR; PG8_WAIT_L(0); PG8_MMA(0, 0, At, B0); PG8_BAR; PG8_SCHED;
            PG8_LDB(B1, 0, 1); PG8_STAGE(PG8_SB(0, 0), b2, voffB);
            PG8_BAR; PG8_WAIT_L(0); PG8_MMA(0, 1, At, B1); PG8_BAR;
            PG8_LDA(At, 0, 1); PG8_STAGE(PG8_SA(0, 0), a2, voffA);
            PG8_BAR; PG8_WAIT_L(0); PG8_MMA(1, 0, At, B0); PG8_BAR; PG8_SCHED;
            PG8_STAGE(PG8_SB(0, 1), b2 + hstep, voffB);
            PG8_WAIT_V(6); PG8_BAR; PG8_MMA(1, 1, At, B1); PG8_BAR;
            PG8_LDB(B0, 1, 0); PG8_SCHED; PG8_LDA(At, 1, 0); PG8_STAGE(PG8_SA(0, 1), a2 + hstep, voffA);
            PG8_WAIT_L(8); PG8_BAR; PG8_WAIT_L(0); PG8_MMA(0, 0, At, B0); PG8_BAR; PG8_SCHED;
            PG8_LDB(B1, 1, 1); PG8_STAGE(PG8_SB(1, 0), b3, voffB);
            PG8_BAR; PG8_WAIT_L(0); PG8_MMA(0, 1, At, B1); PG8_BAR;
            PG8_LDA(At, 1, 1); PG8_STAGE(PG8_SA(1, 0), a3, voffA);
            PG8_BAR; PG8_WAIT_L(0); PG8_MMA(1, 0, At, B0); PG8_BAR; PG8_SCHED;
            PG8_STAGE(PG8_SB(1, 1), b3 + hstep, voffB);
            PG8_WAIT_V(6); PG8_BAR; PG8_MMA(1, 1, At, B1); PG8_BAR;
            }
        }
        if constexpr (ALIGN_EPI) { if (wr == 0) PG8_BAR; }
        if constexpr (F8) {
            asm volatile("s_nop 15\n\ts_nop 15" ::: "memory");
#pragma unroll
            for (int a = 0; a < 2; ++a)
#pragma unroll
                for (int b = 0; b < 2; ++b)
#pragma unroll
                    for (int m = 0; m < 4; ++m) asm volatile("" : "+v"(acc[a][b][m][0]), "+v"(acc[a][b][m][1]));
        }
        if constexpr (!Epi::AFTER_DRAIN) { E(acc, cur, wr, wc, fr, fq); S.done(cur); }
        if (!has_next) break;
#pragma unroll
        for (int a = 0; a < 2; ++a)
#pragma unroll
            for (int b = 0; b < 2; ++b)
#pragma unroll
                for (int m = 0; m < 4; ++m)
#pragma unroll
                    for (int n = 0; n < 2; ++n) acc[a][b][m][n] = (f32x4){0.f, 0.f, 0.f, 0.f};
        cur = nxt; cA = nA; cB = nB; ++ui;
        if constexpr (ALIGN_EPI) { if (wr == 1) PG8_BAR; }
    }
    PG8_WAIT_V(0);
    if constexpr (!ALIGN_EPI) { if (wr == 0) PG8_BAR; }
    PG8_BAR;
    if constexpr (Epi::AFTER_DRAIN) { E.fused(acc, cur, wr, wc, fr, fq, lds, wid, lane); S.done(cur); }
#undef PG8_SA
#undef PG8_SB
#undef PG8_STAGE
#undef PG8_LDA
#undef PG8_LDB
#undef PG8_MMA
#undef PG8_WAIT_V
#undef PG8_WAIT_L
#undef PG8_BAR
#undef PG8_SCHED
}
}
namespace hy {
using pg8::bf16_t; using pg8::f32x4; using pg8::u32x4; using pg8::bf16x8;
#define LAS __attribute__((address_space(3)))
constexpr int NB = 4, SEQ = 4096, DM = 1024, CTXL = 256;
constexpr int M_LAT = NB * SEQ, M_CTX = NB * CTXL, M_ALL = M_LAT + M_CTX;
constexpr int IN_COLS = 3104, NE = 16, CAP = 512, DE = 2816, NSLOT = NE * NB * CAP;
constexpr int PROJ_LD = 2304, PC_NAK = 0, PC_GK = 512, PC_NAQ = 768, PC_GQ = 1280, PC_GG = 1536, PC_AD = 2048;
constexpr int VT_LD = M_ALL;
constexpr float EPS = 1e-6f;
constexpr int TKB = SEQ + CTXL;
constexpr size_t MiB = 1u << 20;
constexpr size_t WS_MODP = 1 * MiB, WS_MOD = 3 * MiB, WS_WTIN = 4 * MiB, WS_WTV = 9 * MiB, WS_WTOUT = 11 * MiB, WS_AFF = 13 * MiB, WS_IDX = 14 * MiB, WS_GATE = 14 * MiB + 256 * 1024, WS_INV = 15 * MiB;
constexpr size_t WS_WTGU = 16 * MiB, WS_WTDN = 192 * MiB, WS_H = 280 * MiB, WS_PROJ = 314 * MiB, WS_VT = 391 * MiB, WS_OMIX = 425 * MiB, WS_MIX = 457 * MiB, WS_HID = 280 * MiB;
constexpr size_t WS_HF = 489 * MiB, WS_XS = 521 * MiB, WS_GLAT = 590 * MiB, WS_QF = 590 * MiB, WS_KF = 606 * MiB, WS_KFT = 622 * MiB, WS_AT = 639 * MiB, WS_SB = 640 * MiB, WS_UPF = 639 * MiB + 768 * 1024, WS_KH = 521 * MiB, WS_VB = 538 * MiB, WS_END = 672 * MiB;
static_assert(WS_WTIN + (size_t)PROJ_LD * DM * 2 <= WS_WTV && WS_WTGU + (size_t)NE * 2 * DE * DM * 2 <= WS_WTDN && WS_WTDN + (size_t)NE * DM * DE * 2 <= WS_H, "ws map 1");
static_assert(WS_H + (size_t)M_ALL * DM * 2 <= WS_PROJ && WS_PROJ + (size_t)M_ALL * PROJ_LD * 2 <= WS_VT && WS_VT + (size_t)1024 * VT_LD * 2 <= WS_OMIX, "ws map 2");
static_assert(WS_HID + (size_t)NSLOT * DE * 2 <= WS_MIX && WS_XS + (size_t)NSLOT * DM * 2 <= WS_GLAT && WS_SB + (size_t)2 * NB * 4 * 64 * 128 * 64 * 2 <= WS_END && WS_KFT + (size_t)2 * 256 * M_ALL * 2 <= WS_AT, "ws map 3");

__device__ __forceinline__ float bf2f(bf16_t x) { return __uint_as_float((unsigned)x << 16); }
__device__ __forceinline__ unsigned f2bf(float f) { unsigned u = __float_as_uint(f); return (u + 0x7fffu + ((u >> 16) & 1u)) >> 16; }
__device__ __forceinline__ unsigned pk2(float lo, float hi) { return f2bf(lo) | (f2bf(hi) << 16); }
__device__ __forceinline__ float wave_sum(float v) {
#pragma unroll
    for (int o = 1; o < 64; o <<= 1) v += __shfl_xor(v, o);
    return v;
}
__device__ __forceinline__ float silu_f(float x) { return x / (1.f + __expf(-x)); }

__device__ __forceinline__ void ph_mod(const float* __restrict__ c, const float* __restrict__ c_ctx, const float* __restrict__ w_mod, const float* __restrict__ b_mod, float* __restrict__ mod, LAS unsigned char* lds, int bid, int G) {
    LAS float* s = (LAS float*)lds;
    LAS float* red = s + 5 * 1024;
    const int tid = threadIdx.x;
    __syncthreads();
    for (int i = tid; i < 5 * 1024; i += 512) { const int v = i >> 10, k = i & 1023; const float x = v < 4 ? c[v * 1024 + k] : c_ctx[k]; s[i] = x / (1.f + expf(-x)); }
    __syncthreads();
    for (int cg = bid; cg < 256; cg += G) {
        const int ks = tid / 24, cj = tid % 24, j = cg * 24 + cj;
        if (tid < 504) {
            float acc[5] = {0.f, 0.f, 0.f, 0.f, 0.f};
            const int k0 = ks * 49, k1 = min(k0 + 49, 1024);
#pragma unroll 7
            for (int k = k0; k < k1; ++k) { const float w = w_mod[(size_t)k * 6144 + j];
#pragma unroll
                for (int v = 0; v < 5; ++v) acc[v] += s[v * 1024 + k] * w; }
#pragma unroll
            for (int v = 0; v < 5; ++v) red[(v * 21 + ks) * 24 + cj] = acc[v];
        }
        __syncthreads();
        if (tid < 120) { const int v = tid / 24, cc = tid % 24; float a = b_mod[cg * 24 + cc];
            for (int q = 0; q < 21; ++q) a += red[(v * 21 + q) * 24 + cc];
            mod[(size_t)v * 6144 + cg * 24 + cc] = a; }
        __syncthreads();
    }
}

__device__ __forceinline__ void transpose_item(const float* __restrict__ W, int N, int k0, int n0, bf16_t* dst, int K, float scale, LAS float* scr, int lane) {
    float wv[32];
#pragma unroll
    for (int i = 0; i < 32; ++i) wv[i] = W[(size_t)(k0 + 2 * i + (lane >> 5)) * N + n0 + (lane & 31)];
#pragma unroll
    for (int i = 0; i < 32; ++i) scr[(2 * i + (lane >> 5)) * 33 + (lane & 31)] = wv[i];
    asm volatile("s_waitcnt lgkmcnt(0)" ::: "memory");
    const int c = lane & 7;
#pragma unroll
    for (int j = 0; j < 4; ++j) { const int n = (lane >> 3) + 8 * j; const LAS float* s = scr + (8 * c) * 33 + n;
        u32x4 o; o.x = pk2(s[0 * 33] * scale, s[1 * 33] * scale); o.y = pk2(s[2 * 33] * scale, s[3 * 33] * scale); o.z = pk2(s[4 * 33] * scale, s[5 * 33] * scale); o.w = pk2(s[6 * 33] * scale, s[7 * 33] * scale);
        *(u32x4*)(dst + (size_t)n * K + k0 + 8 * c) = o; }
    asm volatile("s_waitcnt lgkmcnt(0)" ::: "memory");
}
constexpr float SX8 = 16.f, SW1 = 64.f, SH8 = 8.f, SW2 = 128.f;
__device__ __forceinline__ float clamp448(float v) { return fminf(fmaxf(v, -448.f), 448.f); }
__device__ __forceinline__ unsigned pk4_fp8(float a, float b, float c, float d) {
    int w = 0; w = __builtin_amdgcn_cvt_pk_fp8_f32(clamp448(a), clamp448(b), w, false); w = __builtin_amdgcn_cvt_pk_fp8_f32(clamp448(c), clamp448(d), w, true); return (unsigned)w; }
__device__ __forceinline__ void transpose_item_f8(const float* __restrict__ W, int N, int k0, int n0, unsigned char* dst, int Kb, float scale, LAS float* scr, int lane) {
    float wv[32];
#pragma unroll
    for (int i = 0; i < 32; ++i) wv[i] = W[(size_t)(k0 + 2 * i + (lane >> 5)) * N + n0 + (lane & 31)];
#pragma unroll
    for (int i = 0; i < 32; ++i) scr[(2 * i + (lane >> 5)) * 33 + (lane & 31)] = wv[i];
    asm volatile("s_waitcnt lgkmcnt(0)" ::: "memory");
    const int c = lane & 3;
#pragma unroll
    for (int j = 0; j < 2; ++j) { const int n = (lane >> 2) + 16 * j; const LAS float* s = scr + (16 * c) * 33 + n;
        u32x4 o; o.x = pk4_fp8(s[0 * 33] * scale, s[1 * 33] * scale, s[2 * 33] * scale, s[3 * 33] * scale); o.y = pk4_fp8(s[4 * 33] * scale, s[5 * 33] * scale, s[6 * 33] * scale, s[7 * 33] * scale);
        o.z = pk4_fp8(s[8 * 33] * scale, s[9 * 33] * scale, s[10 * 33] * scale, s[11 * 33] * scale); o.w = pk4_fp8(s[12 * 33] * scale, s[13 * 33] * scale, s[14 * 33] * scale, s[15 * 33] * scale);
        *(u32x4*)(dst + (size_t)n * Kb + k0 + 16 * c) = o; }
    asm volatile("s_waitcnt lgkmcnt(0)" ::: "memory");
}
struct PrepArgs { const float *x, *ctx, *g_pre, *mod, *w_in, *w_out, *w_gate, *w_up, *w_down; bf16_t *WTIN, *WTV, *WTOUT; unsigned char *WTGU, *WTDN; bf16_t* H; };
constexpr int IT_IN = 16 * 97, IT_OUT = 16 * 32, IT_GU1 = 16 * 16 * 88, IT_DN = 16 * 44 * 32, IT_ALL = IT_IN + IT_OUT + 2 * IT_GU1 + IT_DN;
__device__ __forceinline__ void ph_convert(const PrepArgs& a, LAS unsigned char* lds, int bid, int G) {
    const int tid = threadIdx.x, lane = tid & 63, wave = tid >> 6;
    LAS float* scr = (LAS float*)(lds + wave * 8448);
    const int gw = bid * 8 + wave, NGW = G * 8;
    { u32x4* z = (u32x4*)(a.WTIN + (size_t)(PC_AD + 32) * DM); const int nz = (PROJ_LD - PC_AD - 32) * DM * 2 / 16;
      for (int i = bid * 512 + tid; i < nz; i += G * 512) z[i] = (u32x4){0u, 0u, 0u, 0u}; }
    for (int it = gw; it < IT_ALL; it += NGW) {
        int r = it;
        if (r < IT_IN) { const int kb = r / 97, n0 = (r % 97) * 32; bf16_t* dst; float sc = 1.f;
            if (n0 < 512) dst = a.WTIN + (size_t)(PC_NAK + n0) * DM;
            else if (n0 < 1024) dst = a.WTV + (size_t)(n0 - 512) * DM;
            else if (n0 < 1280) dst = a.WTIN + (size_t)(PC_GK + n0 - 1024) * DM;
            else if (n0 < 1792) dst = a.WTV + (size_t)(512 + n0 - 1280) * DM;
            else if (n0 < 1824) dst = a.WTIN + (size_t)(PC_AD + n0 - 1792) * DM;
            else if (n0 < 2336) { dst = a.WTIN + (size_t)(PC_NAQ + n0 - 1824) * DM; sc = 0.125f; }
            else if (n0 < 2592) { dst = a.WTIN + (size_t)(PC_GQ + n0 - 2336) * DM; sc = 0.125f; }
            else dst = a.WTIN + (size_t)(PC_GG + n0 - 2592) * DM;
            transpose_item(a.w_in, IN_COLS, kb * 64, n0, dst, DM, sc, scr, lane); continue; }
        r -= IT_IN;
        if (r < IT_OUT) { const int kb = r / 32, n0 = (r % 32) * 32; transpose_item(a.w_out, DM, kb * 64, n0, a.WTOUT + (size_t)n0 * DM, DM, 1.f, scr, lane); continue; }
        r -= IT_OUT;
        if (r < 2 * IT_GU1) { const int which = r / IT_GU1; r %= IT_GU1; const int e = r / (16 * 88); r %= (16 * 88); const int kb = r / 88, n0 = (r % 88) * 32;
            const float* W = (which ? a.w_up : a.w_gate) + (size_t)e * DM * DE;
            unsigned char* dst = a.WTGU + ((size_t)e * 2 * DE + (n0 / 128) * 256 + (n0 % 128) + which * 128) * DM;
            transpose_item_f8(W, DE, kb * 64, n0, dst, DM, SW1, scr, lane); continue; }
        r -= 2 * IT_GU1;
        { const int e = r / (44 * 32); r %= (44 * 32); const int kb = r / 32, n0 = (r % 32) * 32;
          transpose_item_f8(a.w_down + (size_t)e * DE * DM, DM, kb * 64, n0, a.WTDN + ((size_t)e * DM + n0) * DE, DE, SW2, scr, lane); }
    }
}
__device__ __forceinline__ void ph_modulate(const PrepArgs& a, int bid, int G) {
    const int tid = threadIdx.x, lane = tid & 63, wave = tid >> 6;
    const int gw = bid * 8 + wave, NGW = G * 8;
    for (int m = gw; m < M_ALL; m += NGW) {
        const float* src; int v;
        if (m < M_LAT) { src = a.x + (size_t)m * DM; v = m / SEQ; } else { src = a.ctx + (size_t)(m - M_LAT) * DM; v = 4; }
        const f32x4* xr = (const f32x4*)src + lane; f32x4 xv[4]; float ss = 0.f;
#pragma unroll
        for (int j = 0; j < 4; ++j) { xv[j] = xr[64 * j]; ss += (xv[j].x * xv[j].x + xv[j].y * xv[j].y) + (xv[j].z * xv[j].z + xv[j].w * xv[j].w); }
        const float rstd = rsqrtf(wave_sum(ss) * (1.f / DM) + EPS);
        const float* mv = a.mod + (size_t)v * 6144;
        unsigned long long* o8 = (unsigned long long*)(a.H + (size_t)m * DM) + lane;
#pragma unroll
        for (int j = 0; j < 4; ++j) { const int col = 4 * lane + 256 * j;
            const f32x4 g = *(const f32x4*)(a.g_pre + col), sh = *(const f32x4*)(mv + col), sc = *(const f32x4*)(mv + 1024 + col);
            const f32x4 hv = xv[j] * rstd * g * (sc + 1.f) + sh;
            o8[64 * j] = (unsigned long long)pk2(hv.x, hv.y) | ((unsigned long long)pk2(hv.z, hv.w) << 32); }
    }
}


__device__ __forceinline__ void tok_of_row(int row, int& bb, int& tk) { if (row < M_LAT) { bb = row >> 12; tk = row & (SEQ - 1); } else { const int r2 = row - M_LAT; bb = r2 >> 8; tk = SEQ + (r2 & (CTXL - 1)); } }
struct EpiProj {
    static constexpr bool PERM = true, AFTER_DRAIN = false;
    bf16_t* O; int ldc; bf16_t* KH;
    __device__ __forceinline__ void operator()(const f32x4 (&acc)[2][2][4][2], const pg8::Unit& u, int wr, int wc, int fr, int fq) const {
        const int row0 = u.pm * 256 + wr * 64 + fr, col0 = u.pn * 256 + wc * 32 + 8 * fq;
#pragma unroll
        for (int ai = 0; ai < 2; ++ai)
#pragma unroll
            for (int m = 0; m < 4; ++m) { const int row = row0 + ai * 128 + m * 16; int bb, tk; tok_of_row(row, bb, tk);
#pragma unroll
                for (int bj = 0; bj < 2; ++bj) { const f32x4 v0 = acc[ai][bj][m][0], v1 = acc[ai][bj][m][1];
                    u32x4 w; w.x = pg8::cvt_pk_bf16(v0[0], v0[1]); w.y = pg8::cvt_pk_bf16(v0[2], v0[3]); w.z = pg8::cvt_pk_bf16(v1[0], v1[1]); w.w = pg8::cvt_pk_bf16(v1[2], v1[3]);
                    const int col = col0 + bj * 128;
                    if (u.pn < 2) { const int hh = col >> 6, ks = (col >> 5) & 1; *(u32x4*)(KH + ((size_t)((bb * 8 + hh) * 2 + ks) * TKB + tk) * 32 + (col & 31)) = w; }
                    else *(u32x4*)(O + (size_t)row * ldc + col) = w; } }
    }
};
struct EpiVal {
    static constexpr bool PERM = true, AFTER_DRAIN = false;
    bf16_t* VT; int ldc; bf16_t* VB;
    __device__ __forceinline__ void operator()(const f32x4 (&acc)[2][2][4][2], const pg8::Unit& u, int wr, int wc, int fr, int fq) const {
        const int row0 = u.pm * 256 + wr * 64 + fr, col0 = u.pn * 256 + wc * 32 + 8 * fq;
#pragma unroll
        for (int ai = 0; ai < 2; ++ai)
#pragma unroll
            for (int m = 0; m < 4; ++m) { const int vr = row0 + ai * 128 + m * 16;
#pragma unroll
                for (int bj = 0; bj < 2; ++bj) { const f32x4 v0 = acc[ai][bj][m][0], v1 = acc[ai][bj][m][1];
                    u32x4 w; w.x = pg8::cvt_pk_bf16(v0[0], v0[1]); w.y = pg8::cvt_pk_bf16(v0[2], v0[3]); w.z = pg8::cvt_pk_bf16(v1[0], v1[1]); w.w = pg8::cvt_pk_bf16(v1[2], v1[3]);
                    const int col = col0 + bj * 128;
                    if (u.pm < 2) { int bb, tk; tok_of_row(col, bb, tk); const int hh = vr >> 6, dt = (vr >> 4) & 3, dd = vr & 15;
                        *(u32x4*)(VB + ((size_t)(((bb * 8 + hh) * 4 + dt) * (TKB / 8) + (tk >> 3)) * 16 + dd) * 8) = w; }
                    else *(u32x4*)(VT + (size_t)vr * ldc + col) = w; } }
    }
};
struct EpiSwiGLU {
    static constexpr bool PERM = true, AFTER_DRAIN = false;
    unsigned char* O; int ldc;
    __device__ __forceinline__ void operator()(const f32x4 (&acc)[2][2][4][2], const pg8::Unit& u, int wr, int wc, int fr, int fq) const {
        const int row0 = u.pm * 256 + wr * 64 + fr, col0 = u.pn * 128 + wc * 32 + 8 * fq;
        constexpr float DS = 1.f / (SX8 * SW1);
#pragma unroll
        for (int ai = 0; ai < 2; ++ai)
#pragma unroll
            for (int m = 0; m < 4; ++m) { unsigned char* rowp = O + (size_t)(row0 + ai * 128 + m * 16) * ldc + col0;
                const f32x4 g0 = acc[ai][0][m][0] * DS, g1 = acc[ai][0][m][1] * DS, u0 = acc[ai][1][m][0] * (DS * SH8), u1 = acc[ai][1][m][1] * (DS * SH8);
                uint2 w; w.x = pk4_fp8(silu_f(g0[0]) * u0[0], silu_f(g0[1]) * u0[1], silu_f(g0[2]) * u0[2], silu_f(g0[3]) * u0[3]);
                w.y = pk4_fp8(silu_f(g1[0]) * u1[0], silu_f(g1[1]) * u1[1], silu_f(g1[2]) * u1[2], silu_f(g1[3]) * u1[3]);
                *(uint2*)rowp = w; }
    }
};
struct EpiRowScale {
    static constexpr bool PERM = true, AFTER_DRAIN = false;
    bf16_t* O; int ldc; const float* rowscale;
    __device__ __forceinline__ void operator()(const f32x4 (&acc)[2][2][4][2], const pg8::Unit& u, int wr, int wc, int fr, int fq) const {
        const int row0 = u.pm * 256 + wr * 64 + fr, col0 = u.pn * 256 + wc * 32 + 8 * fq;
#pragma unroll
        for (int ai = 0; ai < 2; ++ai)
#pragma unroll
            for (int m = 0; m < 4; ++m) { const int row = row0 + ai * 128 + m * 16; const float sc = rowscale[row] * (1.f / (SH8 * SW2)); bf16_t* rowp = O + (size_t)row * ldc + col0;
#pragma unroll
                for (int bj = 0; bj < 2; ++bj) { const f32x4 v0 = acc[ai][bj][m][0] * sc, v1 = acc[ai][bj][m][1] * sc;
                    u32x4 w; w.x = pg8::cvt_pk_bf16(v0[0], v0[1]); w.y = pg8::cvt_pk_bf16(v0[2], v0[3]); w.z = pg8::cvt_pk_bf16(v1[0], v1[1]); w.w = pg8::cvt_pk_bf16(v1[2], v1[3]);
                    *(u32x4*)(rowp + bj * 128) = w; } }
    }
};
struct ExpertOrder {
    int nT, G, c;
    __device__ __forceinline__ bool next(int i, pg8::Unit& u) const {
        if (G == 256) { if (2 * i >= nT) return false; const int x = c & 7, j = c >> 3, e = 2 * x + (j >> 4), mt = j & 7, pn = 2 * i + ((j >> 3) & 1);
            u.pm = e * 8 + mt; u.pn = pn; u.bt = e * nT + pn; return true; }
        const long L = (long)i * G + c; if (L >= (long)128 * nT) return false;
        const int e = (int)(L / (8 * nT)), r = (int)(L % (8 * nT)); u.pm = e * 8 + (r % 8); u.pn = r / 8; u.bt = e * nT + u.pn; return true;
    }
    __device__ __forceinline__ void a_ready(const pg8::Unit&) const {}
    __device__ __forceinline__ void done(const pg8::Unit&) const {}
};
__device__ __forceinline__ void ph_na_naive(const bf16_t* __restrict__ PROJ, const bf16_t* __restrict__ VT, const float* __restrict__ rpb, bf16_t* __restrict__ OMIX, int bid, int G) {
  for (int vb = bid * 8 + (threadIdx.x >> 6); vb < NB * 8 * 64; vb += G * 8) {
    const int r = vb % 64, h = (vb / 64) % 8, b = vb / 512, c = threadIdx.x & 63;
    const size_t mq = (size_t)b * SEQ + r * 64 + c;
    float q[64], acc[64];
    { const u32x4* qp = (const u32x4*)(PROJ + mq * PROJ_LD + PC_NAQ + h * 64);
#pragma unroll
      for (int i = 0; i < 8; ++i) { const u32x4 w = qp[i]; q[8 * i + 0] = __uint_as_float(w.x << 16); q[8 * i + 1] = __uint_as_float(w.x & 0xffff0000u); q[8 * i + 2] = __uint_as_float(w.y << 16); q[8 * i + 3] = __uint_as_float(w.y & 0xffff0000u);
          q[8 * i + 4] = __uint_as_float(w.z << 16); q[8 * i + 5] = __uint_as_float(w.z & 0xffff0000u); q[8 * i + 6] = __uint_as_float(w.w << 16); q[8 * i + 7] = __uint_as_float(w.w & 0xffff0000u); } }
#pragma unroll
    for (int d = 0; d < 64; ++d) acc[d] = 0.f;
    float mx = -INFINITY, l = 0.f;
    const int rs = min(max(r - 4, 0), 56), cs = min(max(c - 8, 0), 48);
    for (int kk = 0; kk < 128 + CTXL; ++kk) {
        size_t mk; float bias = 0.f;
        if (kk < 128) { const int krow = rs + (kk >> 4), kcol = cs + (kk & 15); mk = (size_t)b * SEQ + krow * 64 + kcol; bias = rpb[(h * 15 + (krow - r + 7)) * 31 + (kcol - c + 15)]; }
        else mk = (size_t)M_LAT + b * CTXL + (kk - 128);
        const u32x4* kp = (const u32x4*)(PROJ + mk * PROJ_LD + PC_NAK + h * 64);
        float s = 0.f;
#pragma unroll
        for (int i = 0; i < 8; ++i) { const u32x4 w = kp[i];
            s += q[8 * i + 0] * __uint_as_float(w.x << 16) + q[8 * i + 1] * __uint_as_float(w.x & 0xffff0000u) + q[8 * i + 2] * __uint_as_float(w.y << 16) + q[8 * i + 3] * __uint_as_float(w.y & 0xffff0000u)
               + q[8 * i + 4] * __uint_as_float(w.z << 16) + q[8 * i + 5] * __uint_as_float(w.z & 0xffff0000u) + q[8 * i + 6] * __uint_as_float(w.w << 16) + q[8 * i + 7] * __uint_as_float(w.w & 0xffff0000u); }
        s += bias;
        const float mn = fmaxf(mx, s), al = __expf(mx - mn), p = __expf(s - mn);
        l = l * al + p; mx = mn;
        const bf16_t* vp = VT + (size_t)(h * 64) * VT_LD + mk;
#pragma unroll
        for (int d = 0; d < 64; ++d) acc[d] = acc[d] * al + p * bf2f(vp[(size_t)d * VT_LD]);
    }
    const float inv = 1.f / l;
    unsigned* op = (unsigned*)(OMIX + mq * DM + h * 64);
#pragma unroll
    for (int i = 0; i < 32; ++i) op[i] = pk2(acc[2 * i] * inv, acc[2 * i + 1] * inv);
  }
}

__device__ __forceinline__ f32x4 mfma16(bf16x8 a, bf16x8 b, f32x4 c) { return __builtin_amdgcn_mfma_f32_16x16x32_bf16(a, b, c, 0, 0, 0); }
__device__ __forceinline__ void na_unit(int u, const bf16_t* __restrict__ PROJ, const bf16_t* __restrict__ KH, const bf16_t* __restrict__ VB, const LAS float* rb, bf16_t* __restrict__ OMIX, int lane) {
    const int q = lane & 15, g = lane >> 4;
    const int bh = u >> 8, b = bh >> 3, h = bh & 7, r = (u & 255) >> 2, qt = u & 3;
    const int c0 = (qt == 0) ? 0 : (qt == 3 ? 32 : 16 * qt - 8);
    const int rs = min(max(r - 4, 0), 56);
    const int cq = 16 * qt + q, cs = min(max(cq - 8, 0), 48);
    const size_t mq = (size_t)b * SEQ + r * 64 + cq;
    const bf16_t* qp = PROJ + mq * PROJ_LD + PC_NAQ + h * 64 + 8 * g;
    const bf16x8 qf0 = *(const bf16x8*)qp, qf1 = *(const bf16x8*)(qp + 32);
    const bf16_t* kb0 = KH + ((size_t)(bh * 2) * TKB + 8 * (q >> 2) + (q & 3)) * 32 + 8 * g;
    const bf16_t* kb1 = kb0 + (size_t)TKB * 32;
    f32x4 S[32];
#pragma unroll
    for (int p = 0; p < 16; ++p) {
        const int s = (p < 8) ? ((rs + p) * 64 + c0) : (SEQ + 32 * (p - 8));
#pragma unroll
        for (int half = 0; half < 2; ++half) {
            const size_t off = (size_t)(s + 4 * half) * 32;
            f32x4 acc = (f32x4){0.f, 0.f, 0.f, 0.f};
            acc = mfma16(*(const bf16x8*)(kb0 + off), qf0, acc); acc = mfma16(*(const bf16x8*)(kb1 + off), qf1, acc);
            if (p < 8) {
                const LAS float* rbr = rb + (h * 15 + (rs + p - r + 7)) * 31;
#pragma unroll
                for (int i = 0; i < 4; ++i) { const int kcol = c0 + 8 * g + 4 * half + i; const bool valid = (kcol >= cs) && (kcol < cs + 16);
                    const float bias = rbr[min(max(kcol - cq + 15, 0), 30)];
                    acc[i] = valid ? acc[i] + bias : -INFINITY; }
            }
            S[2 * p + half] = acc;
        }
    }
    float mx = -INFINITY;
#pragma unroll
    for (int T = 0; T < 32; ++T) mx = fmaxf(fmaxf(mx, fmaxf(S[T][0], S[T][1])), fmaxf(S[T][2], S[T][3]));
    mx = fmaxf(mx, __shfl_xor(mx, 16)); mx = fmaxf(mx, __shfl_xor(mx, 32));
    float l = 0.f;
#pragma unroll
    for (int T = 0; T < 32; ++T) {
#pragma unroll
        for (int i = 0; i < 4; ++i) { const float p = __expf(S[T][i] - mx); S[T][i] = p; l += p; } }
    l += __shfl_xor(l, 16); l += __shfl_xor(l, 32);
    f32x4 O[4];
#pragma unroll
    for (int dt = 0; dt < 4; ++dt) O[dt] = (f32x4){0.f, 0.f, 0.f, 0.f};
    const bf16_t* vb0 = VB + ((size_t)(bh * 4) * (TKB / 8) * 16 + (size_t)g * 16 + q) * 8;
#pragma unroll
    for (int p = 0; p < 16; ++p) {
        u32x4 pw; pw.x = pg8::cvt_pk_bf16(S[2 * p][0], S[2 * p][1]); pw.y = pg8::cvt_pk_bf16(S[2 * p][2], S[2 * p][3]); pw.z = pg8::cvt_pk_bf16(S[2 * p + 1][0], S[2 * p + 1][1]); pw.w = pg8::cvt_pk_bf16(S[2 * p + 1][2], S[2 * p + 1][3]);
        const bf16x8 pb = __builtin_bit_cast(bf16x8, pw);
        const int s = (p < 8) ? ((rs + p) * 64 + c0) : (SEQ + 32 * (p - 8));
#pragma unroll
        for (int dt = 0; dt < 4; ++dt) O[dt] = mfma16(*(const bf16x8*)(vb0 + ((size_t)dt * (TKB / 8) + (s >> 3)) * 128), pb, O[dt]);
    }
    const float inv = 1.f / l;
    bf16_t* op = OMIX + mq * DM + h * 64 + 4 * g;
#pragma unroll
    for (int dt = 0; dt < 4; ++dt) { uint2 w; w.x = pg8::cvt_pk_bf16(O[dt][0] * inv, O[dt][1] * inv); w.y = pg8::cvt_pk_bf16(O[dt][2] * inv, O[dt][3] * inv); *(uint2*)(op + dt * 16) = w; }
}
__device__ __forceinline__ void ph_na(const bf16_t* __restrict__ PROJ, const bf16_t* __restrict__ KH, const bf16_t* __restrict__ VB, const float* __restrict__ rpb, bf16_t* __restrict__ OMIX, LAS unsigned char* lds, int bid, int G) {
    LAS float* rb = (LAS float*)lds;
    __syncthreads();
    for (int i = threadIdx.x; i < 8 * 15 * 31; i += 512) rb[i] = rpb[i];
    __syncthreads();
    const int lane = threadIdx.x & 63, wave = threadIdx.x >> 6;
#ifndef REP_NA
#define REP_NA 1
#endif
    for (int rep_ = 0; rep_ < REP_NA; ++rep_)
    for (int u = bid * 8 + wave; u < NB * 8 * 64 * 4; u += G * 8) na_unit(u, PROJ, KH, VB, rb, OMIX, lane);
}

typedef float f32x16 __attribute__((ext_vector_type(16)));
__device__ __forceinline__ f32x16 mfma32(bf16x8 a, bf16x8 b, f32x16 c) { return __builtin_amdgcn_mfma_f32_32x32x16_bf16(a, b, c, 0, 0, 0); }
constexpr int NCHUNK = 272;
__device__ __forceinline__ float logsig16(float z) { return (fminf(z, 0.f) - log1pf(__expf(-fabsf(z)))) * (1.f / 16.f); }
__device__ __forceinline__ void ph_upf(const float* __restrict__ a_up, bf16_t* __restrict__ UPF, int bid, int G) {
    for (int e = bid * 512 + threadIdx.x; e < 1024; e += G * 512) { const int dir = e >> 9, h = (e >> 7) & 3, dd = (e >> 6) & 1, ln = e & 63, d5 = ln & 31, h2 = ln >> 5;
        float v[8];
#pragma unroll
        for (int j = 0; j < 8; ++j) v[j] = a_up[(size_t)(dir * 16 + 8 * h2 + j) * 256 + h * 64 + 32 * dd + d5];
        *(u32x4*)(UPF + (size_t)e * 8) = (u32x4){pk2(v[0], v[1]), pk2(v[2], v[3]), pk2(v[4], v[5]), pk2(v[6], v[7])}; }
}
__device__ __forceinline__ void gla_prep_unit(int uu, const bf16_t* __restrict__ PROJ, const bf16_t* __restrict__ UPF, const float* __restrict__ a_bias, bf16_t* __restrict__ QF, bf16_t* __restrict__ KF, bf16_t* __restrict__ KFT, float* __restrict__ AT,
                                              const LAS float* tab, int lane) {
    const int h = uu & 3, ci = uu >> 2;
    const bool lat = ci < 256;
    const int crow = ci & 63;
    const int m0 = lat ? ((ci >> 6) * SEQ + crow * 64) : (M_LAT + (ci - 256) * 64);
    const int l31 = lane & 31, hh = lane >> 5, fi = l31 & 15; const bool lower = l31 < 16;
    bf16x8 adf[2][2];
#pragma unroll
    for (int dir = 0; dir < 2; ++dir)
#pragma unroll
        for (int tt = 0; tt < 2; ++tt) adf[dir][tt] = *(const bf16x8*)(PROJ + (unsigned)((m0 + 32 * tt + l31) * PROJ_LD + PC_AD + dir * 16 + 8 * hh));
#pragma unroll 1
    for (int dd = 0; dd < 2; ++dd) {
        const int dcol = h * 64 + 32 * dd + l31;
        float la[2][2][16], T[2][2][4], Tp[2][2][4], tot[2];
#pragma unroll
        for (int dir = 0; dir < 2; ++dir) {
            const bf16x8 upf = *(const bf16x8*)(UPF + (unsigned)((((dir * 4 + h) * 2 + dd) * 64 + lane) * 8));
            const float zb = a_bias[dir * 256 + dcol];
            tot[dir] = 0.f;
#pragma unroll
            for (int tt = 0; tt < 2; ++tt) { f32x16 Z;
#pragma unroll
                for (int i = 0; i < 16; ++i) Z[i] = 0.f;
                Z = mfma32(adf[dir][tt], upf, Z);
#pragma unroll
                for (int i = 0; i < 16; ++i) la[dir][tt][i] = logsig16(Z[i] + zb);
#pragma unroll
                for (int g = 0; g < 4; ++g) { la[dir][tt][4 * g + 1] += la[dir][tt][4 * g]; la[dir][tt][4 * g + 2] += la[dir][tt][4 * g + 1]; la[dir][tt][4 * g + 3] += la[dir][tt][4 * g + 2];
                    T[dir][tt][g] = la[dir][tt][4 * g + 3]; Tp[dir][tt][g] = __shfl_xor(T[dir][tt][g], 32); tot[dir] += T[dir][tt][g] + Tp[dir][tt][g]; } }
            if (hh == 0) AT[(unsigned)((dir * NCHUNK + ci) * 256 + dcol)] = __expf(tot[dir]);
        }
        float E[2] = {0.f, 0.f};
#pragma unroll
        for (int tt = 0; tt < 2; ++tt)
#pragma unroll
            for (int g = 0; g < 4; ++g) {
                const int t0 = 32 * tt + 8 * g + 4 * hh;
                float kv[4], qv[4];
#pragma unroll
                for (int k = 0; k < 4; ++k) { const unsigned ro = (unsigned)((m0 + t0 + k) * PROJ_LD + dcol); kv[k] = bf2f(PROJ[ro + PC_GK]); qv[k] = lat ? bf2f(PROJ[ro + PC_GQ]) : 0.f; }
                if (lat) {
#pragma unroll
                    for (int k = 0; k < 4; ++k) { const int pos = dd ? (t0 + k) : crow; const float cs = tab[2 * (pos * 16 + fi)], sn = tab[2 * (pos * 16 + fi) + 1];
                        const float kp = __shfl_xor(kv[k], 16), qp = __shfl_xor(qv[k], 16);
                        kv[k] = lower ? (kv[k] * cs - kp * sn) : (kp * sn + kv[k] * cs);
                        qv[k] = lower ? (qv[k] * cs - qp * sn) : (qp * sn + qv[k] * cs); }
                }
#pragma unroll
                for (int dir = 0; dir < 2; ++dir) {
                    const float offs = E[dir] + (hh ? Tp[dir][tt][g] : 0.f); E[dir] += T[dir][tt][g] + Tp[dir][tt][g];
                    unsigned kb[4];
#pragma unroll
                    for (int k = 0; k < 4; ++k) { const int i = 4 * g + k; const float pin = offs + la[dir][tt][i];
                        const float pex = offs + (k ? la[dir][tt][i - 1] : 0.f);
                        const float lam = dir ? (tot[dir] - pex) : pin;
                        kb[k] = f2bf(kv[k] * __expf(-lam));
                        if (lat) { const unsigned mo = (unsigned)((dir * M_LAT + m0 + t0 + k) * 256 + dcol);
                            QF[mo] = (bf16_t)f2bf(qv[k] * __expf(lam)); KF[mo] = (bf16_t)kb[k]; } }
                    *(uint2*)(KFT + (unsigned)((dir * 256 + dcol) * M_ALL + m0 + t0)) = make_uint2(kb[0] | (kb[1] << 16), kb[2] | (kb[3] << 16));
                }
                asm volatile("" ::: "memory");
            }
    }
}
__device__ __forceinline__ void ph_gla_prep2(const bf16_t* __restrict__ PROJ, const bf16_t* __restrict__ UPF, const float* __restrict__ a_bias, bf16_t* __restrict__ QF, bf16_t* __restrict__ KF, bf16_t* __restrict__ KFT, float* __restrict__ AT,
                                             LAS unsigned char* lds, int bid, int G) {
    LAS float* tab = (LAS float*)(lds + 16384);
    __syncthreads();
    for (int i = threadIdx.x; i < 1024; i += 512) { const int pos = i >> 4, fi = i & 15; const float ang = (float)pos * powf(10000.f, -(float)fi / 16.f); tab[2 * i] = cosf(ang); tab[2 * i + 1] = sinf(ang); }
    __syncthreads();
    const int lane = threadIdx.x & 63, wave = threadIdx.x >> 6;
#ifndef REP_GP
#define REP_GP 1
#endif
    for (int rep_ = 0; rep_ < REP_GP; ++rep_)
    for (int u = bid * 8 + wave; u < NCHUNK * 4; u += G * 8) gla_prep_unit(__builtin_amdgcn_readfirstlane(u), PROJ, UPF, a_bias, QF, KF, KFT, AT, tab, lane);
}
constexpr size_t SB_CH = 128 * 64;
__device__ __forceinline__ void gla_state_unit(int u, const bf16_t* __restrict__ KFT, const bf16_t* __restrict__ VT, const float* __restrict__ AT, bf16_t* __restrict__ SB, int lane) {
    const int es = u & 3, dir = (u >> 2) & 1, h = (u >> 3) & 3, b = u >> 5;
    const int l31 = lane & 31, hh = lane >> 5;
    f32x16 acc[2];
#pragma unroll
    for (int dt = 0; dt < 2; ++dt)
#pragma unroll
        for (int i = 0; i < 16; ++i) acc[dt][i] = 0.f;
    const bf16_t* kft0 = KFT + ((size_t)dir * 256 + h * 64 + l31) * M_ALL + 8 * hh;
    const bf16_t* vt0 = VT + (size_t)(512 + h * 128 + es * 32 + l31) * VT_LD + 8 * hh;
    bf16_t* sb0 = SB + ((size_t)((dir * NB + b) * 4 + h) * 64) * SB_CH + (size_t)(es * 32 + l31) * 64 + 4 * hh;
    for (int s = 0; s < 68; ++s) {
        int ci, m0, c = 0;
        if (s < 4) { const int cc = dir ? 3 - s : s; ci = 256 + b * 4 + cc; m0 = M_LAT + b * CTXL + cc * 64; }
        else { c = dir ? 67 - s : s - 4; ci = b * 64 + c; m0 = b * SEQ + c * 64; }
        bf16x8 af[2][4], bfr[4]; f32x4 av[2][4];
#pragma unroll
        for (int ks = 0; ks < 4; ++ks) { bfr[ks] = *(const bf16x8*)(vt0 + m0 + 16 * ks);
#pragma unroll
            for (int dt = 0; dt < 2; ++dt) af[dt][ks] = *(const bf16x8*)(kft0 + (size_t)dt * 32 * M_ALL + m0 + 16 * ks); }
#pragma unroll
        for (int dt = 0; dt < 2; ++dt)
#pragma unroll
            for (int rr = 0; rr < 4; ++rr) av[dt][rr] = *(const f32x4*)(AT + ((size_t)dir * NCHUNK + ci) * 256 + h * 64 + dt * 32 + 8 * rr + 4 * hh);
        if (s >= 4) {
            bf16_t* sp = sb0 + (size_t)c * SB_CH;
#pragma unroll
            for (int dt = 0; dt < 2; ++dt)
#pragma unroll
                for (int rr = 0; rr < 4; ++rr) { uint2 w; w.x = pg8::cvt_pk_bf16(acc[dt][4 * rr], acc[dt][4 * rr + 1]); w.y = pg8::cvt_pk_bf16(acc[dt][4 * rr + 2], acc[dt][4 * rr + 3]); *(uint2*)(sp + dt * 32 + 8 * rr) = w; }
        }
#pragma unroll
        for (int dt = 0; dt < 2; ++dt) {
#pragma unroll
            for (int ks = 0; ks < 4; ++ks) acc[dt] = mfma32(af[dt][ks], bfr[ks], acc[dt]);
#pragma unroll
            for (int rr = 0; rr < 4; ++rr) { acc[dt][4 * rr] *= av[dt][rr][0]; acc[dt][4 * rr + 1] *= av[dt][rr][1]; acc[dt][4 * rr + 2] *= av[dt][rr][2]; acc[dt][4 * rr + 3] *= av[dt][rr][3]; }
        }
    }
}
__device__ __forceinline__ void gla_out_unit(int u, const bf16_t* __restrict__ PROJ, const bf16_t* __restrict__ QF, const bf16_t* __restrict__ KF, const bf16_t* __restrict__ VT, const bf16_t* __restrict__ SB, const float* __restrict__ gnorm,
                                             bf16_t* __restrict__ OMIX, int lane) {
    const int it = u & 1, c = (u >> 1) & 63, h = (u >> 7) & 3, b = u >> 9;
    const int l31 = lane & 31, hh = lane >> 5;
    const int m0 = b * SEQ + c * 64;
    f32x16 o[4];
#pragma unroll
    for (int et = 0; et < 4; ++et)
#pragma unroll
        for (int i = 0; i < 16; ++i) o[et][i] = 0.f;
#pragma unroll
    for (int dir = 0; dir < 2; ++dir) {
        bf16x8 qf[4];
        const bf16_t* qp = QF + ((size_t)dir * M_LAT + m0 + 32 * it + l31) * 256 + h * 64 + 8 * hh;
#pragma unroll
        for (int ks = 0; ks < 4; ++ks) qf[ks] = *(const bf16x8*)(qp + 16 * ks);
#pragma unroll
        for (int jt = 0; jt < 2; ++jt) {
            const bool need = dir ? (jt >= it) : (jt <= it);
            if (!need) continue;
            f32x16 X;
#pragma unroll
            for (int i = 0; i < 16; ++i) X[i] = 0.f;
            const bf16_t* kp = KF + ((size_t)dir * M_LAT + m0 + 32 * jt + l31) * 256 + h * 64 + 8 * hh;
#pragma unroll
            for (int ks = 0; ks < 4; ++ks) X = mfma32(*(const bf16x8*)(kp + 16 * ks), qf[ks], X);
            if (jt == it) {
#pragma unroll
                for (int i = 0; i < 16; ++i) { const int jr = (i & 3) + 8 * (i >> 2) + 4 * hh; const bool keep = dir ? (jr >= l31) : (jr <= l31); X[i] = keep ? X[i] : 0.f; }
            }
#pragma unroll
            for (int s = 0; s < 2; ++s) {
                u32x4 xw; xw.x = pg8::cvt_pk_bf16(X[8 * s], X[8 * s + 1]); xw.y = pg8::cvt_pk_bf16(X[8 * s + 2], X[8 * s + 3]); xw.z = pg8::cvt_pk_bf16(X[8 * s + 4], X[8 * s + 5]); xw.w = pg8::cvt_pk_bf16(X[8 * s + 6], X[8 * s + 7]);
                const bf16x8 xa = __builtin_bit_cast(bf16x8, xw);
#pragma unroll
                for (int et = 0; et < 4; ++et) {
                    const bf16_t* vp = VT + (size_t)(512 + h * 128 + et * 32 + l31) * VT_LD + m0 + 32 * jt + 16 * s + 4 * hh;
                    const uint2 lo = *(const uint2*)vp, hi = *(const uint2*)(vp + 8);
                    const u32x4 vw = (u32x4){lo.x, lo.y, hi.x, hi.y};
                    o[et] = mfma32(xa, __builtin_bit_cast(bf16x8, vw), o[et]); }
            }
        }
        const bf16_t* sp = SB + ((size_t)(((dir * NB + b) * 4 + h) * 64 + c)) * SB_CH + (size_t)l31 * 64 + 8 * hh;
#pragma unroll
        for (int et = 0; et < 4; ++et)
#pragma unroll
            for (int ks = 0; ks < 4; ++ks) o[et] = mfma32(qf[ks], *(const bf16x8*)(sp + (size_t)et * 32 * 64 + 16 * ks), o[et]);
    }
    float ss[16];
#pragma unroll
    for (int i = 0; i < 16; ++i) { float a = 0.f;
#pragma unroll
        for (int et = 0; et < 4; ++et) a += o[et][i] * o[et][i];
        a += __shfl_xor(a, 1); a += __shfl_xor(a, 2); a += __shfl_xor(a, 4); a += __shfl_xor(a, 8); a += __shfl_xor(a, 16);
        ss[i] = rsqrtf(a * (1.f / 128.f) + EPS); }
#pragma unroll
    for (int et = 0; et < 4; ++et) { const float gn = gnorm[et * 32 + l31];
#pragma unroll
        for (int i = 0; i < 16; ++i) { const size_t m = (size_t)(m0 + 32 * it + (i & 3) + 8 * (i >> 2) + 4 * hh);
            const float g = bf2f(PROJ[m * PROJ_LD + PC_GG + h * 128 + et * 32 + l31]);
            OMIX[m * DM + 512 + h * 128 + et * 32 + l31] = (bf16_t)f2bf(o[et][i] * ss[i] * gn * silu_f(g)); } }
}
__device__ __forceinline__ void ph_gla_state(const bf16_t* KFT, const bf16_t* VT, const float* AT, bf16_t* SB, int bid, int G) {
    const int lane = threadIdx.x & 63, wave = threadIdx.x >> 6;
    for (int u = wave * G + bid; u < NB * 4 * 2 * 4; u += 8 * G) gla_state_unit(u, KFT, VT, AT, SB, lane);
}
__device__ __forceinline__ void ph_gla_out(const bf16_t* PROJ, const bf16_t* QF, const bf16_t* KF, const bf16_t* VT, const bf16_t* SB, const float* gnorm, bf16_t* OMIX, int bid, int G) {
    const int lane = threadIdx.x & 63, wave = threadIdx.x >> 6;
    for (int u = bid * 8 + wave; u < NB * 4 * 64 * 2; u += G * 8) gla_out_unit(u, PROJ, QF, KF, VT, SB, gnorm, OMIX, lane);
}

__device__ __forceinline__ void ph_post_mix(const float* __restrict__ x, const bf16_t* __restrict__ MIX, const float* __restrict__ mod, const float* __restrict__ g_post, const float* __restrict__ g_fpre, const float* __restrict__ router,
                                                  float* __restrict__ xnew, unsigned char* __restrict__ HF, float* __restrict__ aff, LAS unsigned char* lds, int bid, int G) {
    LAS float* rt = (LAS float*)lds;
    __syncthreads();
    for (int i = threadIdx.x; i < DM * NE; i += 512) rt[(i % NE) * DM + (i / NE)] = router[i];
    __syncthreads();
    const int lane = threadIdx.x & 63, wave = threadIdx.x >> 6;
    for (int m = bid * 8 + wave; m < M_LAT; m += G * 8) {
        const int b = m / SEQ, t = m % SEQ; const float* mv = mod + (size_t)b * 6144;
        f32x4 mx[4]; float ss = 0.f;
        const unsigned long long* mp = (const unsigned long long*)(MIX + (size_t)m * DM) + lane;
#pragma unroll
        for (int j = 0; j < 4; ++j) { const unsigned long long w = mp[64 * j]; const unsigned lo = (unsigned)w, hi = (unsigned)(w >> 32);
            mx[j] = (f32x4){__uint_as_float(lo << 16), __uint_as_float(lo & 0xffff0000u), __uint_as_float(hi << 16), __uint_as_float(hi & 0xffff0000u)};
            ss += (mx[j].x * mx[j].x + mx[j].y * mx[j].y) + (mx[j].z * mx[j].z + mx[j].w * mx[j].w); }
        const float rstd = rsqrtf(wave_sum(ss) * (1.f / DM) + EPS);
        f32x4 xn[4]; float s2 = 0.f;
#pragma unroll
        for (int j = 0; j < 4; ++j) { const int col = 4 * lane + 256 * j;
            const f32x4 xv = *(const f32x4*)(x + (size_t)m * DM + col), gp = *(const f32x4*)(g_post + col), gm = *(const f32x4*)(mv + 2048 + col);
            xn[j] = xv + gm * (mx[j] * rstd * gp);
            *(f32x4*)(xnew + (size_t)m * DM + col) = xn[j];
            s2 += (xn[j].x * xn[j].x + xn[j].y * xn[j].y) + (xn[j].z * xn[j].z + xn[j].w * xn[j].w); }
        const float rstd2 = rsqrtf(wave_sum(s2) * (1.f / DM) + EPS);
        f32x4 hv4[4];
        unsigned* hp = (unsigned*)(HF + (size_t)m * DM) + lane;
#pragma unroll
        for (int j = 0; j < 4; ++j) { const int col = 4 * lane + 256 * j;
            const f32x4 gf = *(const f32x4*)(g_fpre + col), sh = *(const f32x4*)(mv + 3072 + col), sc = *(const f32x4*)(mv + 4096 + col);
            hv4[j] = xn[j] * rstd2 * gf * (sc + 1.f) + sh;
            hp[64 * j] = pk4_fp8(hv4[j].x * SX8, hv4[j].y * SX8, hv4[j].z * SX8, hv4[j].w * SX8); }
        float lg[NE]; float mxl = -INFINITY;
#pragma unroll
        for (int e = 0; e < NE; ++e) { float sacc = 0.f;
#pragma unroll
            for (int j = 0; j < 4; ++j) { const f32x4 rv = *(const LAS f32x4*)(rt + e * DM + 4 * lane + 256 * j); sacc += (hv4[j].x * rv.x + hv4[j].y * rv.y) + (hv4[j].z * rv.z + hv4[j].w * rv.w); }
            lg[e] = wave_sum(sacc); mxl = fmaxf(mxl, lg[e]); asm volatile("" ::: "memory"); }
        float den = 0.f;
#pragma unroll
        for (int e = 0; e < NE; ++e) { lg[e] = expf(lg[e] - mxl); den += lg[e]; }
        const float rden = 1.f / den;
#pragma unroll
        for (int e = 0; e < NE; ++e) if (lane == e) aff[((size_t)b * NE + e) * SEQ + t] = lg[e] * rden;
    }
}

__device__ __forceinline__ int block_excl_scan(int v, LAS int* sm  , int& total) {
    const int lane = threadIdx.x & 63, w = threadIdx.x >> 6; int x = v;
#pragma unroll
    for (int o = 1; o < 64; o <<= 1) { const int y = __shfl_up(x, o); if (lane >= o) x += y; }
    __syncthreads();
    if (lane == 63) sm[w] = x;
    __syncthreads();
    int base = 0, tot = 0;
#pragma unroll
    for (int i = 0; i < 8; ++i) { const int s = sm[i]; if (i < w) base += s; tot += s; }
    total = tot;
    return base + x - v;
}
__device__ __forceinline__ void ph_topk(const float* __restrict__ aff, const unsigned char* __restrict__ HF, int* __restrict__ idx, float* __restrict__ gate, int* __restrict__ inv, unsigned char* __restrict__ XS, LAS unsigned char* lds, int bid, int G) {
  LAS int* hist = (LAS int*)lds; LAS int* sm = hist + 256; LAS unsigned* sp = (LAS unsigned*)(sm + 16); LAS int* srm = (LAS int*)(sp + 1); LAS int* s_list = srm + 1;
#define s_prefix (*sp)
#define s_remain (*srm)
  for (int be = bid; be < NB * NE; be += G) {
    const int b = be / NE, e = be % NE, tid = threadIdx.x;
    __syncthreads();
    const float* av = aff + ((size_t)b * NE + e) * SEQ;
    unsigned key[8];
#pragma unroll
    for (int j = 0; j < 8; ++j) key[j] = __float_as_uint(av[tid * 8 + j]);
    if (tid == 0) { s_prefix = 0u; s_remain = CAP; }
    for (int pass = 3; pass >= 0; --pass) {
        if (tid < 256) hist[tid] = 0;
        __syncthreads();
        const unsigned prefix = s_prefix; const int shift = pass * 8; const unsigned himask = pass == 3 ? 0u : (0xffffffffu << (shift + 8));
#pragma unroll
        for (int j = 0; j < 8; ++j) if ((key[j] & himask) == prefix) atomicAdd((int*)(hist + ((key[j] >> shift) & 255u)), 1);
        __syncthreads();
        if (tid == 0) { int rem = s_remain, bin = 255; for (; bin > 0; --bin) { const int cnt = hist[bin]; if (cnt >= rem) break; rem -= cnt; } s_remain = rem; s_prefix = prefix | ((unsigned)bin << shift); }
        __syncthreads();
    }
    const unsigned T = s_prefix; const int remain = s_remain;
    int neq = 0;
#pragma unroll
    for (int j = 0; j < 8; ++j) neq += (key[j] == T);
    int tot; int eqbase = block_excl_scan(neq, sm, tot);
    int flags = 0, nsel = 0;
#pragma unroll
    for (int j = 0; j < 8; ++j) { bool sel = key[j] > T; if (key[j] == T) { sel = eqbase < remain; ++eqbase; } if (sel) { flags |= 1 << j; ++nsel; } }
    int slot = block_excl_scan(nsel, sm, tot);
    const int rowbase = (e * NB + b) * CAP;
#pragma unroll
    for (int j = 0; j < 8; ++j) { const int t = tid * 8 + j; int sl = -1;
        if (flags & (1 << j)) { sl = slot++; idx[rowbase + sl] = t; gate[rowbase + sl] = __uint_as_float(key[j]); s_list[sl] = t; }
        inv[((size_t)b * SEQ + t) * NE + e] = sl; }
    __syncthreads();
    const int lane = tid & 63, wave = tid >> 6;
    for (int s = wave; s < CAP; s += 8) { const u32x4* src = (const u32x4*)(HF + ((size_t)b * SEQ + s_list[s]) * DM); u32x4* dst = (u32x4*)(XS + (size_t)(rowbase + s) * DM);
        dst[lane] = src[lane]; }
  }
#undef s_prefix
#undef s_remain
}

__device__ __forceinline__ void ph_combine(const bf16_t* __restrict__ Y, const int* __restrict__ inv, const float* __restrict__ mod, const float* __restrict__ g_fpost, float* __restrict__ out, int bid, int G) {
    const int lane = threadIdx.x & 63, wave = threadIdx.x >> 6;
    for (int m = bid * 8 + wave; m < M_LAT; m += G * 8) {
        const int b = m / SEQ; const float* mv = mod + (size_t)b * 6144;
        const int sl = (lane < NE) ? inv[(size_t)m * NE + lane] : -1;
        unsigned mask = (unsigned)__ballot(sl >= 0);
        f32x4 xn[4];
#pragma unroll
        for (int j = 0; j < 4; ++j) xn[j] = *(const f32x4*)(out + (size_t)m * DM + 4 * lane + 256 * j);
        f32x4 y[4];
#pragma unroll
        for (int j = 0; j < 4; ++j) y[j] = (f32x4){0.f, 0.f, 0.f, 0.f};
        while (mask) {
            const unsigned long long* yp[4]; float w[4];
#pragma unroll
            for (int k = 0; k < 4; ++k) { const unsigned mm = mask ? mask : 1u; const int e = __builtin_ctz(mm); w[k] = mask ? 1.f : 0.f; mask &= mask - 1u;
                const int s = __builtin_amdgcn_readlane(sl, e); const int s2 = s < 0 ? 0 : s;
                yp[k] = (const unsigned long long*)(Y + (size_t)((e * NB + b) * CAP + s2) * DM) + lane; }
            unsigned long long v[4][4];
#pragma unroll
            for (int k = 0; k < 4; ++k)
#pragma unroll
                for (int j = 0; j < 4; ++j) v[k][j] = yp[k][64 * j];
#pragma unroll
            for (int k = 0; k < 4; ++k)
#pragma unroll
                for (int j = 0; j < 4; ++j) { const unsigned lo = (unsigned)v[k][j], hi = (unsigned)(v[k][j] >> 32);
                    y[j] += (f32x4){__uint_as_float(lo << 16), __uint_as_float(lo & 0xffff0000u), __uint_as_float(hi << 16), __uint_as_float(hi & 0xffff0000u)} * w[k]; }
        }
        float ss = 0.f;
#pragma unroll
        for (int j = 0; j < 4; ++j) ss += (y[j].x * y[j].x + y[j].y * y[j].y) + (y[j].z * y[j].z + y[j].w * y[j].w);
        const float rstd = rsqrtf(wave_sum(ss) * (1.f / DM) + EPS);
#pragma unroll
        for (int j = 0; j < 4; ++j) { const int col = 4 * lane + 256 * j; float* op = out + (size_t)m * DM + col;
            const f32x4 gp = *(const f32x4*)(g_fpost + col), gf = *(const f32x4*)(mv + 5120 + col);
            *(f32x4*)op = xn[j] + gf * (y[j] * rstd * gp); }
    }
}

#define GAS __attribute__((address_space(1)))
#define XB_TMO      128
#define XB_XCNT(j)  (256  + 64 * (j))
#define XB_XSUB(j)  (1280 + 64 * (j))
#define XB_XGEN(j)  (2304 + 64 * (j))
#define XB_TOP      3328
#define XB_TOPGEN   3392
#define XCD_BAR_WORDS 3456
#define XB_SPIN_CAP (1u << 18)

__device__ __forceinline__ unsigned xb_ld(unsigned* p)              { return __hip_atomic_load(p, __ATOMIC_RELAXED, __HIP_MEMORY_SCOPE_AGENT); }
__device__ __forceinline__ unsigned xb_add(unsigned* p, unsigned v) { return __hip_atomic_fetch_add(p, v, __ATOMIC_RELAXED, __HIP_MEMORY_SCOPE_AGENT); }
__device__ __forceinline__ unsigned xb_xcc_id() { return (unsigned)__builtin_amdgcn_s_getreg((3 << 11) | 20) & 0xFu; }
#define XB_SPIN(cond, bar) do { unsigned _sp = 0; while (cond) { __builtin_amdgcn_s_sleep(1); \
    if ((++_sp & 255u) == 0u) { if (xb_ld(&(bar)[XB_TMO])) break; if (_sp > XB_SPIN_CAP) { atomicAdd(&(bar)[XB_TMO], 1u); break; } } } } while (0)

struct XcdBarrier {
    unsigned* bar; unsigned x;
    volatile LAS unsigned* st;
};

__device__ __forceinline__ XcdBarrier xcd_barrier_post(unsigned* bar, volatile LAS unsigned* st) {
    XcdBarrier b; b.bar = bar; b.x = xb_xcc_id(); b.st = st;
    if (threadIdx.x == 0) (void)xb_add(&bar[XB_XCNT(b.x)], 1u);
    return b;
}
__device__ __forceinline__ void xcd_barrier_complete(unsigned* bar, unsigned x, unsigned& nloc, unsigned& nx) {
    const unsigned G = gridDim.x * gridDim.y * gridDim.z;
    unsigned sum, cnt, mine, sp = 0u;
    for (;;) {
        sum = 0u; cnt = 0u; mine = 0u;
#pragma unroll
        for (unsigned j = 0; j < 16; ++j) { const unsigned c = xb_ld(&bar[XB_XCNT(j)]); sum += c; cnt += (c > 0u) ? 1u : 0u; mine = (j == x) ? c : mine; }
        if (sum == G) break;
        __builtin_amdgcn_s_sleep(1);
        if ((++sp & 255u) == 0u) { if (xb_ld(&bar[XB_TMO])) break; if (sp > XB_SPIN_CAP) { atomicAdd(&bar[XB_TMO], 1u); break; } }
    }
    nloc = mine > 0u ? mine : 1u; nx = cnt > 0u ? cnt : 1u;
}

__device__ __forceinline__ void xcd_barrier(const XcdBarrier& b) {
    asm volatile("s_waitcnt vmcnt(0)" ::: "memory");
    __syncthreads();
    if (threadIdx.x == 0) {
        unsigned* bar = b.bar;
        __builtin_amdgcn_s_waitcnt(0);
        unsigned nloc = b.st[0], nx = b.st[1];
        if (nloc == 0u) { xcd_barrier_complete(bar, b.x, nloc, nx); b.st[0] = nloc; b.st[1] = nx; }
        const unsigned old = xb_add(&bar[XB_XSUB(b.x)], 1u);
        const unsigned gen = old / nloc;
        if (old + 1u == (gen + 1u) * nloc) {
            __builtin_amdgcn_fence(__ATOMIC_RELEASE, "agent");
            asm volatile("s_waitcnt vmcnt(0)" ::: "memory");
            const unsigned og = xb_add(&bar[XB_TOP], 1u);
            const unsigned tg = og / nx;
            if (og + 1u == (tg + 1u) * nx) xb_add(&bar[XB_TOPGEN], 1u);
            else XB_SPIN(xb_ld(&bar[XB_TOPGEN]) == tg, bar);
            __builtin_amdgcn_fence(__ATOMIC_ACQUIRE, "agent");
            xb_add(&bar[XB_XGEN(b.x)], 1u);
            asm volatile("s_waitcnt vmcnt(0)" ::: "memory");
        } else {
            XB_SPIN(xb_ld(&bar[XB_XGEN(b.x)]) == gen, bar);
            __builtin_amdgcn_fence(__ATOMIC_ACQUIRE, "agent");
            asm volatile("s_waitcnt vmcnt(0)" ::: "memory");
        }
    }
    __syncthreads();
}


namespace cg = cooperative_groups;
constexpr int LDS_BYTES = 147456;
constexpr int N_PHASES = 12;
constexpr size_t CTL_BYTES = 65536;
#ifndef REP_PH
#define REP_PH -1
#endif
#ifndef REP_SYNC
#define REP_SYNC 0
#endif
struct MegaArgs { const float* in[20]; float* out; unsigned char* ws; int ph_lo, ph_hi; };
__global__ void __launch_bounds__(512, 2) hy_mega(MegaArgs a) {
    extern __shared__ __attribute__((aligned(16))) unsigned char lds_raw[];
    LAS unsigned char* lds = (LAS unsigned char*)lds_raw;
    const int bid = blockIdx.x, G = gridDim.x;
#define Q_x (a.in[0])
#define Q_c (a.in[1])
#define Q_ctx (a.in[2])
#define Q_c_ctx (a.in[3])
#define Q_w_mod (a.in[4])
#define Q_b_mod (a.in[5])
#define Q_g_pre (a.in[6])
#define Q_g_post (a.in[7])
#define Q_g_fpre (a.in[8])
#define Q_g_fpost (a.in[9])
#define Q_w_in (a.in[10])
#define Q_rpb (a.in[11])
#define Q_a_up (a.in[12])
#define Q_a_bias (a.in[13])
#define Q_gnorm (a.in[14])
#define Q_w_out (a.in[15])
#define Q_router (a.in[16])
#define Q_w_gate (a.in[17])
#define Q_w_up (a.in[18])
#define Q_w_down (a.in[19])
#define Q_ws (a.ws)
#define Q_out (a.out)
#define Q_mod ((float*)(a.ws + WS_MOD))
#define Q_WTIN ((bf16_t*)(a.ws + WS_WTIN))
#define Q_WTV ((bf16_t*)(a.ws + WS_WTV))
#define Q_WTOUT ((bf16_t*)(a.ws + WS_WTOUT))
#define Q_WTGU ((unsigned char*)(a.ws + WS_WTGU))
#define Q_WTDN ((unsigned char*)(a.ws + WS_WTDN))
#define Q_H ((bf16_t*)(a.ws + WS_H))
#define Q_PROJ ((bf16_t*)(a.ws + WS_PROJ))
#define Q_VT ((bf16_t*)(a.ws + WS_VT))
#define Q_OMIX ((bf16_t*)(a.ws + WS_OMIX))
#define Q_MIX ((bf16_t*)(a.ws + WS_MIX))
#define Q_HID ((unsigned char*)(a.ws + WS_HID))
#define Q_HF ((unsigned char*)(a.ws + WS_HF))
#define Q_XS ((unsigned char*)(a.ws + WS_XS))
#define Q_Y ((bf16_t*)(a.ws + WS_XS))
#define Q_aff ((float*)(a.ws + WS_AFF))
#define Q_idx ((int*)(a.ws + WS_IDX))
#define Q_gate ((float*)(a.ws + WS_GATE))
#define Q_inv ((int*)(a.ws + WS_INV))
#define Q_QF ((bf16_t*)(a.ws + WS_QF))
#define Q_KF ((bf16_t*)(a.ws + WS_KF))
#define Q_KFT ((bf16_t*)(a.ws + WS_KFT))
#define Q_AT ((float*)(a.ws + WS_AT))
#define Q_SB ((bf16_t*)(a.ws + WS_SB))
#define Q_KH ((bf16_t*)(a.ws + WS_KH))
#define Q_UPF ((bf16_t*)(a.ws + WS_UPF))
#define Q_VB ((bf16_t*)(a.ws + WS_VB))
    volatile LAS unsigned* bst = (volatile LAS unsigned*)(lds + LDS_BYTES - 64);
    if (threadIdx.x < 16) bst[threadIdx.x] = 0u;
    __syncthreads();
    XcdBarrier bar = xcd_barrier_post((unsigned*)a.ws, bst);
    if (a.ph_hi < 0) cg::this_grid().sync();
    const int lo = a.ph_lo, hi = a.ph_hi;
#define IN(k) (lo <= (k) && (k) < hi)
#define SEAM(k) do { if (IN(k) && IN((k) + 1)) xcd_barrier(bar); } while (0)
#define MKP PrepArgs p; p.x = Q_x; p.ctx = Q_ctx; p.g_pre = Q_g_pre; p.mod = Q_mod; p.w_in = Q_w_in; p.w_out = Q_w_out; p.w_gate = Q_w_gate; p.w_up = Q_w_up; p.w_down = Q_w_down; p.WTIN = Q_WTIN; p.WTV = Q_WTV; p.WTOUT = Q_WTOUT; p.WTGU = Q_WTGU; p.WTDN = Q_WTDN; p.H = Q_H;
#define PH0 if (IN(0)) { MKP ph_mod(Q_c, Q_c_ctx, Q_w_mod, Q_b_mod, Q_mod, lds, bid, G); ph_upf(Q_a_up, Q_UPF, bid, G); ph_convert(p, lds, bid, G); }
#define PH1 if (IN(1)) { MKP ph_modulate(p, bid, G); }
#define PH2 if (IN(2)) { \
        { pg8::Gemm g{Q_H, Q_WTIN, M_ALL, PROJ_LD, DM}; pg8::StaticOrder S; S.init(g.M, g.N, G, bid); EpiProj E{Q_PROJ, PROJ_LD, Q_KH}; \
          pg8::gemm_phase<EpiProj, pg8::StaticOrder, true, true>(lds, g, S, E); } \
        { pg8::Gemm g{Q_WTV, Q_H, 1024, M_ALL, DM}; pg8::StaticOrder S; S.init(g.M, g.N, G, bid); EpiVal E{Q_VT, VT_LD, Q_VB}; \
          pg8::gemm_phase<EpiVal, pg8::StaticOrder, true, true>(lds, g, S, E); } }
#define PH3 if (IN(3)) { ph_gla_prep2(Q_PROJ, Q_UPF, Q_a_bias, Q_QF, Q_KF, Q_KFT, Q_AT, lds, bid, G); ph_na(Q_PROJ, Q_KH, Q_VB, Q_rpb, Q_OMIX, lds, bid, G); }
#define PH4 if (IN(4)) ph_gla_state(Q_KFT, Q_VT, Q_AT, Q_SB, bid, G);
#define PH5 if (IN(5)) ph_gla_out(Q_PROJ, Q_QF, Q_KF, Q_VT, Q_SB, Q_gnorm, Q_OMIX, bid, G);
#define PH6 if (IN(6)) { pg8::Gemm g{Q_OMIX, Q_WTOUT, M_LAT, DM, DM}; pg8::StaticOrder S; S.init(g.M, g.N, G, bid); pg8::EpiBf16<0> E{Q_MIX, DM, nullptr, 0, 0, 1.f}; \
        pg8::gemm_phase<pg8::EpiBf16<0>, pg8::StaticOrder, true, true>(lds, g, S, E); }
#define PH7 if (IN(7)) ph_post_mix(Q_x, Q_MIX, Q_mod, Q_g_post, Q_g_fpre, Q_router, Q_out, Q_HF, Q_aff, lds, bid, G);
#define PH8 if (IN(8)) ph_topk(Q_aff, Q_HF, Q_idx, Q_gate, Q_inv, Q_XS, lds, bid, G);
#define PH9 if (IN(9)) { pg8::Gemm g{(const bf16_t*)Q_XS, (const bf16_t*)Q_WTGU, NSLOT, 2 * DE, DM / 2}; ExpertOrder S{22, G, bid}; EpiSwiGLU E{Q_HID, DE}; \
        pg8::gemm_phase<EpiSwiGLU, ExpertOrder, true, true, true>(lds, g, S, E); }
#define PH10 if (IN(10)) { pg8::Gemm g{(const bf16_t*)Q_HID, (const bf16_t*)Q_WTDN, NSLOT, DM, DE / 2}; ExpertOrder S{4, G, bid}; EpiRowScale E{Q_Y, DM, Q_gate}; \
        pg8::gemm_phase<EpiRowScale, ExpertOrder, true, true, true>(lds, g, S, E); }
#define PH11 if (IN(11)) ph_combine(Q_Y, Q_inv, Q_mod, Q_g_fpost, Q_out, bid, G);
#define RUN(k, PH) PH
    PH0
#if REP_PH == 0
    PH0
#endif
    SEAM(0);
    for (int rs_ = 0; rs_ < REP_SYNC; ++rs_) xcd_barrier(bar);
    PH1
#if REP_PH == 1
    PH1
#endif
    SEAM(1);
    PH2
#if REP_PH == 2
    PH2
#endif
    SEAM(2);
    PH3
#if REP_PH == 3
    PH3
#endif
    SEAM(3);
    PH4
#if REP_PH == 4
    PH4
#endif
    SEAM(4);
    PH5
#if REP_PH == 5
    PH5
#endif
    SEAM(5);
    PH6
#if REP_PH == 6
    PH6
#endif
    SEAM(6);
    PH7
#if REP_PH == 7
    PH7
#endif
    SEAM(7);
    PH8
#if REP_PH == 8
    PH8
#endif
    SEAM(8);
    PH9
#if REP_PH == 9
    PH9
#endif
    SEAM(9);
    PH10
#if REP_PH == 10
    PH10
#endif
    SEAM(10);
    PH11
#undef IN
#undef SEAM
}
}

extern "C" void kernel_launch(void* const* d_in, const int* in_sizes, int n_in, void* d_out, int out_size, void* d_ws, size_t ws_size, hipStream_t stream) {
    using namespace hy;
    static int grid = 0;
    if (grid == 0) {
        if (n_in != 20 || in_sizes[0] != M_LAT * DM || out_size != M_LAT * DM || ws_size < WS_END) { fprintf(stderr, "kernel_launch: unexpected shapes / workspace (n_in %d, ws %zu)\n", n_in, ws_size); grid = -1; return; }
        int dev = 0, cus = 0, per_cu = 0;
        if (hipGetDevice(&dev) != hipSuccess || hipDeviceGetAttribute(&cus, hipDeviceAttributeMultiprocessorCount, dev) != hipSuccess) { grid = -1; return; }
        if (hipFuncSetAttribute((const void*)hy_mega, hipFuncAttributeMaxDynamicSharedMemorySize, LDS_BYTES) != hipSuccess) { fprintf(stderr, "kernel_launch: hipFuncSetAttribute failed\n"); grid = -1; return; }
        if (hipOccupancyMaxActiveBlocksPerMultiprocessor(&per_cu, (const void*)hy_mega, 512, LDS_BYTES) != hipSuccess || per_cu < 1) { fprintf(stderr, "kernel_launch: occupancy query says %d\n", per_cu); per_cu = 1; }
        (void)hipGetLastError();
        grid = cus;
    }
    if (grid < 0) return;
    (void)hipMemsetAsync(d_ws, 0, CTL_BYTES, stream);
    MegaArgs a{};
    for (int i = 0; i < 20; ++i) a.in[i] = (const float*)d_in[i];
    a.out = (float*)d_out; a.ws = (unsigned char*)d_ws;
    a.ph_lo = 0; a.ph_hi = N_PHASES;
    void* args[] = {&a};
    hipError_t e = hipLaunchCooperativeKernel((const void*)hy_mega, dim3(grid), dim3(512), args, LDS_BYTES, stream);
    if (e != hipSuccess) fprintf(stderr, "cooperative launch failed: %s (grid %d)\n", hipGetErrorString(e), grid);
}
```

```cpp
#define CVT_Q0 0
#define CVT_Q1 19000
#include <hip/hip_runtime.h>
#include <hip/hip_cooperative_groups.h>
#include <cstdio>
#include <cstdint>
namespace pg8 {
#define PG8_LAS __attribute__((address_space(3)))
typedef unsigned short bf16_t;
typedef short bf16x8 __attribute__((ext_vector_type(8)));
typedef float f32x4 __attribute__((ext_vector_type(4)));
typedef unsigned u32x4 __attribute__((ext_vector_type(4)));
constexpr int BM = 256, BK = 64, HALF = 128, HTB = HALF * BK * 2  , STAGE_BYTES = 8 * HTB, NXCD = 8, WGM = 8;

__host__ __device__ __forceinline__ int lds_byte(int r, int c) { const int st = (r >> 4) * 2 + (c >> 5), rr = r & 15, cc = c & 31, ob = rr * 64 + cc * 2; return st * 1024 + (ob ^ (((ob >> 9) & 1) << 5)); }
__host__ __device__ __forceinline__ void stage_rc(int b, int& R, int& C) { const int st = b / 1024, sb = b % 1024, swz = sb ^ (((sb >> 9) & 1) << 5); R = (st >> 1) * 16 + swz / 64; C = (st & 1) * 32 + (swz % 64) / 2; }
__host__ __device__ __forceinline__ int perm32(int rho) { const int n = rho >> 4, i = rho & 15; return 8 * (i >> 2) + 4 * n + (i & 3); }

struct Unit { int pm, pn, bt; };
struct Gemm { const bf16_t* A; const bf16_t* Bt; int M, N, K; };

struct StaticOrder {
    int nM, nN, nwg, G, c;
    __host__ __device__ void init(int M, int N, int G_, int c_) { nM = M / BM; nN = N / BM; nwg = nM * nN; G = G_; c = c_; }
    __host__ __device__ bool next(int i, Unit& u) const {
        const long L = (long)i * G + c; if (L >= nwg) return false;
        int wgid = (int)L; { const int q = nwg / NXCD, r = nwg % NXCD, xcd = wgid % NXCD, off = wgid / NXCD; wgid = (xcd < r ? xcd * (q + 1) : r * (q + 1) + (xcd - r) * q) + off; }
        const int nig = WGM * nN, gid = wgid / nig, fm = gid * WGM, gsz = (nM - fm) < WGM ? (nM - fm) : WGM;
        u.pm = fm + ((wgid % nig) % gsz); u.pn = (wgid % nig) / gsz; u.bt = u.pn; return true;
    }
    __device__ __forceinline__ void a_ready(const Unit&) const {}
    __device__ __forceinline__ void done(const Unit&) const {}
};

__device__ __forceinline__ unsigned cvt_pk_bf16(float lo, float hi) { unsigned r; asm volatile("v_cvt_pk_bf16_f32 %0, %1, %2" : "=v"(r) : "v"(lo), "v"(hi)); return r; }
typedef float f32x2 __attribute__((ext_vector_type(2)));
__device__ __forceinline__ f32x2 gelu_pk(f32x2 v) {
    const f32x2 av = __builtin_elementwise_abs(v), d = av * 0.2316418882f + 1.0f;
    f32x2 t; t.x = __builtin_amdgcn_rcpf(d.x); t.y = __builtin_amdgcn_rcpf(d.y);
    f32x2 q = t * 0.5307027145f + (-0.7265760135f); q = q * t + 0.7107068705f; q = q * t + (-0.142248368f); q = q * t + 0.127414796f; q = q * t;
    const f32x2 s = (v * v) * (-0.72134752044f);
    f32x2 e; e.x = __builtin_amdgcn_exp2f(s.x); e.y = __builtin_amdgcn_exp2f(s.y);
    const f32x2 m = v * (q * e), r = v - m;
    f32x2 o; o.x = v.x < 0.f ? m.x : r.x; o.y = v.y < 0.f ? m.y : r.y; return o;
}

template <int ACT  > struct EpiBf16 {
    static constexpr bool PERM = true, AFTER_DRAIN = false; static_assert(ACT == 0 || ACT == 1, "EpiBf16: ACT is 0 (none) or 1 (gelu_pk)");
    bf16_t* O; int ldc; const float* bias; int split_cols; size_t split_stride; float scale0;
    __device__ __forceinline__ void operator()(const f32x4 (&acc)[2][2][4][2], const Unit& u, int wr, int wc, int fr, int fq) const {
        const int row0 = u.pm * BM + wr * 64 + fr; int colt = u.pn * BM; bf16_t* base = O;
        float sc = 1.f; if (split_cols) { const int t = colt / split_cols; base += (size_t)t * split_stride; colt -= t * split_cols; if (t == 0) sc = scale0; }
        const int col0 = colt + wc * 32 + 8 * fq, bcol0 = u.pn * BM + wc * 32 + 8 * fq;
        f32x4 bv[2][2];
#pragma unroll
        for (int bj = 0; bj < 2; ++bj)
#pragma unroll
            for (int n = 0; n < 2; ++n) bv[bj][n] = bias ? *(const f32x4*)(bias + bcol0 + bj * HALF + 4 * n) : (f32x4){0.f, 0.f, 0.f, 0.f};
#pragma unroll
        for (int ai = 0; ai < 2; ++ai)
#pragma unroll
            for (int m = 0; m < 4; ++m) { bf16_t* rowp = base + (size_t)(row0 + ai * HALF + m * 16) * ldc + col0;
#pragma unroll
                for (int bj = 0; bj < 2; ++bj) { f32x4 v0 = acc[ai][bj][m][0] + bv[bj][0], v1 = acc[ai][bj][m][1] + bv[bj][1];
                    if (ACT == 1) { f32x2 a = gelu_pk((f32x2){v0[0], v0[1]}), b = gelu_pk((f32x2){v0[2], v0[3]}), c = gelu_pk((f32x2){v1[0], v1[1]}), d = gelu_pk((f32x2){v1[2], v1[3]});
                        v0 = (f32x4){a.x, a.y, b.x, b.y}; v1 = (f32x4){c.x, c.y, d.x, d.y}; }
                    v0 = v0 * sc; v1 = v1 * sc; u32x4 w; w.x = cvt_pk_bf16(v0[0], v0[1]); w.y = cvt_pk_bf16(v0[2], v0[3]); w.z = cvt_pk_bf16(v1[0], v1[1]); w.w = cvt_pk_bf16(v1[2], v1[3]);
                    *(u32x4*)(rowp + bj * HALF) = w; } }
    }
};
typedef int i32x8 __attribute__((ext_vector_type(8)));
typedef int i32x4v __attribute__((ext_vector_type(4)));
__device__ __forceinline__ f32x4 mfma_f8(bf16x8 b0, bf16x8 b1, bf16x8 a0, bf16x8 a1, f32x4 c) {
    const i32x8 bv = __builtin_shufflevector(__builtin_bit_cast(i32x4v, b0), __builtin_bit_cast(i32x4v, b1), 0, 1, 2, 3, 4, 5, 6, 7);
    const i32x8 av = __builtin_shufflevector(__builtin_bit_cast(i32x4v, a0), __builtin_bit_cast(i32x4v, a1), 0, 1, 2, 3, 4, 5, 6, 7);
    return __builtin_amdgcn_mfma_scale_f32_16x16x128_f8f6f4(bv, av, c, 0, 0, 0, 0x7f7f7f7f, 0, 0x7f7f7f7f);
}
struct Frag16 { bf16x8 k[2]; };
template <bool F8> struct FragSel { typedef Frag16 A; };
template <> struct FragSel<true> { typedef i32x8 A; };
__device__ __forceinline__ void frag_load(Frag16& d, const PG8_LAS unsigned char* p) { d.k[0] = *(const PG8_LAS bf16x8*)p; d.k[1] = *(const PG8_LAS bf16x8*)(p + 1024); }
__device__ __forceinline__ void frag_load(i32x8& d, const PG8_LAS unsigned char* p) { const i32x4v lo = *(const PG8_LAS i32x4v*)p, hi = *(const PG8_LAS i32x4v*)(p + 1024); d = __builtin_shufflevector(lo, hi, 0, 1, 2, 3, 4, 5, 6, 7); }
__device__ __forceinline__ f32x4 frag_mma(const Frag16& b, const Frag16& a, f32x4 c) { c = __builtin_amdgcn_mfma_f32_16x16x32_bf16(b.k[0], a.k[0], c, 0, 0, 0); return __builtin_amdgcn_mfma_f32_16x16x32_bf16(b.k[1], a.k[1], c, 0, 0, 0); }
__device__ __forceinline__ f32x4 frag_mma(const i32x8& b, const i32x8& a, f32x4 c) {
    const int sc = 0x7f7f7f7f;
    asm volatile("s_nop 1\n\tv_mfma_scale_f32_16x16x128_f8f6f4 %0, %1, %2, %0, %3, %3 op_sel_hi:[0,0,0]" : "+v"(c) : "v"(b), "v"(a), "v"(sc));
    return c; }
template <class Epi, class Sched, bool ALIGN_EPI = false, bool SP2 = false, bool F8 = false>
__device__ __forceinline__ void gemm_phase(PG8_LAS unsigned char* lds, const Gemm g, const Sched& S, const Epi& E) {
    const int tid = threadIdx.x, wid = __builtin_amdgcn_readfirstlane(tid >> 6), lane = tid & 63, wr = wid >> 2, wc = wid & 3, fr = lane & 15, fq = lane >> 4;
    const int K = g.K, nt = K / BK;
    unsigned voffA[2], voffB[2];
#pragma unroll
    for (int i = 0; i < 2; ++i) { int R, C; stage_rc(tid * 16 + i * 8192, R, C); const int Rb = Epi::PERM ? ((R & ~31) + perm32(R & 31)) : R;
        voffA[i] = (unsigned)(R * K + C) * 2u; voffB[i] = (unsigned)(Rb * K + C) * 2u; }
    const size_t kstep = (size_t)(BK * 2);
    const size_t hstep = (size_t)HALF * K * 2;
    const size_t tstep = 2 * hstep;
    const unsigned ldsw = (unsigned)wid * 1024u;
    const int aoff = lds_byte(wr * 64 + fr, fq * 8), boff = lds_byte(wc * 32 + fr, fq * 8);
#define PG8_SA(b, h) (((b) * 2 + (h)) * HTB)
#define PG8_SB(b, h) ((4 + (b) * 2 + (h)) * HTB)
#define PG8_STAGE(bufoff, gbase, voff) do { _Pragma("unroll") for (int _i = 0; _i < 2; ++_i) \
        __builtin_amdgcn_global_load_lds((const unsigned*)((const char*)(gbase) + (voff)[_i]), (PG8_LAS unsigned*)(lds + (bufoff) + ldsw + _i * 8192), 16, 0, 0); } while (0)
#define PG8_LDA(dst, b, h) do { _Pragma("unroll") for (int m = 0; m < 4; ++m) frag_load(dst[m], lds + PG8_SA(b, h) + aoff + m * 2048); } while (0)
#define PG8_LDB(dst, b, h) do { _Pragma("unroll") for (int n = 0; n < 2; ++n) frag_load(dst[n], lds + PG8_SB(b, h) + boff + n * 2048); } while (0)
#define PG8_MMA(ai, bj, At, Bt) do { __builtin_amdgcn_s_setprio(1); _Pragma("unroll") for (int m = 0; m < 4; ++m) _Pragma("unroll") for (int n = 0; n < 2; ++n) \
        acc[ai][bj][m][n] = frag_mma(Bt[n], At[m], acc[ai][bj][m][n]); __builtin_amdgcn_s_setprio(0); } while (0)
#define PG8_WAIT_V(n) asm volatile("s_waitcnt vmcnt(" #n ")" ::: "memory")
#define PG8_WAIT_L(n) asm volatile("s_waitcnt lgkmcnt(" #n ")" ::: "memory")
#define PG8_BAR __builtin_amdgcn_s_barrier()
#define PG8_SCHED __builtin_amdgcn_sched_barrier(0)
    Unit cur, nxt; int ui = 0;
    if (!S.next(0, cur)) return;
    f32x4 acc[2][2][4][2];
#pragma unroll
    for (int a = 0; a < 2; ++a)
#pragma unroll
        for (int b = 0; b < 2; ++b)
#pragma unroll
            for (int m = 0; m < 4; ++m)
#pragma unroll
                for (int n = 0; n < 2; ++n) acc[a][b][m][n] = (f32x4){0.f, 0.f, 0.f, 0.f};
    typename FragSel<F8>::A At[4]; typename FragSel<F8>::A B0[2], B1[2];
    const char* cA = (const char*)g.A + (size_t)cur.pm * tstep; const char* cB = (const char*)g.Bt + (size_t)cur.bt * tstep;
    S.a_ready(cur);
    if constexpr (SP2) {
        PG8_STAGE(PG8_SB(0, 0), cB, voffB); PG8_STAGE(PG8_SB(0, 1), cB + hstep, voffB); PG8_STAGE(PG8_SA(0, 0), cA, voffA); PG8_STAGE(PG8_SA(0, 1), cA + hstep, voffA);
        if (wr == 1) PG8_BAR;
        PG8_WAIT_V(2); PG8_BAR;
        PG8_STAGE(PG8_SB(1, 0), cB + kstep, voffB); PG8_STAGE(PG8_SA(1, 0), cA + kstep, voffA); PG8_STAGE(PG8_SB(1, 1), cB + hstep + kstep, voffB);
        PG8_WAIT_V(6); PG8_BAR;
    } else {
        PG8_STAGE(PG8_SB(0, 0), cB, voffB); PG8_STAGE(PG8_SA(0, 0), cA, voffA); PG8_STAGE(PG8_SB(0, 1), cB + hstep, voffB); PG8_STAGE(PG8_SA(0, 1), cA + hstep, voffA);
        if (wr == 1) PG8_BAR;
        PG8_WAIT_V(4); PG8_BAR;
        PG8_STAGE(PG8_SB(1, 0), cB + kstep, voffB); PG8_STAGE(PG8_SA(1, 0), cA + kstep, voffA); PG8_STAGE(PG8_SB(1, 1), cB + hstep + kstep, voffB);
        PG8_WAIT_V(6); PG8_BAR;
    }
    for (;;) {
        const bool has_next = S.next(ui + 1, nxt);
        const char* nA = has_next ? (const char*)g.A + (size_t)nxt.pm * tstep : cA; const char* nB = has_next ? (const char*)g.Bt + (size_t)nxt.bt * tstep : cB;
        for (int t = 0; t < nt; t += 2) {
            const bool last = (t == nt - 2);
            const char* a1 = cA + (size_t)(t + 1) * kstep;
            const char* a2 = last ? nA : cA + (size_t)(t + 2) * kstep; const char* b2 = last ? nB : cB + (size_t)(t + 2) * kstep;
            const char* a3 = a2 + kstep; const char* b3 = b2 + kstep;
            if (last && has_next) S.a_ready(nxt);
            if constexpr (SP2) {
            PG8_LDB(B0, 0, 0); PG8_LDB(B1, 0, 1); PG8_SCHED; PG8_LDA(At, 0, 0); PG8_STAGE(PG8_SA(1, 1), a1 + hstep, voffA);
            PG8_WAIT_V(8); PG8_WAIT_L(0); PG8_BAR; PG8_MMA(0, 0, At, B0); PG8_MMA(0, 1, At, B1); PG8_BAR; PG8_SCHED;
            PG8_LDA(At, 0, 1); PG8_STAGE(PG8_SB(0, 0), b2, voffB); PG8_STAGE(PG8_SB(0, 1), b2 + hstep, voffB); PG8_STAGE(PG8_SA(0, 0), a2, voffA);
            PG8_WAIT_V(8); PG8_WAIT_L(0); PG8_BAR; PG8_MMA(1, 0, At, B0); PG8_MMA(1, 1, At, B1); PG8_BAR; PG8_SCHED;
            PG8_LDB(B0, 1, 0); PG8_LDB(B1, 1, 1); PG8_SCHED; PG8_LDA(At, 1, 0); PG8_STAGE(PG8_SA(0, 1), a2 + hstep, voffA);
            PG8_WAIT_V(8); PG8_WAIT_L(0); PG8_BAR; PG8_MMA(0, 0, At, B0); PG8_MMA(0, 1, At, B1); PG8_BAR; PG8_SCHED;
            PG8_LDA(At, 1, 1); PG8_STAGE(PG8_SB(1, 0), b3, voffB); PG8_STAGE(PG8_SB(1, 1), b3 + hstep, voffB); PG8_STAGE(PG8_SA(1, 0), a3, voffA);
            PG8_WAIT_V(8); PG8_WAIT_L(0); PG8_BAR; PG8_MMA(1, 0, At, B0); PG8_MMA(1, 1, At, B1); PG8_BAR; PG8_SCHED;
            } else {
            PG8_LDB(B0, 0, 0); PG8_SCHED; PG8_LDA(At, 0, 0); PG8_STAGE(PG8_SA(1, 1), a1 + hstep, voffA);
            PG8_WAIT_L(8); PG8_BAR; PG8_WAIT_L(0); PG8_MMA(0, 0, At, B0); PG8_BAR; PG8_SCHED;
            PG8_LDB(B1, 0, 1); PG8_STAGE(PG8_SB(0, 0), b2, voffB);
            PG8_BAR; PG8_WAIT_L(0); PG8_MMA(0, 1, At, B1); PG8_BAR;
            PG8_LDA(At, 0, 1); PG8_STAGE(PG8_SA(0, 0), a2, voffA);
            PG8_BAR; PG8_WAIT_L(0); PG8_MMA(1, 0, At, B0); PG8_BAR; PG8_SCHED;
            PG8_STAGE(PG8_SB(0, 1), b2 + hstep, voffB);
            PG8_WAIT_V(6); PG8_BAR; PG8_MMA(1, 1, At, B1); PG8_BAR;
            PG8_LDB(B0, 1, 0); PG8_SCHED; PG8_LDA(At, 1, 0); PG8_STAGE(PG8_SA(0, 1), a2 + hstep, voffA);
            PG8_WAIT_L(8); PG8_BAR; PG8_WAIT_L(0); PG8_MMA(0, 0, At, B0); PG8_BAR; PG8_SCHED;
            PG8_LDB(B1, 1, 1); PG8_STAGE(PG8_SB(1, 0), b3, voffB);
            PG8_BAR; PG8_WAIT_L(0); PG8_MMA(0, 1, At, B1); PG8_BAR;
            PG8_LDA(At, 1, 1); PG8_STAGE(PG8_SA(1, 0), a3, voffA);
            PG8_BAR; PG8_WAIT_L(0); PG8_MMA(1, 0, At, B0); PG8_BAR; PG8_SCHED;
            PG8_STAGE(PG8_SB(1, 1), b3 + hstep, voffB);
            PG8_WAIT_V(6); PG8_BAR; PG8_MMA(1, 1, At, B1); PG8_BAR;
            }
        }
        if constexpr (ALIGN_EPI) { if (wr == 0) PG8_BAR; }
        if constexpr (F8) {
            asm volatile("s_nop 15\n\ts_nop 15" ::: "memory");
#pragma unroll
            for (int a = 0; a < 2; ++a)
#pragma unroll
                for (int b = 0; b < 2; ++b)
#pragma unroll
                    for (int m = 0; m < 4; ++m) asm volatile("" : "+v"(acc[a][b][m][0]), "+v"(acc[a][b][m][1]));
        }
        if constexpr (!Epi::AFTER_DRAIN) { E(acc, cur, wr, wc, fr, fq); S.done(cur); }
        if (!has_next) break;
#pragma unroll
        for (int a = 0; a < 2; ++a)
#pragma unroll
            for (int b = 0; b < 2; ++b)
#pragma unroll
                for (int m = 0; m < 4; ++m)
#pragma unroll
                    for (int n = 0; n < 2; ++n) acc[a][b][m][n] = (f32x4){0.f, 0.f, 0.f, 0.f};
        cur = nxt; cA = nA; cB = nB; ++ui;
        if constexpr (ALIGN_EPI) { if (wr == 1) PG8_BAR; }
    }
    PG8_WAIT_V(0);
    if constexpr (!ALIGN_EPI) { if (wr == 0) PG8_BAR; }
    PG8_BAR;
    if constexpr (Epi::AFTER_DRAIN) { E.fused(acc, cur, wr, wc, fr, fq, lds, wid, lane); S.done(cur); }
#undef PG8_SA
#undef PG8_SB
#undef PG8_STAGE
#undef PG8_LDA
#undef PG8_LDB
#undef PG8_MMA
#undef PG8_WAIT_V
#undef PG8_WAIT_L
#undef PG8_BAR
#undef PG8_SCHED
}
}
namespace hy {
using pg8::bf16_t; using pg8::f32x4; using pg8::u32x4; using pg8::bf16x8;
#define LAS __attribute__((address_space(3)))
constexpr int NB = 4, SEQ = 4096, DM = 1024, CTXL = 256;
constexpr int M_LAT = NB * SEQ, M_CTX = NB * CTXL, M_ALL = M_LAT + M_CTX;
constexpr int IN_COLS = 3104, NE = 16, CAP = 512, DE = 2816, NSLOT = NE * NB * CAP;
constexpr int PROJ_LD = 2304, PC_NAK = 0, PC_GK = 512, PC_NAQ = 768, PC_GQ = 1280, PC_GG = 1536, PC_AD = 2048;
constexpr int VT_LD = M_ALL;
constexpr float EPS = 1e-6f;
constexpr int TKB = SEQ + CTXL;
constexpr size_t MiB = 1u << 20;
constexpr size_t WS_MODP = 1 * MiB, WS_MOD = 3 * MiB, WS_WTIN = 4 * MiB, WS_WTV = 9 * MiB, WS_WTOUT = 11 * MiB, WS_AFF = 13 * MiB, WS_IDX = 14 * MiB, WS_GATE = 14 * MiB + 256 * 1024, WS_INV = 15 * MiB;
constexpr size_t WS_WTGU = 16 * MiB, WS_WTDN = 192 * MiB, WS_H = 280 * MiB, WS_PROJ = 314 * MiB, WS_VT = 391 * MiB, WS_OMIX = 425 * MiB, WS_MIX = 457 * MiB, WS_HID = 280 * MiB;
constexpr size_t WS_HF = 489 * MiB, WS_XS = 521 * MiB, WS_GLAT = 590 * MiB, WS_QF = 590 * MiB, WS_KF = 606 * MiB, WS_KFT = 622 * MiB, WS_AT = 639 * MiB, WS_SB = 640 * MiB, WS_UPF = 639 * MiB + 768 * 1024, WS_KH = 521 * MiB, WS_VB = 538 * MiB, WS_END = 672 * MiB;
static_assert(WS_WTIN + (size_t)PROJ_LD * DM * 2 <= WS_WTV && WS_WTGU + (size_t)NE * 2 * DE * DM * 2 <= WS_WTDN && WS_WTDN + (size_t)NE * DM * DE * 2 <= WS_H, "ws map 1");
static_assert(WS_H + (size_t)M_ALL * DM * 2 <= WS_PROJ && WS_PROJ + (size_t)M_ALL * PROJ_LD * 2 <= WS_VT && WS_VT + (size_t)1024 * VT_LD * 2 <= WS_OMIX, "ws map 2");
static_assert(WS_HID + (size_t)NSLOT * DE * 2 <= WS_MIX && WS_XS + (size_t)NSLOT * DM * 2 <= WS_GLAT && WS_SB + (size_t)2 * NB * 4 * 64 * 128 * 64 * 2 <= WS_END && WS_KFT + (size_t)2 * 256 * M_ALL * 2 <= WS_AT, "ws map 3");

__device__ __forceinline__ float bf2f(bf16_t x) { return __uint_as_float((unsigned)x << 16); }
__device__ __forceinline__ unsigned f2bf(float f) { unsigned u = __float_as_uint(f); return (u + 0x7fffu + ((u >> 16) & 1u)) >> 16; }
__device__ __forceinline__ unsigned pk2(float lo, float hi) { return f2bf(lo) | (f2bf(hi) << 16); }
__device__ __forceinline__ float wave_sum(float v) {
#pragma unroll
    for (int o = 1; o < 64; o <<= 1) v += __shfl_xor(v, o);
    return v;
}
__device__ __forceinline__ float silu_f(float x) { return x / (1.f + __expf(-x)); }

__device__ __forceinline__ void ph_mod(const float* __restrict__ c, const float* __restrict__ c_ctx, const float* __restrict__ w_mod, const float* __restrict__ b_mod, float* __restrict__ mod, LAS unsigned char* lds, int bid, int G) {
    LAS float* s = (LAS float*)lds;
    LAS float* red = s + 5 * 1024;
    const int tid = threadIdx.x;
    __syncthreads();
    for (int i = tid; i < 5 * 1024; i += 512) { const int v = i >> 10, k = i & 1023; const float x = v < 4 ? c[v * 1024 + k] : c_ctx[k]; s[i] = x / (1.f + expf(-x)); }
    __syncthreads();
    for (int cg = bid; cg < 256; cg += G) {
        const int ks = tid / 24, cj = tid % 24, j = cg * 24 + cj;
        if (tid < 504) {
            float acc[5] = {0.f, 0.f, 0.f, 0.f, 0.f};
            const int k0 = ks * 49, k1 = min(k0 + 49, 1024);
#pragma unroll 7
            for (int k = k0; k < k1; ++k) { const float w = w_mod[(size_t)k * 6144 + j];
#pragma unroll
                for (int v = 0; v < 5; ++v) acc[v] += s[v * 1024 + k] * w; }
#pragma unroll
            for (int v = 0; v < 5; ++v) red[(v * 21 + ks) * 24 + cj] = acc[v];
        }
        __syncthreads();
        if (tid < 120) { const int v = tid / 24, cc = tid % 24; float a = b_mod[cg * 24 + cc];
            for (int q = 0; q < 21; ++q) a += red[(v * 21 + q) * 24 + cc];
            mod[(size_t)v * 6144 + cg * 24 + cc] = a; }
        __syncthreads();
    }
}

__device__ __forceinline__ void transpose_item(const float* __restrict__ W, int N, int k0, int n0, bf16_t* dst, int K, float scale, LAS float* scr, int lane) {
    float wv[32];
#pragma unroll
    for (int i = 0; i < 32; ++i) wv[i] = W[(size_t)(k0 + 2 * i + (lane >> 5)) * N + n0 + (lane & 31)];
#pragma unroll
    for (int i = 0; i < 32; ++i) scr[(2 * i + (lane >> 5)) * 33 + (lane & 31)] = wv[i];
    asm volatile("s_waitcnt lgkmcnt(0)" ::: "memory");
    const int c = lane & 7;
#pragma unroll
    for (int j = 0; j < 4; ++j) { const int n = (lane >> 3) + 8 * j; const LAS float* s = scr + (8 * c) * 33 + n;
        u32x4 o; o.x = pk2(s[0 * 33] * scale, s[1 * 33] * scale); o.y = pk2(s[2 * 33] * scale, s[3 * 33] * scale); o.z = pk2(s[4 * 33] * scale, s[5 * 33] * scale); o.w = pk2(s[6 * 33] * scale, s[7 * 33] * scale);
        *(u32x4*)(dst + (size_t)n * K + k0 + 8 * c) = o; }
    asm volatile("s_waitcnt lgkmcnt(0)" ::: "memory");
}
constexpr float SX8 = 16.f, SW1 = 64.f, SH8 = 8.f, SW2 = 128.f;
__device__ __forceinline__ float clamp448(float v) { return fminf(fmaxf(v, -448.f), 448.f); }
__device__ __forceinline__ unsigned pk4_fp8(float a, float b, float c, float d) {
    int w = 0; w = __builtin_amdgcn_cvt_pk_fp8_f32(clamp448(a), clamp448(b), w, false); w = __builtin_amdgcn_cvt_pk_fp8_f32(clamp448(c), clamp448(d), w, true); return (unsigned)w; }
__device__ __forceinline__ void transpose_item_f8(const float* __restrict__ W, int N, int k0, int n0, unsigned char* dst, int Kb, float scale, LAS float* scr, int lane) {
    float wv[32];
#pragma unroll
    for (int i = 0; i < 32; ++i) wv[i] = W[(size_t)(k0 + 2 * i + (lane >> 5)) * N + n0 + (lane & 31)];
#pragma unroll
    for (int i = 0; i < 32; ++i) scr[(2 * i + (lane >> 5)) * 33 + (lane & 31)] = wv[i];
    asm volatile("s_waitcnt lgkmcnt(0)" ::: "memory");
    const int c = lane & 3;
#pragma unroll
    for (int j = 0; j < 2; ++j) { const int n = (lane >> 2) + 16 * j; const LAS float* s = scr + (16 * c) * 33 + n;
        u32x4 o; o.x = pk4_fp8(s[0 * 33] * scale, s[1 * 33] * scale, s[2 * 33] * scale, s[3 * 33] * scale); o.y = pk4_fp8(s[4 * 33] * scale, s[5 * 33] * scale, s[6 * 33] * scale, s[7 * 33] * scale);
        o.z = pk4_fp8(s[8 * 33] * scale, s[9 * 33] * scale, s[10 * 33] * scale, s[11 * 33] * scale); o.w = pk4_fp8(s[12 * 33] * scale, s[13 * 33] * scale, s[14 * 33] * scale, s[15 * 33] * scale);
        *(u32x4*)(dst + (size_t)n * Kb + k0 + 16 * c) = o; }
    asm volatile("s_waitcnt lgkmcnt(0)" ::: "memory");
}
struct PrepArgs { const float *x, *ctx, *g_pre, *mod, *w_in, *w_out, *w_gate, *w_up, *w_down; bf16_t *WTIN, *WTV, *WTOUT; unsigned char *WTGU, *WTDN; bf16_t* H; };
constexpr int IT_IN = 16 * 97, IT_OUT = 16 * 32, IT_GU1 = 16 * 16 * 88, IT_DN = 16 * 44 * 32, IT_ALL = IT_IN + IT_OUT + 2 * IT_GU1 + IT_DN;
struct CvtItem { const float* W; unsigned char* dst; int N, Kb; float scale; };
constexpr int IT16 = IT_IN + IT_OUT;
constexpr int IT8_GU1 = 16 * 8 * 88, IT8_DN = 16 * 22 * 32, IT8 = 2 * IT8_GU1 + IT8_DN;
#ifndef CVT_Q0
#define CVT_Q0 0
#endif
#ifndef CVT_Q1
#define CVT_Q1 23000
#endif
__device__ __forceinline__ CvtItem cvt_decode16(const PrepArgs& a, int it) {
    CvtItem c; int r = it;
    if (r < IT_IN) { const int kb = r / 97, n0 = (r % 97) * 32; bf16_t* dst; float sc = 1.f;
        if (n0 < 512) dst = a.WTIN + (size_t)(PC_NAK + n0) * DM;
        else if (n0 < 1024) dst = a.WTV + (size_t)(n0 - 512) * DM;
        else if (n0 < 1280) dst = a.WTIN + (size_t)(PC_GK + n0 - 1024) * DM;
        else if (n0 < 1792) dst = a.WTV + (size_t)(512 + n0 - 1280) * DM;
        else if (n0 < 1824) dst = a.WTIN + (size_t)(PC_AD + n0 - 1792) * DM;
        else if (n0 < 2336) { dst = a.WTIN + (size_t)(PC_NAQ + n0 - 1824) * DM; sc = 0.125f; }
        else if (n0 < 2592) { dst = a.WTIN + (size_t)(PC_GQ + n0 - 2336) * DM; sc = 0.125f; }
        else dst = a.WTIN + (size_t)(PC_GG + n0 - 2592) * DM;
        c.W = a.w_in + (size_t)(kb * 64) * IN_COLS + n0; c.N = IN_COLS; c.dst = (unsigned char*)(dst + kb * 64); c.Kb = DM * 2; c.scale = sc; return c; }
    r -= IT_IN;
    { const int kb = r / 32, n0 = (r % 32) * 32; c.W = a.w_out + (size_t)(kb * 64) * DM + n0; c.N = DM; c.dst = (unsigned char*)(a.WTOUT + (size_t)n0 * DM + kb * 64); c.Kb = DM * 2; c.scale = 1.f; return c; }
}
__device__ __forceinline__ CvtItem cvt_decode8(const PrepArgs& a, int it) {
    CvtItem c; int r = it;
    if (r < 2 * IT8_GU1) { const int which = r / IT8_GU1; r %= IT8_GU1; const int e = r / (8 * 88); r %= (8 * 88); const int kb = r / 88, n0 = (r % 88) * 32;
        c.W = (which ? a.w_up : a.w_gate) + (size_t)e * DM * DE + (size_t)(kb * 128) * DE + n0; c.N = DE;
        c.dst = a.WTGU + ((size_t)e * 2 * DE + (n0 / 128) * 256 + (n0 % 128) + which * 128) * DM + kb * 128; c.Kb = DM; c.scale = SW1; return c; }
    r -= 2 * IT8_GU1;
    { const int e = r / (22 * 32); r %= (22 * 32); const int kb = r / 32, n0 = (r % 32) * 32;
      c.W = a.w_down + (size_t)e * DE * DM + (size_t)(kb * 128) * DM + n0; c.N = DM; c.dst = a.WTDN + ((size_t)e * DM + n0) * DE + kb * 128; c.Kb = DE; c.scale = SW2; return c; }
}
__device__ __forceinline__ void cvt_load(const CvtItem& c, int half, float (&wv)[32], int lane) {
    const float* W = c.W + (size_t)(64 * half) * c.N;
#pragma unroll
    for (int i = 0; i < 32; ++i) wv[i] = __builtin_nontemporal_load(&W[(size_t)(2 * i + (lane >> 5)) * c.N + (lane & 31)]);
}
template <bool F8> __device__ __forceinline__ void cvt_store(const CvtItem& c, int half, const float (&wv)[32], LAS float* scr, int lane) {
#pragma unroll
    for (int i = 0; i < 32; ++i) scr[(2 * i + (lane >> 5)) * 33 + (lane & 31)] = wv[i];
    asm volatile("s_waitcnt lgkmcnt(0)" ::: "memory");
    const float scale = c.scale;
    if constexpr (F8) {
        const int cc = lane & 3; unsigned char* dst = c.dst + 64 * half;
#pragma unroll
        for (int j = 0; j < 2; ++j) { const int n = (lane >> 2) + 16 * j; const LAS float* s = scr + (16 * cc) * 33 + n;
            u32x4 o; o.x = pk4_fp8(s[0 * 33] * scale, s[1 * 33] * scale, s[2 * 33] * scale, s[3 * 33] * scale); o.y = pk4_fp8(s[4 * 33] * scale, s[5 * 33] * scale, s[6 * 33] * scale, s[7 * 33] * scale);
            o.z = pk4_fp8(s[8 * 33] * scale, s[9 * 33] * scale, s[10 * 33] * scale, s[11 * 33] * scale); o.w = pk4_fp8(s[12 * 33] * scale, s[13 * 33] * scale, s[14 * 33] * scale, s[15 * 33] * scale);
            *(u32x4*)(dst + (size_t)n * c.Kb + 16 * cc) = o; }
    } else {
        const int cc = lane & 7;
#pragma unroll
        for (int j = 0; j < 4; ++j) { const int n = (lane >> 3) + 8 * j; const LAS float* s = scr + (8 * cc) * 33 + n;
            u32x4 o; o.x = pk2(s[0 * 33] * scale, s[1 * 33] * scale); o.y = pk2(s[2 * 33] * scale, s[3 * 33] * scale); o.z = pk2(s[4 * 33] * scale, s[5 * 33] * scale); o.w = pk2(s[6 * 33] * scale, s[7 * 33] * scale);
            *(u32x4*)(c.dst + (size_t)n * c.Kb + 16 * cc) = o; }
    }
    asm volatile("s_waitcnt lgkmcnt(0)" ::: "memory");
}
template <bool F8> __device__ __forceinline__ void cvt_run(const PrepArgs& a, int it_lo, int it_hi, int wv0, int nwv, LAS float* scr, int lane) {
    int it = it_lo + wv0; if (it >= it_hi) return;
    float wa[32], wb[32];
    if constexpr (F8) {
        CvtItem c = cvt_decode8(a, it); cvt_load(c, 0, wa, lane);
        for (;;) {
            cvt_load(c, 1, wb, lane);
            cvt_store<true>(c, 0, wa, scr, lane);
            const int itn = it + nwv; const bool hn = itn < it_hi;
            const CvtItem cn = cvt_decode8(a, hn ? itn : it); cvt_load(cn, 0, wa, lane);
            cvt_store<true>(c, 1, wb, scr, lane);
            if (!hn) break;
            c = cn; it = itn;
        }
    } else {
        CvtItem ca = cvt_decode16(a, it), cb;  cvt_load(ca, 0, wa, lane);
        for (;;) {
            int itn = it + nwv; bool hn = itn < it_hi;
            cb = cvt_decode16(a, hn ? itn : it); cvt_load(cb, 0, wb, lane);
            cvt_store<false>(ca, 0, wa, scr, lane);
            if (!hn) break;
            it = itn; itn = it + nwv; hn = itn < it_hi;
            ca = cvt_decode16(a, hn ? itn : it); cvt_load(ca, 0, wa, lane);
            cvt_store<false>(cb, 0, wb, scr, lane);
            if (!hn) break;
            it = itn;
        }
    }
}
__device__ __forceinline__ void ph_convert(const PrepArgs& a, LAS unsigned char* lds, int bid, int G) {
    const int tid = threadIdx.x, lane = tid & 63, wave = tid >> 6;
    LAS float* scr = (LAS float*)(lds + wave * 8448);
    { u32x4* z = (u32x4*)(a.WTIN + (size_t)(PC_AD + 32) * DM); const int nz = (PROJ_LD - PC_AD - 32) * DM * 2 / 16;
      for (int i = bid * 512 + tid; i < nz; i += G * 512) z[i] = (u32x4){0u, 0u, 0u, 0u}; }
    cvt_run<false>(a, 0, IT16, bid * 8 + wave, G * 8, scr, lane);
    cvt_run<true>(a, 0, CVT_Q0, bid * 8 + wave, G * 8, scr, lane);
}
__device__ __forceinline__ void ph_convert_bg(const PrepArgs& a, int lo, int hi, int pid, int npid, LAS unsigned char* lds) {
    const int lane = threadIdx.x & 63, wave = threadIdx.x >> 6;
    if (pid < 0) return;
    cvt_run<true>(a, lo, hi, pid, npid, (LAS float*)(lds + 32768 + wave * 8448), lane);
}
__device__ __forceinline__ void ph_modulate(const PrepArgs& a, int bid, int G) {
    const int tid = threadIdx.x, lane = tid & 63, wave = tid >> 6;
    const int gw = bid * 8 + wave, NGW = G * 8;
    for (int m = gw; m < M_ALL; m += NGW) {
        const float* src; int v;
        if (m < M_LAT) { src = a.x + (size_t)m * DM; v = m / SEQ; } else { src = a.ctx + (size_t)(m - M_LAT) * DM; v = 4; }
        const f32x4* xr = (const f32x4*)src + lane; f32x4 xv[4]; float ss = 0.f;
#pragma unroll
        for (int j = 0; j < 4; ++j) { xv[j] = xr[64 * j]; ss += (xv[j].x * xv[j].x + xv[j].y * xv[j].y) + (xv[j].z * xv[j].z + xv[j].w * xv[j].w); }
        const float rstd = rsqrtf(wave_sum(ss) * (1.f / DM) + EPS);
        const float* mv = a.mod + (size_t)v * 6144;
        unsigned long long* o8 = (unsigned long long*)(a.H + (size_t)m * DM) + lane;
#pragma unroll
        for (int j = 0; j < 4; ++j) { const int col = 4 * lane + 256 * j;
            const f32x4 g = *(const f32x4*)(a.g_pre + col), sh = *(const f32x4*)(mv + col), sc = *(const f32x4*)(mv + 1024 + col);
            const f32x4 hv = xv[j] * rstd * g * (sc + 1.f) + sh;
            o8[64 * j] = (unsigned long long)pk2(hv.x, hv.y) | ((unsigned long long)pk2(hv.z, hv.w) << 32); }
    }
}


__device__ __forceinline__ void tok_of_row(int row, int& bb, int& tk) { if (row < M_LAT) { bb = row >> 12; tk = row & (SEQ - 1); } else { const int r2 = row - M_LAT; bb = r2 >> 8; tk = SEQ + (r2 & (CTXL - 1)); } }
struct EpiProj {
    static constexpr bool PERM = true, AFTER_DRAIN = false;
    bf16_t* O; int ldc; bf16_t* KH;
    __device__ __forceinline__ void operator()(const f32x4 (&acc)[2][2][4][2], const pg8::Unit& u, int wr, int wc, int fr, int fq) const {
        const int row0 = u.pm * 256 + wr * 64 + fr, col0 = u.pn * 256 + wc * 32 + 8 * fq;
#pragma unroll
        for (int ai = 0; ai < 2; ++ai)
#pragma unroll
            for (int m = 0; m < 4; ++m) { const int row = row0 + ai * 128 + m * 16; int bb, tk; tok_of_row(row, bb, tk);
#pragma unroll
                for (int bj = 0; bj < 2; ++bj) { const f32x4 v0 = acc[ai][bj][m][0], v1 = acc[ai][bj][m][1];
                    u32x4 w; w.x = pg8::cvt_pk_bf16(v0[0], v0[1]); w.y = pg8::cvt_pk_bf16(v0[2], v0[3]); w.z = pg8::cvt_pk_bf16(v1[0], v1[1]); w.w = pg8::cvt_pk_bf16(v1[2], v1[3]);
                    const int col = col0 + bj * 128;
                    if (u.pn < 2) { const int hh = col >> 6, ks = (col >> 5) & 1; *(u32x4*)(KH + ((size_t)((bb * 8 + hh) * 2 + ks) * TKB + tk) * 32 + (col & 31)) = w; }
                    else *(u32x4*)(O + (size_t)row * ldc + col) = w; } }
    }
};
struct EpiVal {
    static constexpr bool PERM = true, AFTER_DRAIN = false;
    bf16_t* VT; int ldc; bf16_t* VB;
    __device__ __forceinline__ void operator()(const f32x4 (&acc)[2][2][4][2], const pg8::Unit& u, int wr, int wc, int fr, int fq) const {
        const int row0 = u.pm * 256 + wr * 64 + fr, col0 = u.pn * 256 + wc * 32 + 8 * fq;
#pragma unroll
        for (int ai = 0; ai < 2; ++ai)
#pragma unroll
            for (int m = 0; m < 4; ++m) { const int vr = row0 + ai * 128 + m * 16;
#pragma unroll
                for (int bj = 0; bj < 2; ++bj) { const f32x4 v0 = acc[ai][bj][m][0], v1 = acc[ai][bj][m][1];
                    u32x4 w; w.x = pg8::cvt_pk_bf16(v0[0], v0[1]); w.y = pg8::cvt_pk_bf16(v0[2], v0[3]); w.z = pg8::cvt_pk_bf16(v1[0], v1[1]); w.w = pg8::cvt_pk_bf16(v1[2], v1[3]);
                    const int col = col0 + bj * 128;
                    if (u.pm < 2) { int bb, tk; tok_of_row(col, bb, tk); const int hh = vr >> 6, dt = (vr >> 4) & 3, dd = vr & 15;
                        *(u32x4*)(VB + ((size_t)(((bb * 8 + hh) * 4 + dt) * (TKB / 8) + (tk >> 3)) * 16 + dd) * 8) = w; }
                    else *(u32x4*)(VT + (size_t)vr * ldc + col) = w; } }
    }
};
struct EpiSwiGLU {
    static constexpr bool PERM = true, AFTER_DRAIN = false;
    unsigned char* O; int ldc;
    __device__ __forceinline__ void operator()(const f32x4 (&acc)[2][2][4][2], const pg8::Unit& u, int wr, int wc, int fr, int fq) const {
        const int row0 = u.pm * 256 + wr * 64 + fr, col0 = u.pn * 128 + wc * 32 + 8 * fq;
        constexpr float DS = 1.f / (SX8 * SW1);
#pragma unroll
        for (int ai = 0; ai < 2; ++ai)
#pragma unroll
            for (int m = 0; m < 4; ++m) { unsigned char* rowp = O + (size_t)(row0 + ai * 128 + m * 16) * ldc + col0;
                const f32x4 g0 = acc[ai][0][m][0] * DS, g1 = acc[ai][0][m][1] * DS, u0 = acc[ai][1][m][0] * (DS * SH8), u1 = acc[ai][1][m][1] * (DS * SH8);
                uint2 w; w.x = pk4_fp8(silu_f(g0[0]) * u0[0], silu_f(g0[1]) * u0[1], silu_f(g0[2]) * u0[2], silu_f(g0[3]) * u0[3]);
                w.y = pk4_fp8(silu_f(g1[0]) * u1[0], silu_f(g1[1]) * u1[1], silu_f(g1[2]) * u1[2], silu_f(g1[3]) * u1[3]);
                *(uint2*)rowp = w; }
    }
};
struct EpiRowScale {
    static constexpr bool PERM = true, AFTER_DRAIN = false;
    bf16_t* O; int ldc; const float* rowscale;
    __device__ __forceinline__ void operator()(const f32x4 (&acc)[2][2][4][2], const pg8::Unit& u, int wr, int wc, int fr, int fq) const {
        const int row0 = u.pm * 256 + wr * 64 + fr, col0 = u.pn * 256 + wc * 32 + 8 * fq;
#pragma unroll
        for (int ai = 0; ai < 2; ++ai)
#pragma unroll
            for (int m = 0; m < 4; ++m) { const int row = row0 + ai * 128 + m * 16; const float sc = rowscale[row] * (1.f / (SH8 * SW2)); bf16_t* rowp = O + (size_t)row * ldc + col0;
#pragma unroll
                for (int bj = 0; bj < 2; ++bj) { const f32x4 v0 = acc[ai][bj][m][0] * sc, v1 = acc[ai][bj][m][1] * sc;
                    u32x4 w; w.x = pg8::cvt_pk_bf16(v0[0], v0[1]); w.y = pg8::cvt_pk_bf16(v0[2], v0[3]); w.z = pg8::cvt_pk_bf16(v1[0], v1[1]); w.w = pg8::cvt_pk_bf16(v1[2], v1[3]);
                    *(u32x4*)(rowp + bj * 128) = w; } }
    }
};
struct ExpertOrder {
    int nT, G, c;
    __device__ __forceinline__ bool next(int i, pg8::Unit& u) const {
        if (G == 256) { if (2 * i >= nT) return false; const int x = c & 7, j = c >> 3, e = 2 * x + (j >> 4), mt = j & 7, pn = 2 * i + ((j >> 3) & 1);
            u.pm = e * 8 + mt; u.pn = pn; u.bt = e * nT + pn; return true; }
        const long L = (long)i * G + c; if (L >= (long)128 * nT) return false;
        const int e = (int)(L / (8 * nT)), r = (int)(L % (8 * nT)); u.pm = e * 8 + (r % 8); u.pn = r / 8; u.bt = e * nT + u.pn; return true;
    }
    __device__ __forceinline__ void a_ready(const pg8::Unit&) const {}
    __device__ __forceinline__ void done(const pg8::Unit&) const {}
};
__device__ __forceinline__ void ph_na_naive(const bf16_t* __restrict__ PROJ, const bf16_t* __restrict__ VT, const float* __restrict__ rpb, bf16_t* __restrict__ OMIX, int bid, int G) {
  for (int vb = bid * 8 + (threadIdx.x >> 6); vb < NB * 8 * 64; vb += G * 8) {
    const int r = vb % 64, h = (vb / 64) % 8, b = vb / 512, c = threadIdx.x & 63;
    const size_t mq = (size_t)b * SEQ + r * 64 + c;
    float q[64], acc[64];
    { const u32x4* qp = (const u32x4*)(PROJ + mq * PROJ_LD + PC_NAQ + h * 64);
#pragma unroll
      for (int i = 0; i < 8; ++i) { const u32x4 w = qp[i]; q[8 * i + 0] = __uint_as_float(w.x << 16); q[8 * i + 1] = __uint_as_float(w.x & 0xffff0000u); q[8 * i + 2] = __uint_as_float(w.y << 16); q[8 * i + 3] = __uint_as_float(w.y & 0xffff0000u);
          q[8 * i + 4] = __uint_as_float(w.z << 16); q[8 * i + 5] = __uint_as_float(w.z & 0xffff0000u); q[8 * i + 6] = __uint_as_float(w.w << 16); q[8 * i + 7] = __uint_as_float(w.w & 0xffff0000u); } }
#pragma unroll
    for (int d = 0; d < 64; ++d) acc[d] = 0.f;
    float mx = -INFINITY, l = 0.f;
    const int rs = min(max(r - 4, 0), 56), cs = min(max(c - 8, 0), 48);
    for (int kk = 0; kk < 128 + CTXL; ++kk) {
        size_t mk; float bias = 0.f;
        if (kk < 128) { const int krow = rs + (kk >> 4), kcol = cs + (kk & 15); mk = (size_t)b * SEQ + krow * 64 + kcol; bias = rpb[(h * 15 + (krow - r + 7)) * 31 + (kcol - c + 15)]; }
        else mk = (size_t)M_LAT + b * CTXL + (kk - 128);
        const u32x4* kp = (const u32x4*)(PROJ + mk * PROJ_LD + PC_NAK + h * 64);
        float s = 0.f;
#pragma unroll
        for (int i = 0; i < 8; ++i) { const u32x4 w = kp[i];
            s += q[8 * i + 0] * __uint_as_float(w.x << 16) + q[8 * i + 1] * __uint_as_float(w.x & 0xffff0000u) + q[8 * i + 2] * __uint_as_float(w.y << 16) + q[8 * i + 3] * __uint_as_float(w.y & 0xffff0000u)
               + q[8 * i + 4] * __uint_as_float(w.z << 16) + q[8 * i + 5] * __uint_as_float(w.z & 0xffff0000u) + q[8 * i + 6] * __uint_as_float(w.w << 16) + q[8 * i + 7] * __uint_as_float(w.w & 0xffff0000u); }
        s += bias;
        const float mn = fmaxf(mx, s), al = __expf(mx - mn), p = __expf(s - mn);
        l = l * al + p; mx = mn;
        const bf16_t* vp = VT + (size_t)(h * 64) * VT_LD + mk;
#pragma unroll
        for (int d = 0; d < 64; ++d) acc[d] = acc[d] * al + p * bf2f(vp[(size_t)d * VT_LD]);
    }
    const float inv = 1.f / l;
    unsigned* op = (unsigned*)(OMIX + mq * DM + h * 64);
#pragma unroll
    for (int i = 0; i < 32; ++i) op[i] = pk2(acc[2 * i] * inv, acc[2 * i + 1] * inv);
  }
}

__device__ __forceinline__ f32x4 mfma16(bf16x8 a, bf16x8 b, f32x4 c) { return __builtin_amdgcn_mfma_f32_16x16x32_bf16(a, b, c, 0, 0, 0); }
__device__ __forceinline__ void na_unit(int u, const bf16_t* __restrict__ PROJ, const bf16_t* __restrict__ KH, const bf16_t* __restrict__ VB, const LAS float* rb, bf16_t* __restrict__ OMIX, int lane) {
    const int q = lane & 15, g = lane >> 4;
    const int bh = u >> 8, b = bh >> 3, h = bh & 7, r = (u & 255) >> 2, qt = u & 3;
    const int c0 = (qt == 0) ? 0 : (qt == 3 ? 32 : 16 * qt - 8);
    const int rs = min(max(r - 4, 0), 56);
    const int cq = 16 * qt + q, cs = min(max(cq - 8, 0), 48);
    const size_t mq = (size_t)b * SEQ + r * 64 + cq;
    const bf16_t* qp = PROJ + mq * PROJ_LD + PC_NAQ + h * 64 + 8 * g;
    const bf16x8 qf0 = *(const bf16x8*)qp, qf1 = *(const bf16x8*)(qp + 32);
    const bf16_t* kb0 = KH + ((size_t)(bh * 2) * TKB + 8 * (q >> 2) + (q & 3)) * 32 + 8 * g;
    const bf16_t* kb1 = kb0 + (size_t)TKB * 32;
    f32x4 S[32];
#pragma unroll
    for (int p = 0; p < 16; ++p) {
        const int s = (p < 8) ? ((rs + p) * 64 + c0) : (SEQ + 32 * (p - 8));
#pragma unroll
        for (int half = 0; half < 2; ++half) {
            const size_t off = (size_t)(s + 4 * half) * 32;
            f32x4 acc = (f32x4){0.f, 0.f, 0.f, 0.f};
            acc = mfma16(*(const bf16x8*)(kb0 + off), qf0, acc); acc = mfma16(*(const bf16x8*)(kb1 + off), qf1, acc);
            if (p < 8) {
                const LAS float* rbr = rb + (h * 15 + (rs + p - r + 7)) * 31;
#pragma unroll
                for (int i = 0; i < 4; ++i) { const int kcol = c0 + 8 * g + 4 * half + i; const bool valid = (kcol >= cs) && (kcol < cs + 16);
                    const float bias = rbr[min(max(kcol - cq + 15, 0), 30)];
                    acc[i] = valid ? acc[i] + bias : -INFINITY; }
            }
            S[2 * p + half] = acc;
        }
    }
    float mx = -INFINITY;
#pragma unroll
    for (int T = 0; T < 32; ++T) mx = fmaxf(fmaxf(mx, fmaxf(S[T][0], S[T][1])), fmaxf(S[T][2], S[T][3]));
    mx = fmaxf(mx, __shfl_xor(mx, 16)); mx = fmaxf(mx, __shfl_xor(mx, 32));
    float l = 0.f;
#pragma unroll
    for (int T = 0; T < 32; ++T) {
#pragma unroll
        for (int i = 0; i < 4; ++i) { const float p = __expf(S[T][i] - mx); S[T][i] = p; l += p; } }
    l += __shfl_xor(l, 16); l += __shfl_xor(l, 32);
    f32x4 O[4];
#pragma unroll
    for (int dt = 0; dt < 4; ++dt) O[dt] = (f32x4){0.f, 0.f, 0.f, 0.f};
    const bf16_t* vb0 = VB + ((size_t)(bh * 4) * (TKB / 8) * 16 + (size_t)g * 16 + q) * 8;
#pragma unroll
    for (int p = 0; p < 16; ++p) {
        u32x4 pw; pw.x = pg8::cvt_pk_bf16(S[2 * p][0], S[2 * p][1]); pw.y = pg8::cvt_pk_bf16(S[2 * p][2], S[2 * p][3]); pw.z = pg8::cvt_pk_bf16(S[2 * p + 1][0], S[2 * p + 1][1]); pw.w = pg8::cvt_pk_bf16(S[2 * p + 1][2], S[2 * p + 1][3]);
        const bf16x8 pb = __builtin_bit_cast(bf16x8, pw);
        const int s = (p < 8) ? ((rs + p) * 64 + c0) : (SEQ + 32 * (p - 8));
#pragma unroll
        for (int dt = 0; dt < 4; ++dt) O[dt] = mfma16(*(const bf16x8*)(vb0 + ((size_t)dt * (TKB / 8) + (s >> 3)) * 128), pb, O[dt]);
    }
    const float inv = 1.f / l;
    bf16_t* op = OMIX + mq * DM + h * 64 + 4 * g;
#pragma unroll
    for (int dt = 0; dt < 4; ++dt) { uint2 w; w.x = pg8::cvt_pk_bf16(O[dt][0] * inv, O[dt][1] * inv); w.y = pg8::cvt_pk_bf16(O[dt][2] * inv, O[dt][3] * inv); *(uint2*)(op + dt * 16) = w; }
}
__device__ __forceinline__ void ph_na(const bf16_t* __restrict__ PROJ, const bf16_t* __restrict__ KH, const bf16_t* __restrict__ VB, const float* __restrict__ rpb, bf16_t* __restrict__ OMIX, LAS unsigned char* lds, int bid, int G) {
    LAS float* rb = (LAS float*)lds;
    __syncthreads();
    for (int i = threadIdx.x; i < 8 * 15 * 31; i += 512) rb[i] = rpb[i];
    __syncthreads();
    const int lane = threadIdx.x & 63, wave = threadIdx.x >> 6;
#ifndef REP_NA
#define REP_NA 1
#endif
    for (int rep_ = 0; rep_ < REP_NA; ++rep_)
    for (int u = bid * 8 + wave; u < NB * 8 * 64 * 4; u += G * 8) na_unit(u, PROJ, KH, VB, rb, OMIX, lane);
}

typedef float f32x16 __attribute__((ext_vector_type(16)));
__device__ __forceinline__ f32x16 mfma32(bf16x8 a, bf16x8 b, f32x16 c) { return __builtin_amdgcn_mfma_f32_32x32x16_bf16(a, b, c, 0, 0, 0); }
constexpr int NCHUNK = 272;
__device__ __forceinline__ float logsig16(float z) { return (fminf(z, 0.f) - log1pf(__expf(-fabsf(z)))) * (1.f / 16.f); }
__device__ __forceinline__ void ph_upf(const float* __restrict__ a_up, bf16_t* __restrict__ UPF, int bid, int G) {
    for (int e = bid * 512 + threadIdx.x; e < 1024; e += G * 512) { const int dir = e >> 9, h = (e >> 7) & 3, dd = (e >> 6) & 1, ln = e & 63, d5 = ln & 31, h2 = ln >> 5;
        float v[8];
#pragma unroll
        for (int j = 0; j < 8; ++j) v[j] = a_up[(size_t)(dir * 16 + 8 * h2 + j) * 256 + h * 64 + 32 * dd + d5];
        *(u32x4*)(UPF + (size_t)e * 8) = (u32x4){pk2(v[0], v[1]), pk2(v[2], v[3]), pk2(v[4], v[5]), pk2(v[6], v[7])}; }
}
__device__ __forceinline__ void gla_prep_unit(int uu, const bf16_t* __restrict__ PROJ, const bf16_t* __restrict__ UPF, const float* __restrict__ a_bias, bf16_t* __restrict__ QF, bf16_t* __restrict__ KF, bf16_t* __restrict__ KFT, float* __restrict__ AT,
                                              const LAS float* tab, int lane) {
    const int h = uu & 3, ci = uu >> 2;
    const bool lat = ci < 256;
    const int crow = ci & 63;
    const int m0 = lat ? ((ci >> 6) * SEQ + crow * 64) : (M_LAT + (ci - 256) * 64);
    const int l31 = lane & 31, hh = lane >> 5, fi = l31 & 15; const bool lower = l31 < 16;
    bf16x8 adf[2][2];
#pragma unroll
    for (int dir = 0; dir < 2; ++dir)
#pragma unroll
        for (int tt = 0; tt < 2; ++tt) adf[dir][tt] = *(const bf16x8*)(PROJ + (unsigned)((m0 + 32 * tt + l31) * PROJ_LD + PC_AD + dir * 16 + 8 * hh));
#pragma unroll 1
    for (int dd = 0; dd < 2; ++dd) {
        const int dcol = h * 64 + 32 * dd + l31;
        float la[2][2][16], T[2][2][4], Tp[2][2][4], tot[2];
#pragma unroll
        for (int dir = 0; dir < 2; ++dir) {
            const bf16x8 upf = *(const bf16x8*)(UPF + (unsigned)((((dir * 4 + h) * 2 + dd) * 64 + lane) * 8));
            const float zb = a_bias[dir * 256 + dcol];
            tot[dir] = 0.f;
#pragma unroll
            for (int tt = 0; tt < 2; ++tt) { f32x16 Z;
#pragma unroll
                for (int i = 0; i < 16; ++i) Z[i] = 0.f;
                Z = mfma32(adf[dir][tt], upf, Z);
#pragma unroll
                for (int i = 0; i < 16; ++i) la[dir][tt][i] = logsig16(Z[i] + zb);
#pragma unroll
                for (int g = 0; g < 4; ++g) { la[dir][tt][4 * g + 1] += la[dir][tt][4 * g]; la[dir][tt][4 * g + 2] += la[dir][tt][4 * g + 1]; la[dir][tt][4 * g + 3] += la[dir][tt][4 * g + 2];
                    T[dir][tt][g] = la[dir][tt][4 * g + 3]; Tp[dir][tt][g] = __shfl_xor(T[dir][tt][g], 32); tot[dir] += T[dir][tt][g] + Tp[dir][tt][g]; } }
            if (hh == 0) AT[(unsigned)((dir * NCHUNK + ci) * 256 + dcol)] = __expf(tot[dir]);
        }
        float E[2] = {0.f, 0.f};
#pragma unroll
        for (int tt = 0; tt < 2; ++tt)
#pragma unroll
            for (int g = 0; g < 4; ++g) {
                const int t0 = 32 * tt + 8 * g + 4 * hh;
                float kv[4], qv[4];
#pragma unroll
                for (int k = 0; k < 4; ++k) { const unsigned ro = (unsigned)((m0 + t0 + k) * PROJ_LD + dcol); kv[k] = bf2f(PROJ[ro + PC_GK]); qv[k] = lat ? bf2f(PROJ[ro + PC_GQ]) : 0.f; }
                if (lat) {
#pragma unroll
                    for (int k = 0; k < 4; ++k) { const int pos = dd ? (t0 + k) : crow; const float cs = tab[2 * (pos * 16 + fi)], sn = tab[2 * (pos * 16 + fi) + 1];
                        const float kp = __shfl_xor(kv[k], 16), qp = __shfl_xor(qv[k], 16);
                        kv[k] = lower ? (kv[k] * cs - kp * sn) : (kp * sn + kv[k] * cs);
                        qv[k] = lower ? (qv[k] * cs - qp * sn) : (qp * sn + qv[k] * cs); }
                }
#pragma unroll
                for (int dir = 0; dir < 2; ++dir) {
                    const float offs = E[dir] + (hh ? Tp[dir][tt][g] : 0.f); E[dir] += T[dir][tt][g] + Tp[dir][tt][g];
                    unsigned kb[4];
#pragma unroll
                    for (int k = 0; k < 4; ++k) { const int i = 4 * g + k; const float pin = offs + la[dir][tt][i];
                        const float pex = offs + (k ? la[dir][tt][i - 1] : 0.f);
                        const float lam = dir ? (tot[dir] - pex) : pin;
                        kb[k] = f2bf(kv[k] * __expf(-lam));
                        if (lat) { const unsigned mo = (unsigned)((dir * M_LAT + m0 + t0 + k) * 256 + dcol);
                            QF[mo] = (bf16_t)f2bf(qv[k] * __expf(lam)); KF[mo] = (bf16_t)kb[k]; } }
                    *(uint2*)(KFT + (unsigned)((dir * 256 + dcol) * M_ALL + m0 + t0)) = make_uint2(kb[0] | (kb[1] << 16), kb[2] | (kb[3] << 16));
                }
                asm volatile("" ::: "memory");
            }
    }
}
__device__ __forceinline__ void ph_gla_prep2(const bf16_t* __restrict__ PROJ, const bf16_t* __restrict__ UPF, const float* __restrict__ a_bias, bf16_t* __restrict__ QF, bf16_t* __restrict__ KF, bf16_t* __restrict__ KFT, float* __restrict__ AT,
                                             LAS unsigned char* lds, int bid, int G) {
    LAS float* tab = (LAS float*)(lds + 16384);
    __syncthreads();
    for (int i = threadIdx.x; i < 1024; i += 512) { const int pos = i >> 4, fi = i & 15; const float ang = (float)pos * powf(10000.f, -(float)fi / 16.f); tab[2 * i] = cosf(ang); tab[2 * i + 1] = sinf(ang); }
    __syncthreads();
    const int lane = threadIdx.x & 63, wave = threadIdx.x >> 6;
#ifndef REP_GP
#define REP_GP 1
#endif
    for (int rep_ = 0; rep_ < REP_GP; ++rep_)
    for (int u = bid * 8 + wave; u < NCHUNK * 4; u += G * 8) gla_prep_unit(__builtin_amdgcn_readfirstlane(u), PROJ, UPF, a_bias, QF, KF, KFT, AT, tab, lane);
}
constexpr size_t SB_CH = 128 * 64;
__device__ __forceinline__ void gla_state_unit(int u, const bf16_t* __restrict__ KFT, const bf16_t* __restrict__ VT, const float* __restrict__ AT, bf16_t* __restrict__ SB, int lane) {
    const int es = u & 3, dir = (u >> 2) & 1, h = (u >> 3) & 3, b = u >> 5;
    const int l31 = lane & 31, hh = lane >> 5;
    f32x16 acc[2];
#pragma unroll
    for (int dt = 0; dt < 2; ++dt)
#pragma unroll
        for (int i = 0; i < 16; ++i) acc[dt][i] = 0.f;
    const bf16_t* kft0 = KFT + ((size_t)dir * 256 + h * 64 + l31) * M_ALL + 8 * hh;
    const bf16_t* vt0 = VT + (size_t)(512 + h * 128 + es * 32 + l31) * VT_LD + 8 * hh;
    bf16_t* sb0 = SB + ((size_t)((dir * NB + b) * 4 + h) * 64) * SB_CH + (size_t)(es * 32 + l31) * 64 + 4 * hh;
    for (int s = 0; s < 68; ++s) {
        int ci, m0, c = 0;
        if (s < 4) { const int cc = dir ? 3 - s : s; ci = 256 + b * 4 + cc; m0 = M_LAT + b * CTXL + cc * 64; }
        else { c = dir ? 67 - s : s - 4; ci = b * 64 + c; m0 = b * SEQ + c * 64; }
        bf16x8 af[2][4], bfr[4]; f32x4 av[2][4];
#pragma unroll
        for (int ks = 0; ks < 4; ++ks) { bfr[ks] = *(const bf16x8*)(vt0 + m0 + 16 * ks);
#pragma unroll
            for (int dt = 0; dt < 2; ++dt) af[dt][ks] = *(const bf16x8*)(kft0 + (size_t)dt * 32 * M_ALL + m0 + 16 * ks); }
#pragma unroll
        for (int dt = 0; dt < 2; ++dt)
#pragma unroll
            for (int rr = 0; rr < 4; ++rr) av[dt][rr] = *(const f32x4*)(AT + ((size_t)dir * NCHUNK + ci) * 256 + h * 64 + dt * 32 + 8 * rr + 4 * hh);
        if (s >= 4) {
            bf16_t* sp = sb0 + (size_t)c * SB_CH;
#pragma unroll
            for (int dt = 0; dt < 2; ++dt)
#pragma unroll
                for (int rr = 0; rr < 4; ++rr) { uint2 w; w.x = pg8::cvt_pk_bf16(acc[dt][4 * rr], acc[dt][4 * rr + 1]); w.y = pg8::cvt_pk_bf16(acc[dt][4 * rr + 2], acc[dt][4 * rr + 3]); *(uint2*)(sp + dt * 32 + 8 * rr) = w; }
        }
#pragma unroll
        for (int dt = 0; dt < 2; ++dt) {
#pragma unroll
            for (int ks = 0; ks < 4; ++ks) acc[dt] = mfma32(af[dt][ks], bfr[ks], acc[dt]);
#pragma unroll
            for (int rr = 0; rr < 4; ++rr) { acc[dt][4 * rr] *= av[dt][rr][0]; acc[dt][4 * rr + 1] *= av[dt][rr][1]; acc[dt][4 * rr + 2] *= av[dt][rr][2]; acc[dt][4 * rr + 3] *= av[dt][rr][3]; }
        }
    }
}
__device__ __forceinline__ void gla_out_unit(int u, const bf16_t* __restrict__ PROJ, const bf16_t* __restrict__ QF, const bf16_t* __restrict__ KF, const bf16_t* __restrict__ VT, const bf16_t* __restrict__ SB, const float* __restrict__ gnorm,
                                             bf16_t* __restrict__ OMIX, int lane) {
    const int it = u & 1, c = (u >> 1) & 63, h = (u >> 7) & 3, b = u >> 9;
    const int l31 = lane & 31, hh = lane >> 5;
    const int m0 = b * SEQ + c * 64;
    f32x16 o[4];
#pragma unroll
    for (int et = 0; et < 4; ++et)
#pragma unroll
        for (int i = 0; i < 16; ++i) o[et][i] = 0.f;
#pragma unroll
    for (int dir = 0; dir < 2; ++dir) {
        bf16x8 qf[4];
        const bf16_t* qp = QF + ((size_t)dir * M_LAT + m0 + 32 * it + l31) * 256 + h * 64 + 8 * hh;
#pragma unroll
        for (int ks = 0; ks < 4; ++ks) qf[ks] = *(const bf16x8*)(qp + 16 * ks);
#pragma unroll
        for (int jt = 0; jt < 2; ++jt) {
            const bool need = dir ? (jt >= it) : (jt <= it);
            if (!need) continue;
            f32x16 X;
#pragma unroll
            for (int i = 0; i < 16; ++i) X[i] = 0.f;
            const bf16_t* kp = KF + ((size_t)dir * M_LAT + m0 + 32 * jt + l31) * 256 + h * 64 + 8 * hh;
#pragma unroll
            for (int ks = 0; ks < 4; ++ks) X = mfma32(*(const bf16x8*)(kp + 16 * ks), qf[ks], X);
            if (jt == it) {
#pragma unroll
                for (int i = 0; i < 16; ++i) { const int jr = (i & 3) + 8 * (i >> 2) + 4 * hh; const bool keep = dir ? (jr >= l31) : (jr <= l31); X[i] = keep ? X[i] : 0.f; }
            }
#pragma unroll
            for (int s = 0; s < 2; ++s) {
                u32x4 xw; xw.x = pg8::cvt_pk_bf16(X[8 * s], X[8 * s + 1]); xw.y = pg8::cvt_pk_bf16(X[8 * s + 2], X[8 * s + 3]); xw.z = pg8::cvt_pk_bf16(X[8 * s + 4], X[8 * s + 5]); xw.w = pg8::cvt_pk_bf16(X[8 * s + 6], X[8 * s + 7]);
                const bf16x8 xa = __builtin_bit_cast(bf16x8, xw);
#pragma unroll
                for (int et = 0; et < 4; ++et) {
                    const bf16_t* vp = VT + (size_t)(512 + h * 128 + et * 32 + l31) * VT_LD + m0 + 32 * jt + 16 * s + 4 * hh;
                    const uint2 lo = *(const uint2*)vp, hi = *(const uint2*)(vp + 8);
                    const u32x4 vw = (u32x4){lo.x, lo.y, hi.x, hi.y};
                    o[et] = mfma32(xa, __builtin_bit_cast(bf16x8, vw), o[et]); }
            }
        }
        const bf16_t* sp = SB + ((size_t)(((dir * NB + b) * 4 + h) * 64 + c)) * SB_CH + (size_t)l31 * 64 + 8 * hh;
#pragma unroll
        for (int et = 0; et < 4; ++et)
#pragma unroll
            for (int ks = 0; ks < 4; ++ks) o[et] = mfma32(qf[ks], *(const bf16x8*)(sp + (size_t)et * 32 * 64 + 16 * ks), o[et]);
    }
    float ss[16];
#pragma unroll
    for (int i = 0; i < 16; ++i) { float a = 0.f;
#pragma unroll
        for (int et = 0; et < 4; ++et) a += o[et][i] * o[et][i];
        a += __shfl_xor(a, 1); a += __shfl_xor(a, 2); a += __shfl_xor(a, 4); a += __shfl_xor(a, 8); a += __shfl_xor(a, 16);
        ss[i] = rsqrtf(a * (1.f / 128.f) + EPS); }
#pragma unroll
    for (int et = 0; et < 4; ++et) { const float gn = gnorm[et * 32 + l31];
#pragma unroll
        for (int i = 0; i < 16; ++i) { const size_t m = (size_t)(m0 + 32 * it + (i & 3) + 8 * (i >> 2) + 4 * hh);
            const float g = bf2f(PROJ[m * PROJ_LD + PC_GG + h * 128 + et * 32 + l31]);
            OMIX[m * DM + 512 + h * 128 + et * 32 + l31] = (bf16_t)f2bf(o[et][i] * ss[i] * gn * silu_f(g)); } }
}
__device__ __forceinline__ void ph_gla_state(const bf16_t* KFT, const bf16_t* VT, const float* AT, bf16_t* SB, int bid, int G) {
    const int lane = threadIdx.x & 63, wave = threadIdx.x >> 6;
    for (int u = wave * G + bid; u < NB * 4 * 2 * 4; u += 8 * G) gla_state_unit(u, KFT, VT, AT, SB, lane);
}
__device__ __forceinline__ void ph_gla_out(const bf16_t* PROJ, const bf16_t* QF, const bf16_t* KF, const bf16_t* VT, const bf16_t* SB, const float* gnorm, bf16_t* OMIX, int bid, int G) {
    const int lane = threadIdx.x & 63, wave = threadIdx.x >> 6;
    for (int u = bid * 8 + wave; u < NB * 4 * 64 * 2; u += G * 8) gla_out_unit(u, PROJ, QF, KF, VT, SB, gnorm, OMIX, lane);
}

__device__ __forceinline__ void ph_post_mix(const float* __restrict__ x, const bf16_t* __restrict__ MIX, const float* __restrict__ mod, const float* __restrict__ g_post, const float* __restrict__ g_fpre, const float* __restrict__ router,
                                                  float* __restrict__ xnew, unsigned char* __restrict__ HF, float* __restrict__ aff, LAS unsigned char* lds, int bid, int G) {
    LAS float* rt = (LAS float*)lds;
    __syncthreads();
    for (int i = threadIdx.x; i < DM * NE; i += 512) rt[(i % NE) * DM + (i / NE)] = router[i];
    __syncthreads();
    const int lane = threadIdx.x & 63, wave = threadIdx.x >> 6;
    for (int m = bid * 8 + wave; m < M_LAT; m += G * 8) {
        const int b = m / SEQ, t = m % SEQ; const float* mv = mod + (size_t)b * 6144;
        f32x4 mx[4]; float ss = 0.f;
        const unsigned long long* mp = (const unsigned long long*)(MIX + (size_t)m * DM) + lane;
#pragma unroll
        for (int j = 0; j < 4; ++j) { const unsigned long long w = mp[64 * j]; const unsigned lo = (unsigned)w, hi = (unsigned)(w >> 32);
            mx[j] = (f32x4){__uint_as_float(lo << 16), __uint_as_float(lo & 0xffff0000u), __uint_as_float(hi << 16), __uint_as_float(hi & 0xffff0000u)};
            ss += (mx[j].x * mx[j].x + mx[j].y * mx[j].y) + (mx[j].z * mx[j].z + mx[j].w * mx[j].w); }
        const float rstd = rsqrtf(wave_sum(ss) * (1.f / DM) + EPS);
        f32x4 xn[4]; float s2 = 0.f;
#pragma unroll
        for (int j = 0; j < 4; ++j) { const int col = 4 * lane + 256 * j;
            const f32x4 xv = *(const f32x4*)(x + (size_t)m * DM + col), gp = *(const f32x4*)(g_post + col), gm = *(const f32x4*)(mv + 2048 + col);
            xn[j] = xv + gm * (mx[j] * rstd * gp);
            *(f32x4*)(xnew + (size_t)m * DM + col) = xn[j];
            s2 += (xn[j].x * xn[j].x + xn[j].y * xn[j].y) + (xn[j].z * xn[j].z + xn[j].w * xn[j].w); }
        const float rstd2 = rsqrtf(wave_sum(s2) * (1.f / DM) + EPS);
        f32x4 hv4[4];
        unsigned* hp = (unsigned*)(HF + (size_t)m * DM) + lane;
#pragma unroll
        for (int j = 0; j < 4; ++j) { const int col = 4 * lane + 256 * j;
            const f32x4 gf = *(const f32x4*)(g_fpre + col), sh = *(const f32x4*)(mv + 3072 + col), sc = *(const f32x4*)(mv + 4096 + col);
            hv4[j] = xn[j] * rstd2 * gf * (sc + 1.f) + sh;
            hp[64 * j] = pk4_fp8(hv4[j].x * SX8, hv4[j].y * SX8, hv4[j].z * SX8, hv4[j].w * SX8); }
        float lg[NE]; float mxl = -INFINITY;
#pragma unroll
        for (int e = 0; e < NE; ++e) { float sacc = 0.f;
#pragma unroll
            for (int j = 0; j < 4; ++j) { const f32x4 rv = *(const LAS f32x4*)(rt + e * DM + 4 * lane + 256 * j); sacc += (hv4[j].x * rv.x + hv4[j].y * rv.y) + (hv4[j].z * rv.z + hv4[j].w * rv.w); }
            lg[e] = wave_sum(sacc); mxl = fmaxf(mxl, lg[e]); asm volatile("" ::: "memory"); }
        float den = 0.f;
#pragma unroll
        for (int e = 0; e < NE; ++e) { lg[e] = expf(lg[e] - mxl); den += lg[e]; }
        const float rden = 1.f / den;
#pragma unroll
        for (int e = 0; e < NE; ++e) if (lane == e) aff[((size_t)b * NE + e) * SEQ + t] = lg[e] * rden;
    }
}

__device__ __forceinline__ int block_excl_scan(int v, LAS int* sm  , int& total) {
    const int lane = threadIdx.x & 63, w = threadIdx.x >> 6; int x = v;
#pragma unroll
    for (int o = 1; o < 64; o <<= 1) { const int y = __shfl_up(x, o); if (lane >= o) x += y; }
    __syncthreads();
    if (lane == 63) sm[w] = x;
    __syncthreads();
    int base = 0, tot = 0;
#pragma unroll
    for (int i = 0; i < 8; ++i) { const int s = sm[i]; if (i < w) base += s; tot += s; }
    total = tot;
    return base + x - v;
}
__device__ __forceinline__ void ph_topk(const float* __restrict__ aff, const unsigned char* __restrict__ HF, int* __restrict__ idx, float* __restrict__ gate, int* __restrict__ inv, unsigned char* __restrict__ XS, LAS unsigned char* lds, int bid, int G) {
  LAS int* hist = (LAS int*)lds; LAS int* sm = hist + 256; LAS unsigned* sp = (LAS unsigned*)(sm + 16); LAS int* srm = (LAS int*)(sp + 1); LAS int* s_list = srm + 1;
#define s_prefix (*sp)
#define s_remain (*srm)
  for (int be = bid; be < NB * NE; be += G) {
    const int b = be / NE, e = be % NE, tid = threadIdx.x;
    __syncthreads();
    const float* av = aff + ((size_t)b * NE + e) * SEQ;
    unsigned key[8];
#pragma unroll
    for (int j = 0; j < 8; ++j) key[j] = __float_as_uint(av[tid * 8 + j]);
    if (tid == 0) { s_prefix = 0u; s_remain = CAP; }
    for (int pass = 3; pass >= 0; --pass) {
        if (tid < 256) hist[tid] = 0;
        __syncthreads();
        const unsigned prefix = s_prefix; const int shift = pass * 8; const unsigned himask = pass == 3 ? 0u : (0xffffffffu << (shift + 8));
#pragma unroll
        for (int j = 0; j < 8; ++j) if ((key[j] & himask) == prefix) atomicAdd((int*)(hist + ((key[j] >> shift) & 255u)), 1);
        __syncthreads();
        {
            const int rem = s_remain; const int lane_ = tid & 63, w_ = tid >> 6;
            int hcnt = 0, suf = 0;
            if (tid < 256) { hcnt = hist[tid]; suf = hcnt;
#pragma unroll
                for (int o = 1; o < 64; o <<= 1) { const int y = __shfl_down(suf, o); if (lane_ + o < 64) suf += y; }
                if (lane_ == 0) sm[8 + w_] = suf; }
            __syncthreads();
            if (tid < 256) { int above = suf - hcnt; for (int w2 = w_ + 1; w2 < 4; ++w2) above += sm[8 + w2];
                if (hcnt > 0 && above < rem && rem <= above + hcnt) { s_remain = rem - above; s_prefix = prefix | ((unsigned)tid << shift); } }
            __syncthreads();
        }
    }
    const unsigned T = s_prefix; const int remain = s_remain;
    int neq = 0;
#pragma unroll
    for (int j = 0; j < 8; ++j) neq += (key[j] == T);
    int tot; int eqbase = block_excl_scan(neq, sm, tot);
    int flags = 0, nsel = 0;
#pragma unroll
    for (int j = 0; j < 8; ++j) { bool sel = key[j] > T; if (key[j] == T) { sel = eqbase < remain; ++eqbase; } if (sel) { flags |= 1 << j; ++nsel; } }
    int slot = block_excl_scan(nsel, sm, tot);
    const int rowbase = (e * NB + b) * CAP;
#pragma unroll
    for (int j = 0; j < 8; ++j) { const int t = tid * 8 + j; int sl = -1;
        if (flags & (1 << j)) { sl = slot++; idx[rowbase + sl] = t; gate[rowbase + sl] = __uint_as_float(key[j]); s_list[sl] = t; }
        inv[((size_t)b * SEQ + t) * NE + e] = sl; }
    __syncthreads();
    const int lane = tid & 63, wave = tid >> 6;
    for (int s = wave; s < CAP; s += 8) { const u32x4* src = (const u32x4*)(HF + ((size_t)b * SEQ + s_list[s]) * DM); u32x4* dst = (u32x4*)(XS + (size_t)(rowbase + s) * DM);
        dst[lane] = src[lane]; }
  }
#undef s_prefix
#undef s_remain
}

__device__ __forceinline__ void ph_combine(const bf16_t* __restrict__ Y, const int* __restrict__ inv, const float* __restrict__ mod, const float* __restrict__ g_fpost, float* __restrict__ out, int bid, int G) {
    const int lane = threadIdx.x & 63, wave = threadIdx.x >> 6;
    for (int m = bid * 8 + wave; m < M_LAT; m += G * 8) {
        const int b = m / SEQ; const float* mv = mod + (size_t)b * 6144;
        const int sl = (lane < NE) ? inv[(size_t)m * NE + lane] : -1;
        unsigned mask = (unsigned)__ballot(sl >= 0);
        f32x4 xn[4];
#pragma unroll
        for (int j = 0; j < 4; ++j) xn[j] = *(const f32x4*)(out + (size_t)m * DM + 4 * lane + 256 * j);
        f32x4 y[4];
#pragma unroll
        for (int j = 0; j < 4; ++j) y[j] = (f32x4){0.f, 0.f, 0.f, 0.f};
        while (mask) {
            const unsigned long long* yp[4]; float w[4];
#pragma unroll
            for (int k = 0; k < 4; ++k) { const unsigned mm = mask ? mask : 1u; const int e = __builtin_ctz(mm); w[k] = mask ? 1.f : 0.f; mask &= mask - 1u;
                const int s = __builtin_amdgcn_readlane(sl, e); const int s2 = s < 0 ? 0 : s;
                yp[k] = (const unsigned long long*)(Y + (size_t)((e * NB + b) * CAP + s2) * DM) + lane; }
            unsigned long long v[4][4];
#pragma unroll
            for (int k = 0; k < 4; ++k)
#pragma unroll
                for (int j = 0; j < 4; ++j) v[k][j] = yp[k][64 * j];
#pragma unroll
            for (int k = 0; k < 4; ++k)
#pragma unroll
                for (int j = 0; j < 4; ++j) { const unsigned lo = (unsigned)v[k][j], hi = (unsigned)(v[k][j] >> 32);
                    y[j] += (f32x4){__uint_as_float(lo << 16), __uint_as_float(lo & 0xffff0000u), __uint_as_float(hi << 16), __uint_as_float(hi & 0xffff0000u)} * w[k]; }
        }
        float ss = 0.f;
#pragma unroll
        for (int j = 0; j < 4; ++j) ss += (y[j].x * y[j].x + y[j].y * y[j].y) + (y[j].z * y[j].z + y[j].w * y[j].w);
        const float rstd = rsqrtf(wave_sum(ss) * (1.f / DM) + EPS);
#pragma unroll
        for (int j = 0; j < 4; ++j) { const int col = 4 * lane + 256 * j; float* op = out + (size_t)m * DM + col;
            const f32x4 gp = *(const f32x4*)(g_fpost + col), gf = *(const f32x4*)(mv + 5120 + col);
            *(f32x4*)op = xn[j] + gf * (y[j] * rstd * gp); }
    }
}

#define GAS __attribute__((address_space(1)))
#define XB_TMO      128
#define XB_XCNT(j)  (256  + 64 * (j))
#define XB_XSUB(j)  (1280 + 64 * (j))
#define XB_XGEN(j)  (2304 + 64 * (j))
#define XB_TOP      3328
#define XB_TOPGEN   3392
#define XCD_BAR_WORDS 3456
#define XB_SPIN_CAP (1u << 18)

__device__ __forceinline__ unsigned xb_ld(unsigned* p)              { return __hip_atomic_load(p, __ATOMIC_RELAXED, __HIP_MEMORY_SCOPE_AGENT); }
__device__ __forceinline__ unsigned xb_add(unsigned* p, unsigned v) { return __hip_atomic_fetch_add(p, v, __ATOMIC_RELAXED, __HIP_MEMORY_SCOPE_AGENT); }
__device__ __forceinline__ unsigned xb_xcc_id() { return (unsigned)__builtin_amdgcn_s_getreg((3 << 11) | 20) & 0xFu; }
#define XB_SPIN(cond, bar) do { unsigned _sp = 0; while (cond) { __builtin_amdgcn_s_sleep(1); \
    if ((++_sp & 255u) == 0u) { if (xb_ld(&(bar)[XB_TMO])) break; if (_sp > XB_SPIN_CAP) { atomicAdd(&(bar)[XB_TMO], 1u); break; } } } } while (0)

struct XcdBarrier {
    unsigned* bar; unsigned x;
    volatile LAS unsigned* st;
};

__device__ __forceinline__ XcdBarrier xcd_barrier_post(unsigned* bar, volatile LAS unsigned* st) {
    XcdBarrier b; b.bar = bar; b.x = xb_xcc_id(); b.st = st;
    if (threadIdx.x == 0) (void)xb_add(&bar[XB_XCNT(b.x)], 1u);
    return b;
}
__device__ __forceinline__ void xcd_barrier_complete(unsigned* bar, unsigned x, unsigned& nloc, unsigned& nx) {
    const unsigned G = gridDim.x * gridDim.y * gridDim.z;
    unsigned sum, cnt, mine, sp = 0u;
    for (;;) {
        sum = 0u; cnt = 0u; mine = 0u;
#pragma unroll
        for (unsigned j = 0; j < 16; ++j) { const unsigned c = xb_ld(&bar[XB_XCNT(j)]); sum += c; cnt += (c > 0u) ? 1u : 0u; mine = (j == x) ? c : mine; }
        if (sum == G) break;
        __builtin_amdgcn_s_sleep(1);
        if ((++sp & 255u) == 0u) { if (xb_ld(&bar[XB_TMO])) break; if (sp > XB_SPIN_CAP) { atomicAdd(&bar[XB_TMO], 1u); break; } }
    }
    nloc = mine > 0u ? mine : 1u; nx = cnt > 0u ? cnt : 1u;
}

__device__ __forceinline__ void xcd_barrier(const XcdBarrier& b) {
    asm volatile("s_waitcnt vmcnt(0)" ::: "memory");
    __syncthreads();
    if (threadIdx.x == 0) {
        unsigned* bar = b.bar;
        __builtin_amdgcn_s_waitcnt(0);
        unsigned nloc = b.st[0], nx = b.st[1];
        if (nloc == 0u) { xcd_barrier_complete(bar, b.x, nloc, nx); b.st[0] = nloc; b.st[1] = nx; }
        const unsigned old = xb_add(&bar[XB_XSUB(b.x)], 1u);
        const unsigned gen = old / nloc;
        if (old + 1u == (gen + 1u) * nloc) {
            __builtin_amdgcn_fence(__ATOMIC_RELEASE, "agent");
            asm volatile("s_waitcnt vmcnt(0)" ::: "memory");
            const unsigned og = xb_add(&bar[XB_TOP], 1u);
            const unsigned tg = og / nx;
            if (og + 1u == (tg + 1u) * nx) xb_add(&bar[XB_TOPGEN], 1u);
            else XB_SPIN(xb_ld(&bar[XB_TOPGEN]) == tg, bar);
            __builtin_amdgcn_fence(__ATOMIC_ACQUIRE, "agent");
            xb_add(&bar[XB_XGEN(b.x)], 1u);
            asm volatile("s_waitcnt vmcnt(0)" ::: "memory");
        } else {
            XB_SPIN(xb_ld(&bar[XB_XGEN(b.x)]) == gen, bar);
            __builtin_amdgcn_fence(__ATOMIC_ACQUIRE, "agent");
            asm volatile("s_waitcnt vmcnt(0)" ::: "memory");
        }
    }
    __syncthreads();
}


namespace cg = cooperative_groups;
constexpr int LDS_BYTES = 147456;
constexpr int N_PHASES = 12;
constexpr size_t CTL_BYTES = 65536;
#ifndef REP_PH
#define REP_PH -1
#endif
#ifndef REP_SYNC
#define REP_SYNC 0
#endif
struct MegaArgs { const float* in[20]; float* out; unsigned char* ws; int ph_lo, ph_hi; };
__global__ void __launch_bounds__(512, 2) hy_mega(MegaArgs a) {
    extern __shared__ __attribute__((aligned(16))) unsigned char lds_raw[];
    LAS unsigned char* lds = (LAS unsigned char*)lds_raw;
    const int bid = blockIdx.x, G = gridDim.x;
#define Q_x (a.in[0])
#define Q_c (a.in[1])
#define Q_ctx (a.in[2])
#define Q_c_ctx (a.in[3])
#define Q_w_mod (a.in[4])
#define Q_b_mod (a.in[5])
#define Q_g_pre (a.in[6])
#define Q_g_post (a.in[7])
#define Q_g_fpre (a.in[8])
#define Q_g_fpost (a.in[9])
#define Q_w_in (a.in[10])
#define Q_rpb (a.in[11])
#define Q_a_up (a.in[12])
#define Q_a_bias (a.in[13])
#define Q_gnorm (a.in[14])
#define Q_w_out (a.in[15])
#define Q_router (a.in[16])
#define Q_w_gate (a.in[17])
#define Q_w_up (a.in[18])
#define Q_w_down (a.in[19])
#define Q_ws (a.ws)
#define Q_out (a.out)
#define Q_mod ((float*)(a.ws + WS_MOD))
#define Q_WTIN ((bf16_t*)(a.ws + WS_WTIN))
#define Q_WTV ((bf16_t*)(a.ws + WS_WTV))
#define Q_WTOUT ((bf16_t*)(a.ws + WS_WTOUT))
#define Q_WTGU ((unsigned char*)(a.ws + WS_WTGU))
#define Q_WTDN ((unsigned char*)(a.ws + WS_WTDN))
#define Q_H ((bf16_t*)(a.ws + WS_H))
#define Q_PROJ ((bf16_t*)(a.ws + WS_PROJ))
#define Q_VT ((bf16_t*)(a.ws + WS_VT))
#define Q_OMIX ((bf16_t*)(a.ws + WS_OMIX))
#define Q_MIX ((bf16_t*)(a.ws + WS_MIX))
#define Q_HID ((unsigned char*)(a.ws + WS_HID))
#define Q_HF ((unsigned char*)(a.ws + WS_HF))
#define Q_XS ((unsigned char*)(a.ws + WS_XS))
#define Q_Y ((bf16_t*)(a.ws + WS_XS))
#define Q_aff ((float*)(a.ws + WS_AFF))
#define Q_idx ((int*)(a.ws + WS_IDX))
#define Q_gate ((float*)(a.ws + WS_GATE))
#define Q_inv ((int*)(a.ws + WS_INV))
#define Q_QF ((bf16_t*)(a.ws + WS_QF))
#define Q_KF ((bf16_t*)(a.ws + WS_KF))
#define Q_KFT ((bf16_t*)(a.ws + WS_KFT))
#define Q_AT ((float*)(a.ws + WS_AT))
#define Q_SB ((bf16_t*)(a.ws + WS_SB))
#define Q_KH ((bf16_t*)(a.ws + WS_KH))
#define Q_UPF ((bf16_t*)(a.ws + WS_UPF))
#define Q_VB ((bf16_t*)(a.ws + WS_VB))
    volatile LAS unsigned* bst = (volatile LAS unsigned*)(lds + LDS_BYTES - 64);
    if (threadIdx.x < 16) bst[threadIdx.x] = 0u;
    __syncthreads();
    XcdBarrier bar = xcd_barrier_post((unsigned*)a.ws, bst);
    if (a.ph_hi < 0) cg::this_grid().sync();
    const int lo = a.ph_lo, hi = a.ph_hi;
#define IN(k) (lo <= (k) && (k) < hi)
#define SEAM(k) do { if (IN(k) && IN((k) + 1)) xcd_barrier(bar); } while (0)
#define MKP PrepArgs p; p.x = Q_x; p.ctx = Q_ctx; p.g_pre = Q_g_pre; p.mod = Q_mod; p.w_in = Q_w_in; p.w_out = Q_w_out; p.w_gate = Q_w_gate; p.w_up = Q_w_up; p.w_down = Q_w_down; p.WTIN = Q_WTIN; p.WTV = Q_WTV; p.WTOUT = Q_WTOUT; p.WTGU = Q_WTGU; p.WTDN = Q_WTDN; p.H = Q_H;
#define PH0 if (IN(0)) { MKP ph_mod(Q_c, Q_c_ctx, Q_w_mod, Q_b_mod, Q_mod, lds, bid, G); ph_upf(Q_a_up, Q_UPF, bid, G); ph_convert(p, lds, bid, G); }
#define PH1 if (IN(1)) { MKP ph_modulate(p, bid, G); }
#define PH2 if (IN(2)) { \
        { pg8::Gemm g{Q_H, Q_WTIN, M_ALL, PROJ_LD, DM}; pg8::StaticOrder S; S.init(g.M, g.N, G, bid); EpiProj E{Q_PROJ, PROJ_LD, Q_KH}; \
          pg8::gemm_phase<EpiProj, pg8::StaticOrder, true, true>(lds, g, S, E); } \
        { pg8::Gemm g{Q_WTV, Q_H, 1024, M_ALL, DM}; pg8::StaticOrder S; S.init(g.M, g.N, G, bid); EpiVal E{Q_VT, VT_LD, Q_VB}; \
          pg8::gemm_phase<EpiVal, pg8::StaticOrder, true, true>(lds, g, S, E); } }
#define PH3 if (IN(3)) { ph_gla_prep2(Q_PROJ, Q_UPF, Q_a_bias, Q_QF, Q_KF, Q_KFT, Q_AT, lds, bid, G); ph_na(Q_PROJ, Q_KH, Q_VB, Q_rpb, Q_OMIX, lds, bid, G); }
#define PH4 if (IN(4)) { MKP ph_gla_state(Q_KFT, Q_VT, Q_AT, Q_SB, bid, G); \
        { const int wv_ = threadIdx.x >> 6; const int nst_ = G < 128 ? G : 128; const int pid_ = bid < nst_ ? (wv_ == 0 ? -1 : bid * 7 + wv_ - 1) : nst_ * 7 + (bid - nst_) * 8 + wv_; \
          ph_convert_bg(p, CVT_Q0, CVT_Q1, pid_, nst_ * 7 + (G - nst_) * 8, lds); } }
#define PH5 if (IN(5)) ph_gla_out(Q_PROJ, Q_QF, Q_KF, Q_VT, Q_SB, Q_gnorm, Q_OMIX, bid, G);
#define PH6 if (IN(6)) { pg8::Gemm g{Q_OMIX, Q_WTOUT, M_LAT, DM, DM}; pg8::StaticOrder S; S.init(g.M, g.N, G, bid); pg8::EpiBf16<0> E{Q_MIX, DM, nullptr, 0, 0, 1.f}; \
        pg8::gemm_phase<pg8::EpiBf16<0>, pg8::StaticOrder, true, true>(lds, g, S, E); }
#define PH7 if (IN(7)) ph_post_mix(Q_x, Q_MIX, Q_mod, Q_g_post, Q_g_fpre, Q_router, Q_out, Q_HF, Q_aff, lds, bid, G);
#define PH8 if (IN(8)) { MKP ph_topk(Q_aff, Q_HF, Q_idx, Q_gate, Q_inv, Q_XS, lds, bid, G); \
        { const int nb_ = G < 64 ? G : 64; const int pid_ = (G > 64) ? (bid < 64 ? -1 : (bid - 64) * 8 + (int)(threadIdx.x >> 6)) : bid * 8 + (int)(threadIdx.x >> 6); \
          ph_convert_bg(p, CVT_Q1, IT8, pid_, (G > 64 ? (G - 64) : G) * 8, lds); } }
#define PH9 if (IN(9)) { pg8::Gemm g{(const bf16_t*)Q_XS, (const bf16_t*)Q_WTGU, NSLOT, 2 * DE, DM / 2}; ExpertOrder S{22, G, bid}; EpiSwiGLU E{Q_HID, DE}; \
        pg8::gemm_phase<EpiSwiGLU, ExpertOrder, true, true, true>(lds, g, S, E); }
#define PH10 if (IN(10)) { pg8::Gemm g{(const bf16_t*)Q_HID, (const bf16_t*)Q_WTDN, NSLOT, DM, DE / 2}; ExpertOrder S{4, G, bid}; EpiRowScale E{Q_Y, DM, Q_gate}; \
        pg8::gemm_phase<EpiRowScale, ExpertOrder, true, true, true>(lds, g, S, E); }
#define PH11 if (IN(11)) ph_combine(Q_Y, Q_inv, Q_mod, Q_g_fpost, Q_out, bid, G);
#define RUN(k, PH) PH
    PH0
#if REP_PH == 0
    PH0
#endif
    SEAM(0);
    for (int rs_ = 0; rs_ < REP_SYNC; ++rs_) xcd_barrier(bar);
    PH1
#if REP_PH == 1
    PH1
#endif
    SEAM(1);
    PH2
#if REP_PH == 2
    PH2
#endif
    SEAM(2);
    PH3
#if REP_PH == 3
    PH3
#endif
    SEAM(3);
    PH4
#if REP_PH == 4
    PH4
#endif
    SEAM(4);
    PH5
#if REP_PH == 5
    PH5
#endif
    SEAM(5);
    PH6
#if REP_PH == 6
    PH6
#endif
    SEAM(6);
    PH7
#if REP_PH == 7
    PH7
#endif
    SEAM(7);
    PH8
#if REP_PH == 8
    PH8
#endif
    SEAM(8);
    PH9
#if REP_PH == 9
    PH9
#endif
    SEAM(9);
    PH10
#if REP_PH == 10
    PH10
#endif
    SEAM(10);
    PH11
#undef IN
#undef SEAM
}
}

extern "C" void kernel_launch(void* const* d_in, const int* in_sizes, int n_in, void* d_out, int out_size, void* d_ws, size_t ws_size, hipStream_t stream) {
    using namespace hy;
    static int grid = 0;
    if (grid == 0) {
        if (n_in != 20 || in_sizes[0] != M_LAT * DM || out_size != M_LAT * DM || ws_size < WS_END) { fprintf(stderr, "kernel_launch: unexpected shapes / workspace (n_in %d, ws %zu)\n", n_in, ws_size); grid = -1; return; }
        int dev = 0, cus = 0, per_cu = 0;
        if (hipGetDevice(&dev) != hipSuccess || hipDeviceGetAttribute(&cus, hipDeviceAttributeMultiprocessorCount, dev) != hipSuccess) { grid = -1; return; }
        if (hipFuncSetAttribute((const void*)hy_mega, hipFuncAttributeMaxDynamicSharedMemorySize, LDS_BYTES) != hipSuccess) { fprintf(stderr, "kernel_launch: hipFuncSetAttribute failed\n"); grid = -1; return; }
        if (hipOccupancyMaxActiveBlocksPerMultiprocessor(&per_cu, (const void*)hy_mega, 512, LDS_BYTES) != hipSuccess || per_cu < 1) { fprintf(stderr, "kernel_launch: occupancy query says %d\n", per_cu); per_cu = 1; }
        (void)hipGetLastError();
        grid = cus;
    }
    if (grid < 0) return;
    (void)hipMemsetAsync(d_ws, 0, CTL_BYTES, stream);
    MegaArgs a{};
    for (int i = 0; i < 20; ++i) a.in[i] = (const float*)d_in[i];
    a.out = (float*)d_out; a.ws = (unsigned char*)d_ws;
    a.ph_lo = 0; a.ph_hi = N_PHASES;
    void* args[] = {&a};
    hipError_t e = hipLaunchCooperativeKernel((const void*)hy_mega, dim3(grid), dim3(512), args, LDS_BYTES, stream);
    if (e != hipSuccess) fprintf(stderr, "cooperative launch failed: %s (grid %d)\n", hipGetErrorString(e), grid);
}
```

```cpp
#define CVT_Q0 0
#define CVT_Q1 19000
#include <hip/hip_runtime.h>
#include <hip/hip_cooperative_groups.h>
#include <cstdio>
#include <cstdint>
namespace pg8 {
#define PG8_LAS __attribute__((address_space(3)))
typedef unsigned short bf16_t;
typedef short bf16x8 __attribute__((ext_vector_type(8)));
typedef float f32x4 __attribute__((ext_vector_type(4)));
typedef unsigned u32x4 __attribute__((ext_vector_type(4)));
constexpr int BM = 256, BK = 64, HALF = 128, HTB = HALF * BK * 2  , STAGE_BYTES = 8 * HTB, NXCD = 8, WGM = 8;

__host__ __device__ __forceinline__ int lds_byte(int r, int c) { const int st = (r >> 4) * 2 + (c >> 5), rr = r & 15, cc = c & 31, ob = rr * 64 + cc * 2; return st * 1024 + (ob ^ (((ob >> 9) & 1) << 5)); }
__host__ __device__ __forceinline__ void stage_rc(int b, int& R, int& C) { const int st = b / 1024, sb = b % 1024, swz = sb ^ (((sb >> 9) & 1) << 5); R = (st >> 1) * 16 + swz / 64; C = (st & 1) * 32 + (swz % 64) / 2; }
__host__ __device__ __forceinline__ int perm32(int rho) { const int n = rho >> 4, i = rho & 15; return 8 * (i >> 2) + 4 * n + (i & 3); }

struct Unit { int pm, pn, bt; };
struct Gemm { const bf16_t* A; const bf16_t* Bt; int M, N, K; };

struct StaticOrder {
    int nM, nN, nwg, G, c;
    __host__ __device__ void init(int M, int N, int G_, int c_) { nM = M / BM; nN = N / BM; nwg = nM * nN; G = G_; c = c_; }
    __host__ __device__ bool next(int i, Unit& u) const {
        const long L = (long)i * G + c; if (L >= nwg) return false;
        int wgid = (int)L; { const int q = nwg / NXCD, r = nwg % NXCD, xcd = wgid % NXCD, off = wgid / NXCD; wgid = (xcd < r ? xcd * (q + 1) : r * (q + 1) + (xcd - r) * q) + off; }
        const int nig = WGM * nN, gid = wgid / nig, fm = gid * WGM, gsz = (nM - fm) < WGM ? (nM - fm) : WGM;
        u.pm = fm + ((wgid % nig) % gsz); u.pn = (wgid % nig) / gsz; u.bt = u.pn; return true;
    }
    __device__ __forceinline__ void a_ready(const Unit&) const {}
    __device__ __forceinline__ void done(const Unit&) const {}
};

__device__ __forceinline__ unsigned cvt_pk_bf16(float lo, float hi) { unsigned r; asm volatile("v_cvt_pk_bf16_f32 %0, %1, %2" : "=v"(r) : "v"(lo), "v"(hi)); return r; }
typedef float f32x2 __attribute__((ext_vector_type(2)));
__device__ __forceinline__ f32x2 gelu_pk(f32x2 v) {
    const f32x2 av = __builtin_elementwise_abs(v), d = av * 0.2316418882f + 1.0f;
    f32x2 t; t.x = __builtin_amdgcn_rcpf(d.x); t.y = __builtin_amdgcn_rcpf(d.y);
    f32x2 q = t * 0.5307027145f + (-0.7265760135f); q = q * t + 0.7107068705f; q = q * t + (-0.142248368f); q = q * t + 0.127414796f; q = q * t;
    const f32x2 s = (v * v) * (-0.72134752044f);
    f32x2 e; e.x = __builtin_amdgcn_exp2f(s.x); e.y = __builtin_amdgcn_exp2f(s.y);
    const f32x2 m = v * (q * e), r = v - m;
    f32x2 o; o.x = v.x < 0.f ? m.x : r.x; o.y = v.y < 0.f ? m.y : r.y; return o;
}

template <int ACT  > struct EpiBf16 {
    static constexpr bool PERM = true, AFTER_DRAIN = false; static_assert(ACT == 0 || ACT == 1, "EpiBf16: ACT is 0 (none) or 1 (gelu_pk)");
    bf16_t* O; int ldc; const float* bias; int split_cols; size_t split_stride; float scale0;
    __device__ __forceinline__ void operator()(const f32x4 (&acc)[2][2][4][2], const Unit& u, int wr, int wc, int fr, int fq) const {
        const int row0 = u.pm * BM + wr * 64 + fr; int colt = u.pn * BM; bf16_t* base = O;
        float sc = 1.f; if (split_cols) { const int t = colt / split_cols; base += (size_t)t * split_stride; colt -= t * split_cols; if (t == 0) sc = scale0; }
        const int col0 = colt + wc * 32 + 8 * fq, bcol0 = u.pn * BM + wc * 32 + 8 * fq;
        f32x4 bv[2][2];
#pragma unroll
        for (int bj = 0; bj < 2; ++bj)
#pragma unroll
            for (int n = 0; n < 2; ++n) bv[bj][n] = bias ? *(const f32x4*)(bias + bcol0 + bj * HALF + 4 * n) : (f32x4){0.f, 0.f, 0.f, 0.f};
#pragma unroll
        for (int ai = 0; ai < 2; ++ai)
#pragma unroll
            for (int m = 0; m < 4; ++m) { bf16_t* rowp = base + (size_t)(row0 + ai * HALF + m * 16) * ldc + col0;
#pragma unroll
                for (int bj = 0; bj < 2; ++bj) { f32x4 v0 = acc[ai][bj][m][0] + bv[bj][0], v1 = acc[ai][bj][m][1] + bv[bj][1];
                    if (ACT == 1) { f32x2 a = gelu_pk((f32x2){v0[0], v0[1]}), b = gelu_pk((f32x2){v0[2], v0[3]}), c = gelu_pk((f32x2){v1[0], v1[1]}), d = gelu_pk((f32x2){v1[2], v1[3]});
                        v0 = (f32x4){a.x, a.y, b.x, b.y}; v1 = (f32x4){c.x, c.y, d.x, d.y}; }
                    v0 = v0 * sc; v1 = v1 * sc; u32x4 w; w.x = cvt_pk_bf16(v0[0], v0[1]); w.y = cvt_pk_bf16(v0[2], v0[3]); w.z = cvt_pk_bf16(v1[0], v1[1]); w.w = cvt_pk_bf16(v1[2], v1[3]);
                    *(u32x4*)(rowp + bj * HALF) = w; } }
    }
};
typedef int i32x8 __attribute__((ext_vector_type(8)));
typedef int i32x4v __attribute__((ext_vector_type(4)));
__device__ __forceinline__ f32x4 mfma_f8(bf16x8 b0, bf16x8 b1, bf16x8 a0, bf16x8 a1, f32x4 c) {
    const i32x8 bv = __builtin_shufflevector(__builtin_bit_cast(i32x4v, b0), __builtin_bit_cast(i32x4v, b1), 0, 1, 2, 3, 4, 5, 6, 7);
    const i32x8 av = __builtin_shufflevector(__builtin_bit_cast(i32x4v, a0), __builtin_bit_cast(i32x4v, a1), 0, 1, 2, 3, 4, 5, 6, 7);
    return __builtin_amdgcn_mfma_scale_f32_16x16x128_f8f6f4(bv, av, c, 0, 0, 0, 0x7f7f7f7f, 0, 0x7f7f7f7f);
}
struct Frag16 { bf16x8 k[2]; };
template <bool F8> struct FragSel { typedef Frag16 A; };
template <> struct FragSel<true> { typedef i32x8 A; };
__device__ __forceinline__ void frag_load(Frag16& d, const PG8_LAS unsigned char* p) { d.k[0] = *(const PG8_LAS bf16x8*)p; d.k[1] = *(const PG8_LAS bf16x8*)(p + 1024); }
__device__ __forceinline__ void frag_load(i32x8& d, const PG8_LAS unsigned char* p) { const i32x4v lo = *(const PG8_LAS i32x4v*)p, hi = *(const PG8_LAS i32x4v*)(p + 1024); d = __builtin_shufflevector(lo, hi, 0, 1, 2, 3, 4, 5, 6, 7); }
__device__ __forceinline__ f32x4 frag_mma(const Frag16& b, const Frag16& a, f32x4 c) { c = __builtin_amdgcn_mfma_f32_16x16x32_bf16(b.k[0], a.k[0], c, 0, 0, 0); return __builtin_amdgcn_mfma_f32_16x16x32_bf16(b.k[1], a.k[1], c, 0, 0, 0); }
__device__ __forceinline__ f32x4 frag_mma(const i32x8& b, const i32x8& a, f32x4 c) {
    const int sc = 0x7f7f7f7f;
    asm volatile("s_nop 1\n\tv_mfma_scale_f32_16x16x128_f8f6f4 %0, %1, %2, %0, %3, %3 op_sel_hi:[0,0,0]" : "+v"(c) : "v"(b), "v"(a), "v"(sc));
    return c; }
template <class Epi, class Sched, bool ALIGN_EPI = false, bool SP2 = false, bool F8 = false>
__device__ __forceinline__ void gemm_phase(PG8_LAS unsigned char* lds, const Gemm g, const Sched& S, const Epi& E) {
    const int tid = threadIdx.x, wid = __builtin_amdgcn_readfirstlane(tid >> 6), lane = tid & 63, wr = wid >> 2, wc = wid & 3, fr = lane & 15, fq = lane >> 4;
    const int K = g.K, nt = K / BK;
    unsigned voffA[2], voffB[2];
#pragma unroll
    for (int i = 0; i < 2; ++i) { int R, C; stage_rc(tid * 16 + i * 8192, R, C); const int Rb = Epi::PERM ? ((R & ~31) + perm32(R & 31)) : R;
        voffA[i] = (unsigned)(R * K + C) * 2u; voffB[i] = (unsigned)(Rb * K + C) * 2u; }
    const size_t kstep = (size_t)(BK * 2);
    const size_t hstep = (size_t)HALF * K * 2;
    const size_t tstep = 2 * hstep;
    const unsigned ldsw = (unsigned)wid * 1024u;
    const int aoff = lds_byte(wr * 64 + fr, fq * 8), boff = lds_byte(wc * 32 + fr, fq * 8);
#define PG8_SA(b, h) (((b) * 2 + (h)) * HTB)
#define PG8_SB(b, h) ((4 + (b) * 2 + (h)) * HTB)
#define PG8_STAGE(bufoff, gbase, voff) do { _Pragma("unroll") for (int _i = 0; _i < 2; ++_i) \
        __builtin_amdgcn_global_load_lds((const unsigned*)((const char*)(gbase) + (voff)[_i]), (PG8_LAS unsigned*)(lds + (bufoff) + ldsw + _i * 8192), 16, 0, 0); } while (0)
#define PG8_LDA(dst, b, h) do { _Pragma("unroll") for (int m = 0; m < 4; ++m) frag_load(dst[m], lds + PG8_SA(b, h) + aoff + m * 2048); } while (0)
#define PG8_LDB(dst, b, h) do { _Pragma("unroll") for (int n = 0; n < 2; ++n) frag_load(dst[n], lds + PG8_SB(b, h) + boff + n * 2048); } while (0)
#define PG8_MMA(ai, bj, At, Bt) do { __builtin_amdgcn_s_setprio(1); _Pragma("unroll") for (int m = 0; m < 4; ++m) _Pragma("unroll") for (int n = 0; n < 2; ++n) \
        acc[ai][bj][m][n] = frag_mma(Bt[n], At[m], acc[ai][bj][m][n]); __builtin_amdgcn_s_setprio(0); } while (0)
#define PG8_WAIT_V(n) asm volatile("s_waitcnt vmcnt(" #n ")" ::: "memory")
#define PG8_WAIT_L(n) asm volatile("s_waitcnt lgkmcnt(" #n ")" ::: "memory")
#define PG8_BAR __builtin_amdgcn_s_barrier()
#define PG8_SCHED __builtin_amdgcn_sched_barrier(0)
    Unit cur, nxt; int ui = 0;
    if (!S.next(0, cur)) return;
    f32x4 acc[2][2][4][2];
#pragma unroll
    for (int a = 0; a < 2; ++a)
#pragma unroll
        for (int b = 0; b < 2; ++b)
#pragma unroll
            for (int m = 0; m < 4; ++m)
#pragma unroll
                for (int n = 0; n < 2; ++n) acc[a][b][m][n] = (f32x4){0.f, 0.f, 0.f, 0.f};
    typename FragSel<F8>::A At[4]; typename FragSel<F8>::A B0[2], B1[2];
    const char* cA = (const char*)g.A + (size_t)cur.pm * tstep; const char* cB = (const char*)g.Bt + (size_t)cur.bt * tstep;
    S.a_ready(cur);
    if constexpr (SP2) {
        PG8_STAGE(PG8_SB(0, 0), cB, voffB); PG8_STAGE(PG8_SB(0, 1), cB + hstep, voffB); PG8_STAGE(PG8_SA(0, 0), cA, voffA); PG8_STAGE(PG8_SA(0, 1), cA + hstep, voffA);
        if (wr == 1) PG8_BAR;
        PG8_WAIT_V(2); PG8_BAR;
        PG8_STAGE(PG8_SB(1, 0), cB + kstep, voffB); PG8_STAGE(PG8_SA(1, 0), cA + kstep, voffA); PG8_STAGE(PG8_SB(1, 1), cB + hstep + kstep, voffB);
        PG8_WAIT_V(6); PG8_BAR;
    } else {
        PG8_STAGE(PG8_SB(0, 0), cB, voffB); PG8_STAGE(PG8_SA(0, 0), cA, voffA); PG8_STAGE(PG8_SB(0, 1), cB + hstep, voffB); PG8_STAGE(PG8_SA(0, 1), cA + hstep, voffA);
        if (wr == 1) PG8_BAR;
        PG8_WAIT_V(4); PG8_BAR;
        PG8_STAGE(PG8_SB(1, 0), cB + kstep, voffB); PG8_STAGE(PG8_SA(1, 0), cA + kstep, voffA); PG8_STAGE(PG8_SB(1, 1), cB + hstep + kstep, voffB);
        PG8_WAIT_V(6); PG8_BAR;
    }
    for (;;) {
        const bool has_next = S.next(ui + 1, nxt);
        const char* nA = has_next ? (const char*)g.A + (size_t)nxt.pm * tstep : cA; const char* nB = has_next ? (const char*)g.Bt + (size_t)nxt.bt * tstep : cB;
        for (int t = 0; t < nt; t += 2) {
            const bool last = (t == nt - 2);
            const char* a1 = cA + (size_t)(t + 1) * kstep;
            const char* a2 = last ? nA : cA + (size_t)(t + 2) * kstep; const char* b2 = last ? nB : cB + (size_t)(t + 2) * kstep;
            const char* a3 = a2 + kstep; const char* b3 = b2 + kstep;
            if (last && has_next) S.a_ready(nxt);
            if constexpr (SP2) {
            PG8_LDB(B0, 0, 0); PG8_LDB(B1, 0, 1); PG8_SCHED; PG8_LDA(At, 0, 0); PG8_STAGE(PG8_SA(1, 1), a1 + hstep, voffA);
            PG8_WAIT_V(8); PG8_WAIT_L(0); PG8_BAR; PG8_MMA(0, 0, At, B0); PG8_MMA(0, 1, At, B1); PG8_BAR; PG8_SCHED;
            PG8_LDA(At, 0, 1); PG8_STAGE(PG8_SB(0, 0), b2, voffB); PG8_STAGE(PG8_SB(0, 1), b2 + hstep, voffB); PG8_STAGE(PG8_SA(0, 0), a2, voffA);
            PG8_WAIT_V(8); PG8_WAIT_L(0); PG8_BAR; PG8_MMA(1, 0, At, B0); PG8_MMA(1, 1, At, B1); PG8_BAR; PG8_SCHED;
            PG8_LDB(B0, 1, 0); PG8_LDB(B1, 1, 1); PG8_SCHED; PG8_LDA(At, 1, 0); PG8_STAGE(PG8_SA(0, 1), a2 + hstep, voffA);
            PG8_WAIT_V(8); PG8_WAIT_L(0); PG8_BAR; PG8_MMA(0, 0, At, B0); PG8_MMA(0, 1, At, B1); PG8_BAR; PG8_SCHED;
            PG8_LDA(At, 1, 1); PG8_STAGE(PG8_SB(1, 0), b3, voffB); PG8_STAGE(PG8_SB(1, 1), b3 + hstep, voffB); PG8_STAGE(PG8_SA(1, 0), a3, voffA);
            PG8_WAIT_V(8); PG8_WAIT_L(0); PG8_BAR; PG8_MMA(1, 0, At, B0); PG8_MMA(1, 1, At, B1); PG8_BAR; PG8_SCHED;
            } else {
            PG8_LDB(B0, 0, 0); PG8_SCHED; PG8_LDA(At, 0, 0); PG8_STAGE(PG8_SA(1, 1), a1 + hstep, voffA);
            PG8_WAIT_L(8); PG8_BAR; PG8_WAIT_L(0); PG8_MMA(0, 0, At, B0); PG8_BAR; PG8_SCHED;
            PG8_LDB(B1, 0, 1); PG8_STAGE(PG8_SB(0, 0), b2, voffB);
            PG8_BAR; PG8_WAIT_L(0); PG8_MMA(0, 1, At, B1); PG8_BAR;
            PG8_LDA(At, 0, 1); PG8_STAGE(PG8_SA(0, 0), a2, voffA);
            PG8_BAR; PG8_WAIT_L(0); PG8_MMA(1, 0, At, B0); PG8_BAR; PG8_SCHED;
            PG8_STAGE(PG8_SB(0, 1), b2 + hstep, voffB);
            PG8_WAIT_V(6); PG8_BAR; PG8_MMA(1, 1, At, B1); PG8_BAR;
            PG8_LDB(B0, 1, 0); PG8_SCHED; PG8_LDA(At, 1, 0); PG8_STAGE(PG8_SA(0, 1), a2 + hstep, voffA);
            PG8_WAIT_L(8); PG8_BAR; PG8_WAIT_L(0); PG8_MMA(0, 0, At, B0); PG8_BAR; PG8_SCHED;
            PG8_LDB(B1, 1, 1); PG8_STAGE(PG8_SB(1, 0), b3, voffB);
            PG8_BAR; PG8_WAIT_L(0); PG8_MMA(0, 1, At, B1); PG8_BAR;
            PG8_LDA(At, 1, 1); PG8_STAGE(PG8_SA(1, 0), a3, voffA);
            PG8_BAR; PG8_WAIT_L(0); PG8_MMA(1, 0, At, B0); PG8_BAR; PG8_SCHED;
            PG8_STAGE(PG8_SB(1, 1), b3 + hstep, voffB);
            PG8_WAIT_V(6); PG8_BAR; PG8_MMA(1, 1, At, B1); PG8_BAR;
            }
        }
        if constexpr (ALIGN_EPI) { if (wr == 0) PG8_BAR; }
        if constexpr (F8) {
            asm volatile("s_nop 15\n\ts_nop 15" ::: "memory");
#pragma unroll
            for (int a = 0; a < 2; ++a)
#pragma unroll
                for (int b = 0; b < 2; ++b)
#pragma unroll
                    for (int m = 0; m < 4; ++m) asm volatile("" : "+v"(acc[a][b][m][0]), "+v"(acc[a][b][m][1]));
        }
        if constexpr (!Epi::AFTER_DRAIN) { E(acc, cur, wr, wc, fr, fq); S.done(cur); }
        if (!has_next) break;
#pragma unroll
        for (int a = 0; a < 2; ++a)
#pragma unroll
            for (int b = 0; b < 2; ++b)
#pragma unroll
                for (int m = 0; m < 4; ++m)
#pragma unroll
                    for (int n = 0; n < 2; ++n) acc[a][b][m][n] = (f32x4){0.f, 0.f, 0.f, 0.f};
        cur = nxt; cA = nA; cB = nB; ++ui;
        if constexpr (ALIGN_EPI) { if (wr == 1) PG8_BAR; }
    }
    PG8_WAIT_V(0);
    if constexpr (!ALIGN_EPI) { if (wr == 0) PG8_BAR; }
    PG8_BAR;
    if constexpr (Epi::AFTER_DRAIN) { E.fused(acc, cur, wr, wc, fr, fq, lds, wid, lane); S.done(cur); }
#undef PG8_SA
#undef PG8_SB
#undef PG8_STAGE
#undef PG8_LDA
#undef PG8_LDB
#undef PG8_MMA
#undef PG8_WAIT_V
#undef PG8_WAIT_L
#undef PG8_BAR
#undef PG8_SCHED
}
}
namespace hy {
using pg8::bf16_t; using pg8::f32x4; using pg8::u32x4; using pg8::bf16x8;
#define LAS __attribute__((address_space(3)))
constexpr int NB = 4, SEQ = 4096, DM = 1024, CTXL = 256;
constexpr int M_LAT = NB * SEQ, M_CTX = NB * CTXL, M_ALL = M_LAT + M_CTX;
constexpr int IN_COLS = 3104, NE = 16, CAP = 512, DE = 2816, NSLOT = NE * NB * CAP;
constexpr int PROJ_LD = 2304, PC_NAK = 0, PC_GK = 512, PC_NAQ = 768, PC_GQ = 1280, PC_GG = 1536, PC_AD = 2048;
constexpr int VT_LD = M_ALL;
constexpr float EPS = 1e-6f;
constexpr int TKB = SEQ + CTXL;
constexpr size_t MiB = 1u << 20;
constexpr size_t WS_MODP = 1 * MiB, WS_MOD = 3 * MiB, WS_WTIN = 4 * MiB, WS_WTV = 9 * MiB, WS_WTOUT = 11 * MiB, WS_AFF = 13 * MiB, WS_IDX = 14 * MiB, WS_GATE = 14 * MiB + 256 * 1024, WS_INV = 15 * MiB;
constexpr size_t WS_WTGU = 16 * MiB, WS_WTDN = 192 * MiB, WS_H = 280 * MiB, WS_PROJ = 314 * MiB, WS_VT = 391 * MiB, WS_OMIX = 425 * MiB, WS_MIX = 457 * MiB, WS_HID = 280 * MiB;
constexpr size_t WS_HF = 489 * MiB, WS_XS = 521 * MiB, WS_GLAT = 590 * MiB, WS_QF = 590 * MiB, WS_KF = 606 * MiB, WS_KFT = 622 * MiB, WS_AT = 639 * MiB, WS_SB = 640 * MiB, WS_UPF = 639 * MiB + 768 * 1024, WS_KH = 521 * MiB, WS_VB = 538 * MiB, WS_END = 672 * MiB;
static_assert(WS_WTIN + (size_t)PROJ_LD * DM * 2 <= WS_WTV && WS_WTGU + (size_t)NE * 2 * DE * DM * 2 <= WS_WTDN && WS_WTDN + (size_t)NE * DM * DE * 2 <= WS_H, "ws map 1");
static_assert(WS_H + (size_t)M_ALL * DM * 2 <= WS_PROJ && WS_PROJ + (size_t)M_ALL * PROJ_LD * 2 <= WS_VT && WS_VT + (size_t)1024 * VT_LD * 2 <= WS_OMIX, "ws map 2");
static_assert(WS_HID + (size_t)NSLOT * DE * 2 <= WS_MIX && WS_XS + (size_t)NSLOT * DM * 2 <= WS_GLAT && WS_SB + (size_t)2 * NB * 4 * 64 * 128 * 64 * 2 <= WS_END && WS_KFT + (size_t)2 * 256 * M_ALL * 2 <= WS_AT, "ws map 3");

__device__ __forceinline__ float bf2f(bf16_t x) { return __uint_as_float((unsigned)x << 16); }
__device__ __forceinline__ unsigned f2bf(float f) { unsigned u = __float_as_uint(f); return (u + 0x7fffu + ((u >> 16) & 1u)) >> 16; }
__device__ __forceinline__ unsigned pk2(float lo, float hi) { return f2bf(lo) | (f2bf(hi) << 16); }
__device__ __forceinline__ float wave_sum(float v) {
#pragma unroll
    for (int o = 1; o < 64; o <<= 1) v += __shfl_xor(v, o);
    return v;
}
__device__ __forceinline__ float silu_f(float x) { return x / (1.f + __expf(-x)); }

__device__ __forceinline__ void ph_mod(const float* __restrict__ c, const float* __restrict__ c_ctx, const float* __restrict__ w_mod, const float* __restrict__ b_mod, float* __restrict__ mod, LAS unsigned char* lds, int bid, int G) {
    LAS float* s = (LAS float*)lds;
    LAS float* red = s + 5 * 1024;
    const int tid = threadIdx.x;
    __syncthreads();
    for (int i = tid; i < 5 * 1024; i += 512) { const int v = i >> 10, k = i & 1023; const float x = v < 4 ? c[v * 1024 + k] : c_ctx[k]; s[i] = x / (1.f + expf(-x)); }
    __syncthreads();
    for (int cg = bid; cg < 256; cg += G) {
        const int ks = tid / 24, cj = tid % 24, j = cg * 24 + cj;
        if (tid < 504) {
            float acc[5] = {0.f, 0.f, 0.f, 0.f, 0.f};
            const int k0 = ks * 49, k1 = min(k0 + 49, 1024);
#pragma unroll 7
            for (int k = k0; k < k1; ++k) { const float w = w_mod[(size_t)k * 6144 + j];
#pragma unroll
                for (int v = 0; v < 5; ++v) acc[v] += s[v * 1024 + k] * w; }
#pragma unroll
            for (int v = 0; v < 5; ++v) red[(v * 21 + ks) * 24 + cj] = acc[v];
        }
        __syncthreads();
        if (tid < 120) { const int v = tid / 24, cc = tid % 24; float a = b_mod[cg * 24 + cc];
            for (int q = 0; q < 21; ++q) a += red[(v * 21 + q) * 24 + cc];
            mod[(size_t)v * 6144 + cg * 24 + cc] = a; }
        __syncthreads();
    }
}

__device__ __forceinline__ void transpose_item(const float* __restrict__ W, int N, int k0, int n0, bf16_t* dst, int K, float scale, LAS float* scr, int lane) {
    float wv[32];
#pragma unroll
    for (int i = 0; i < 32; ++i) wv[i] = W[(size_t)(k0 + 2 * i + (lane >> 5)) * N + n0 + (lane & 31)];
#pragma unroll
    for (int i = 0; i < 32; ++i) scr[(2 * i + (lane >> 5)) * 33 + (lane & 31)] = wv[i];
    asm volatile("s_waitcnt lgkmcnt(0)" ::: "memory");
    const int c = lane & 7;
#pragma unroll
    for (int j = 0; j < 4; ++j) { const int n = (lane >> 3) + 8 * j; const LAS float* s = scr + (8 * c) * 33 + n;
        u32x4 o; o.x = pk2(s[0 * 33] * scale, s[1 * 33] * scale); o.y = pk2(s[2 * 33] * scale, s[3 * 33] * scale); o.z = pk2(s[4 * 33] * scale, s[5 * 33] * scale); o.w = pk2(s[6 * 33] * scale, s[7 * 33] * scale);
        *(u32x4*)(dst + (size_t)n * K + k0 + 8 * c) = o; }
    asm volatile("s_waitcnt lgkmcnt(0)" ::: "memory");
}
constexpr float SX8 = 16.f, SW1 = 64.f, SH8 = 8.f, SW2 = 128.f;
__device__ __forceinline__ float clamp448(float v) { return fminf(fmaxf(v, -448.f), 448.f); }
__device__ __forceinline__ unsigned pk4_fp8(float a, float b, float c, float d) {
    int w = 0; w = __builtin_amdgcn_cvt_pk_fp8_f32(clamp448(a), clamp448(b), w, false); w = __builtin_amdgcn_cvt_pk_fp8_f32(clamp448(c), clamp448(d), w, true); return (unsigned)w; }
__device__ __forceinline__ void transpose_item_f8(const float* __restrict__ W, int N, int k0, int n0, unsigned char* dst, int Kb, float scale, LAS float* scr, int lane) {
    float wv[32];
#pragma unroll
    for (int i = 0; i < 32; ++i) wv[i] = W[(size_t)(k0 + 2 * i + (lane >> 5)) * N + n0 + (lane & 31)];
#pragma unroll
    for (int i = 0; i < 32; ++i) scr[(2 * i + (lane >> 5)) * 33 + (lane & 31)] = wv[i];
    asm volatile("s_waitcnt lgkmcnt(0)" ::: "memory");
    const int c = lane & 3;
#pragma unroll
    for (int j = 0; j < 2; ++j) { const int n = (lane >> 2) + 16 * j; const LAS float* s = scr + (16 * c) * 33 + n;
        u32x4 o; o.x = pk4_fp8(s[0 * 33] * scale, s[1 * 33] * scale, s[2 * 33] * scale, s[3 * 33] * scale); o.y = pk4_fp8(s[4 * 33] * scale, s[5 * 33] * scale, s[6 * 33] * scale, s[7 * 33] * scale);
        o.z = pk4_fp8(s[8 * 33] * scale, s[9 * 33] * scale, s[10 * 33] * scale, s[11 * 33] * scale); o.w = pk4_fp8(s[12 * 33] * scale, s[13 * 33] * scale, s[14 * 33] * scale, s[15 * 33] * scale);
        *(u32x4*)(dst + (size_t)n * Kb + k0 + 16 * c) = o; }
    asm volatile("s_waitcnt lgkmcnt(0)" ::: "memory");
}
struct PrepArgs { const float *x, *ctx, *g_pre, *mod, *w_in, *w_out, *w_gate, *w_up, *w_down; bf16_t *WTIN, *WTV, *WTOUT; unsigned char *WTGU, *WTDN; bf16_t* H; };
constexpr int IT_IN = 16 * 97, IT_OUT = 16 * 32, IT_GU1 = 16 * 16 * 88, IT_DN = 16 * 44 * 32, IT_ALL = IT_IN + IT_OUT + 2 * IT_GU1 + IT_DN;
struct CvtItem { const float* W; unsigned char* dst; int N, Kb; float scale; };
constexpr int IT16 = IT_IN + IT_OUT;
constexpr int IT8_GU1 = 16 * 8 * 88, IT8_DN = 16 * 22 * 32, IT8 = 2 * IT8_GU1 + IT8_DN;
#ifndef CVT_Q0
#define CVT_Q0 0
#endif
#ifndef CVT_Q1
#define CVT_Q1 23000
#endif
__device__ __forceinline__ CvtItem cvt_decode16(const PrepArgs& a, int it) {
    CvtItem c; int r = it;
    if (r < IT_IN) { const int kb = r / 97, n0 = (r % 97) * 32; bf16_t* dst; float sc = 1.f;
        if (n0 < 512) dst = a.WTIN + (size_t)(PC_NAK + n0) * DM;
        else if (n0 < 1024) dst = a.WTV + (size_t)(n0 - 512) * DM;
        else if (n0 < 1280) dst = a.WTIN + (size_t)(PC_GK + n0 - 1024) * DM;
        else if (n0 < 1792) dst = a.WTV + (size_t)(512 + n0 - 1280) * DM;
        else if (n0 < 1824) dst = a.WTIN + (size_t)(PC_AD + n0 - 1792) * DM;
        else if (n0 < 2336) { dst = a.WTIN + (size_t)(PC_NAQ + n0 - 1824) * DM; sc = 0.125f; }
        else if (n0 < 2592) { dst = a.WTIN + (size_t)(PC_GQ + n0 - 2336) * DM; sc = 0.125f; }
        else dst = a.WTIN + (size_t)(PC_GG + n0 - 2592) * DM;
        c.W = a.w_in + (size_t)(kb * 64) * IN_COLS + n0; c.N = IN_COLS; c.dst = (unsigned char*)(dst + kb * 64); c.Kb = DM * 2; c.scale = sc; return c; }
    r -= IT_IN;
    { const int kb = r / 32, n0 = (r % 32) * 32; c.W = a.w_out + (size_t)(kb * 64) * DM + n0; c.N = DM; c.dst = (unsigned char*)(a.WTOUT + (size_t)n0 * DM + kb * 64); c.Kb = DM * 2; c.scale = 1.f; return c; }
}
__device__ __forceinline__ CvtItem cvt_decode8(const PrepArgs& a, int it) {
    CvtItem c; int r = it;
    if (r < 2 * IT8_GU1) { const int which = r / IT8_GU1; r %= IT8_GU1; const int e = r / (8 * 88); r %= (8 * 88); const int kb = r / 88, n0 = (r % 88) * 32;
        c.W = (which ? a.w_up : a.w_gate) + (size_t)e * DM * DE + (size_t)(kb * 128) * DE + n0; c.N = DE;
        c.dst = a.WTGU + ((size_t)e * 2 * DE + (n0 / 128) * 256 + (n0 % 128) + which * 128) * DM + kb * 128; c.Kb = DM; c.scale = SW1; return c; }
    r -= 2 * IT8_GU1;
    { const int e = r / (22 * 32); r %= (22 * 32); const int kb = r / 32, n0 = (r % 32) * 32;
      c.W = a.w_down + (size_t)e * DE * DM + (size_t)(kb * 128) * DM + n0; c.N = DM; c.dst = a.WTDN + ((size_t)e * DM + n0) * DE + kb * 128; c.Kb = DE; c.scale = SW2; return c; }
}
__device__ __forceinline__ void cvt_load(const CvtItem& c, int half, float (&wv)[32], int lane) {
    const float* W = c.W + (size_t)(64 * half) * c.N;
#pragma unroll
    for (int i = 0; i < 32; ++i) wv[i] = __builtin_nontemporal_load(&W[(size_t)(2 * i + (lane >> 5)) * c.N + (lane & 31)]);
}
template <bool F8> __device__ __forceinline__ void cvt_store(const CvtItem& c, int half, const float (&wv)[32], LAS float* scr, int lane) {
#pragma unroll
    for (int i = 0; i < 32; ++i) scr[(2 * i + (lane >> 5)) * 33 + (lane & 31)] = wv[i];
    asm volatile("s_waitcnt lgkmcnt(0)" ::: "memory");
    const float scale = c.scale;
    if constexpr (F8) {
        const int cc = lane & 3; unsigned char* dst = c.dst + 64 * half;
#pragma unroll
        for (int j = 0; j < 2; ++j) { const int n = (lane >> 2) + 16 * j; const LAS float* s = scr + (16 * cc) * 33 + n;
            u32x4 o; o.x = pk4_fp8(s[0 * 33] * scale, s[1 * 33] * scale, s[2 * 33] * scale, s[3 * 33] * scale); o.y = pk4_fp8(s[4 * 33] * scale, s[5 * 33] * scale, s[6 * 33] * scale, s[7 * 33] * scale);
            o.z = pk4_fp8(s[8 * 33] * scale, s[9 * 33] * scale, s[10 * 33] * scale, s[11 * 33] * scale); o.w = pk4_fp8(s[12 * 33] * scale, s[13 * 33] * scale, s[14 * 33] * scale, s[15 * 33] * scale);
            *(u32x4*)(dst + (size_t)n * c.Kb + 16 * cc) = o; }
    } else {
        const int cc = lane & 7;
#pragma unroll
        for (int j = 0; j < 4; ++j) { const int n = (lane >> 3) + 8 * j; const LAS float* s = scr + (8 * cc) * 33 + n;
            u32x4 o; o.x = pk2(s[0 * 33] * scale, s[1 * 33] * scale); o.y = pk2(s[2 * 33] * scale, s[3 * 33] * scale); o.z = pk2(s[4 * 33] * scale, s[5 * 33] * scale); o.w = pk2(s[6 * 33] * scale, s[7 * 33] * scale);
            *(u32x4*)(c.dst + (size_t)n * c.Kb + 16 * cc) = o; }
    }
    asm volatile("s_waitcnt lgkmcnt(0)" ::: "memory");
}
template <bool F8> __device__ __forceinline__ void cvt_run(const PrepArgs& a, int it_lo, int it_hi, int wv0, int nwv, LAS float* scr, int lane) {
    int it = it_lo + wv0; if (it >= it_hi) return;
    float wa[32], wb[32];
    if constexpr (F8) {
        CvtItem c = cvt_decode8(a, it); cvt_load(c, 0, wa, lane);
        for (;;) {
            cvt_load(c, 1, wb, lane);
            cvt_store<true>(c, 0, wa, scr, lane);
            const int itn = it + nwv; const bool hn = itn < it_hi;
            const CvtItem cn = cvt_decode8(a, hn ? itn : it); cvt_load(cn, 0, wa, lane);
            cvt_store<true>(c, 1, wb, scr, lane);
            if (!hn) break;
            c = cn; it = itn;
        }
    } else {
        CvtItem ca = cvt_decode16(a, it), cb;  cvt_load(ca, 0, wa, lane);
        for (;;) {
            int itn = it + nwv; bool hn = itn < it_hi;
            cb = cvt_decode16(a, hn ? itn : it); cvt_load(cb, 0, wb, lane);
            cvt_store<false>(ca, 0, wa, scr, lane);
            if (!hn) break;
            it = itn; itn = it + nwv; hn = itn < it_hi;
            ca = cvt_decode16(a, hn ? itn : it); cvt_load(ca, 0, wa, lane);
            cvt_store<false>(cb, 0, wb, scr, lane);
            if (!hn) break;
            it = itn;
        }
    }
}
__device__ __forceinline__ void ph_convert(const PrepArgs& a, LAS unsigned char* lds, int bid, int G) {
    const int tid = threadIdx.x, lane = tid & 63, wave = tid >> 6;
    LAS float* scr = (LAS float*)(lds + wave * 8448);
    { u32x4* z = (u32x4*)(a.WTIN + (size_t)(PC_AD + 32) * DM); const int nz = (PROJ_LD - PC_AD - 32) * DM * 2 / 16;
      for (int i = bid * 512 + tid; i < nz; i += G * 512) z[i] = (u32x4){0u, 0u, 0u, 0u}; }
    cvt_run<false>(a, 0, IT16, bid * 8 + wave, G * 8, scr, lane);
    cvt_run<true>(a, 0, CVT_Q0, bid * 8 + wave, G * 8, scr, lane);
}
__device__ __forceinline__ void ph_convert_bg(const PrepArgs& a, int lo, int hi, int pid, int npid, LAS unsigned char* lds) {
    const int lane = threadIdx.x & 63, wave = threadIdx.x >> 6;
    if (pid < 0) return;
    cvt_run<true>(a, lo, hi, pid, npid, (LAS float*)(lds + 32768 + wave * 8448), lane);
}
__device__ __forceinline__ void ph_modulate(const PrepArgs& a, int bid, int G) {
    const int tid = threadIdx.x, lane = tid & 63, wave = tid >> 6;
    const int gw = bid * 8 + wave, NGW = G * 8;
    for (int m = gw; m < M_ALL; m += NGW) {
        const float* src; int v;
        if (m < M_LAT) { src = a.x + (size_t)m * DM; v = m / SEQ; } else { src = a.ctx + (size_t)(m - M_LAT) * DM; v = 4; }
        const f32x4* xr = (const f32x4*)src + lane; f32x4 xv[4]; float ss = 0.f;
#pragma unroll
        for (int j = 0; j < 4; ++j) { xv[j] = xr[64 * j]; ss += (xv[j].x * xv[j].x + xv[j].y * xv[j].y) + (xv[j].z * xv[j].z + xv[j].w * xv[j].w); }
        const float rstd = rsqrtf(wave_sum(ss) * (1.f / DM) + EPS);
        const float* mv = a.mod + (size_t)v * 6144;
        unsigned long long* o8 = (unsigned long long*)(a.H + (size_t)m * DM) + lane;
#pragma unroll
        for (int j = 0; j < 4; ++j) { const int col = 4 * lane + 256 * j;
            const f32x4 g = *(const f32x4*)(a.g_pre + col), sh = *(const f32x4*)(mv + col), sc = *(const f32x4*)(mv + 1024 + col);
            const f32x4 hv = xv[j] * rstd * g * (sc + 1.f) + sh;
            o8[64 * j] = (unsigned long long)pk2(hv.x, hv.y) | ((unsigned long long)pk2(hv.z, hv.w) << 32); }
    }
}


__device__ __forceinline__ void tok_of_row(int row, int& bb, int& tk) { if (row < M_LAT) { bb = row >> 12; tk = row & (SEQ - 1); } else { const int r2 = row - M_LAT; bb = r2 >> 8; tk = SEQ + (r2 & (CTXL - 1)); } }
struct EpiProj {
    static constexpr bool PERM = true, AFTER_DRAIN = false;
    bf16_t* O; int ldc; bf16_t* KH;
    __device__ __forceinline__ void operator()(const f32x4 (&acc)[2][2][4][2], const pg8::Unit& u, int wr, int wc, int fr, int fq) const {
        const int row0 = u.pm * 256 + wr * 64 + fr, col0 = u.pn * 256 + wc * 32 + 8 * fq;
#pragma unroll
        for (int ai = 0; ai < 2; ++ai)
#pragma unroll
            for (int m = 0; m < 4; ++m) { const int row = row0 + ai * 128 + m * 16; int bb, tk; tok_of_row(row, bb, tk);
#pragma unroll
                for (int bj = 0; bj < 2; ++bj) { const f32x4 v0 = acc[ai][bj][m][0], v1 = acc[ai][bj][m][1];
                    u32x4 w; w.x = pg8::cvt_pk_bf16(v0[0], v0[1]); w.y = pg8::cvt_pk_bf16(v0[2], v0[3]); w.z = pg8::cvt_pk_bf16(v1[0], v1[1]); w.w = pg8::cvt_pk_bf16(v1[2], v1[3]);
                    const int col = col0 + bj * 128;
                    if (u.pn < 2) { const int hh = col >> 6, ks = (col >> 5) & 1; *(u32x4*)(KH + ((size_t)((bb * 8 + hh) * 2 + ks) * TKB + tk) * 32 + (col & 31)) = w; }
                    else *(u32x4*)(O + (size_t)row * ldc + col) = w; } }
    }
};
struct EpiVal {
    static constexpr bool PERM = true, AFTER_DRAIN = false;
    bf16_t* VT; int ldc; bf16_t* VB;
    __device__ __forceinline__ void operator()(const f32x4 (&acc)[2][2][4][2], const pg8::Unit& u, int wr, int wc, int fr, int fq) const {
        const int row0 = u.pm * 256 + wr * 64 + fr, col0 = u.pn * 256 + wc * 32 + 8 * fq;
#pragma unroll
        for (int ai = 0; ai < 2; ++ai)
#pragma unroll
            for (int m = 0; m < 4; ++m) { const int vr = row0 + ai * 128 + m * 16;
#pragma unroll
                for (int bj = 0; bj < 2; ++bj) { const f32x4 v0 = acc[ai][bj][m][0], v1 = acc[ai][bj][m][1];
                    u32x4 w; w.x = pg8::cvt_pk_bf16(v0[0], v0[1]); w.y = pg8::cvt_pk_bf16(v0[2], v0[3]); w.z = pg8::cvt_pk_bf16(v1[0], v1[1]); w.w = pg8::cvt_pk_bf16(v1[2], v1[3]);
                    const int col = col0 + bj * 128;
                    if (u.pm < 2) { int bb, tk; tok_of_row(col, bb, tk); const int hh = vr >> 6, dt = (vr >> 4) & 3, dd = vr & 15;
                        *(u32x4*)(VB + ((size_t)(((bb * 8 + hh) * 4 + dt) * (TKB / 8) + (tk >> 3)) * 16 + dd) * 8) = w; }
                    else *(u32x4*)(VT + (size_t)vr * ldc + col) = w; } }
    }
};
struct EpiSwiGLU {
    static constexpr bool PERM = true, AFTER_DRAIN = false;
    unsigned char* O; int ldc;
    __device__ __forceinline__ void operator()(const f32x4 (&acc)[2][2][4][2], const pg8::Unit& u, int wr, int wc, int fr, int fq) const {
        const int row0 = u.pm * 256 + wr * 64 + fr, col0 = u.pn * 128 + wc * 32 + 8 * fq;
        constexpr float DS = 1.f / (SX8 * SW1);
#pragma unroll
        for (int ai = 0; ai < 2; ++ai)
#pragma unroll
            for (int m = 0; m < 4; ++m) { unsigned char* rowp = O + (size_t)(row0 + ai * 128 + m * 16) * ldc + col0;
                const f32x4 g0 = acc[ai][0][m][0] * DS, g1 = acc[ai][0][m][1] * DS, u0 = acc[ai][1][m][0] * (DS * SH8), u1 = acc[ai][1][m][1] * (DS * SH8);
                uint2 w; w.x = pk4_fp8(silu_f(g0[0]) * u0[0], silu_f(g0[1]) * u0[1], silu_f(g0[2]) * u0[2], silu_f(g0[3]) * u0[3]);
                w.y = pk4_fp8(silu_f(g1[0]) * u1[0], silu_f(g1[1]) * u1[1], silu_f(g1[2]) * u1[2], silu_f(g1[3]) * u1[3]);
                *(uint2*)rowp = w; }
    }
};
struct EpiRowScale {
    static constexpr bool PERM = true, AFTER_DRAIN = false;
    bf16_t* O; int ldc; const float* rowscale;
    __device__ __forceinline__ void operator()(const f32x4 (&acc)[2][2][4][2], const pg8::Unit& u, int wr, int wc, int fr, int fq) const {
        const int row0 = u.pm * 256 + wr * 64 + fr, col0 = u.pn * 256 + wc * 32 + 8 * fq;
#pragma unroll
        for (int ai = 0; ai < 2; ++ai)
#pragma unroll
            for (int m = 0; m < 4; ++m) { const int row = row0 + ai * 128 + m * 16; const float sc = rowscale[row] * (1.f / (SH8 * SW2)); bf16_t* rowp = O + (size_t)row * ldc + col0;
#pragma unroll
                for (int bj = 0; bj < 2; ++bj) { const f32x4 v0 = acc[ai][bj][m][0] * sc, v1 = acc[ai][bj][m][1] * sc;
                    u32x4 w; w.x = pg8::cvt_pk_bf16(v0[0], v0[1]); w.y = pg8::cvt_pk_bf16(v0[2], v0[3]); w.z = pg8::cvt_pk_bf16(v1[0], v1[1]); w.w = pg8::cvt_pk_bf16(v1[2], v1[3]);
                    *(u32x4*)(rowp + bj * 128) = w; } }
    }
};
struct ExpertOrder {
    int nT, G, c;
    __device__ __forceinline__ bool next(int i, pg8::Unit& u) const {
        if (G == 256) { const int x = c & 7, j = c >> 3, mt = j & 7, q = j >> 3;
            int e, pn;
            if (nT == 4) { if (i >= 2) return false; e = 2 * x + i; pn = q; }
            else { if (i >= 11) return false;
                if (i < 5) { e = 2 * x; pn = 4 * i + q; } else if (i == 5) { e = 2 * x + (q >> 1); pn = 20 + (q & 1); } else { e = 2 * x + 1; pn = 4 * (i - 6) + q; } }
            u.pm = e * 8 + mt; u.pn = pn; u.bt = e * nT + pn; return true; }
        const long L = (long)i * G + c; if (L >= (long)128 * nT) return false;
        const int e = (int)(L / (8 * nT)), r = (int)(L % (8 * nT)); u.pm = e * 8 + (r % 8); u.pn = r / 8; u.bt = e * nT + u.pn; return true;
    }
    __device__ __forceinline__ void a_ready(const pg8::Unit&) const {}
    __device__ __forceinline__ void done(const pg8::Unit&) const {}
};
__device__ __forceinline__ void ph_na_naive(const bf16_t* __restrict__ PROJ, const bf16_t* __restrict__ VT, const float* __restrict__ rpb, bf16_t* __restrict__ OMIX, int bid, int G) {
  for (int vb = bid * 8 + (threadIdx.x >> 6); vb < NB * 8 * 64; vb += G * 8) {
    const int r = vb % 64, h = (vb / 64) % 8, b = vb / 512, c = threadIdx.x & 63;
    const size_t mq = (size_t)b * SEQ + r * 64 + c;
    float q[64], acc[64];
    { const u32x4* qp = (const u32x4*)(PROJ + mq * PROJ_LD + PC_NAQ + h * 64);
#pragma unroll
      for (int i = 0; i < 8; ++i) { const u32x4 w = qp[i]; q[8 * i + 0] = __uint_as_float(w.x << 16); q[8 * i + 1] = __uint_as_float(w.x & 0xffff0000u); q[8 * i + 2] = __uint_as_float(w.y << 16); q[8 * i + 3] = __uint_as_float(w.y & 0xffff0000u);
          q[8 * i + 4] = __uint_as_float(w.z << 16); q[8 * i + 5] = __uint_as_float(w.z & 0xffff0000u); q[8 * i + 6] = __uint_as_float(w.w << 16); q[8 * i + 7] = __uint_as_float(w.w & 0xffff0000u); } }
#pragma unroll
    for (int d = 0; d < 64; ++d) acc[d] = 0.f;
    float mx = -INFINITY, l = 0.f;
    const int rs = min(max(r - 4, 0), 56), cs = min(max(c - 8, 0), 48);
    for (int kk = 0; kk < 128 + CTXL; ++kk) {
        size_t mk; float bias = 0.f;
        if (kk < 128) { const int krow = rs + (kk >> 4), kcol = cs + (kk & 15); mk = (size_t)b * SEQ + krow * 64 + kcol; bias = rpb[(h * 15 + (krow - r + 7)) * 31 + (kcol - c + 15)]; }
        else mk = (size_t)M_LAT + b * CTXL + (kk - 128);
        const u32x4* kp = (const u32x4*)(PROJ + mk * PROJ_LD + PC_NAK + h * 64);
        float s = 0.f;
#pragma unroll
        for (int i = 0; i < 8; ++i) { const u32x4 w = kp[i];
            s += q[8 * i + 0] * __uint_as_float(w.x << 16) + q[8 * i + 1] * __uint_as_float(w.x & 0xffff0000u) + q[8 * i + 2] * __uint_as_float(w.y << 16) + q[8 * i + 3] * __uint_as_float(w.y & 0xffff0000u)
               + q[8 * i + 4] * __uint_as_float(w.z << 16) + q[8 * i + 5] * __uint_as_float(w.z & 0xffff0000u) + q[8 * i + 6] * __uint_as_float(w.w << 16) + q[8 * i + 7] * __uint_as_float(w.w & 0xffff0000u); }
        s += bias;
        const float mn = fmaxf(mx, s), al = __expf(mx - mn), p = __expf(s - mn);
        l = l * al + p; mx = mn;
        const bf16_t* vp = VT + (size_t)(h * 64) * VT_LD + mk;
#pragma unroll
        for (int d = 0; d < 64; ++d) acc[d] = acc[d] * al + p * bf2f(vp[(size_t)d * VT_LD]);
    }
    const float inv = 1.f / l;
    unsigned* op = (unsigned*)(OMIX + mq * DM + h * 64);
#pragma unroll
    for (int i = 0; i < 32; ++i) op[i] = pk2(acc[2 * i] * inv, acc[2 * i + 1] * inv);
  }
}

__device__ __forceinline__ f32x4 mfma16(bf16x8 a, bf16x8 b, f32x4 c) { return __builtin_amdgcn_mfma_f32_16x16x32_bf16(a, b, c, 0, 0, 0); }
__device__ __forceinline__ void na_unit(int u, const bf16_t* __restrict__ PROJ, const bf16_t* __restrict__ KH, const bf16_t* __restrict__ VB, const LAS float* rb, const LAS unsigned char* ck, const LAS unsigned char* cv, bf16_t* __restrict__ OMIX, int lane) {
    const int q = lane & 15, g = lane >> 4;
    const int bh = u >> 8, b = bh >> 3, h = bh & 7, r = (u & 255) >> 2, qt = u & 3;
    const int c0 = (qt == 0) ? 0 : (qt == 3 ? 32 : 16 * qt - 8);
    const int rs = min(max(r - 4, 0), 56);
    const int cq = 16 * qt + q, cs = min(max(cq - 8, 0), 48);
    const size_t mq = (size_t)b * SEQ + r * 64 + cq;
    const bf16_t* qp = PROJ + mq * PROJ_LD + PC_NAQ + h * 64 + 8 * g;
    const bf16x8 qf0 = *(const bf16x8*)qp, qf1 = *(const bf16x8*)(qp + 32);
    const bf16_t* kb0 = KH + ((size_t)(bh * 2) * TKB + 8 * (q >> 2) + (q & 3)) * 32 + 8 * g;
    const bf16_t* kb1 = kb0 + (size_t)TKB * 32;
    f32x4 S[32];
#pragma unroll
    for (int p = 0; p < 8; ++p) {
        const int s = (rs + p) * 64 + c0;
#pragma unroll
        for (int half = 0; half < 2; ++half) {
            const size_t off = (size_t)(s + 4 * half) * 32;
            f32x4 acc = (f32x4){0.f, 0.f, 0.f, 0.f};
            acc = mfma16(*(const bf16x8*)(kb0 + off), qf0, acc); acc = mfma16(*(const bf16x8*)(kb1 + off), qf1, acc);
            const LAS float* rbr = rb + (h * 15 + (rs + p - r + 7)) * 31;
#pragma unroll
            for (int i = 0; i < 4; ++i) { const int kcol = c0 + 8 * g + 4 * half + i; const bool valid = (kcol >= cs) && (kcol < cs + 16);
                const float bias = rbr[min(max(kcol - cq + 15, 0), 30)];
                acc[i] = valid ? acc[i] + bias : -INFINITY; }
            S[2 * p + half] = acc;
        }
    }
#pragma unroll
    for (int p = 0; p < 8; ++p)
#pragma unroll
        for (int half = 0; half < 2; ++half) { const LAS unsigned char* kp = ck + ((p * 2 + half) * 2) * 1024 + lane * 16;
            f32x4 acc = (f32x4){0.f, 0.f, 0.f, 0.f};
            acc = mfma16(*(const LAS bf16x8*)kp, qf0, acc); acc = mfma16(*(const LAS bf16x8*)(kp + 1024), qf1, acc);
            S[16 + 2 * p + half] = acc; }
    float mx4[4] = {-INFINITY, -INFINITY, -INFINITY, -INFINITY};
#pragma unroll
    for (int T = 0; T < 32; ++T) mx4[T & 3] = fmaxf(fmaxf(mx4[T & 3], fmaxf(S[T][0], S[T][1])), fmaxf(S[T][2], S[T][3]));
    float mx = fmaxf(fmaxf(mx4[0], mx4[1]), fmaxf(mx4[2], mx4[3]));
    mx = fmaxf(mx, __shfl_xor(mx, 16)); mx = fmaxf(mx, __shfl_xor(mx, 32));
    float l4[4] = {0.f, 0.f, 0.f, 0.f};
#pragma unroll
    for (int T = 0; T < 32; ++T) {
#pragma unroll
        for (int i = 0; i < 4; ++i) { const float p = __expf(S[T][i] - mx); S[T][i] = p; l4[i] += p; } }
    float l = (l4[0] + l4[1]) + (l4[2] + l4[3]);
    l += __shfl_xor(l, 16); l += __shfl_xor(l, 32);
    f32x4 O[4];
#pragma unroll
    for (int dt = 0; dt < 4; ++dt) O[dt] = (f32x4){0.f, 0.f, 0.f, 0.f};
    const bf16_t* vb0 = VB + ((size_t)(bh * 4) * (TKB / 8) * 16 + (size_t)g * 16 + q) * 8;
#pragma unroll
    for (int p = 0; p < 16; ++p) {
        u32x4 pw; pw.x = pg8::cvt_pk_bf16(S[2 * p][0], S[2 * p][1]); pw.y = pg8::cvt_pk_bf16(S[2 * p][2], S[2 * p][3]); pw.z = pg8::cvt_pk_bf16(S[2 * p + 1][0], S[2 * p + 1][1]); pw.w = pg8::cvt_pk_bf16(S[2 * p + 1][2], S[2 * p + 1][3]);
        const bf16x8 pb = __builtin_bit_cast(bf16x8, pw);
        if (p < 8) { const int s = (rs + p) * 64 + c0;
#pragma unroll
            for (int dt = 0; dt < 4; ++dt) O[dt] = mfma16(*(const bf16x8*)(vb0 + ((size_t)dt * (TKB / 8) + (s >> 3)) * 128), pb, O[dt]);
        } else {
#pragma unroll
            for (int dt = 0; dt < 4; ++dt) O[dt] = mfma16(*(const LAS bf16x8*)(cv + ((p - 8) * 4 + dt) * 1024 + lane * 16), pb, O[dt]);
        }
    }
    const float inv = 1.f / l;
    bf16_t* op = OMIX + mq * DM + h * 64 + 4 * g;
#pragma unroll
    for (int dt = 0; dt < 4; ++dt) { uint2 w; w.x = pg8::cvt_pk_bf16(O[dt][0] * inv, O[dt][1] * inv); w.y = pg8::cvt_pk_bf16(O[dt][2] * inv, O[dt][3] * inv); *(uint2*)(op + dt * 16) = w; }
}
__device__ __forceinline__ void ph_na(const bf16_t* __restrict__ PROJ, const bf16_t* __restrict__ KH, const bf16_t* __restrict__ VB, const float* __restrict__ rpb, bf16_t* __restrict__ OMIX, LAS unsigned char* lds, int bid, int G) {
    LAS float* rb = (LAS float*)lds;
    LAS unsigned char* ck = lds + 16384; LAS unsigned char* cv = lds + 49152;
    const int lane = threadIdx.x & 63, wave = threadIdx.x >> 6;
    __syncthreads();
    for (int i = threadIdx.x; i < 8 * 15 * 31; i += 512) rb[i] = rpb[i];
    for (int u0 = bid * 32; u0 < NB * 8 * 64 * 4; u0 += G * 32) {
        const int bh = u0 >> 8;
        __syncthreads();
        for (int i = threadIdx.x; i < 2048; i += 512) { const int ln = i & 63, ks = (i >> 6) & 1, half = (i >> 7) & 1, p = i >> 8, q = ln & 15, g = ln >> 4;
            *(LAS u32x4*)(ck + i * 16) = *(const u32x4*)(KH + ((size_t)(bh * 2 + ks) * TKB + SEQ + 32 * p + 8 * (q >> 2) + (q & 3) + 4 * half) * 32 + 8 * g); }
        for (int i = threadIdx.x; i < 2048; i += 512) { const int ln = i & 63, dt = (i >> 6) & 3, p = i >> 8;
            *(LAS u32x4*)(cv + i * 16) = *(const u32x4*)(VB + ((size_t)((bh * 4 + dt) * (TKB / 8) + SEQ / 8 + 4 * p) * 16) * 8 + ln * 8); }
        __syncthreads();
#pragma unroll 1
        for (int it = 0; it < 4; ++it) na_unit(u0 + it * 8 + wave, PROJ, KH, VB, rb, ck, cv, OMIX, lane);
    }
}

typedef float f32x16 __attribute__((ext_vector_type(16)));
__device__ __forceinline__ f32x16 mfma32(bf16x8 a, bf16x8 b, f32x16 c) { return __builtin_amdgcn_mfma_f32_32x32x16_bf16(a, b, c, 0, 0, 0); }
constexpr int NCHUNK = 272;
__device__ __forceinline__ float logsig16(float z) { return (fminf(z, 0.f) - log1pf(__expf(-fabsf(z)))) * (1.f / 16.f); }
__device__ __forceinline__ void ph_upf(const float* __restrict__ a_up, bf16_t* __restrict__ UPF, int bid, int G) {
    for (int e = bid * 512 + threadIdx.x; e < 1024; e += G * 512) { const int dir = e >> 9, h = (e >> 7) & 3, dd = (e >> 6) & 1, ln = e & 63, d5 = ln & 31, h2 = ln >> 5;
        float v[8];
#pragma unroll
        for (int j = 0; j < 8; ++j) v[j] = a_up[(size_t)(dir * 16 + 8 * h2 + j) * 256 + h * 64 + 32 * dd + d5];
        *(u32x4*)(UPF + (size_t)e * 8) = (u32x4){pk2(v[0], v[1]), pk2(v[2], v[3]), pk2(v[4], v[5]), pk2(v[6], v[7])}; }
}
__device__ __forceinline__ float scan32(float v) {
    v += __int_as_float(__builtin_amdgcn_update_dpp(0, __float_as_int(v), 0x111, 0xf, 0xf, true));
    v += __int_as_float(__builtin_amdgcn_update_dpp(0, __float_as_int(v), 0x112, 0xf, 0xf, true));
    v += __int_as_float(__builtin_amdgcn_update_dpp(0, __float_as_int(v), 0x114, 0xf, 0xf, true));
    v += __int_as_float(__builtin_amdgcn_update_dpp(0, __float_as_int(v), 0x118, 0xf, 0xf, true));
    v += __int_as_float(__builtin_amdgcn_update_dpp(0, __float_as_int(v), 0x142, 0xa, 0xf, false));
    return v;
}
__device__ __forceinline__ void gla_prep_unit(int uu, const bf16_t* __restrict__ PROJ, const bf16_t* __restrict__ UPF, const float* __restrict__ a_bias, bf16_t* __restrict__ QF, bf16_t* __restrict__ KF, bf16_t* __restrict__ KFT, float* __restrict__ AT,
                                              const LAS float* tab, const LAS float* lbias, const LAS unsigned char* lupf, LAS unsigned char* tile, int lane) {
    const int h = uu & 3, ci = uu >> 2;
    const bool lat = ci < 256;
    const int crow = ci & 63;
    const int m0 = lat ? ((ci >> 6) * SEQ + crow * 64) : (M_LAT + (ci - 256) * 64);
    const int l31 = lane & 31, hh = lane >> 5;
    constexpr int TS2 = 144;
    bf16x8 adf[2][2];
#pragma unroll
    for (int dir = 0; dir < 2; ++dir)
#pragma unroll
        for (int tt = 0; tt < 2; ++tt) adf[dir][tt] = *(const bf16x8*)(PROJ + (unsigned)((m0 + 32 * tt + l31) * PROJ_LD + PC_AD + dir * 16 + 8 * hh));
#pragma unroll 1
    for (int dd = 0; dd < 2; ++dd) {
        const int dbase = h * 64 + 32 * dd + 4 * hh;
        float kv[2][16], qv[2][16];
#pragma unroll
        for (int tt = 0; tt < 2; ++tt)
#pragma unroll
            for (int rr = 0; rr < 4; ++rr) { const unsigned ro = (unsigned)((m0 + 32 * tt + l31) * PROJ_LD + dbase + 8 * rr);
                const uint2 kw = *(const uint2*)(PROJ + ro + PC_GK);
                kv[tt][4 * rr] = __uint_as_float(kw.x << 16); kv[tt][4 * rr + 1] = __uint_as_float(kw.x & 0xffff0000u); kv[tt][4 * rr + 2] = __uint_as_float(kw.y << 16); kv[tt][4 * rr + 3] = __uint_as_float(kw.y & 0xffff0000u);
                if (lat) { const uint2 qw = *(const uint2*)(PROJ + ro + PC_GQ);
                    qv[tt][4 * rr] = __uint_as_float(qw.x << 16); qv[tt][4 * rr + 1] = __uint_as_float(qw.x & 0xffff0000u); qv[tt][4 * rr + 2] = __uint_as_float(qw.y << 16); qv[tt][4 * rr + 3] = __uint_as_float(qw.y & 0xffff0000u); }
                else { qv[tt][4 * rr] = 0.f; qv[tt][4 * rr + 1] = 0.f; qv[tt][4 * rr + 2] = 0.f; qv[tt][4 * rr + 3] = 0.f; } }
        if (lat) {
#pragma unroll
            for (int tt = 0; tt < 2; ++tt) { const int pos = dd ? (32 * tt + l31) : crow;
#pragma unroll
                for (int r2 = 0; r2 < 2; ++r2) {
                    const LAS float* tp = tab + 2 * (pos * 16 + 8 * r2 + 4 * hh);
                    const f32x4 c01 = *(const LAS f32x4*)tp, c23 = *(const LAS f32x4*)(tp + 4);
                    const float cs[4] = {c01[0], c01[2], c23[0], c23[2]}, sn[4] = {c01[1], c01[3], c23[1], c23[3]};
#pragma unroll
                    for (int k = 0; k < 4; ++k) { const int lo = 4 * r2 + k, hi = lo + 8;
                        const float k1 = kv[tt][lo], k2 = kv[tt][hi], q1 = qv[tt][lo], q2 = qv[tt][hi];
                        kv[tt][lo] = k1 * cs[k] - k2 * sn[k]; kv[tt][hi] = k1 * sn[k] + k2 * cs[k];
                        qv[tt][lo] = q1 * cs[k] - q2 * sn[k]; qv[tt][hi] = q1 * sn[k] + q2 * cs[k]; } } }
        }
#pragma unroll
        for (int dir = 0; dir < 2; ++dir) {
            const bf16x8 upf = *(const LAS bf16x8*)(lupf + (((dir * 4 + h) * 2 + dd) * 64 + lane) * 16);
            float lam[2][16], la1[16];
            float tot0[16];
            f32x4 zb[4];
#pragma unroll
            for (int rr = 0; rr < 4; ++rr) zb[rr] = *(const LAS f32x4*)(lbias + dir * 256 + dbase + 8 * rr);
#pragma unroll
            for (int tt = 0; tt < 2; ++tt) { f32x16 Z;
#pragma unroll
                for (int i = 0; i < 16; ++i) Z[i] = 0.f;
                Z = mfma32(upf, adf[dir][tt], Z);
                float la[16], p[16];
#pragma unroll
                for (int i = 0; i < 16; ++i) { const float z = Z[i] + zb[i >> 2][i & 3]; la[i] = (fminf(z, 0.f) - __logf(1.f + __expf(-fabsf(z)))) * (1.f / 16.f); p[i] = la[i]; }
#pragma unroll
                for (int i = 0; i < 16; ++i) p[i] += __int_as_float(__builtin_amdgcn_update_dpp(0, __float_as_int(p[i]), 0x111, 0xf, 0xf, true));
#pragma unroll
                for (int i = 0; i < 16; ++i) p[i] += __int_as_float(__builtin_amdgcn_update_dpp(0, __float_as_int(p[i]), 0x112, 0xf, 0xf, true));
#pragma unroll
                for (int i = 0; i < 16; ++i) p[i] += __int_as_float(__builtin_amdgcn_update_dpp(0, __float_as_int(p[i]), 0x114, 0xf, 0xf, true));
#pragma unroll
                for (int i = 0; i < 16; ++i) p[i] += __int_as_float(__builtin_amdgcn_update_dpp(0, __float_as_int(p[i]), 0x118, 0xf, 0xf, true));
#pragma unroll
                for (int i = 0; i < 16; ++i) p[i] += __int_as_float(__builtin_amdgcn_update_dpp(0, __float_as_int(p[i]), 0x142, 0xa, 0xf, false));
#pragma unroll
                for (int i = 0; i < 16; ++i) {
                    if (tt == 1) p[i] += tot0[i];
                    const float t31 = __int_as_float(__builtin_amdgcn_readlane(__float_as_int(p[i]), 31)), t63 = __int_as_float(__builtin_amdgcn_readlane(__float_as_int(p[i]), 63));
                    const float tl = hh ? t63 : t31;
                    if (tt == 0) { la1[i] = la[i]; lam[0][i] = p[i]; tot0[i] = tl; }
                    else { tot0[i] = tl; lam[1][i] = dir ? (tl - p[i] + la[i]) : p[i]; }
                }
                if (tt == 1 && dir) {
#pragma unroll
                    for (int i = 0; i < 16; ++i) lam[0][i] = tot0[i] - lam[0][i] + la1[i];
                }
            }
            if (l31 == 0) {
#pragma unroll
                for (int rr = 0; rr < 4; ++rr) *(f32x4*)(AT + (unsigned)((dir * NCHUNK + ci) * 256 + dbase + 8 * rr)) = (f32x4){__expf(tot0[4 * rr]), __expf(tot0[4 * rr + 1]), __expf(tot0[4 * rr + 2]), __expf(tot0[4 * rr + 3])};
            }
#pragma unroll
            for (int tt = 0; tt < 2; ++tt) { const int t = 32 * tt + l31;
#pragma unroll
                for (int rr = 0; rr < 4; ++rr) { unsigned kb[4], qb[4];
#pragma unroll
                    for (int k = 0; k < 4; ++k) { const int i = 4 * rr + k; const float el = __expf(lam[tt][i]);
                        kb[k] = f2bf(kv[tt][i] * __expf(-lam[tt][i])); qb[k] = f2bf(qv[tt][i] * el);
                        *(LAS bf16_t*)(tile + (8 * rr + 4 * hh + k) * TS2 + t * 2) = (bf16_t)kb[k]; }
                    if (lat) { const unsigned mo = (unsigned)((dir * M_LAT + m0 + t) * 256 + dbase + 8 * rr);
                        *(uint2*)(QF + mo) = make_uint2(qb[0] | (qb[1] << 16), qb[2] | (qb[3] << 16)); *(uint2*)(KF + mo) = make_uint2(kb[0] | (kb[1] << 16), kb[2] | (kb[3] << 16)); } } }
            asm volatile("s_waitcnt lgkmcnt(0)" ::: "memory");
#pragma unroll
            for (int j = 0; j < 4; ++j) { const int ch = lane + 64 * j, dl = ch >> 3, c8 = ch & 7;
                *(u32x4*)(KFT + (unsigned)((dir * 256 + h * 64 + 32 * dd + dl) * M_ALL + m0 + 8 * c8)) = *(const LAS u32x4*)(tile + dl * TS2 + c8 * 16); }
            asm volatile("s_waitcnt lgkmcnt(0)" ::: "memory");
        }
    }
}
__device__ __forceinline__ void ph_gla_prep2(const bf16_t* __restrict__ PROJ, const bf16_t* __restrict__ UPF, const float* __restrict__ a_bias, bf16_t* __restrict__ QF, bf16_t* __restrict__ KF, bf16_t* __restrict__ KFT, float* __restrict__ AT,
                                             LAS unsigned char* lds, int bid, int G) {
    LAS float* tab = (LAS float*)(lds + 16384);
    LAS float* lbias = (LAS float*)(lds + 24576);
    LAS unsigned char* lupf = lds + 26624;
    __syncthreads();
    lbias[threadIdx.x] = a_bias[threadIdx.x];
    for (int i = threadIdx.x; i < 1024; i += 512) *(LAS u32x4*)(lupf + i * 16) = *(const u32x4*)(UPF + (size_t)i * 8);
    for (int i = threadIdx.x; i < 1024; i += 512) { const int pos = i >> 4, fi = i & 15; const float ang = (float)pos * powf(10000.f, -(float)fi / 16.f); tab[2 * i] = cosf(ang); tab[2 * i + 1] = sinf(ang); }
    __syncthreads();
    const int lane = threadIdx.x & 63, wave = threadIdx.x >> 6;
#ifndef REP_GP
#define REP_GP 1
#endif
    for (int rep_ = 0; rep_ < REP_GP; ++rep_)
    for (int u = bid * 8 + wave; u < NCHUNK * 4; u += G * 8) gla_prep_unit(__builtin_amdgcn_readfirstlane(u), PROJ, UPF, a_bias, QF, KF, KFT, AT, tab, lbias, lupf, lds + 49152 + wave * 4608, lane);
}
constexpr size_t SB_CH = 128 * 64;
__device__ __forceinline__ void gla_state_unit(int u, const bf16_t* __restrict__ KFT, const bf16_t* __restrict__ VT, const float* __restrict__ AT, bf16_t* __restrict__ SB, int lane) {
    const int es = u & 3, dir = (u >> 2) & 1, h = (u >> 3) & 3, b = u >> 5;
    const int l31 = lane & 31, hh = lane >> 5;
    f32x16 acc[2];
#pragma unroll
    for (int dt = 0; dt < 2; ++dt)
#pragma unroll
        for (int i = 0; i < 16; ++i) acc[dt][i] = 0.f;
    const bf16_t* kft0 = KFT + ((size_t)dir * 256 + h * 64 + l31) * M_ALL + 8 * hh;
    const bf16_t* vt0 = VT + (size_t)(512 + h * 128 + es * 32 + l31) * VT_LD + 8 * hh;
    bf16_t* sb0 = SB + ((size_t)((dir * NB + b) * 4 + h) * 64) * SB_CH + (size_t)(es * 32 + l31) * 64 + 4 * hh;
    for (int s = 0; s < 68; ++s) {
        int ci, m0, c = 0;
        if (s < 4) { const int cc = dir ? 3 - s : s; ci = 256 + b * 4 + cc; m0 = M_LAT + b * CTXL + cc * 64; }
        else { c = dir ? 67 - s : s - 4; ci = b * 64 + c; m0 = b * SEQ + c * 64; }
        bf16x8 af[2][4], bfr[4]; f32x4 av[2][4];
#pragma unroll
        for (int ks = 0; ks < 4; ++ks) { bfr[ks] = *(const bf16x8*)(vt0 + m0 + 16 * ks);
#pragma unroll
            for (int dt = 0; dt < 2; ++dt) af[dt][ks] = *(const bf16x8*)(kft0 + (size_t)dt * 32 * M_ALL + m0 + 16 * ks); }
#pragma unroll
        for (int dt = 0; dt < 2; ++dt)
#pragma unroll
            for (int rr = 0; rr < 4; ++rr) av[dt][rr] = *(const f32x4*)(AT + ((size_t)dir * NCHUNK + ci) * 256 + h * 64 + dt * 32 + 8 * rr + 4 * hh);
        if (s >= 4) {
            bf16_t* sp = sb0 + (size_t)c * SB_CH;
#pragma unroll
            for (int dt = 0; dt < 2; ++dt)
#pragma unroll
                for (int rr = 0; rr < 4; ++rr) { uint2 w; w.x = pg8::cvt_pk_bf16(acc[dt][4 * rr], acc[dt][4 * rr + 1]); w.y = pg8::cvt_pk_bf16(acc[dt][4 * rr + 2], acc[dt][4 * rr + 3]); *(uint2*)(sp + dt * 32 + 8 * rr) = w; }
        }
#pragma unroll
        for (int dt = 0; dt < 2; ++dt) {
#pragma unroll
            for (int ks = 0; ks < 4; ++ks) acc[dt] = mfma32(af[dt][ks], bfr[ks], acc[dt]);
#pragma unroll
            for (int rr = 0; rr < 4; ++rr) { acc[dt][4 * rr] *= av[dt][rr][0]; acc[dt][4 * rr + 1] *= av[dt][rr][1]; acc[dt][4 * rr + 2] *= av[dt][rr][2]; acc[dt][4 * rr + 3] *= av[dt][rr][3]; }
        }
    }
}
__device__ __forceinline__ void gla_out_unit(int u, const bf16_t* __restrict__ PROJ, const bf16_t* __restrict__ QF, const bf16_t* __restrict__ KF, const bf16_t* __restrict__ VT, const bf16_t* __restrict__ SB, const float* __restrict__ gnorm,
                                             bf16_t* __restrict__ OMIX, LAS unsigned char* tile, int lane) {
    const int it = u & 1, c = (u >> 1) & 63, h = (u >> 7) & 3, b = u >> 9;
    const int l31 = lane & 31, hh = lane >> 5;
    const int m0 = b * SEQ + c * 64;
    f32x16 o[4];
#pragma unroll
    for (int et = 0; et < 4; ++et)
#pragma unroll
        for (int i = 0; i < 16; ++i) o[et][i] = 0.f;
#pragma unroll
    for (int dir = 0; dir < 2; ++dir) {
        bf16x8 qf[4];
        const bf16_t* qp = QF + ((size_t)dir * M_LAT + m0 + 32 * it + l31) * 256 + h * 64 + 8 * hh;
#pragma unroll
        for (int ks = 0; ks < 4; ++ks) qf[ks] = *(const bf16x8*)(qp + 16 * ks);
#pragma unroll
        for (int jt = 0; jt < 2; ++jt) {
            const bool need = dir ? (jt >= it) : (jt <= it);
            if (!need) continue;
            f32x16 X;
#pragma unroll
            for (int i = 0; i < 16; ++i) X[i] = 0.f;
            const bf16_t* kp = KF + ((size_t)dir * M_LAT + m0 + 32 * jt + l31) * 256 + h * 64 + 8 * hh;
#pragma unroll
            for (int ks = 0; ks < 4; ++ks) X = mfma32(*(const bf16x8*)(kp + 16 * ks), qf[ks], X);
            if (jt == it) {
#pragma unroll
                for (int i = 0; i < 16; ++i) { const int jr = (i & 3) + 8 * (i >> 2) + 4 * hh; const bool keep = dir ? (jr >= l31) : (jr <= l31); X[i] = keep ? X[i] : 0.f; }
            }
#pragma unroll
            for (int s = 0; s < 2; ++s) {
                u32x4 xw; xw.x = pg8::cvt_pk_bf16(X[8 * s], X[8 * s + 1]); xw.y = pg8::cvt_pk_bf16(X[8 * s + 2], X[8 * s + 3]); xw.z = pg8::cvt_pk_bf16(X[8 * s + 4], X[8 * s + 5]); xw.w = pg8::cvt_pk_bf16(X[8 * s + 6], X[8 * s + 7]);
                const bf16x8 xa = __builtin_bit_cast(bf16x8, xw);
#pragma unroll
                for (int et = 0; et < 4; ++et) {
                    const bf16_t* vp = VT + (size_t)(512 + h * 128 + et * 32 + l31) * VT_LD + m0 + 32 * jt + 16 * s + 4 * hh;
                    const uint2 lo = *(const uint2*)vp, hi = *(const uint2*)(vp + 8);
                    const u32x4 vw = (u32x4){lo.x, lo.y, hi.x, hi.y};
                    o[et] = mfma32(xa, __builtin_bit_cast(bf16x8, vw), o[et]); }
            }
        }
        const bf16_t* sp = SB + ((size_t)(((dir * NB + b) * 4 + h) * 64 + c)) * SB_CH + (size_t)l31 * 64 + 8 * hh;
#pragma unroll
        for (int et = 0; et < 4; ++et)
#pragma unroll
            for (int ks = 0; ks < 4; ++ks) o[et] = mfma32(qf[ks], *(const bf16x8*)(sp + (size_t)et * 32 * 64 + 16 * ks), o[et]);
    }
    float ss[16];
#pragma unroll
    for (int i = 0; i < 16; ++i) { float a = 0.f;
#pragma unroll
        for (int et = 0; et < 4; ++et) a += o[et][i] * o[et][i];
        a += __shfl_xor(a, 1); a += __shfl_xor(a, 2); a += __shfl_xor(a, 4); a += __shfl_xor(a, 8); a += __shfl_xor(a, 16);
        ss[i] = rsqrtf(a * (1.f / 128.f) + EPS); }
    constexpr int TS = 272;
    const size_t mrow0 = (size_t)(m0 + 32 * it);
#pragma unroll
    for (int j = 0; j < 8; ++j) { const int ch = lane + 64 * j, t = ch >> 4, c16 = ch & 15;
        *(LAS u32x4*)(tile + t * TS + c16 * 16) = *(const u32x4*)(PROJ + (mrow0 + t) * PROJ_LD + PC_GG + h * 128 + c16 * 8); }
    asm volatile("s_waitcnt vmcnt(0) lgkmcnt(0)" ::: "memory");
#pragma unroll
    for (int et = 0; et < 4; ++et) { const float gn = gnorm[et * 32 + l31];
#pragma unroll
        for (int i = 0; i < 16; ++i) { const int t = (i & 3) + 8 * (i >> 2) + 4 * hh;
            LAS bf16_t* p = (LAS bf16_t*)(tile + t * TS) + et * 32 + l31;
            const float g = bf2f(*p);
            *p = (bf16_t)f2bf(o[et][i] * ss[i] * gn * silu_f(g)); } }
    asm volatile("s_waitcnt lgkmcnt(0)" ::: "memory");
#pragma unroll
    for (int j = 0; j < 8; ++j) { const int ch = lane + 64 * j, t = ch >> 4, c16 = ch & 15;
        *(u32x4*)(OMIX + (mrow0 + t) * DM + 512 + h * 128 + c16 * 8) = *(const LAS u32x4*)(tile + t * TS + c16 * 16); }
    asm volatile("s_waitcnt lgkmcnt(0)" ::: "memory");
}
__device__ __forceinline__ void ph_gla_state(const bf16_t* KFT, const bf16_t* VT, const float* AT, bf16_t* SB, int bid, int G) {
    const int lane = threadIdx.x & 63, wave = threadIdx.x >> 6;
    for (int u = wave * G + bid; u < NB * 4 * 2 * 4; u += 8 * G) gla_state_unit(u, KFT, VT, AT, SB, lane);
}
__device__ __forceinline__ void ph_gla_out(const bf16_t* PROJ, const bf16_t* QF, const bf16_t* KF, const bf16_t* VT, const bf16_t* SB, const float* gnorm, bf16_t* OMIX, LAS unsigned char* lds, int bid, int G) {
    const int lane = threadIdx.x & 63, wave = threadIdx.x >> 6;
    for (int u = bid * 8 + wave; u < NB * 4 * 64 * 2; u += G * 8) gla_out_unit(u, PROJ, QF, KF, VT, SB, gnorm, OMIX, lds + wave * (32 * 272), lane);
}

__device__ __forceinline__ void ph_post_mix(const float* __restrict__ x, const bf16_t* __restrict__ MIX, const float* __restrict__ mod, const float* __restrict__ g_post, const float* __restrict__ g_fpre, const float* __restrict__ router,
                                                  float* __restrict__ xnew, unsigned char* __restrict__ HF, float* __restrict__ aff, LAS unsigned char* lds, int bid, int G) {
    LAS float* rt = (LAS float*)lds;
    __syncthreads();
    for (int i = threadIdx.x; i < DM * NE; i += 512) rt[(i % NE) * DM + (i / NE)] = router[i];
    __syncthreads();
    const int lane = threadIdx.x & 63, wave = threadIdx.x >> 6;
    for (int m = bid * 8 + wave; m < M_LAT; m += G * 8) {
        const int b = m / SEQ, t = m % SEQ; const float* mv = mod + (size_t)b * 6144;
        f32x4 mx[4]; float ss = 0.f;
        const unsigned long long* mp = (const unsigned long long*)(MIX + (size_t)m * DM) + lane;
#pragma unroll
        for (int j = 0; j < 4; ++j) { const unsigned long long w = mp[64 * j]; const unsigned lo = (unsigned)w, hi = (unsigned)(w >> 32);
            mx[j] = (f32x4){__uint_as_float(lo << 16), __uint_as_float(lo & 0xffff0000u), __uint_as_float(hi << 16), __uint_as_float(hi & 0xffff0000u)};
            ss += (mx[j].x * mx[j].x + mx[j].y * mx[j].y) + (mx[j].z * mx[j].z + mx[j].w * mx[j].w); }
        const float rstd = rsqrtf(wave_sum(ss) * (1.f / DM) + EPS);
        f32x4 xn[4]; float s2 = 0.f;
#pragma unroll
        for (int j = 0; j < 4; ++j) { const int col = 4 * lane + 256 * j;
            const f32x4 xv = *(const f32x4*)(x + (size_t)m * DM + col), gp = *(const f32x4*)(g_post + col), gm = *(const f32x4*)(mv + 2048 + col);
            xn[j] = xv + gm * (mx[j] * rstd * gp);
            *(f32x4*)(xnew + (size_t)m * DM + col) = xn[j];
            s2 += (xn[j].x * xn[j].x + xn[j].y * xn[j].y) + (xn[j].z * xn[j].z + xn[j].w * xn[j].w); }
        const float rstd2 = rsqrtf(wave_sum(s2) * (1.f / DM) + EPS);
        f32x4 hv4[4];
        unsigned* hp = (unsigned*)(HF + (size_t)m * DM) + lane;
#pragma unroll
        for (int j = 0; j < 4; ++j) { const int col = 4 * lane + 256 * j;
            const f32x4 gf = *(const f32x4*)(g_fpre + col), sh = *(const f32x4*)(mv + 3072 + col), sc = *(const f32x4*)(mv + 4096 + col);
            hv4[j] = xn[j] * rstd2 * gf * (sc + 1.f) + sh;
            hp[64 * j] = pk4_fp8(hv4[j].x * SX8, hv4[j].y * SX8, hv4[j].z * SX8, hv4[j].w * SX8); }
        float lg[NE]; float mxl = -INFINITY;
#pragma unroll
        for (int e = 0; e < NE; ++e) { float sacc = 0.f;
#pragma unroll
            for (int j = 0; j < 4; ++j) { const f32x4 rv = *(const LAS f32x4*)(rt + e * DM + 4 * lane + 256 * j); sacc += (hv4[j].x * rv.x + hv4[j].y * rv.y) + (hv4[j].z * rv.z + hv4[j].w * rv.w); }
            lg[e] = wave_sum(sacc); mxl = fmaxf(mxl, lg[e]); asm volatile("" ::: "memory"); }
        float den = 0.f;
#pragma unroll
        for (int e = 0; e < NE; ++e) { lg[e] = expf(lg[e] - mxl); den += lg[e]; }
        const float rden = 1.f / den;
#pragma unroll
        for (int e = 0; e < NE; ++e) if (lane == e) aff[((size_t)b * NE + e) * SEQ + t] = lg[e] * rden;
    }
}

__device__ __forceinline__ int block_excl_scan(int v, LAS int* sm  , int& total) {
    const int lane = threadIdx.x & 63, w = threadIdx.x >> 6; int x = v;
#pragma unroll
    for (int o = 1; o < 64; o <<= 1) { const int y = __shfl_up(x, o); if (lane >= o) x += y; }
    __syncthreads();
    if (lane == 63) sm[w] = x;
    __syncthreads();
    int base = 0, tot = 0;
#pragma unroll
    for (int i = 0; i < 8; ++i) { const int s = sm[i]; if (i < w) base += s; tot += s; }
    total = tot;
    return base + x - v;
}
__device__ __forceinline__ void ph_topk(const float* __restrict__ aff, const unsigned char* __restrict__ HF, int* __restrict__ idx, float* __restrict__ gate, int* __restrict__ inv, unsigned char* __restrict__ XS, LAS unsigned char* lds, int bid, int G) {
  LAS int* hist = (LAS int*)lds; LAS int* sm = hist + 256; LAS unsigned* sp = (LAS unsigned*)(sm + 16); LAS int* srm = (LAS int*)(sp + 1); LAS int* s_list = srm + 1;
#define s_prefix (*sp)
#define s_remain (*srm)
  for (int be = bid; be < NB * NE; be += G) {
    const int b = be / NE, e = be % NE, tid = threadIdx.x;
    __syncthreads();
    const float* av = aff + ((size_t)b * NE + e) * SEQ;
    unsigned key[8];
#pragma unroll
    for (int j = 0; j < 8; ++j) key[j] = __float_as_uint(av[tid * 8 + j]);
    if (tid == 0) { s_prefix = 0u; s_remain = CAP; }
    for (int pass = 3; pass >= 0; --pass) {
        if (tid < 256) hist[tid] = 0;
        __syncthreads();
        const unsigned prefix = s_prefix; const int shift = pass * 8; const unsigned himask = pass == 3 ? 0u : (0xffffffffu << (shift + 8));
#pragma unroll
        for (int j = 0; j < 8; ++j) if ((key[j] & himask) == prefix) atomicAdd((int*)(hist + ((key[j] >> shift) & 255u)), 1);
        __syncthreads();
        {
            const int rem = s_remain; const int lane_ = tid & 63, w_ = tid >> 6;
            int hcnt = 0, suf = 0;
            if (tid < 256) { hcnt = hist[tid]; suf = hcnt;
#pragma unroll
                for (int o = 1; o < 64; o <<= 1) { const int y = __shfl_down(suf, o); if (lane_ + o < 64) suf += y; }
                if (lane_ == 0) sm[8 + w_] = suf; }
            __syncthreads();
            if (tid < 256) { int above = suf - hcnt; for (int w2 = w_ + 1; w2 < 4; ++w2) above += sm[8 + w2];
                if (hcnt > 0 && above < rem && rem <= above + hcnt) { s_remain = rem - above; s_prefix = prefix | ((unsigned)tid << shift); } }
            __syncthreads();
        }
    }
    const unsigned T = s_prefix; const int remain = s_remain;
    int neq = 0;
#pragma unroll
    for (int j = 0; j < 8; ++j) neq += (key[j] == T);
    int tot; int eqbase = block_excl_scan(neq, sm, tot);
    int flags = 0, nsel = 0;
#pragma unroll
    for (int j = 0; j < 8; ++j) { bool sel = key[j] > T; if (key[j] == T) { sel = eqbase < remain; ++eqbase; } if (sel) { flags |= 1 << j; ++nsel; } }
    int slot = block_excl_scan(nsel, sm, tot);
    const int rowbase = (e * NB + b) * CAP;
#pragma unroll
    for (int j = 0; j < 8; ++j) { const int t = tid * 8 + j; int sl = -1;
        if (flags & (1 << j)) { sl = slot++; idx[rowbase + sl] = t; gate[rowbase + sl] = __uint_as_float(key[j]); s_list[sl] = t; }
        inv[((size_t)b * SEQ + t) * NE + e] = sl; }
    __syncthreads();
    const int lane = tid & 63, wave = tid >> 6;
    for (int s = wave; s < CAP; s += 8) { const u32x4* src = (const u32x4*)(HF + ((size_t)b * SEQ + s_list[s]) * DM); u32x4* dst = (u32x4*)(XS + (size_t)(rowbase + s) * DM);
        dst[lane] = src[lane]; }
  }
#undef s_prefix
#undef s_remain
}

__device__ __forceinline__ void ph_combine(const bf16_t* __restrict__ Y, const int* __restrict__ inv, const float* __restrict__ mod, const float* __restrict__ g_fpost, float* __restrict__ out, int bid, int G) {
    const int lane = threadIdx.x & 63, wave = threadIdx.x >> 6;
    for (int m = bid * 8 + wave; m < M_LAT; m += G * 8) {
        const int b = m / SEQ; const float* mv = mod + (size_t)b * 6144;
        const int sl = (lane < NE) ? inv[(size_t)m * NE + lane] : -1;
        unsigned mask = (unsigned)__ballot(sl >= 0);
        f32x4 xn[4];
#pragma unroll
        for (int j = 0; j < 4; ++j) xn[j] = *(const f32x4*)(out + (size_t)m * DM + 4 * lane + 256 * j);
        f32x4 y[4];
#pragma unroll
        for (int j = 0; j < 4; ++j) y[j] = (f32x4){0.f, 0.f, 0.f, 0.f};
        while (mask) {
            const unsigned long long* yp[4]; float w[4];
#pragma unroll
            for (int k = 0; k < 4; ++k) { const unsigned mm = mask ? mask : 1u; const int e = __builtin_ctz(mm); w[k] = mask ? 1.f : 0.f; mask &= mask - 1u;
                const int s = __builtin_amdgcn_readlane(sl, e); const int s2 = s < 0 ? 0 : s;
                yp[k] = (const unsigned long long*)(Y + (size_t)((e * NB + b) * CAP + s2) * DM) + lane; }
            unsigned long long v[4][4];
#pragma unroll
            for (int k = 0; k < 4; ++k)
#pragma unroll
                for (int j = 0; j < 4; ++j) v[k][j] = yp[k][64 * j];
#pragma unroll
            for (int k = 0; k < 4; ++k)
#pragma unroll
                for (int j = 0; j < 4; ++j) { const unsigned lo = (unsigned)v[k][j], hi = (unsigned)(v[k][j] >> 32);
                    y[j] += (f32x4){__uint_as_float(lo << 16), __uint_as_float(lo & 0xffff0000u), __uint_as_float(hi << 16), __uint_as_float(hi & 0xffff0000u)} * w[k]; }
        }
        float ss = 0.f;
#pragma unroll
        for (int j = 0; j < 4; ++j) ss += (y[j].x * y[j].x + y[j].y * y[j].y) + (y[j].z * y[j].z + y[j].w * y[j].w);
        const float rstd = rsqrtf(wave_sum(ss) * (1.f / DM) + EPS);
#pragma unroll
        for (int j = 0; j < 4; ++j) { const int col = 4 * lane + 256 * j; float* op = out + (size_t)m * DM + col;
            const f32x4 gp = *(const f32x4*)(g_fpost + col), gf = *(const f32x4*)(mv + 5120 + col);
            *(f32x4*)op = xn[j] + gf * (y[j] * rstd * gp); }
    }
}

#define GAS __attribute__((address_space(1)))
#define XB_TMO      128
#define XB_XCNT(j)  (256  + 64 * (j))
#define XB_XSUB(j)  (1280 + 64 * (j))
#define XB_XGEN(j)  (2304 + 64 * (j))
#define XB_TOP      3328
#define XB_TOPGEN   3392
#define XCD_BAR_WORDS 3456
#define XB_SPIN_CAP (1u << 18)

__device__ __forceinline__ unsigned xb_ld(unsigned* p)              { return __hip_atomic_load(p, __ATOMIC_RELAXED, __HIP_MEMORY_SCOPE_AGENT); }
__device__ __forceinline__ unsigned xb_add(unsigned* p, unsigned v) { return __hip_atomic_fetch_add(p, v, __ATOMIC_RELAXED, __HIP_MEMORY_SCOPE_AGENT); }
__device__ __forceinline__ unsigned xb_xcc_id() { return (unsigned)__builtin_amdgcn_s_getreg((3 << 11) | 20) & 0xFu; }
#define XB_SPIN(cond, bar) do { unsigned _sp = 0; while (cond) { __builtin_amdgcn_s_sleep(1); \
    if ((++_sp & 255u) == 0u) { if (xb_ld(&(bar)[XB_TMO])) break; if (_sp > XB_SPIN_CAP) { atomicAdd(&(bar)[XB_TMO], 1u); break; } } } } while (0)

struct XcdBarrier {
    unsigned* bar; unsigned x;
    volatile LAS unsigned* st;
};

__device__ __forceinline__ XcdBarrier xcd_barrier_post(unsigned* bar, volatile LAS unsigned* st) {
    XcdBarrier b; b.bar = bar; b.x = xb_xcc_id(); b.st = st;
    if (threadIdx.x == 0) (void)xb_add(&bar[XB_XCNT(b.x)], 1u);
    return b;
}
__device__ __forceinline__ void xcd_barrier_complete(unsigned* bar, unsigned x, unsigned& nloc, unsigned& nx) {
    const unsigned G = gridDim.x * gridDim.y * gridDim.z;
    unsigned sum, cnt, mine, sp = 0u;
    for (;;) {
        sum = 0u; cnt = 0u; mine = 0u;
#pragma unroll
        for (unsigned j = 0; j < 16; ++j) { const unsigned c = xb_ld(&bar[XB_XCNT(j)]); sum += c; cnt += (c > 0u) ? 1u : 0u; mine = (j == x) ? c : mine; }
        if (sum == G) break;
        __builtin_amdgcn_s_sleep(1);
        if ((++sp & 255u) == 0u) { if (xb_ld(&bar[XB_TMO])) break; if (sp > XB_SPIN_CAP) { atomicAdd(&bar[XB_TMO], 1u); break; } }
    }
    nloc = mine > 0u ? mine : 1u; nx = cnt > 0u ? cnt : 1u;
}

__device__ __forceinline__ void xcd_barrier(const XcdBarrier& b) {
    asm volatile("s_waitcnt vmcnt(0)" ::: "memory");
    __syncthreads();
    if (threadIdx.x == 0) {
        unsigned* bar = b.bar;
        __builtin_amdgcn_s_waitcnt(0);
        unsigned nloc = b.st[0], nx = b.st[1];
        if (nloc == 0u) { xcd_barrier_complete(bar, b.x, nloc, nx); b.st[0] = nloc; b.st[1] = nx; }
        const unsigned old = xb_add(&bar[XB_XSUB(b.x)], 1u);
        const unsigned gen = old / nloc;
        if (old + 1u == (gen + 1u) * nloc) {
            __builtin_amdgcn_fence(__ATOMIC_RELEASE, "agent");
            asm volatile("s_waitcnt vmcnt(0)" ::: "memory");
            const unsigned og = xb_add(&bar[XB_TOP], 1u);
            const unsigned tg = og / nx;
            if (og + 1u == (tg + 1u) * nx) xb_add(&bar[XB_TOPGEN], 1u);
            else XB_SPIN(xb_ld(&bar[XB_TOPGEN]) == tg, bar);
            __builtin_amdgcn_fence(__ATOMIC_ACQUIRE, "agent");
            xb_add(&bar[XB_XGEN(b.x)], 1u);
            asm volatile("s_waitcnt vmcnt(0)" ::: "memory");
        } else {
            XB_SPIN(xb_ld(&bar[XB_XGEN(b.x)]) == gen, bar);
            __builtin_amdgcn_fence(__ATOMIC_ACQUIRE, "agent");
            asm volatile("s_waitcnt vmcnt(0)" ::: "memory");
        }
    }
    __syncthreads();
}


namespace cg = cooperative_groups;
constexpr int LDS_BYTES = 147456;
constexpr int N_PHASES = 12;
constexpr size_t CTL_BYTES = 65536;
#ifndef REP_PH
#define REP_PH -1
#endif
#ifndef REP_SYNC
#define REP_SYNC 0
#endif
struct MegaArgs { const float* in[20]; float* out; unsigned char* ws; int ph_lo, ph_hi; };
__global__ void __launch_bounds__(512, 2) hy_mega(MegaArgs a) {
    extern __shared__ __attribute__((aligned(16))) unsigned char lds_raw[];
    LAS unsigned char* lds = (LAS unsigned char*)lds_raw;
    const int bid = blockIdx.x, G = gridDim.x;
#define Q_x (a.in[0])
#define Q_c (a.in[1])
#define Q_ctx (a.in[2])
#define Q_c_ctx (a.in[3])
#define Q_w_mod (a.in[4])
#define Q_b_mod (a.in[5])
#define Q_g_pre (a.in[6])
#define Q_g_post (a.in[7])
#define Q_g_fpre (a.in[8])
#define Q_g_fpost (a.in[9])
#define Q_w_in (a.in[10])
#define Q_rpb (a.in[11])
#define Q_a_up (a.in[12])
#define Q_a_bias (a.in[13])
#define Q_gnorm (a.in[14])
#define Q_w_out (a.in[15])
#define Q_router (a.in[16])
#define Q_w_gate (a.in[17])
#define Q_w_up (a.in[18])
#define Q_w_down (a.in[19])
#define Q_ws (a.ws)
#define Q_out (a.out)
#define Q_mod ((float*)(a.ws + WS_MOD))
#define Q_WTIN ((bf16_t*)(a.ws + WS_WTIN))
#define Q_WTV ((bf16_t*)(a.ws + WS_WTV))
#define Q_WTOUT ((bf16_t*)(a.ws + WS_WTOUT))
#define Q_WTGU ((unsigned char*)(a.ws + WS_WTGU))
#define Q_WTDN ((unsigned char*)(a.ws + WS_WTDN))
#define Q_H ((bf16_t*)(a.ws + WS_H))
#define Q_PROJ ((bf16_t*)(a.ws + WS_PROJ))
#define Q_VT ((bf16_t*)(a.ws + WS_VT))
#define Q_OMIX ((bf16_t*)(a.ws + WS_OMIX))
#define Q_MIX ((bf16_t*)(a.ws + WS_MIX))
#define Q_HID ((unsigned char*)(a.ws + WS_HID))
#define Q_HF ((unsigned char*)(a.ws + WS_HF))
#define Q_XS ((unsigned char*)(a.ws + WS_XS))
#define Q_Y ((bf16_t*)(a.ws + WS_XS))
#define Q_aff ((float*)(a.ws + WS_AFF))
#define Q_idx ((int*)(a.ws + WS_IDX))
#define Q_gate ((float*)(a.ws + WS_GATE))
#define Q_inv ((int*)(a.ws + WS_INV))
#define Q_QF ((bf16_t*)(a.ws + WS_QF))
#define Q_KF ((bf16_t*)(a.ws + WS_KF))
#define Q_KFT ((bf16_t*)(a.ws + WS_KFT))
#define Q_AT ((float*)(a.ws + WS_AT))
#define Q_SB ((bf16_t*)(a.ws + WS_SB))
#define Q_KH ((bf16_t*)(a.ws + WS_KH))
#define Q_UPF ((bf16_t*)(a.ws + WS_UPF))
#define Q_VB ((bf16_t*)(a.ws + WS_VB))
    volatile LAS unsigned* bst = (volatile LAS unsigned*)(lds + LDS_BYTES - 64);
    if (threadIdx.x < 16) bst[threadIdx.x] = 0u;
    __syncthreads();
    XcdBarrier bar = xcd_barrier_post((unsigned*)a.ws, bst);
    if (a.ph_hi < 0) cg::this_grid().sync();
    const int lo = a.ph_lo, hi = a.ph_hi;
#define IN(k) (lo <= (k) && (k) < hi)
#define SEAM(k) do { if (IN(k) && IN((k) + 1)) xcd_barrier(bar); } while (0)
#define MKP PrepArgs p; p.x = Q_x; p.ctx = Q_ctx; p.g_pre = Q_g_pre; p.mod = Q_mod; p.w_in = Q_w_in; p.w_out = Q_w_out; p.w_gate = Q_w_gate; p.w_up = Q_w_up; p.w_down = Q_w_down; p.WTIN = Q_WTIN; p.WTV = Q_WTV; p.WTOUT = Q_WTOUT; p.WTGU = Q_WTGU; p.WTDN = Q_WTDN; p.H = Q_H;
#define PH0 if (IN(0)) { MKP ph_mod(Q_c, Q_c_ctx, Q_w_mod, Q_b_mod, Q_mod, lds, bid, G); ph_upf(Q_a_up, Q_UPF, bid, G); ph_convert(p, lds, bid, G); }
#define PH1 if (IN(1)) { MKP ph_modulate(p, bid, G); }
#define PH2 if (IN(2)) { \
        { pg8::Gemm g{Q_H, Q_WTIN, M_ALL, PROJ_LD, DM}; pg8::StaticOrder S; S.init(g.M, g.N, G, bid); EpiProj E{Q_PROJ, PROJ_LD, Q_KH}; \
          pg8::gemm_phase<EpiProj, pg8::StaticOrder, true, true>(lds, g, S, E); } \
        { pg8::Gemm g{Q_WTV, Q_H, 1024, M_ALL, DM}; pg8::StaticOrder S; S.init(g.M, g.N, G, bid); EpiVal E{Q_VT, VT_LD, Q_VB}; \
          pg8::gemm_phase<EpiVal, pg8::StaticOrder, true, true>(lds, g, S, E); } }
#define PH3 if (IN(3)) { ph_gla_prep2(Q_PROJ, Q_UPF, Q_a_bias, Q_QF, Q_KF, Q_KFT, Q_AT, lds, bid, G); ph_na(Q_PROJ, Q_KH, Q_VB, Q_rpb, Q_OMIX, lds, bid, G); }
#define PH4 if (IN(4)) { MKP ph_gla_state(Q_KFT, Q_VT, Q_AT, Q_SB, bid, G); \
        { const int wv_ = threadIdx.x >> 6; const int nst_ = G < 128 ? G : 128; const int pid_ = bid < nst_ ? (wv_ == 0 ? -1 : bid * 7 + wv_ - 1) : nst_ * 7 + (bid - nst_) * 8 + wv_; \
          ph_convert_bg(p, CVT_Q0, CVT_Q1, pid_, nst_ * 7 + (G - nst_) * 8, lds); } }
#define PH5 if (IN(5)) ph_gla_out(Q_PROJ, Q_QF, Q_KF, Q_VT, Q_SB, Q_gnorm, Q_OMIX, lds, bid, G);
#define PH6 if (IN(6)) { pg8::Gemm g{Q_OMIX, Q_WTOUT, M_LAT, DM, DM}; pg8::StaticOrder S; S.init(g.M, g.N, G, bid); pg8::EpiBf16<0> E{Q_MIX, DM, nullptr, 0, 0, 1.f}; \
        pg8::gemm_phase<pg8::EpiBf16<0>, pg8::StaticOrder, true, true>(lds, g, S, E); }
#define PH7 if (IN(7)) ph_post_mix(Q_x, Q_MIX, Q_mod, Q_g_post, Q_g_fpre, Q_router, Q_out, Q_HF, Q_aff, lds, bid, G);
#define PH8 if (IN(8)) { MKP ph_topk(Q_aff, Q_HF, Q_idx, Q_gate, Q_inv, Q_XS, lds, bid, G); \
        { const int nb_ = G < 64 ? G : 64; const int pid_ = (G > 64) ? (bid < 64 ? -1 : (bid - 64) * 8 + (int)(threadIdx.x >> 6)) : bid * 8 + (int)(threadIdx.x >> 6); \
          ph_convert_bg(p, CVT_Q1, IT8, pid_, (G > 64 ? (G - 64) : G) * 8, lds); } }
#define PH9 if (IN(9)) { pg8::Gemm g{(const bf16_t*)Q_XS, (const bf16_t*)Q_WTGU, NSLOT, 2 * DE, DM / 2}; ExpertOrder S{22, G, bid}; EpiSwiGLU E{Q_HID, DE}; \
        pg8::gemm_phase<EpiSwiGLU, ExpertOrder, true, true, true>(lds, g, S, E); }
#define PH10 if (IN(10)) { pg8::Gemm g{(const bf16_t*)Q_HID, (const bf16_t*)Q_WTDN, NSLOT, DM, DE / 2}; ExpertOrder S{4, G, bid}; EpiRowScale E{Q_Y, DM, Q_gate}; \
        pg8::gemm_phase<EpiRowScale, ExpertOrder, true, true, true>(lds, g, S, E); }
#define PH11 if (IN(11)) ph_combine(Q_Y, Q_inv, Q_mod, Q_g_fpost, Q_out, bid, G);
#define RUN(k, PH) PH
    PH0
#if REP_PH == 0
    PH0
#endif
    SEAM(0);
    for (int rs_ = 0; rs_ < REP_SYNC; ++rs_) xcd_barrier(bar);
    PH1
#if REP_PH == 1
    PH1
#endif
    SEAM(1);
    PH2
#if REP_PH == 2
    PH2
#endif
    SEAM(2);
    PH3
#if REP_PH == 3
    PH3
#endif
    SEAM(3);
    PH4
#if REP_PH == 4
    PH4
#endif
    SEAM(4);
    PH5
#if REP_PH == 5
    PH5
#endif
    SEAM(5);
    PH6
#if REP_PH == 6
    PH6
#endif
    SEAM(6);
    PH7
#if REP_PH == 7
    PH7
#endif
    SEAM(7);
    PH8
#if REP_PH == 8
    PH8
#endif
    SEAM(8);
    PH9
#if REP_PH == 9
    PH9
#endif
    SEAM(9);
    PH10
#if REP_PH == 10
    PH10
#endif
    SEAM(10);
    PH11
#undef IN
#undef SEAM
}
}

extern "C" void kernel_launch(void* const* d_in, const int* in_sizes, int n_in, void* d_out, int out_size, void* d_ws, size_t ws_size, hipStream_t stream) {
    using namespace hy;
    static int grid = 0;
    if (grid == 0) {
        if (n_in != 20 || in_sizes[0] != M_LAT * DM || out_size != M_LAT * DM || ws_size < WS_END) { fprintf(stderr, "kernel_launch: unexpected shapes / workspace (n_in %d, ws %zu)\n", n_in, ws_size); grid = -1; return; }
        int dev = 0, cus = 0, per_cu = 0;
        if (hipGetDevice(&dev) != hipSuccess || hipDeviceGetAttribute(&cus, hipDeviceAttributeMultiprocessorCount, dev) != hipSuccess) { grid = -1; return; }
        if (hipFuncSetAttribute((const void*)hy_mega, hipFuncAttributeMaxDynamicSharedMemorySize, LDS_BYTES) != hipSuccess) { fprintf(stderr, "kernel_launch: hipFuncSetAttribute failed\n"); grid = -1; return; }
        if (hipOccupancyMaxActiveBlocksPerMultiprocessor(&per_cu, (const void*)hy_mega, 512, LDS_BYTES) != hipSuccess || per_cu < 1) { fprintf(stderr, "kernel_launch: occupancy query says %d\n", per_cu); per_cu = 1; }
        (void)hipGetLastError();
        grid = cus;
    }
    if (grid < 0) return;
    (void)hipMemsetAsync(d_ws, 0, CTL_BYTES, stream);
    MegaArgs a{};
    for (int i = 0; i < 20; ++i) a.in[i] = (const float*)d_in[i];
    a.out = (float*)d_out; a.ws = (unsigned char*)d_ws;
    a.ph_lo = 0; a.ph_hi = N_PHASES;
    void* args[] = {&a};
    hipError_t e = hipLaunchCooperativeKernel((const void*)hy_mega, dim3(grid), dim3(512), args, LDS_BYTES, stream);
    if (e != hipSuccess) fprintf(stderr, "cooperative launch failed: %s (grid %d)\n", hipGetErrorString(e), grid);
}
```

```cpp
#define CVT_Q0 0
#define CVT_Q1 19000
#include <hip/hip_runtime.h>
#include <hip/hip_cooperative_groups.h>
#include <cstdio>
#include <cstdint>
namespace pg8 {
#define PG8_LAS __attribute__((address_space(3)))
typedef unsigned short bf16_t;
typedef short bf16x8 __attribute__((ext_vector_type(8)));
typedef float f32x4 __attribute__((ext_vector_type(4)));
typedef unsigned u32x4 __attribute__((ext_vector_type(4)));
constexpr int BM = 256, BK = 64, HALF = 128, HTB = HALF * BK * 2  , STAGE_BYTES = 8 * HTB, NXCD = 8, WGM = 8;

__host__ __device__ __forceinline__ int lds_byte(int r, int c) { const int st = (r >> 4) * 2 + (c >> 5), rr = r & 15, cc = c & 31, ob = rr * 64 + cc * 2; return st * 1024 + (ob ^ (((ob >> 9) & 1) << 5)); }
__host__ __device__ __forceinline__ void stage_rc(int b, int& R, int& C) { const int st = b / 1024, sb = b % 1024, swz = sb ^ (((sb >> 9) & 1) << 5); R = (st >> 1) * 16 + swz / 64; C = (st & 1) * 32 + (swz % 64) / 2; }
__host__ __device__ __forceinline__ int perm32(int rho) { const int n = rho >> 4, i = rho & 15; return 8 * (i >> 2) + 4 * n + (i & 3); }

struct Unit { int pm, pn, bt, kind; const char* a; const char* b; };
struct Gemm { const bf16_t* A; const bf16_t* Bt; int M, N, K; };

struct StaticOrder {
    int nM, nN, nwg, G, c; const char* A; const char* B; size_t ts;
    __host__ __device__ void init(int M, int N, int G_, int c_) { nM = M / BM; nN = N / BM; nwg = nM * nN; G = G_; c = c_; }
    __host__ __device__ void bind(const Gemm& g) { A = (const char*)g.A; B = (const char*)g.Bt; ts = (size_t)BM * g.K * 2; }
    __host__ __device__ bool next(int i, Unit& u) const {
        const long L = (long)i * G + c; if (L >= nwg) return false;
        int wgid = (int)L; { const int q = nwg / NXCD, r = nwg % NXCD, xcd = wgid % NXCD, off = wgid / NXCD; wgid = (xcd < r ? xcd * (q + 1) : r * (q + 1) + (xcd - r) * q) + off; }
        const int nig = WGM * nN, gid = wgid / nig, fm = gid * WGM, gsz = (nM - fm) < WGM ? (nM - fm) : WGM;
        u.pm = fm + ((wgid % nig) % gsz); u.pn = (wgid % nig) / gsz; u.bt = u.pn; u.kind = 0; u.a = A + (size_t)u.pm * ts; u.b = B + (size_t)u.bt * ts; return true;
    }
    __device__ __forceinline__ void a_ready(const Unit&) const {}
    __device__ __forceinline__ void done(const Unit&) const {}
};

__device__ __forceinline__ unsigned cvt_pk_bf16(float lo, float hi) { unsigned r; asm volatile("v_cvt_pk_bf16_f32 %0, %1, %2" : "=v"(r) : "v"(lo), "v"(hi)); return r; }
typedef float f32x2 __attribute__((ext_vector_type(2)));
__device__ __forceinline__ f32x2 gelu_pk(f32x2 v) {
    const f32x2 av = __builtin_elementwise_abs(v), d = av * 0.2316418882f + 1.0f;
    f32x2 t; t.x = __builtin_amdgcn_rcpf(d.x); t.y = __builtin_amdgcn_rcpf(d.y);
    f32x2 q = t * 0.5307027145f + (-0.7265760135f); q = q * t + 0.7107068705f; q = q * t + (-0.142248368f); q = q * t + 0.127414796f; q = q * t;
    const f32x2 s = (v * v) * (-0.72134752044f);
    f32x2 e; e.x = __builtin_amdgcn_exp2f(s.x); e.y = __builtin_amdgcn_exp2f(s.y);
    const f32x2 m = v * (q * e), r = v - m;
    f32x2 o; o.x = v.x < 0.f ? m.x : r.x; o.y = v.y < 0.f ? m.y : r.y; return o;
}

template <int ACT  > struct EpiBf16 {
    static constexpr bool PERM = true, AFTER_DRAIN = false; static_assert(ACT == 0 || ACT == 1, "EpiBf16: ACT is 0 (none) or 1 (gelu_pk)");
    bf16_t* O; int ldc; const float* bias; int split_cols; size_t split_stride; float scale0;
    __device__ __forceinline__ void operator()(const f32x4 (&acc)[2][2][4][2], const Unit& u, int wr, int wc, int fr, int fq) const {
        const int row0 = u.pm * BM + wr * 64 + fr; int colt = u.pn * BM; bf16_t* base = O;
        float sc = 1.f; if (split_cols) { const int t = colt / split_cols; base += (size_t)t * split_stride; colt -= t * split_cols; if (t == 0) sc = scale0; }
        const int col0 = colt + wc * 32 + 8 * fq, bcol0 = u.pn * BM + wc * 32 + 8 * fq;
        f32x4 bv[2][2];
#pragma unroll
        for (int bj = 0; bj < 2; ++bj)
#pragma unroll
            for (int n = 0; n < 2; ++n) bv[bj][n] = bias ? *(const f32x4*)(bias + bcol0 + bj * HALF + 4 * n) : (f32x4){0.f, 0.f, 0.f, 0.f};
#pragma unroll
        for (int ai = 0; ai < 2; ++ai)
#pragma unroll
            for (int m = 0; m < 4; ++m) { bf16_t* rowp = base + (size_t)(row0 + ai * HALF + m * 16) * ldc + col0;
#pragma unroll
                for (int bj = 0; bj < 2; ++bj) { f32x4 v0 = acc[ai][bj][m][0] + bv[bj][0], v1 = acc[ai][bj][m][1] + bv[bj][1];
                    if (ACT == 1) { f32x2 a = gelu_pk((f32x2){v0[0], v0[1]}), b = gelu_pk((f32x2){v0[2], v0[3]}), c = gelu_pk((f32x2){v1[0], v1[1]}), d = gelu_pk((f32x2){v1[2], v1[3]});
                        v0 = (f32x4){a.x, a.y, b.x, b.y}; v1 = (f32x4){c.x, c.y, d.x, d.y}; }
                    v0 = v0 * sc; v1 = v1 * sc; u32x4 w; w.x = cvt_pk_bf16(v0[0], v0[1]); w.y = cvt_pk_bf16(v0[2], v0[3]); w.z = cvt_pk_bf16(v1[0], v1[1]); w.w = cvt_pk_bf16(v1[2], v1[3]);
                    *(u32x4*)(rowp + bj * HALF) = w; } }
    }
};
typedef int i32x8 __attribute__((ext_vector_type(8)));
typedef int i32x4v __attribute__((ext_vector_type(4)));
__device__ __forceinline__ f32x4 mfma_f8(bf16x8 b0, bf16x8 b1, bf16x8 a0, bf16x8 a1, f32x4 c) {
    const i32x8 bv = __builtin_shufflevector(__builtin_bit_cast(i32x4v, b0), __builtin_bit_cast(i32x4v, b1), 0, 1, 2, 3, 4, 5, 6, 7);
    const i32x8 av = __builtin_shufflevector(__builtin_bit_cast(i32x4v, a0), __builtin_bit_cast(i32x4v, a1), 0, 1, 2, 3, 4, 5, 6, 7);
    return __builtin_amdgcn_mfma_scale_f32_16x16x128_f8f6f4(bv, av, c, 0, 0, 0, 0x7f7f7f7f, 0, 0x7f7f7f7f);
}
struct Frag16 { bf16x8 k[2]; };
template <bool F8> struct FragSel { typedef Frag16 A; };
template <> struct FragSel<true> { typedef i32x8 A; };
__device__ __forceinline__ void frag_load(Frag16& d, const PG8_LAS unsigned char* p) { d.k[0] = *(const PG8_LAS bf16x8*)p; d.k[1] = *(const PG8_LAS bf16x8*)(p + 1024); }
__device__ __forceinline__ void frag_load(i32x8& d, const PG8_LAS unsigned char* p) { const i32x4v lo = *(const PG8_LAS i32x4v*)p, hi = *(const PG8_LAS i32x4v*)(p + 1024); d = __builtin_shufflevector(lo, hi, 0, 1, 2, 3, 4, 5, 6, 7); }
__device__ __forceinline__ f32x4 frag_mma(const Frag16& b, const Frag16& a, f32x4 c) { c = __builtin_amdgcn_mfma_f32_16x16x32_bf16(b.k[0], a.k[0], c, 0, 0, 0); return __builtin_amdgcn_mfma_f32_16x16x32_bf16(b.k[1], a.k[1], c, 0, 0, 0); }
__device__ __forceinline__ f32x4 frag_mma(const i32x8& b, const i32x8& a, f32x4 c) {
    const int sc = 0x7f7f7f7f;
    asm volatile("s_nop 1\n\tv_mfma_scale_f32_16x16x128_f8f6f4 %0, %1, %2, %0, %3, %3 op_sel_hi:[0,0,0]" : "+v"(c) : "v"(b), "v"(a), "v"(sc));
    return c; }
template <class Epi, class Sched, bool ALIGN_EPI = false, bool SP2 = false, bool F8 = false>
__device__ __forceinline__ void gemm_phase(PG8_LAS unsigned char* lds, const Gemm g, const Sched& S, const Epi& E) {
    const int tid = threadIdx.x, wid = __builtin_amdgcn_readfirstlane(tid >> 6), lane = tid & 63, wr = wid >> 2, wc = wid & 3, fr = lane & 15, fq = lane >> 4;
    const int K = g.K, nt = K / BK;
    unsigned voffA[2], voffB[2];
#pragma unroll
    for (int i = 0; i < 2; ++i) { int R, C; stage_rc(tid * 16 + i * 8192, R, C); const int Rb = Epi::PERM ? ((R & ~31) + perm32(R & 31)) : R;
        voffA[i] = (unsigned)(R * K + C) * 2u; voffB[i] = (unsigned)(Rb * K + C) * 2u; }
    const size_t kstep = (size_t)(BK * 2);
    const size_t hstep = (size_t)HALF * K * 2;
    const size_t tstep = 2 * hstep;
    const unsigned ldsw = (unsigned)wid * 1024u;
    const int aoff = lds_byte(wr * 64 + fr, fq * 8), boff = lds_byte(wc * 32 + fr, fq * 8);
#define PG8_SA(b, h) (((b) * 2 + (h)) * HTB)
#define PG8_SB(b, h) ((4 + (b) * 2 + (h)) * HTB)
#define PG8_STAGE(bufoff, gbase, voff) do { _Pragma("unroll") for (int _i = 0; _i < 2; ++_i) \
        __builtin_amdgcn_global_load_lds((const unsigned*)((const char*)(gbase) + (voff)[_i]), (PG8_LAS unsigned*)(lds + (bufoff) + ldsw + _i * 8192), 16, 0, 0); } while (0)
#define PG8_LDA(dst, b, h) do { _Pragma("unroll") for (int m = 0; m < 4; ++m) frag_load(dst[m], lds + PG8_SA(b, h) + aoff + m * 2048); } while (0)
#define PG8_LDB(dst, b, h) do { _Pragma("unroll") for (int n = 0; n < 2; ++n) frag_load(dst[n], lds + PG8_SB(b, h) + boff + n * 2048); } while (0)
#define PG8_MMA(ai, bj, At, Bt) do { __builtin_amdgcn_s_setprio(1); _Pragma("unroll") for (int m = 0; m < 4; ++m) _Pragma("unroll") for (int n = 0; n < 2; ++n) \
        acc[ai][bj][m][n] = frag_mma(Bt[n], At[m], acc[ai][bj][m][n]); __builtin_amdgcn_s_setprio(0); } while (0)
#define PG8_WAIT_V(n) asm volatile("s_waitcnt vmcnt(" #n ")" ::: "memory")
#define PG8_WAIT_L(n) asm volatile("s_waitcnt lgkmcnt(" #n ")" ::: "memory")
#define PG8_BAR __builtin_amdgcn_s_barrier()
#define PG8_SCHED __builtin_amdgcn_sched_barrier(0)
    Unit cur, nxt; int ui = 0;
    if (!S.next(0, cur)) return;
    f32x4 acc[2][2][4][2];
#pragma unroll
    for (int a = 0; a < 2; ++a)
#pragma unroll
        for (int b = 0; b < 2; ++b)
#pragma unroll
            for (int m = 0; m < 4; ++m)
#pragma unroll
                for (int n = 0; n < 2; ++n) acc[a][b][m][n] = (f32x4){0.f, 0.f, 0.f, 0.f};
    typename FragSel<F8>::A At[4]; typename FragSel<F8>::A B0[2], B1[2];
    const char* cA = cur.a; const char* cB = cur.b;
    S.a_ready(cur);
    if constexpr (SP2) {
        PG8_STAGE(PG8_SB(0, 0), cB, voffB); PG8_STAGE(PG8_SB(0, 1), cB + hstep, voffB); PG8_STAGE(PG8_SA(0, 0), cA, voffA); PG8_STAGE(PG8_SA(0, 1), cA + hstep, voffA);
        if (wr == 1) PG8_BAR;
        PG8_WAIT_V(2); PG8_BAR;
        PG8_STAGE(PG8_SB(1, 0), cB + kstep, voffB); PG8_STAGE(PG8_SA(1, 0), cA + kstep, voffA); PG8_STAGE(PG8_SB(1, 1), cB + hstep + kstep, voffB);
        PG8_WAIT_V(6); PG8_BAR;
    } else {
        PG8_STAGE(PG8_SB(0, 0), cB, voffB); PG8_STAGE(PG8_SA(0, 0), cA, voffA); PG8_STAGE(PG8_SB(0, 1), cB + hstep, voffB); PG8_STAGE(PG8_SA(0, 1), cA + hstep, voffA);
        if (wr == 1) PG8_BAR;
        PG8_WAIT_V(4); PG8_BAR;
        PG8_STAGE(PG8_SB(1, 0), cB + kstep, voffB); PG8_STAGE(PG8_SA(1, 0), cA + kstep, voffA); PG8_STAGE(PG8_SB(1, 1), cB + hstep + kstep, voffB);
        PG8_WAIT_V(6); PG8_BAR;
    }
    for (;;) {
        const bool has_next = S.next(ui + 1, nxt);
        const char* nA = has_next ? nxt.a : cA; const char* nB = has_next ? nxt.b : cB;
        for (int t = 0; t < nt; t += 2) {
            const bool last = (t == nt - 2);
            const char* a1 = cA + (size_t)(t + 1) * kstep;
            const char* a2 = last ? nA : cA + (size_t)(t + 2) * kstep; const char* b2 = last ? nB : cB + (size_t)(t + 2) * kstep;
            const char* a3 = a2 + kstep; const char* b3 = b2 + kstep;
            if (last && has_next) S.a_ready(nxt);
            if constexpr (SP2) {
            PG8_LDB(B0, 0, 0); PG8_LDB(B1, 0, 1); PG8_SCHED; PG8_LDA(At, 0, 0); PG8_STAGE(PG8_SA(1, 1), a1 + hstep, voffA);
            PG8_WAIT_V(8); PG8_WAIT_L(0); PG8_BAR; PG8_MMA(0, 0, At, B0); PG8_MMA(0, 1, At, B1); PG8_BAR; PG8_SCHED;
            PG8_LDA(At, 0, 1); PG8_STAGE(PG8_SB(0, 0), b2, voffB); PG8_STAGE(PG8_SB(0, 1), b2 + hstep, voffB); PG8_STAGE(PG8_SA(0, 0), a2, voffA);
            PG8_WAIT_V(8); PG8_WAIT_L(0); PG8_BAR; PG8_MMA(1, 0, At, B0); PG8_MMA(1, 1, At, B1); PG8_BAR; PG8_SCHED;
            PG8_LDB(B0, 1, 0); PG8_LDB(B1, 1, 1); PG8_SCHED; PG8_LDA(At, 1, 0); PG8_STAGE(PG8_SA(0, 1), a2 + hstep, voffA);
            PG8_WAIT_V(8); PG8_WAIT_L(0); PG8_BAR; PG8_MMA(0, 0, At, B0); PG8_MMA(0, 1, At, B1); PG8_BAR; PG8_SCHED;
            PG8_LDA(At, 1, 1); PG8_STAGE(PG8_SB(1, 0), b3, voffB); PG8_STAGE(PG8_SB(1, 1), b3 + hstep, voffB); PG8_STAGE(PG8_SA(1, 0), a3, voffA);
            PG8_WAIT_V(8); PG8_WAIT_L(0); PG8_BAR; PG8_MMA(1, 0, At, B0); PG8_MMA(1, 1, At, B1); PG8_BAR; PG8_SCHED;
            } else {
            PG8_LDB(B0, 0, 0); PG8_SCHED; PG8_LDA(At, 0, 0); PG8_STAGE(PG8_SA(1, 1), a1 + hstep, voffA);
            PG8_WAIT_L(8); PG8_BAR; PG8_WAIT_L(0); PG8_MMA(0, 0, At, B0); PG8_BAR; PG8_SCHED;
            PG8_LDB(B1, 0, 1); PG8_STAGE(PG8_SB(0, 0), b2, voffB);
            PG8_BAR; PG8_WAIT_L(0); PG8_MMA(0, 1, At, B1); PG8_BAR;
            PG8_LDA(At, 0, 1); PG8_STAGE(PG8_SA(0, 0), a2, voffA);
            PG8_BAR; PG8_WAIT_L(0); PG8_MMA(1, 0, At, B0); PG8_BAR; PG8_SCHED;
            PG8_STAGE(PG8_SB(0, 1), b2 + hstep, voffB);
            PG8_WAIT_V(6); PG8_BAR; PG8_MMA(1, 1, At, B1); PG8_BAR;
            PG8_LDB(B0, 1, 0); PG8_SCHED; PG8_LDA(At, 1, 0); PG8_STAGE(PG8_SA(0, 1), a2 + hstep, voffA);
            PG8_WAIT_L(8); PG8_BAR; PG8_WAIT_L(0); PG8_MMA(0, 0, At, B0); PG8_BAR; PG8_SCHED;
            PG8_LDB(B1, 1, 1); PG8_STAGE(PG8_SB(1, 0), b3, voffB);
            PG8_BAR; PG8_WAIT_L(0); PG8_MMA(0, 1, At, B1); PG8_BAR;
            PG8_LDA(At, 1, 1); PG8_STAGE(PG8_SA(1, 0), a3, voffA);
            PG8_BAR; PG8_WAIT_L(0); PG8_MMA(1, 0, At, B0); PG8_BAR; PG8_SCHED;
            PG8_STAGE(PG8_SB(1, 1), b3 + hstep, voffB);
            PG8_WAIT_V(6); PG8_BAR; PG8_MMA(1, 1, At, B1); PG8_BAR;
            }
        }
        if constexpr (ALIGN_EPI) { if (wr == 0) PG8_BAR; }
        if constexpr (F8) {
            asm volatile("s_nop 15\n\ts_nop 15" ::: "memory");
#pragma unroll
            for (int a = 0; a < 2; ++a)
#pragma unroll
                for (int b = 0; b < 2; ++b)
#pragma unroll
                    for (int m = 0; m < 4; ++m) asm volatile("" : "+v"(acc[a][b][m][0]), "+v"(acc[a][b][m][1]));
        }
        if constexpr (!Epi::AFTER_DRAIN) { E(acc, cur, wr, wc, fr, fq); S.done(cur); }
        if (!has_next) break;
#pragma unroll
        for (int a = 0; a < 2; ++a)
#pragma unroll
            for (int b = 0; b < 2; ++b)
#pragma unroll
                for (int m = 0; m < 4; ++m)
#pragma unroll
                    for (int n = 0; n < 2; ++n) acc[a][b][m][n] = (f32x4){0.f, 0.f, 0.f, 0.f};
        cur = nxt; cA = nA; cB = nB; ++ui;
        if constexpr (ALIGN_EPI) { if (wr == 1) PG8_BAR; }
    }
    PG8_WAIT_V(0);
    if constexpr (!ALIGN_EPI) { if (wr == 0) PG8_BAR; }
    PG8_BAR;
    if constexpr (Epi::AFTER_DRAIN) { E.fused(acc, cur, wr, wc, fr, fq, lds, wid, lane); S.done(cur); }
#undef PG8_SA
#undef PG8_SB
#undef PG8_STAGE
#undef PG8_LDA
#undef PG8_LDB
#undef PG8_MMA
#undef PG8_WAIT_V
#undef PG8_WAIT_L
#undef PG8_BAR
#undef PG8_SCHED
}
}
namespace hy {
using pg8::bf16_t; using pg8::f32x4; using pg8::u32x4; using pg8::bf16x8;
#define LAS __attribute__((address_space(3)))
constexpr int NB = 4, SEQ = 4096, DM = 1024, CTXL = 256;
constexpr int M_LAT = NB * SEQ, M_CTX = NB * CTXL, M_ALL = M_LAT + M_CTX;
constexpr int IN_COLS = 3104, NE = 16, CAP = 512, DE = 2816, NSLOT = NE * NB * CAP;
constexpr int PROJ_LD = 2304, PC_NAK = 0, PC_GK = 512, PC_NAQ = 768, PC_GQ = 1280, PC_GG = 1536, PC_AD = 2048;
constexpr int VT_LD = M_ALL;
constexpr float EPS = 1e-6f;
constexpr int TKB = SEQ + CTXL;
constexpr size_t MiB = 1u << 20;
constexpr size_t WS_MODP = 1 * MiB, WS_MOD = 3 * MiB, WS_WTIN = 4 * MiB, WS_WTV = 9 * MiB, WS_WTOUT = 11 * MiB, WS_AFF = 13 * MiB, WS_IDX = 14 * MiB, WS_GATE = 14 * MiB + 256 * 1024, WS_INV = 15 * MiB;
constexpr size_t WS_WTGU = 16 * MiB, WS_WTDN = 192 * MiB, WS_H = 280 * MiB, WS_PROJ = 314 * MiB, WS_VT = 391 * MiB, WS_OMIX = 425 * MiB, WS_MIX = 457 * MiB, WS_HID = 280 * MiB;
constexpr size_t WS_HF = 489 * MiB, WS_XS = 521 * MiB, WS_GLAT = 590 * MiB, WS_QF = 590 * MiB, WS_KF = 606 * MiB, WS_KFT = 622 * MiB, WS_AT = 639 * MiB, WS_SB = 640 * MiB, WS_UPF = 639 * MiB + 768 * 1024, WS_KH = 521 * MiB, WS_VB = 538 * MiB, WS_END = 672 * MiB;
static_assert(WS_WTIN + (size_t)PROJ_LD * DM * 2 <= WS_WTV && WS_WTGU + (size_t)NE * 2 * DE * DM * 2 <= WS_WTDN && WS_WTDN + (size_t)NE * DM * DE * 2 <= WS_H, "ws map 1");
static_assert(WS_H + (size_t)M_ALL * DM * 2 <= WS_PROJ && WS_PROJ + (size_t)M_ALL * PROJ_LD * 2 <= WS_VT && WS_VT + (size_t)1024 * VT_LD * 2 <= WS_OMIX, "ws map 2");
static_assert(WS_HID + (size_t)NSLOT * DE * 2 <= WS_MIX && WS_XS + (size_t)NSLOT * DM * 2 <= WS_GLAT && WS_SB + (size_t)2 * NB * 4 * 64 * 128 * 64 * 2 <= WS_END && WS_KFT + (size_t)2 * 256 * M_ALL * 2 <= WS_AT, "ws map 3");

__device__ __forceinline__ float bf2f(bf16_t x) { return __uint_as_float((unsigned)x << 16); }
__device__ __forceinline__ unsigned f2bf(float f) { unsigned u = __float_as_uint(f); return (u + 0x7fffu + ((u >> 16) & 1u)) >> 16; }
__device__ __forceinline__ unsigned pk2(float lo, float hi) { return f2bf(lo) | (f2bf(hi) << 16); }
__device__ __forceinline__ float wave_sum(float v) {
#pragma unroll
    for (int o = 1; o < 64; o <<= 1) v += __shfl_xor(v, o);
    return v;
}
__device__ __forceinline__ float silu_f(float x) { return x / (1.f + __expf(-x)); }

__device__ __forceinline__ void ph_mod(const float* __restrict__ c, const float* __restrict__ c_ctx, const float* __restrict__ w_mod, const float* __restrict__ b_mod, float* __restrict__ mod, LAS unsigned char* lds, int bid, int G) {
    LAS float* s = (LAS float*)lds;
    LAS float* red = s + 5 * 1024;
    const int tid = threadIdx.x;
    __syncthreads();
    for (int i = tid; i < 5 * 1024; i += 512) { const int v = i >> 10, k = i & 1023; const float x = v < 4 ? c[v * 1024 + k] : c_ctx[k]; s[i] = x / (1.f + expf(-x)); }
    __syncthreads();
    for (int cg = bid; cg < 256; cg += G) {
        const int ks = tid / 24, cj = tid % 24, j = cg * 24 + cj;
        if (tid < 504) {
            float acc[5] = {0.f, 0.f, 0.f, 0.f, 0.f};
            const int k0 = ks * 49, k1 = min(k0 + 49, 1024);
#pragma unroll 7
            for (int k = k0; k < k1; ++k) { const float w = w_mod[(size_t)k * 6144 + j];
#pragma unroll
                for (int v = 0; v < 5; ++v) acc[v] += s[v * 1024 + k] * w; }
#pragma unroll
            for (int v = 0; v < 5; ++v) red[(v * 21 + ks) * 24 + cj] = acc[v];
        }
        __syncthreads();
        if (tid < 120) { const int v = tid / 24, cc = tid % 24; float a = b_mod[cg * 24 + cc];
            for (int q = 0; q < 21; ++q) a += red[(v * 21 + q) * 24 + cc];
            mod[(size_t)v * 6144 + cg * 24 + cc] = a; }
        __syncthreads();
    }
}

__device__ __forceinline__ void transpose_item(const float* __restrict__ W, int N, int k0, int n0, bf16_t* dst, int K, float scale, LAS float* scr, int lane) {
    float wv[32];
#pragma unroll
    for (int i = 0; i < 32; ++i) wv[i] = W[(size_t)(k0 + 2 * i + (lane >> 5)) * N + n0 + (lane & 31)];
#pragma unroll
    for (int i = 0; i < 32; ++i) scr[(2 * i + (lane >> 5)) * 33 + (lane & 31)] = wv[i];
    asm volatile("s_waitcnt lgkmcnt(0)" ::: "memory");
    const int c = lane & 7;
#pragma unroll
    for (int j = 0; j < 4; ++j) { const int n = (lane >> 3) + 8 * j; const LAS float* s = scr + (8 * c) * 33 + n;
        u32x4 o; o.x = pk2(s[0 * 33] * scale, s[1 * 33] * scale); o.y = pk2(s[2 * 33] * scale, s[3 * 33] * scale); o.z = pk2(s[4 * 33] * scale, s[5 * 33] * scale); o.w = pk2(s[6 * 33] * scale, s[7 * 33] * scale);
        *(u32x4*)(dst + (size_t)n * K + k0 + 8 * c) = o; }
    asm volatile("s_waitcnt lgkmcnt(0)" ::: "memory");
}
constexpr float SX8 = 16.f, SW1 = 64.f, SH8 = 8.f, SW2 = 128.f;
__device__ __forceinline__ float clamp448(float v) { return fminf(fmaxf(v, -448.f), 448.f); }
__device__ __forceinline__ unsigned pk4_fp8(float a, float b, float c, float d) {
    int w = 0; w = __builtin_amdgcn_cvt_pk_fp8_f32(clamp448(a), clamp448(b), w, false); w = __builtin_amdgcn_cvt_pk_fp8_f32(clamp448(c), clamp448(d), w, true); return (unsigned)w; }
__device__ __forceinline__ void transpose_item_f8(const float* __restrict__ W, int N, int k0, int n0, unsigned char* dst, int Kb, float scale, LAS float* scr, int lane) {
    float wv[32];
#pragma unroll
    for (int i = 0; i < 32; ++i) wv[i] = W[(size_t)(k0 + 2 * i + (lane >> 5)) * N + n0 + (lane & 31)];
#pragma unroll
    for (int i = 0; i < 32; ++i) scr[(2 * i + (lane >> 5)) * 33 + (lane & 31)] = wv[i];
    asm volatile("s_waitcnt lgkmcnt(0)" ::: "memory");
    const int c = lane & 3;
#pragma unroll
    for (int j = 0; j < 2; ++j) { const int n = (lane >> 2) + 16 * j; const LAS float* s = scr + (16 * c) * 33 + n;
        u32x4 o; o.x = pk4_fp8(s[0 * 33] * scale, s[1 * 33] * scale, s[2 * 33] * scale, s[3 * 33] * scale); o.y = pk4_fp8(s[4 * 33] * scale, s[5 * 33] * scale, s[6 * 33] * scale, s[7 * 33] * scale);
        o.z = pk4_fp8(s[8 * 33] * scale, s[9 * 33] * scale, s[10 * 33] * scale, s[11 * 33] * scale); o.w = pk4_fp8(s[12 * 33] * scale, s[13 * 33] * scale, s[14 * 33] * scale, s[15 * 33] * scale);
        *(u32x4*)(dst + (size_t)n * Kb + k0 + 16 * c) = o; }
    asm volatile("s_waitcnt lgkmcnt(0)" ::: "memory");
}
struct PrepArgs { const float *x, *ctx, *g_pre, *mod, *w_in, *w_out, *w_gate, *w_up, *w_down; bf16_t *WTIN, *WTV, *WTOUT; unsigned char *WTGU, *WTDN; bf16_t* H; };
constexpr int IT_IN = 16 * 97, IT_OUT = 16 * 32, IT_GU1 = 16 * 16 * 88, IT_DN = 16 * 44 * 32, IT_ALL = IT_IN + IT_OUT + 2 * IT_GU1 + IT_DN;
struct CvtItem { const float* W; unsigned char* dst; int N, Kb; float scale; };
constexpr int IT16 = IT_IN + IT_OUT;
constexpr int IT8_GU1 = 16 * 8 * 88, IT8_DN = 16 * 22 * 32, IT8 = 2 * IT8_GU1 + IT8_DN;
#ifndef CVT_Q0
#define CVT_Q0 0
#endif
#ifndef CVT_Q1
#define CVT_Q1 23000
#endif
__device__ __forceinline__ CvtItem cvt_decode16(const PrepArgs& a, int it) {
    CvtItem c; int r = it;
    if (r < IT_IN) { const int kb = r / 97, n0 = (r % 97) * 32; bf16_t* dst; float sc = 1.f;
        if (n0 < 512) dst = a.WTIN + (size_t)(PC_NAK + n0) * DM;
        else if (n0 < 1024) dst = a.WTV + (size_t)(n0 - 512) * DM;
        else if (n0 < 1280) dst = a.WTIN + (size_t)(PC_GK + n0 - 1024) * DM;
        else if (n0 < 1792) dst = a.WTV + (size_t)(512 + n0 - 1280) * DM;
        else if (n0 < 1824) dst = a.WTIN + (size_t)(PC_AD + n0 - 1792) * DM;
        else if (n0 < 2336) { dst = a.WTIN + (size_t)(PC_NAQ + n0 - 1824) * DM; sc = 0.125f; }
        else if (n0 < 2592) { dst = a.WTIN + (size_t)(PC_GQ + n0 - 2336) * DM; sc = 0.125f; }
        else dst = a.WTIN + (size_t)(PC_GG + n0 - 2592) * DM;
        c.W = a.w_in + (size_t)(kb * 64) * IN_COLS + n0; c.N = IN_COLS; c.dst = (unsigned char*)(dst + kb * 64); c.Kb = DM * 2; c.scale = sc; return c; }
    r -= IT_IN;
    { const int kb = r / 32, n0 = (r % 32) * 32; c.W = a.w_out + (size_t)(kb * 64) * DM + n0; c.N = DM; c.dst = (unsigned char*)(a.WTOUT + (size_t)n0 * DM + kb * 64); c.Kb = DM * 2; c.scale = 1.f; return c; }
}
__device__ __forceinline__ CvtItem cvt_decode8(const PrepArgs& a, int it) {
    CvtItem c; int r = it;
    if (r < 2 * IT8_GU1) { const int which = r / IT8_GU1; r %= IT8_GU1; const int e = r / (8 * 88); r %= (8 * 88); const int kb = r / 88, n0 = (r % 88) * 32;
        c.W = (which ? a.w_up : a.w_gate) + (size_t)e * DM * DE + (size_t)(kb * 128) * DE + n0; c.N = DE;
        c.dst = a.WTGU + ((size_t)e * 2 * DE + (n0 / 128) * 256 + (n0 % 128) + which * 128) * DM + kb * 128; c.Kb = DM; c.scale = SW1; return c; }
    r -= 2 * IT8_GU1;
    { const int e = r / (22 * 32); r %= (22 * 32); const int kb = r / 32, n0 = (r % 32) * 32;
      c.W = a.w_down + (size_t)e * DE * DM + (size_t)(kb * 128) * DM + n0; c.N = DM; c.dst = a.WTDN + ((size_t)e * DM + n0) * DE + kb * 128; c.Kb = DE; c.scale = SW2; return c; }
}
__device__ __forceinline__ void cvt_load(const CvtItem& c, int half, float (&wv)[32], int lane) {
    const float* W = c.W + (size_t)(64 * half) * c.N;
#pragma unroll
    for (int i = 0; i < 32; ++i) wv[i] = __builtin_nontemporal_load(&W[(size_t)(2 * i + (lane >> 5)) * c.N + (lane & 31)]);
}
template <bool F8> __device__ __forceinline__ void cvt_store(const CvtItem& c, int half, const float (&wv)[32], LAS float* scr, int lane) {
#pragma unroll
    for (int i = 0; i < 32; ++i) scr[(2 * i + (lane >> 5)) * 33 + (lane & 31)] = wv[i];
    asm volatile("s_waitcnt lgkmcnt(0)" ::: "memory");
    const float scale = c.scale;
    if constexpr (F8) {
        const int cc = lane & 3; unsigned char* dst = c.dst + 64 * half;
#pragma unroll
        for (int j = 0; j < 2; ++j) { const int n = (lane >> 2) + 16 * j; const LAS float* s = scr + (16 * cc) * 33 + n;
            u32x4 o; o.x = pk4_fp8(s[0 * 33] * scale, s[1 * 33] * scale, s[2 * 33] * scale, s[3 * 33] * scale); o.y = pk4_fp8(s[4 * 33] * scale, s[5 * 33] * scale, s[6 * 33] * scale, s[7 * 33] * scale);
            o.z = pk4_fp8(s[8 * 33] * scale, s[9 * 33] * scale, s[10 * 33] * scale, s[11 * 33] * scale); o.w = pk4_fp8(s[12 * 33] * scale, s[13 * 33] * scale, s[14 * 33] * scale, s[15 * 33] * scale);
            *(u32x4*)(dst + (size_t)n * c.Kb + 16 * cc) = o; }
    } else {
        const int cc = lane & 7;
#pragma unroll
        for (int j = 0; j < 4; ++j) { const int n = (lane >> 3) + 8 * j; const LAS float* s = scr + (8 * cc) * 33 + n;
            u32x4 o; o.x = pk2(s[0 * 33] * scale, s[1 * 33] * scale); o.y = pk2(s[2 * 33] * scale, s[3 * 33] * scale); o.z = pk2(s[4 * 33] * scale, s[5 * 33] * scale); o.w = pk2(s[6 * 33] * scale, s[7 * 33] * scale);
            *(u32x4*)(c.dst + (size_t)n * c.Kb + 16 * cc) = o; }
    }
    asm volatile("s_waitcnt lgkmcnt(0)" ::: "memory");
}
template <bool F8> __device__ __forceinline__ void cvt_run(const PrepArgs& a, int it_lo, int it_hi, int wv0, int nwv, LAS float* scr, int lane) {
    int it = it_lo + wv0; if (it >= it_hi) return;
    float wa[32], wb[32];
    if constexpr (F8) {
        CvtItem c = cvt_decode8(a, it); cvt_load(c, 0, wa, lane);
        for (;;) {
            cvt_load(c, 1, wb, lane);
            cvt_store<true>(c, 0, wa, scr, lane);
            const int itn = it + nwv; const bool hn = itn < it_hi;
            const CvtItem cn = cvt_decode8(a, hn ? itn : it); cvt_load(cn, 0, wa, lane);
            cvt_store<true>(c, 1, wb, scr, lane);
            if (!hn) break;
            c = cn; it = itn;
        }
    } else {
        CvtItem ca = cvt_decode16(a, it), cb;  cvt_load(ca, 0, wa, lane);
        for (;;) {
            int itn = it + nwv; bool hn = itn < it_hi;
            cb = cvt_decode16(a, hn ? itn : it); cvt_load(cb, 0, wb, lane);
            cvt_store<false>(ca, 0, wa, scr, lane);
            if (!hn) break;
            it = itn; itn = it + nwv; hn = itn < it_hi;
            ca = cvt_decode16(a, hn ? itn : it); cvt_load(ca, 0, wa, lane);
            cvt_store<false>(cb, 0, wb, scr, lane);
            if (!hn) break;
            it = itn;
        }
    }
}
__device__ __forceinline__ void ph_convert(const PrepArgs& a, LAS unsigned char* lds, int bid, int G) {
    const int tid = threadIdx.x, lane = tid & 63, wave = tid >> 6;
    LAS float* scr = (LAS float*)(lds + wave * 8448);
    { u32x4* z = (u32x4*)(a.WTIN + (size_t)(PC_AD + 32) * DM); const int nz = (PROJ_LD - PC_AD - 32) * DM * 2 / 16;
      for (int i = bid * 512 + tid; i < nz; i += G * 512) z[i] = (u32x4){0u, 0u, 0u, 0u}; }
    cvt_run<false>(a, 0, IT16, bid * 8 + wave, G * 8, scr, lane);
    cvt_run<true>(a, 0, CVT_Q0, bid * 8 + wave, G * 8, scr, lane);
}
__device__ __forceinline__ void ph_convert_bg(const PrepArgs& a, int lo, int hi, int pid, int npid, LAS unsigned char* lds) {
    const int lane = threadIdx.x & 63, wave = threadIdx.x >> 6;
    if (pid < 0) return;
    cvt_run<true>(a, lo, hi, pid, npid, (LAS float*)(lds + 32768 + wave * 8448), lane);
}
__device__ __forceinline__ void ph_modulate(const PrepArgs& a, int bid, int G) {
    const int tid = threadIdx.x, lane = tid & 63, wave = tid >> 6;
    const int gw = bid * 8 + wave, NGW = G * 8;
    for (int m0 = gw; m0 < M_ALL; m0 += 2 * NGW) {
        const float* src[2]; int v[2]; int mm[2]; bool ok[2];
#pragma unroll
        for (int r = 0; r < 2; ++r) { const int m = m0 + r * NGW; ok[r] = m < M_ALL; mm[r] = ok[r] ? m : m0;
            if (mm[r] < M_LAT) { src[r] = a.x + (size_t)mm[r] * DM; v[r] = mm[r] / SEQ; } else { src[r] = a.ctx + (size_t)(mm[r] - M_LAT) * DM; v[r] = 4; } }
        f32x4 xv[2][4]; float ss[2] = {0.f, 0.f};
#pragma unroll
        for (int r = 0; r < 2; ++r)
#pragma unroll
            for (int j = 0; j < 4; ++j) xv[r][j] = ((const f32x4*)src[r])[lane + 64 * j];
#pragma unroll
        for (int r = 0; r < 2; ++r)
#pragma unroll
            for (int j = 0; j < 4; ++j) ss[r] += (xv[r][j].x * xv[r][j].x + xv[r][j].y * xv[r][j].y) + (xv[r][j].z * xv[r][j].z + xv[r][j].w * xv[r][j].w);
#pragma unroll
        for (int o = 1; o < 64; o <<= 1) { ss[0] += __shfl_xor(ss[0], o); ss[1] += __shfl_xor(ss[1], o); }
#pragma unroll
        for (int r = 0; r < 2; ++r) { if (!ok[r]) continue;
            const float rstd = rsqrtf(ss[r] * (1.f / DM) + EPS);
            const float* mv = a.mod + (size_t)v[r] * 6144;
            unsigned long long* o8 = (unsigned long long*)(a.H + (size_t)mm[r] * DM) + lane;
#pragma unroll
            for (int j = 0; j < 4; ++j) { const int col = 4 * lane + 256 * j;
                const f32x4 g = *(const f32x4*)(a.g_pre + col), sh = *(const f32x4*)(mv + col), sc = *(const f32x4*)(mv + 1024 + col);
                const f32x4 hv = xv[r][j] * rstd * g * (sc + 1.f) + sh;
                o8[64 * j] = (unsigned long long)pk2(hv.x, hv.y) | ((unsigned long long)pk2(hv.z, hv.w) << 32); } }
    }
}


__device__ __forceinline__ void tok_of_row(int row, int& bb, int& tk) { if (row < M_LAT) { bb = row >> 12; tk = row & (SEQ - 1); } else { const int r2 = row - M_LAT; bb = r2 >> 8; tk = SEQ + (r2 & (CTXL - 1)); } }
struct EpiProj {
    static constexpr bool PERM = true, AFTER_DRAIN = false;
    bf16_t* O; int ldc; bf16_t* KH;
    __device__ __forceinline__ void operator()(const f32x4 (&acc)[2][2][4][2], const pg8::Unit& u, int wr, int wc, int fr, int fq) const {
        const int row0 = u.pm * 256 + wr * 64 + fr, col0 = u.pn * 256 + wc * 32 + 8 * fq;
#pragma unroll
        for (int ai = 0; ai < 2; ++ai)
#pragma unroll
            for (int m = 0; m < 4; ++m) { const int row = row0 + ai * 128 + m * 16; int bb, tk; tok_of_row(row, bb, tk);
#pragma unroll
                for (int bj = 0; bj < 2; ++bj) { const f32x4 v0 = acc[ai][bj][m][0], v1 = acc[ai][bj][m][1];
                    u32x4 w; w.x = pg8::cvt_pk_bf16(v0[0], v0[1]); w.y = pg8::cvt_pk_bf16(v0[2], v0[3]); w.z = pg8::cvt_pk_bf16(v1[0], v1[1]); w.w = pg8::cvt_pk_bf16(v1[2], v1[3]);
                    const int col = col0 + bj * 128;
                    if (u.pn < 2) { const int hh = col >> 6, ks = (col >> 5) & 1; *(u32x4*)(KH + ((size_t)((bb * 8 + hh) * 2 + ks) * TKB + tk) * 32 + (col & 31)) = w; }
                    else *(u32x4*)(O + (size_t)row * ldc + col) = w; } }
    }
};
struct EpiVal {
    static constexpr bool PERM = true, AFTER_DRAIN = false;
    bf16_t* VT; int ldc; bf16_t* VB;
    __device__ __forceinline__ void operator()(const f32x4 (&acc)[2][2][4][2], const pg8::Unit& u, int wr, int wc, int fr, int fq) const {
        const int row0 = u.pm * 256 + wr * 64 + fr, col0 = u.pn * 256 + wc * 32 + 8 * fq;
#pragma unroll
        for (int ai = 0; ai < 2; ++ai)
#pragma unroll
            for (int m = 0; m < 4; ++m) { const int vr = row0 + ai * 128 + m * 16;
#pragma unroll
                for (int bj = 0; bj < 2; ++bj) { const f32x4 v0 = acc[ai][bj][m][0], v1 = acc[ai][bj][m][1];
                    u32x4 w; w.x = pg8::cvt_pk_bf16(v0[0], v0[1]); w.y = pg8::cvt_pk_bf16(v0[2], v0[3]); w.z = pg8::cvt_pk_bf16(v1[0], v1[1]); w.w = pg8::cvt_pk_bf16(v1[2], v1[3]);
                    const int col = col0 + bj * 128;
                    if (u.pm < 2) { int bb, tk; tok_of_row(col, bb, tk); const int hh = vr >> 6, dt = (vr >> 4) & 3, dd = vr & 15;
                        *(u32x4*)(VB + ((size_t)(((bb * 8 + hh) * 4 + dt) * (TKB / 8) + (tk >> 3)) * 16 + dd) * 8) = w; }
                    else *(u32x4*)(VT + (size_t)vr * ldc + col) = w; } }
    }
};
struct InOrder {
    int G, c; const char* H; const char* WTIN; const char* WTV;
    static constexpr int NLAT = 64 * 9, NCTX = 16, NV = 4 * 68, NALL = NLAT + NCTX + NV;
    __device__ __forceinline__ bool next(int i, pg8::Unit& u) const {
        const int L = i * G + c; if (L >= NALL) return false;
        constexpr size_t ts = (size_t)256 * DM * 2;
        if (L < NLAT) { pg8::StaticOrder S; S.nM = 64; S.nN = 9; S.nwg = NLAT; S.G = NLAT; S.c = L; S.A = H; S.B = WTIN; S.ts = ts; S.next(0, u); return true; }
        if (L < NLAT + NCTX) { const int j = L - NLAT, q = j & 3; u.pm = 64 + (j >> 2); u.pn = q == 3 ? 8 : q; u.bt = u.pn; u.kind = 0; u.a = H + (size_t)u.pm * ts; u.b = WTIN + (size_t)u.bt * ts; return true; }
        const int j = L - NLAT - NCTX; u.pm = j & 3; u.pn = j >> 2; u.bt = u.pn; u.kind = 1; u.a = WTV + (size_t)u.pm * ts; u.b = H + (size_t)u.bt * ts; return true;
    }
    __device__ __forceinline__ void a_ready(const pg8::Unit&) const {}
    __device__ __forceinline__ void done(const pg8::Unit&) const {}
};
struct EpiIn {
    static constexpr bool PERM = true, AFTER_DRAIN = false;
    EpiProj P; EpiVal V;
    __device__ __forceinline__ void operator()(const f32x4 (&acc)[2][2][4][2], const pg8::Unit& u, int wr, int wc, int fr, int fq) const { if (u.kind == 0) P(acc, u, wr, wc, fr, fq); else V(acc, u, wr, wc, fr, fq); }
};
struct EpiSwiGLU {
    static constexpr bool PERM = true, AFTER_DRAIN = false;
    unsigned char* O; int ldc;
    __device__ __forceinline__ void operator()(const f32x4 (&acc)[2][2][4][2], const pg8::Unit& u, int wr, int wc, int fr, int fq) const {
        const int row0 = u.pm * 256 + wr * 64 + fr, col0 = u.pn * 128 + wc * 32 + 8 * fq;
        constexpr float DS = 1.f / (SX8 * SW1);
#pragma unroll
        for (int ai = 0; ai < 2; ++ai)
#pragma unroll
            for (int m = 0; m < 4; ++m) { unsigned char* rowp = O + (size_t)(row0 + ai * 128 + m * 16) * ldc + col0;
                const f32x4 g0 = acc[ai][0][m][0] * DS, g1 = acc[ai][0][m][1] * DS, u0 = acc[ai][1][m][0] * (DS * SH8), u1 = acc[ai][1][m][1] * (DS * SH8);
                uint2 w; w.x = pk4_fp8(silu_f(g0[0]) * u0[0], silu_f(g0[1]) * u0[1], silu_f(g0[2]) * u0[2], silu_f(g0[3]) * u0[3]);
                w.y = pk4_fp8(silu_f(g1[0]) * u1[0], silu_f(g1[1]) * u1[1], silu_f(g1[2]) * u1[2], silu_f(g1[3]) * u1[3]);
                *(uint2*)rowp = w; }
    }
};
struct EpiRowScale {
    static constexpr bool PERM = true, AFTER_DRAIN = false;
    bf16_t* O; int ldc; const float* rowscale;
    __device__ __forceinline__ void operator()(const f32x4 (&acc)[2][2][4][2], const pg8::Unit& u, int wr, int wc, int fr, int fq) const {
        const int row0 = u.pm * 256 + wr * 64 + fr, col0 = u.pn * 256 + wc * 32 + 8 * fq;
#pragma unroll
        for (int ai = 0; ai < 2; ++ai)
#pragma unroll
            for (int m = 0; m < 4; ++m) { const int row = row0 + ai * 128 + m * 16; const float sc = rowscale[row] * (1.f / (SH8 * SW2)); bf16_t* rowp = O + (size_t)row * ldc + col0;
#pragma unroll
                for (int bj = 0; bj < 2; ++bj) { const f32x4 v0 = acc[ai][bj][m][0] * sc, v1 = acc[ai][bj][m][1] * sc;
                    u32x4 w; w.x = pg8::cvt_pk_bf16(v0[0], v0[1]); w.y = pg8::cvt_pk_bf16(v0[2], v0[3]); w.z = pg8::cvt_pk_bf16(v1[0], v1[1]); w.w = pg8::cvt_pk_bf16(v1[2], v1[3]);
                    *(u32x4*)(rowp + bj * 128) = w; } }
    }
};
struct ExpertOrder {
    int nT, G, c; const char* A; const char* B; size_t ts;
    __device__ __forceinline__ bool next(int i, pg8::Unit& u) const {
        if (G == 256) { const int x = c & 7, j = c >> 3, mt = j & 7, q = j >> 3;
            int e, pn;
            if (nT == 4) { if (i >= 2) return false; e = 2 * x + i; pn = q; }
            else { if (i >= 11) return false;
                if (i < 5) { e = 2 * x; pn = 4 * i + q; } else if (i == 5) { e = 2 * x + (q >> 1); pn = 20 + (q & 1); } else { e = 2 * x + 1; pn = 4 * (i - 6) + q; } }
            u.pm = e * 8 + mt; u.pn = pn; u.bt = e * nT + pn; u.kind = 0; u.a = A + (size_t)u.pm * ts; u.b = B + (size_t)u.bt * ts; return true; }
        const long L = (long)i * G + c; if (L >= (long)128 * nT) return false;
        const int e = (int)(L / (8 * nT)), r = (int)(L % (8 * nT)); u.pm = e * 8 + (r % 8); u.pn = r / 8; u.bt = e * nT + u.pn; u.kind = 0; u.a = A + (size_t)u.pm * ts; u.b = B + (size_t)u.bt * ts; return true;
    }
    __device__ __forceinline__ void a_ready(const pg8::Unit&) const {}
    __device__ __forceinline__ void done(const pg8::Unit&) const {}
};
__device__ __forceinline__ void ph_na_naive(const bf16_t* __restrict__ PROJ, const bf16_t* __restrict__ VT, const float* __restrict__ rpb, bf16_t* __restrict__ OMIX, int bid, int G) {
  for (int vb = bid * 8 + (threadIdx.x >> 6); vb < NB * 8 * 64; vb += G * 8) {
    const int r = vb % 64, h = (vb / 64) % 8, b = vb / 512, c = threadIdx.x & 63;
    const size_t mq = (size_t)b * SEQ + r * 64 + c;
    float q[64], acc[64];
    { const u32x4* qp = (const u32x4*)(PROJ + mq * PROJ_LD + PC_NAQ + h * 64);
#pragma unroll
      for (int i = 0; i < 8; ++i) { const u32x4 w = qp[i]; q[8 * i + 0] = __uint_as_float(w.x << 16); q[8 * i + 1] = __uint_as_float(w.x & 0xffff0000u); q[8 * i + 2] = __uint_as_float(w.y << 16); q[8 * i + 3] = __uint_as_float(w.y & 0xffff0000u);
          q[8 * i + 4] = __uint_as_float(w.z << 16); q[8 * i + 5] = __uint_as_float(w.z & 0xffff0000u); q[8 * i + 6] = __uint_as_float(w.w << 16); q[8 * i + 7] = __uint_as_float(w.w & 0xffff0000u); } }
#pragma unroll
    for (int d = 0; d < 64; ++d) acc[d] = 0.f;
    float mx = -INFINITY, l = 0.f;
    const int rs = min(max(r - 4, 0), 56), cs = min(max(c - 8, 0), 48);
    for (int kk = 0; kk < 128 + CTXL; ++kk) {
        size_t mk; float bias = 0.f;
        if (kk < 128) { const int krow = rs + (kk >> 4), kcol = cs + (kk & 15); mk = (size_t)b * SEQ + krow * 64 + kcol; bias = rpb[(h * 15 + (krow - r + 7)) * 31 + (kcol - c + 15)]; }
        else mk = (size_t)M_LAT + b * CTXL + (kk - 128);
        const u32x4* kp = (const u32x4*)(PROJ + mk * PROJ_LD + PC_NAK + h * 64);
        float s = 0.f;
#pragma unroll
        for (int i = 0; i < 8; ++i) { const u32x4 w = kp[i];
            s += q[8 * i + 0] * __uint_as_float(w.x << 16) + q[8 * i + 1] * __uint_as_float(w.x & 0xffff0000u) + q[8 * i + 2] * __uint_as_float(w.y << 16) + q[8 * i + 3] * __uint_as_float(w.y & 0xffff0000u)
               + q[8 * i + 4] * __uint_as_float(w.z << 16) + q[8 * i + 5] * __uint_as_float(w.z & 0xffff0000u) + q[8 * i + 6] * __uint_as_float(w.w << 16) + q[8 * i + 7] * __uint_as_float(w.w & 0xffff0000u); }
        s += bias;
        const float mn = fmaxf(mx, s), al = __expf(mx - mn), p = __expf(s - mn);
        l = l * al + p; mx = mn;
        const bf16_t* vp = VT + (size_t)(h * 64) * VT_LD + mk;
#pragma unroll
        for (int d = 0; d < 64; ++d) acc[d] = acc[d] * al + p * bf2f(vp[(size_t)d * VT_LD]);
    }
    const float inv = 1.f / l;
    unsigned* op = (unsigned*)(OMIX + mq * DM + h * 64);
#pragma unroll
    for (int i = 0; i < 32; ++i) op[i] = pk2(acc[2 * i] * inv, acc[2 * i + 1] * inv);
  }
}

__device__ __forceinline__ f32x4 mfma16(bf16x8 a, bf16x8 b, f32x4 c) { return __builtin_amdgcn_mfma_f32_16x16x32_bf16(a, b, c, 0, 0, 0); }
__device__ __forceinline__ void na_unit(int u, const bf16_t* __restrict__ PROJ, const bf16_t* __restrict__ KH, const bf16_t* __restrict__ VB, const LAS float* rb, const LAS unsigned char* ck, const LAS unsigned char* cv, bf16_t* __restrict__ OMIX, int lane) {
    const int q = lane & 15, g = lane >> 4;
    const int bh = u >> 8, b = bh >> 3, h = bh & 7, r = (u & 255) >> 2, qt = u & 3;
    const int c0 = (qt == 0) ? 0 : (qt == 3 ? 32 : 16 * qt - 8);
    const int rs = min(max(r - 4, 0), 56);
    const int cq = 16 * qt + q, cs = min(max(cq - 8, 0), 48);
    const size_t mq = (size_t)b * SEQ + r * 64 + cq;
    const bf16_t* qp = PROJ + mq * PROJ_LD + PC_NAQ + h * 64 + 8 * g;
    const bf16x8 qf0 = *(const bf16x8*)qp, qf1 = *(const bf16x8*)(qp + 32);
    const bf16_t* kb0 = KH + ((size_t)(bh * 2) * TKB + 8 * (q >> 2) + (q & 3)) * 32 + 8 * g;
    const bf16_t* kb1 = kb0 + (size_t)TKB * 32;
    f32x4 S[32];
#pragma unroll
    for (int p = 0; p < 8; ++p) {
        const int s = (rs + p) * 64 + c0;
#pragma unroll
        for (int half = 0; half < 2; ++half) {
            const size_t off = (size_t)(s + 4 * half) * 32;
            f32x4 acc = (f32x4){0.f, 0.f, 0.f, 0.f};
            acc = mfma16(*(const bf16x8*)(kb0 + off), qf0, acc); acc = mfma16(*(const bf16x8*)(kb1 + off), qf1, acc);
            const LAS float* rbr = rb + (h * 15 + (rs + p - r + 7)) * 31;
#pragma unroll
            for (int i = 0; i < 4; ++i) { const int kcol = c0 + 8 * g + 4 * half + i; const bool valid = (kcol >= cs) && (kcol < cs + 16);
                const float bias = rbr[min(max(kcol - cq + 15, 0), 30)];
                acc[i] = valid ? acc[i] + bias : -INFINITY; }
            S[2 * p + half] = acc;
        }
    }
#pragma unroll
    for (int p = 0; p < 8; ++p)
#pragma unroll
        for (int half = 0; half < 2; ++half) { const LAS unsigned char* kp = ck + ((p * 2 + half) * 2) * 1024 + lane * 16;
            f32x4 acc = (f32x4){0.f, 0.f, 0.f, 0.f};
            acc = mfma16(*(const LAS bf16x8*)kp, qf0, acc); acc = mfma16(*(const LAS bf16x8*)(kp + 1024), qf1, acc);
            S[16 + 2 * p + half] = acc; }
    float mx4[4] = {-INFINITY, -INFINITY, -INFINITY, -INFINITY};
#pragma unroll
    for (int T = 0; T < 32; ++T) mx4[T & 3] = fmaxf(fmaxf(mx4[T & 3], fmaxf(S[T][0], S[T][1])), fmaxf(S[T][2], S[T][3]));
    float mx = fmaxf(fmaxf(mx4[0], mx4[1]), fmaxf(mx4[2], mx4[3]));
    mx = fmaxf(mx, __shfl_xor(mx, 16)); mx = fmaxf(mx, __shfl_xor(mx, 32));
    float l4[4] = {0.f, 0.f, 0.f, 0.f};
#pragma unroll
    for (int T = 0; T < 32; ++T) {
#pragma unroll
        for (int i = 0; i < 4; ++i) { const float p = __expf(S[T][i] - mx); S[T][i] = p; l4[i] += p; } }
    float l = (l4[0] + l4[1]) + (l4[2] + l4[3]);
    l += __shfl_xor(l, 16); l += __shfl_xor(l, 32);
    f32x4 O[4];
#pragma unroll
    for (int dt = 0; dt < 4; ++dt) O[dt] = (f32x4){0.f, 0.f, 0.f, 0.f};
    const bf16_t* vb0 = VB + ((size_t)(bh * 4) * (TKB / 8) * 16 + (size_t)g * 16 + q) * 8;
#pragma unroll
    for (int p = 0; p < 16; ++p) {
        u32x4 pw; pw.x = pg8::cvt_pk_bf16(S[2 * p][0], S[2 * p][1]); pw.y = pg8::cvt_pk_bf16(S[2 * p][2], S[2 * p][3]); pw.z = pg8::cvt_pk_bf16(S[2 * p + 1][0], S[2 * p + 1][1]); pw.w = pg8::cvt_pk_bf16(S[2 * p + 1][2], S[2 * p + 1][3]);
        const bf16x8 pb = __builtin_bit_cast(bf16x8, pw);
        if (p < 8) { const int s = (rs + p) * 64 + c0;
#pragma unroll
            for (int dt = 0; dt < 4; ++dt) O[dt] = mfma16(*(const bf16x8*)(vb0 + ((size_t)dt * (TKB / 8) + (s >> 3)) * 128), pb, O[dt]);
        } else {
#pragma unroll
            for (int dt = 0; dt < 4; ++dt) O[dt] = mfma16(*(const LAS bf16x8*)(cv + ((p - 8) * 4 + dt) * 1024 + lane * 16), pb, O[dt]);
        }
    }
    const float inv = 1.f / l;
    bf16_t* op = OMIX + mq * DM + h * 64 + 4 * g;
#pragma unroll
    for (int dt = 0; dt < 4; ++dt) { uint2 w; w.x = pg8::cvt_pk_bf16(O[dt][0] * inv, O[dt][1] * inv); w.y = pg8::cvt_pk_bf16(O[dt][2] * inv, O[dt][3] * inv); *(uint2*)(op + dt * 16) = w; }
}
__device__ __forceinline__ void ph_na(const bf16_t* __restrict__ PROJ, const bf16_t* __restrict__ KH, const bf16_t* __restrict__ VB, const float* __restrict__ rpb, bf16_t* __restrict__ OMIX, LAS unsigned char* lds, int bid, int G) {
    LAS float* rb = (LAS float*)lds;
    LAS unsigned char* ck = lds + 16384; LAS unsigned char* cv = lds + 49152;
    const int lane = threadIdx.x & 63, wave = threadIdx.x >> 6;
    __syncthreads();
    for (int i = threadIdx.x; i < 8 * 15 * 31; i += 512) rb[i] = rpb[i];
    for (int u0 = bid * 32; u0 < NB * 8 * 64 * 4; u0 += G * 32) {
        const int bh = u0 >> 8;
        __syncthreads();
        for (int i = threadIdx.x; i < 2048; i += 512) { const int ln = i & 63, ks = (i >> 6) & 1, half = (i >> 7) & 1, p = i >> 8, q = ln & 15, g = ln >> 4;
            *(LAS u32x4*)(ck + i * 16) = *(const u32x4*)(KH + ((size_t)(bh * 2 + ks) * TKB + SEQ + 32 * p + 8 * (q >> 2) + (q & 3) + 4 * half) * 32 + 8 * g); }
        for (int i = threadIdx.x; i < 2048; i += 512) { const int ln = i & 63, dt = (i >> 6) & 3, p = i >> 8;
            *(LAS u32x4*)(cv + i * 16) = *(const u32x4*)(VB + ((size_t)((bh * 4 + dt) * (TKB / 8) + SEQ / 8 + 4 * p) * 16) * 8 + ln * 8); }
        __syncthreads();
#pragma unroll 1
        for (int it = 0; it < 4; ++it) na_unit(u0 + it * 8 + wave, PROJ, KH, VB, rb, ck, cv, OMIX, lane);
    }
}

typedef float f32x16 __attribute__((ext_vector_type(16)));
__device__ __forceinline__ f32x16 mfma32(bf16x8 a, bf16x8 b, f32x16 c) { return __builtin_amdgcn_mfma_f32_32x32x16_bf16(a, b, c, 0, 0, 0); }
constexpr int NCHUNK = 272;
__device__ __forceinline__ float logsig16(float z) { return (fminf(z, 0.f) - log1pf(__expf(-fabsf(z)))) * (1.f / 16.f); }
__device__ __forceinline__ void ph_upf(const float* __restrict__ a_up, bf16_t* __restrict__ UPF, int bid, int G) {
    for (int e = bid * 512 + threadIdx.x; e < 1024; e += G * 512) { const int dir = e >> 9, h = (e >> 7) & 3, dd = (e >> 6) & 1, ln = e & 63, d5 = ln & 31, h2 = ln >> 5;
        float v[8];
#pragma unroll
        for (int j = 0; j < 8; ++j) v[j] = a_up[(size_t)(dir * 16 + 8 * h2 + j) * 256 + h * 64 + 32 * dd + d5];
        *(u32x4*)(UPF + (size_t)e * 8) = (u32x4){pk2(v[0], v[1]), pk2(v[2], v[3]), pk2(v[4], v[5]), pk2(v[6], v[7])}; }
}
__device__ __forceinline__ float scan32(float v) {
    v += __int_as_float(__builtin_amdgcn_update_dpp(0, __float_as_int(v), 0x111, 0xf, 0xf, true));
    v += __int_as_float(__builtin_amdgcn_update_dpp(0, __float_as_int(v), 0x112, 0xf, 0xf, true));
    v += __int_as_float(__builtin_amdgcn_update_dpp(0, __float_as_int(v), 0x114, 0xf, 0xf, true));
    v += __int_as_float(__builtin_amdgcn_update_dpp(0, __float_as_int(v), 0x118, 0xf, 0xf, true));
    v += __int_as_float(__builtin_amdgcn_update_dpp(0, __float_as_int(v), 0x142, 0xa, 0xf, false));
    return v;
}
__device__ __forceinline__ void gla_prep_unit(int uu, const bf16_t* __restrict__ PROJ, const bf16_t* __restrict__ UPF, const float* __restrict__ a_bias, bf16_t* __restrict__ QF, bf16_t* __restrict__ KF, bf16_t* __restrict__ KFT, float* __restrict__ AT,
                                              const LAS float* tab, const LAS float* lbias, const LAS unsigned char* lupf, LAS unsigned char* tile, int lane) {
    const int h = uu & 3, ci = uu >> 2;
    const bool lat = ci < 256;
    const int crow = ci & 63;
    const int m0 = lat ? ((ci >> 6) * SEQ + crow * 64) : (M_LAT + (ci - 256) * 64);
    const int l31 = lane & 31, hh = lane >> 5;
    constexpr int TS2 = 144;
    bf16x8 adf[2][2];
#pragma unroll
    for (int dir = 0; dir < 2; ++dir)
#pragma unroll
        for (int tt = 0; tt < 2; ++tt) adf[dir][tt] = *(const bf16x8*)(PROJ + (unsigned)((m0 + 32 * tt + l31) * PROJ_LD + PC_AD + dir * 16 + 8 * hh));
#pragma unroll 1
    for (int dd = 0; dd < 2; ++dd) {
        const int dbase = h * 64 + 32 * dd + 4 * hh;
        float kv[2][16], qv[2][16];
#pragma unroll
        for (int tt = 0; tt < 2; ++tt)
#pragma unroll
            for (int rr = 0; rr < 4; ++rr) { const unsigned ro = (unsigned)((m0 + 32 * tt + l31) * PROJ_LD + dbase + 8 * rr);
                const uint2 kw = *(const uint2*)(PROJ + ro + PC_GK);
                kv[tt][4 * rr] = __uint_as_float(kw.x << 16); kv[tt][4 * rr + 1] = __uint_as_float(kw.x & 0xffff0000u); kv[tt][4 * rr + 2] = __uint_as_float(kw.y << 16); kv[tt][4 * rr + 3] = __uint_as_float(kw.y & 0xffff0000u);
                if (lat) { const uint2 qw = *(const uint2*)(PROJ + ro + PC_GQ);
                    qv[tt][4 * rr] = __uint_as_float(qw.x << 16); qv[tt][4 * rr + 1] = __uint_as_float(qw.x & 0xffff0000u); qv[tt][4 * rr + 2] = __uint_as_float(qw.y << 16); qv[tt][4 * rr + 3] = __uint_as_float(qw.y & 0xffff0000u); }
                else { qv[tt][4 * rr] = 0.f; qv[tt][4 * rr + 1] = 0.f; qv[tt][4 * rr + 2] = 0.f; qv[tt][4 * rr + 3] = 0.f; } }
        if (lat) {
#pragma unroll
            for (int tt = 0; tt < 2; ++tt) { const int pos = dd ? (32 * tt + l31) : crow;
#pragma unroll
                for (int r2 = 0; r2 < 2; ++r2) {
                    const LAS float* tp = tab + 2 * (pos * 16 + 8 * r2 + 4 * hh);
                    const f32x4 c01 = *(const LAS f32x4*)tp, c23 = *(const LAS f32x4*)(tp + 4);
                    const float cs[4] = {c01[0], c01[2], c23[0], c23[2]}, sn[4] = {c01[1], c01[3], c23[1], c23[3]};
#pragma unroll
                    for (int k = 0; k < 4; ++k) { const int lo = 4 * r2 + k, hi = lo + 8;
                        const float k1 = kv[tt][lo], k2 = kv[tt][hi], q1 = qv[tt][lo], q2 = qv[tt][hi];
                        kv[tt][lo] = k1 * cs[k] - k2 * sn[k]; kv[tt][hi] = k1 * sn[k] + k2 * cs[k];
                        qv[tt][lo] = q1 * cs[k] - q2 * sn[k]; qv[tt][hi] = q1 * sn[k] + q2 * cs[k]; } } }
        }
#pragma unroll
        for (int dir = 0; dir < 2; ++dir) {
            const bf16x8 upf = *(const LAS bf16x8*)(lupf + (((dir * 4 + h) * 2 + dd) * 64 + lane) * 16);
            float lam[2][16], la1[16];
            float tot0[16];
            f32x4 zb[4];
#pragma unroll
            for (int rr = 0; rr < 4; ++rr) zb[rr] = *(const LAS f32x4*)(lbias + dir * 256 + dbase + 8 * rr);
#pragma unroll
            for (int tt = 0; tt < 2; ++tt) { f32x16 Z;
#pragma unroll
                for (int i = 0; i < 16; ++i) Z[i] = 0.f;
                Z = mfma32(upf, adf[dir][tt], Z);
                float la[16], p[16];
#pragma unroll
                for (int i = 0; i < 16; ++i) { const float z = Z[i] + zb[i >> 2][i & 3]; la[i] = (fminf(z, 0.f) - __logf(1.f + __expf(-fabsf(z)))) * (1.f / 16.f); p[i] = la[i]; }
#pragma unroll
                for (int i = 0; i < 16; ++i) p[i] += __int_as_float(__builtin_amdgcn_update_dpp(0, __float_as_int(p[i]), 0x111, 0xf, 0xf, true));
#pragma unroll
                for (int i = 0; i < 16; ++i) p[i] += __int_as_float(__builtin_amdgcn_update_dpp(0, __float_as_int(p[i]), 0x112, 0xf, 0xf, true));
#pragma unroll
                for (int i = 0; i < 16; ++i) p[i] += __int_as_float(__builtin_amdgcn_update_dpp(0, __float_as_int(p[i]), 0x114, 0xf, 0xf, true));
#pragma unroll
                for (int i = 0; i < 16; ++i) p[i] += __int_as_float(__builtin_amdgcn_update_dpp(0, __float_as_int(p[i]), 0x118, 0xf, 0xf, true));
#pragma unroll
                for (int i = 0; i < 16; ++i) p[i] += __int_as_float(__builtin_amdgcn_update_dpp(0, __float_as_int(p[i]), 0x142, 0xa, 0xf, false));
#pragma unroll
                for (int i = 0; i < 16; ++i) {
                    if (tt == 1) p[i] += tot0[i];
                    const float t31 = __int_as_float(__builtin_amdgcn_readlane(__float_as_int(p[i]), 31)), t63 = __int_as_float(__builtin_amdgcn_readlane(__float_as_int(p[i]), 63));
                    const float tl = hh ? t63 : t31;
                    if (tt == 0) { la1[i] = la[i]; lam[0][i] = p[i]; tot0[i] = tl; }
                    else { tot0[i] = tl; lam[1][i] = dir ? (tl - p[i] + la[i]) : p[i]; }
                }
                if (tt == 1 && dir) {
#pragma unroll
                    for (int i = 0; i < 16; ++i) lam[0][i] = tot0[i] - lam[0][i] + la1[i];
                }
            }
            if (l31 == 0) {
#pragma unroll
                for (int rr = 0; rr < 4; ++rr) *(f32x4*)(AT + (unsigned)((dir * NCHUNK + ci) * 256 + dbase + 8 * rr)) = (f32x4){__expf(tot0[4 * rr]), __expf(tot0[4 * rr + 1]), __expf(tot0[4 * rr + 2]), __expf(tot0[4 * rr + 3])};
            }
#pragma unroll
            for (int tt = 0; tt < 2; ++tt) { const int t = 32 * tt + l31;
#pragma unroll
                for (int rr = 0; rr < 4; ++rr) { unsigned kb[4], qb[4];
#pragma unroll
                    for (int k = 0; k < 4; ++k) { const int i = 4 * rr + k; const float el = __expf(lam[tt][i]);
                        kb[k] = f2bf(kv[tt][i] * __expf(-lam[tt][i])); qb[k] = f2bf(qv[tt][i] * el);
                        *(LAS bf16_t*)(tile + (8 * rr + 4 * hh + k) * TS2 + t * 2) = (bf16_t)kb[k]; }
                    if (lat) { const unsigned mo = (unsigned)((dir * M_LAT + m0 + t) * 256 + dbase + 8 * rr);
                        *(uint2*)(QF + mo) = make_uint2(qb[0] | (qb[1] << 16), qb[2] | (qb[3] << 16)); *(uint2*)(KF + mo) = make_uint2(kb[0] | (kb[1] << 16), kb[2] | (kb[3] << 16)); } } }
            asm volatile("s_waitcnt lgkmcnt(0)" ::: "memory");
#pragma unroll
            for (int j = 0; j < 4; ++j) { const int ch = lane + 64 * j, dl = ch >> 3, c8 = ch & 7;
                *(u32x4*)(KFT + (unsigned)((dir * 256 + h * 64 + 32 * dd + dl) * M_ALL + m0 + 8 * c8)) = *(const LAS u32x4*)(tile + dl * TS2 + c8 * 16); }
            asm volatile("s_waitcnt lgkmcnt(0)" ::: "memory");
        }
    }
}
__device__ __forceinline__ void ph_gla_prep2(const bf16_t* __restrict__ PROJ, const bf16_t* __restrict__ UPF, const float* __restrict__ a_bias, bf16_t* __restrict__ QF, bf16_t* __restrict__ KF, bf16_t* __restrict__ KFT, float* __restrict__ AT,
                                             LAS unsigned char* lds, int bid, int G) {
    LAS float* tab = (LAS float*)(lds + 16384);
    LAS float* lbias = (LAS float*)(lds + 24576);
    LAS unsigned char* lupf = lds + 26624;
    __syncthreads();
    lbias[threadIdx.x] = a_bias[threadIdx.x];
    for (int i = threadIdx.x; i < 1024; i += 512) *(LAS u32x4*)(lupf + i * 16) = *(const u32x4*)(UPF + (size_t)i * 8);
    for (int i = threadIdx.x; i < 1024; i += 512) { const int pos = i >> 4, fi = i & 15; const float ang = (float)pos * powf(10000.f, -(float)fi / 16.f); tab[2 * i] = cosf(ang); tab[2 * i + 1] = sinf(ang); }
    __syncthreads();
    const int lane = threadIdx.x & 63, wave = threadIdx.x >> 6;
#ifndef REP_GP
#define REP_GP 1
#endif
    for (int rep_ = 0; rep_ < REP_GP; ++rep_)
    for (int u = bid * 8 + wave; u < NCHUNK * 4; u += G * 8) gla_prep_unit(__builtin_amdgcn_readfirstlane(u), PROJ, UPF, a_bias, QF, KF, KFT, AT, tab, lbias, lupf, lds + 49152 + wave * 4608, lane);
}
constexpr size_t SB_CH = 128 * 64;
__device__ __forceinline__ void gla_state_unit(int u, const bf16_t* __restrict__ KFT, const bf16_t* __restrict__ VT, const float* __restrict__ AT, bf16_t* __restrict__ SB, int lane) {
    const int es = u & 3, dir = (u >> 2) & 1, h = (u >> 3) & 3, b = u >> 5;
    const int l31 = lane & 31, hh = lane >> 5;
    f32x16 acc[2];
#pragma unroll
    for (int dt = 0; dt < 2; ++dt)
#pragma unroll
        for (int i = 0; i < 16; ++i) acc[dt][i] = 0.f;
    const bf16_t* kft0 = KFT + ((size_t)dir * 256 + h * 64 + l31) * M_ALL + 8 * hh;
    const bf16_t* vt0 = VT + (size_t)(512 + h * 128 + es * 32 + l31) * VT_LD + 8 * hh;
    bf16_t* sb0 = SB + ((size_t)((dir * NB + b) * 4 + h) * 64) * SB_CH + (size_t)(es * 32 + l31) * 64 + 4 * hh;
    for (int s = 0; s < 68; ++s) {
        int ci, m0, c = 0;
        if (s < 4) { const int cc = dir ? 3 - s : s; ci = 256 + b * 4 + cc; m0 = M_LAT + b * CTXL + cc * 64; }
        else { c = dir ? 67 - s : s - 4; ci = b * 64 + c; m0 = b * SEQ + c * 64; }
        bf16x8 af[2][4], bfr[4]; f32x4 av[2][4];
#pragma unroll
        for (int ks = 0; ks < 4; ++ks) { bfr[ks] = *(const bf16x8*)(vt0 + m0 + 16 * ks);
#pragma unroll
            for (int dt = 0; dt < 2; ++dt) af[dt][ks] = *(const bf16x8*)(kft0 + (size_t)dt * 32 * M_ALL + m0 + 16 * ks); }
#pragma unroll
        for (int dt = 0; dt < 2; ++dt)
#pragma unroll
            for (int rr = 0; rr < 4; ++rr) av[dt][rr] = *(const f32x4*)(AT + ((size_t)dir * NCHUNK + ci) * 256 + h * 64 + dt * 32 + 8 * rr + 4 * hh);
        if (s >= 4) {
            bf16_t* sp = sb0 + (size_t)c * SB_CH;
#pragma unroll
            for (int dt = 0; dt < 2; ++dt)
#pragma unroll
                for (int rr = 0; rr < 4; ++rr) { uint2 w; w.x = pg8::cvt_pk_bf16(acc[dt][4 * rr], acc[dt][4 * rr + 1]); w.y = pg8::cvt_pk_bf16(acc[dt][4 * rr + 2], acc[dt][4 * rr + 3]); *(uint2*)(sp + dt * 32 + 8 * rr) = w; }
        }
#pragma unroll
        for (int dt = 0; dt < 2; ++dt) {
#pragma unroll
            for (int ks = 0; ks < 4; ++ks) acc[dt] = mfma32(af[dt][ks], bfr[ks], acc[dt]);
#pragma unroll
            for (int rr = 0; rr < 4; ++rr) { acc[dt][4 * rr] *= av[dt][rr][0]; acc[dt][4 * rr + 1] *= av[dt][rr][1]; acc[dt][4 * rr + 2] *= av[dt][rr][2]; acc[dt][4 * rr + 3] *= av[dt][rr][3]; }
        }
    }
}
__device__ __forceinline__ void gla_out_unit(int u, const bf16_t* __restrict__ PROJ, const bf16_t* __restrict__ QF, const bf16_t* __restrict__ KF, const bf16_t* __restrict__ VT, const bf16_t* __restrict__ SB, const float* __restrict__ gnorm,
                                             bf16_t* __restrict__ OMIX, LAS unsigned char* tile, int lane) {
    const int it = u & 1, c = (u >> 1) & 63, h = (u >> 7) & 3, b = u >> 9;
    const int l31 = lane & 31, hh = lane >> 5;
    const int m0 = b * SEQ + c * 64;
    f32x16 o[4];
#pragma unroll
    for (int et = 0; et < 4; ++et)
#pragma unroll
        for (int i = 0; i < 16; ++i) o[et][i] = 0.f;
#pragma unroll
    for (int dir = 0; dir < 2; ++dir) {
        bf16x8 qf[4];
        const bf16_t* qp = QF + ((size_t)dir * M_LAT + m0 + 32 * it + l31) * 256 + h * 64 + 8 * hh;
#pragma unroll
        for (int ks = 0; ks < 4; ++ks) qf[ks] = *(const bf16x8*)(qp + 16 * ks);
#pragma unroll
        for (int jt = 0; jt < 2; ++jt) {
            const bool need = dir ? (jt >= it) : (jt <= it);
            if (!need) continue;
            f32x16 X;
#pragma unroll
            for (int i = 0; i < 16; ++i) X[i] = 0.f;
            const bf16_t* kp = KF + ((size_t)dir * M_LAT + m0 + 32 * jt + l31) * 256 + h * 64 + 8 * hh;
#pragma unroll
            for (int ks = 0; ks < 4; ++ks) X = mfma32(*(const bf16x8*)(kp + 16 * ks), qf[ks], X);
            if (jt == it) {
#pragma unroll
                for (int i = 0; i < 16; ++i) { const int jr = (i & 3) + 8 * (i >> 2) + 4 * hh; const bool keep = dir ? (jr >= l31) : (jr <= l31); X[i] = keep ? X[i] : 0.f; }
            }
#pragma unroll
            for (int s = 0; s < 2; ++s) {
                u32x4 xw; xw.x = pg8::cvt_pk_bf16(X[8 * s], X[8 * s + 1]); xw.y = pg8::cvt_pk_bf16(X[8 * s + 2], X[8 * s + 3]); xw.z = pg8::cvt_pk_bf16(X[8 * s + 4], X[8 * s + 5]); xw.w = pg8::cvt_pk_bf16(X[8 * s + 6], X[8 * s + 7]);
                const bf16x8 xa = __builtin_bit_cast(bf16x8, xw);
#pragma unroll
                for (int et = 0; et < 4; ++et) {
                    const bf16_t* vp = VT + (size_t)(512 + h * 128 + et * 32 + l31) * VT_LD + m0 + 32 * jt + 16 * s + 4 * hh;
                    const uint2 lo = *(const uint2*)vp, hi = *(const uint2*)(vp + 8);
                    const u32x4 vw = (u32x4){lo.x, lo.y, hi.x, hi.y};
                    o[et] = mfma32(xa, __builtin_bit_cast(bf16x8, vw), o[et]); }
            }
        }
        const bf16_t* sp = SB + ((size_t)(((dir * NB + b) * 4 + h) * 64 + c)) * SB_CH + (size_t)l31 * 64 + 8 * hh;
#pragma unroll
        for (int et = 0; et < 4; ++et)
#pragma unroll
            for (int ks = 0; ks < 4; ++ks) o[et] = mfma32(qf[ks], *(const bf16x8*)(sp + (size_t)et * 32 * 64 + 16 * ks), o[et]);
    }
    float ss[16];
#pragma unroll
    for (int i = 0; i < 16; ++i) { float a = 0.f;
#pragma unroll
        for (int et = 0; et < 4; ++et) a += o[et][i] * o[et][i];
        a += __shfl_xor(a, 1); a += __shfl_xor(a, 2); a += __shfl_xor(a, 4); a += __shfl_xor(a, 8); a += __shfl_xor(a, 16);
        ss[i] = rsqrtf(a * (1.f / 128.f) + EPS); }
    constexpr int TS = 272;
    const size_t mrow0 = (size_t)(m0 + 32 * it);
#pragma unroll
    for (int j = 0; j < 8; ++j) { const int ch = lane + 64 * j, t = ch >> 4, c16 = ch & 15;
        *(LAS u32x4*)(tile + t * TS + c16 * 16) = *(const u32x4*)(PROJ + (mrow0 + t) * PROJ_LD + PC_GG + h * 128 + c16 * 8); }
    asm volatile("s_waitcnt vmcnt(0) lgkmcnt(0)" ::: "memory");
#pragma unroll
    for (int et = 0; et < 4; ++et) { const float gn = gnorm[et * 32 + l31];
#pragma unroll
        for (int i = 0; i < 16; ++i) { const int t = (i & 3) + 8 * (i >> 2) + 4 * hh;
            LAS bf16_t* p = (LAS bf16_t*)(tile + t * TS) + et * 32 + l31;
            const float g = bf2f(*p);
            *p = (bf16_t)f2bf(o[et][i] * ss[i] * gn * silu_f(g)); } }
    asm volatile("s_waitcnt lgkmcnt(0)" ::: "memory");
#pragma unroll
    for (int j = 0; j < 8; ++j) { const int ch = lane + 64 * j, t = ch >> 4, c16 = ch & 15;
        *(u32x4*)(OMIX + (mrow0 + t) * DM + 512 + h * 128 + c16 * 8) = *(const LAS u32x4*)(tile + t * TS + c16 * 16); }
    asm volatile("s_waitcnt lgkmcnt(0)" ::: "memory");
}
__device__ __forceinline__ void ph_gla_state(const bf16_t* KFT, const bf16_t* VT, const float* AT, bf16_t* SB, int bid, int G) {
    const int lane = threadIdx.x & 63, wave = threadIdx.x >> 6;
    for (int u = wave * G + bid; u < NB * 4 * 2 * 4; u += 8 * G) gla_state_unit(u, KFT, VT, AT, SB, lane);
}
__device__ __forceinline__ void ph_gla_out(const bf16_t* PROJ, const bf16_t* QF, const bf16_t* KF, const bf16_t* VT, const bf16_t* SB, const float* gnorm, bf16_t* OMIX, LAS unsigned char* lds, int bid, int G) {
    const int lane = threadIdx.x & 63, wave = threadIdx.x >> 6;
    for (int u = bid * 8 + wave; u < NB * 4 * 64 * 2; u += G * 8) gla_out_unit(u, PROJ, QF, KF, VT, SB, gnorm, OMIX, lds + wave * (32 * 272), lane);
}

__device__ __forceinline__ void ph_post_mix(const float* __restrict__ x, const bf16_t* __restrict__ MIX, const float* __restrict__ mod, const float* __restrict__ g_post, const float* __restrict__ g_fpre, const float* __restrict__ router,
                                                  float* __restrict__ xnew, unsigned char* __restrict__ HF, float* __restrict__ aff, LAS unsigned char* lds, int bid, int G) {
    LAS float* rt = (LAS float*)lds;
    __syncthreads();
    for (int i = threadIdx.x; i < DM * NE; i += 512) rt[(i % NE) * DM + (i / NE)] = router[i];
    __syncthreads();
    const int lane = threadIdx.x & 63, wave = threadIdx.x >> 6;
    const int NGW = G * 8;
    for (int m0 = bid * 8 + wave; m0 < M_LAT; m0 += 2 * NGW) {
        int mm[2]; bool ok[2];
#pragma unroll
        for (int r = 0; r < 2; ++r) { const int m = m0 + r * NGW; ok[r] = m < M_LAT; mm[r] = ok[r] ? m : m0; }
        unsigned long long mw[2][4]; f32x4 xv[2][4];
#pragma unroll
        for (int r = 0; r < 2; ++r)
#pragma unroll
            for (int j = 0; j < 4; ++j) { mw[r][j] = ((const unsigned long long*)(MIX + (size_t)mm[r] * DM))[lane + 64 * j]; xv[r][j] = *(const f32x4*)(x + (size_t)mm[r] * DM + 4 * lane + 256 * j); }
        f32x4 mx[2][4]; float ss[2] = {0.f, 0.f};
#pragma unroll
        for (int r = 0; r < 2; ++r)
#pragma unroll
            for (int j = 0; j < 4; ++j) { const unsigned lo = (unsigned)mw[r][j], hi = (unsigned)(mw[r][j] >> 32);
                mx[r][j] = (f32x4){__uint_as_float(lo << 16), __uint_as_float(lo & 0xffff0000u), __uint_as_float(hi << 16), __uint_as_float(hi & 0xffff0000u)};
                ss[r] += (mx[r][j].x * mx[r][j].x + mx[r][j].y * mx[r][j].y) + (mx[r][j].z * mx[r][j].z + mx[r][j].w * mx[r][j].w); }
#pragma unroll
        for (int o = 1; o < 64; o <<= 1) { ss[0] += __shfl_xor(ss[0], o); ss[1] += __shfl_xor(ss[1], o); }
        f32x4 xn[2][4]; float s2[2] = {0.f, 0.f};
#pragma unroll
        for (int r = 0; r < 2; ++r) { const float rstd = rsqrtf(ss[r] * (1.f / DM) + EPS); const float* mv = mod + (size_t)(mm[r] / SEQ) * 6144;
#pragma unroll
            for (int j = 0; j < 4; ++j) { const int col = 4 * lane + 256 * j;
                const f32x4 gp = *(const f32x4*)(g_post + col), gm = *(const f32x4*)(mv + 2048 + col);
                xn[r][j] = xv[r][j] + gm * (mx[r][j] * rstd * gp);
                if (ok[r]) *(f32x4*)(xnew + (size_t)mm[r] * DM + col) = xn[r][j];
                s2[r] += (xn[r][j].x * xn[r][j].x + xn[r][j].y * xn[r][j].y) + (xn[r][j].z * xn[r][j].z + xn[r][j].w * xn[r][j].w); } }
#pragma unroll
        for (int o = 1; o < 64; o <<= 1) { s2[0] += __shfl_xor(s2[0], o); s2[1] += __shfl_xor(s2[1], o); }
        const bool b5 = lane & 32, b4 = lane & 16, b3 = lane & 8, b2 = lane & 4;
#pragma unroll
        for (int r = 0; r < 2; ++r) { const float rstd2 = rsqrtf(s2[r] * (1.f / DM) + EPS); const float* mv = mod + (size_t)(mm[r] / SEQ) * 6144;
            f32x4 hv4[4]; float lg[NE];
            unsigned* hp = (unsigned*)(HF + (size_t)mm[r] * DM) + lane;
#pragma unroll
            for (int j = 0; j < 4; ++j) { const int col = 4 * lane + 256 * j;
                const f32x4 gf = *(const f32x4*)(g_fpre + col), sh = *(const f32x4*)(mv + 3072 + col), sc = *(const f32x4*)(mv + 4096 + col);
                hv4[j] = xn[r][j] * rstd2 * gf * (sc + 1.f) + sh;
                if (ok[r]) hp[64 * j] = pk4_fp8(hv4[j].x * SX8, hv4[j].y * SX8, hv4[j].z * SX8, hv4[j].w * SX8); }
#pragma unroll
            for (int e = 0; e < NE; ++e) { float sacc = 0.f;
#pragma unroll
                for (int j = 0; j < 4; ++j) { const f32x4 rv = *(const LAS f32x4*)(rt + e * DM + 4 * lane + 256 * j); sacc += (hv4[j].x * rv.x + hv4[j].y * rv.y) + (hv4[j].z * rv.z + hv4[j].w * rv.w); }
                lg[e] = sacc; }
            float w8[8], w4[4], w2[2];
#pragma unroll
            for (int j = 0; j < 8; ++j) { const float keep = b5 ? lg[8 + j] : lg[j], send = b5 ? lg[j] : lg[8 + j]; w8[j] = keep + __shfl_xor(send, 32); }
#pragma unroll
            for (int j = 0; j < 4; ++j) { const float keep = b4 ? w8[4 + j] : w8[j], send = b4 ? w8[j] : w8[4 + j]; w4[j] = keep + __shfl_xor(send, 16); }
#pragma unroll
            for (int j = 0; j < 2; ++j) { const float keep = b3 ? w4[2 + j] : w4[j], send = b3 ? w4[j] : w4[2 + j]; w2[j] = keep + __shfl_xor(send, 8); }
            float z = (b2 ? w2[1] : w2[0]) + __shfl_xor(b2 ? w2[0] : w2[1], 4);
            z += __shfl_xor(z, 2); z += __shfl_xor(z, 1);
            float mxl = z;
            mxl = fmaxf(mxl, __shfl_xor(mxl, 4)); mxl = fmaxf(mxl, __shfl_xor(mxl, 8)); mxl = fmaxf(mxl, __shfl_xor(mxl, 16)); mxl = fmaxf(mxl, __shfl_xor(mxl, 32));
            const float ez = expf(z - mxl); float den = ez;
            den += __shfl_xor(den, 4); den += __shfl_xor(den, 8); den += __shfl_xor(den, 16); den += __shfl_xor(den, 32);
            if (ok[r] && (lane & 3) == 0) aff[((size_t)(mm[r] / SEQ) * NE + (lane >> 2)) * SEQ + (mm[r] % SEQ)] = ez / den;
            asm volatile("" ::: "memory");
        }
    }
}

__device__ __forceinline__ int block_excl_scan(int v, LAS int* sm  , int& total) {
    const int lane = threadIdx.x & 63, w = threadIdx.x >> 6; int x = v;
#pragma unroll
    for (int o = 1; o < 64; o <<= 1) { const int y = __shfl_up(x, o); if (lane >= o) x += y; }
    __syncthreads();
    if (lane == 63) sm[w] = x;
    __syncthreads();
    int base = 0, tot = 0;
#pragma unroll
    for (int i = 0; i < 8; ++i) { const int s = sm[i]; if (i < w) base += s; tot += s; }
    total = tot;
    return base + x - v;
}
__device__ __forceinline__ void ph_topk(const float* __restrict__ aff, const unsigned char* __restrict__ HF, int* __restrict__ idx, float* __restrict__ gate, int* __restrict__ inv, unsigned char* __restrict__ XS, LAS unsigned char* lds, int bid, int G) {
  LAS int* hist = (LAS int*)lds; LAS int* sm = hist + 256; LAS unsigned* sp = (LAS unsigned*)(sm + 16); LAS int* srm = (LAS int*)(sp + 1); LAS int* s_list = srm + 1;
#define s_prefix (*sp)
#define s_remain (*srm)
  for (int be = bid; be < NB * NE; be += G) {
    const int b = be / NE, e = be % NE, tid = threadIdx.x;
    __syncthreads();
    const float* av = aff + ((size_t)b * NE + e) * SEQ;
    unsigned key[8];
#pragma unroll
    for (int j = 0; j < 8; ++j) key[j] = __float_as_uint(av[tid * 8 + j]);
    if (tid == 0) { s_prefix = 0u; s_remain = CAP; }
    for (int pass = 3; pass >= 0; --pass) {
        if (tid < 256) hist[tid] = 0;
        __syncthreads();
        const unsigned prefix = s_prefix; const int shift = pass * 8; const unsigned himask = pass == 3 ? 0u : (0xffffffffu << (shift + 8));
#pragma unroll
        for (int j = 0; j < 8; ++j) if ((key[j] & himask) == prefix) atomicAdd((int*)(hist + ((key[j] >> shift) & 255u)), 1);
        __syncthreads();
        {
            const int rem = s_remain; const int lane_ = tid & 63, w_ = tid >> 6;
            int hcnt = 0, suf = 0;
            if (tid < 256) { hcnt = hist[tid]; suf = hcnt;
#pragma unroll
                for (int o = 1; o < 64; o <<= 1) { const int y = __shfl_down(suf, o); if (lane_ + o < 64) suf += y; }
                if (lane_ == 0) sm[8 + w_] = suf; }
            __syncthreads();
            if (tid < 256) { int above = suf - hcnt; for (int w2 = w_ + 1; w2 < 4; ++w2) above += sm[8 + w2];
                if (hcnt > 0 && above < rem && rem <= above + hcnt) { s_remain = rem - above; s_prefix = prefix | ((unsigned)tid << shift); } }
            __syncthreads();
        }
    }
    const unsigned T = s_prefix; const int remain = s_remain;
    int neq = 0;
#pragma unroll
    for (int j = 0; j < 8; ++j) neq += (key[j] == T);
    int tot; int eqbase = block_excl_scan(neq, sm, tot);
    int flags = 0, nsel = 0;
#pragma unroll
    for (int j = 0; j < 8; ++j) { bool sel = key[j] > T; if (key[j] == T) { sel = eqbase < remain; ++eqbase; } if (sel) { flags |= 1 << j; ++nsel; } }
    int slot = block_excl_scan(nsel, sm, tot);
    const int rowbase = (e * NB + b) * CAP;
#pragma unroll
    for (int j = 0; j < 8; ++j) { const int t = tid * 8 + j; int sl = -1;
        if (flags & (1 << j)) { sl = slot++; idx[rowbase + sl] = t; gate[rowbase + sl] = __uint_as_float(key[j]); s_list[sl] = t; }
        inv[((size_t)b * SEQ + t) * NE + e] = sl; }
    __syncthreads();
    const int lane = tid & 63, wave = tid >> 6;
    for (int s = wave; s < CAP; s += 8) { const u32x4* src = (const u32x4*)(HF + ((size_t)b * SEQ + s_list[s]) * DM); u32x4* dst = (u32x4*)(XS + (size_t)(rowbase + s) * DM);
        dst[lane] = src[lane]; }
  }
#undef s_prefix
#undef s_remain
}

__device__ __forceinline__ void ph_combine(const bf16_t* __restrict__ Y, const int* __restrict__ inv, const float* __restrict__ mod, const float* __restrict__ g_fpost, float* __restrict__ out, int bid, int G) {
    const int lane = threadIdx.x & 63, wave = threadIdx.x >> 6;
    for (int m = bid * 8 + wave; m < M_LAT; m += G * 8) {
        const int b = m / SEQ; const float* mv = mod + (size_t)b * 6144;
        const int sl = (lane < NE) ? inv[(size_t)m * NE + lane] : -1;
        unsigned mask = (unsigned)__ballot(sl >= 0);
        f32x4 xn[4];
#pragma unroll
        for (int j = 0; j < 4; ++j) xn[j] = *(const f32x4*)(out + (size_t)m * DM + 4 * lane + 256 * j);
        f32x4 y[4];
#pragma unroll
        for (int j = 0; j < 4; ++j) y[j] = (f32x4){0.f, 0.f, 0.f, 0.f};
        while (mask) {
            const unsigned long long* yp[4]; float w[4];
#pragma unroll
            for (int k = 0; k < 4; ++k) { const unsigned mm = mask ? mask : 1u; const int e = __builtin_ctz(mm); w[k] = mask ? 1.f : 0.f; mask &= mask - 1u;
                const int s = __builtin_amdgcn_readlane(sl, e); const int s2 = s < 0 ? 0 : s;
                yp[k] = (const unsigned long long*)(Y + (size_t)((e * NB + b) * CAP + s2) * DM) + lane; }
            unsigned long long v[4][4];
#pragma unroll
            for (int k = 0; k < 4; ++k)
#pragma unroll
                for (int j = 0; j < 4; ++j) v[k][j] = yp[k][64 * j];
#pragma unroll
            for (int k = 0; k < 4; ++k)
#pragma unroll
                for (int j = 0; j < 4; ++j) { const unsigned lo = (unsigned)v[k][j], hi = (unsigned)(v[k][j] >> 32);
                    y[j] += (f32x4){__uint_as_float(lo << 16), __uint_as_float(lo & 0xffff0000u), __uint_as_float(hi << 16), __uint_as_float(hi & 0xffff0000u)} * w[k]; }
        }
        float ss = 0.f;
#pragma unroll
        for (int j = 0; j < 4; ++j) ss += (y[j].x * y[j].x + y[j].y * y[j].y) + (y[j].z * y[j].z + y[j].w * y[j].w);
        const float rstd = rsqrtf(wave_sum(ss) * (1.f / DM) + EPS);
#pragma unroll
        for (int j = 0; j < 4; ++j) { const int col = 4 * lane + 256 * j; float* op = out + (size_t)m * DM + col;
            const f32x4 gp = *(const f32x4*)(g_fpost + col), gf = *(const f32x4*)(mv + 5120 + col);
            *(f32x4*)op = xn[j] + gf * (y[j] * rstd * gp); }
    }
}

#define GAS __attribute__((address_space(1)))
#define XB_TMO      128
#define XB_XCNT(j)  (256  + 64 * (j))
#define XB_XSUB(j)  (1280 + 64 * (j))
#define XB_XGEN(j)  (2304 + 64 * (j))
#define XB_TOP      3328
#define XB_TOPGEN   3392
#define XCD_BAR_WORDS 3456
#define XB_SPIN_CAP (1u << 18)

__device__ __forceinline__ unsigned xb_ld(unsigned* p)              { return __hip_atomic_load(p, __ATOMIC_RELAXED, __HIP_MEMORY_SCOPE_AGENT); }
__device__ __forceinline__ unsigned xb_add(unsigned* p, unsigned v) { return __hip_atomic_fetch_add(p, v, __ATOMIC_RELAXED, __HIP_MEMORY_SCOPE_AGENT); }
__device__ __forceinline__ unsigned xb_xcc_id() { return (unsigned)__builtin_amdgcn_s_getreg((3 << 11) | 20) & 0xFu; }
#define XB_SPIN(cond, bar) do { unsigned _sp = 0; while (cond) { __builtin_amdgcn_s_sleep(1); \
    if ((++_sp & 255u) == 0u) { if (xb_ld(&(bar)[XB_TMO])) break; if (_sp > XB_SPIN_CAP) { atomicAdd(&(bar)[XB_TMO], 1u); break; } } } } while (0)

struct XcdBarrier {
    unsigned* bar; unsigned x;
    volatile LAS unsigned* st;
};

__device__ __forceinline__ XcdBarrier xcd_barrier_post(unsigned* bar, volatile LAS unsigned* st) {
    XcdBarrier b; b.bar = bar; b.x = xb_xcc_id(); b.st = st;
    if (threadIdx.x == 0) (void)xb_add(&bar[XB_XCNT(b.x)], 1u);
    return b;
}
__device__ __forceinline__ void xcd_barrier_complete(unsigned* bar, unsigned x, unsigned& nloc, unsigned& nx) {
    const unsigned G = gridDim.x * gridDim.y * gridDim.z;
    unsigned sum, cnt, mine, sp = 0u;
    for (;;) {
        sum = 0u; cnt = 0u; mine = 0u;
#pragma unroll
        for (unsigned j = 0; j < 16; ++j) { const unsigned c = xb_ld(&bar[XB_XCNT(j)]); sum += c; cnt += (c > 0u) ? 1u : 0u; mine = (j == x) ? c : mine; }
        if (sum == G) break;
        __builtin_amdgcn_s_sleep(1);
        if ((++sp & 255u) == 0u) { if (xb_ld(&bar[XB_TMO])) break; if (sp > XB_SPIN_CAP) { atomicAdd(&bar[XB_TMO], 1u); break; } }
    }
    nloc = mine > 0u ? mine : 1u; nx = cnt > 0u ? cnt : 1u;
}

__device__ __forceinline__ void xcd_barrier(const XcdBarrier& b) {
    asm volatile("s_waitcnt vmcnt(0)" ::: "memory");
    __syncthreads();
    if (threadIdx.x == 0) {
        unsigned* bar = b.bar;
        __builtin_amdgcn_s_waitcnt(0);
        unsigned nloc = b.st[0], nx = b.st[1];
        if (nloc == 0u) { xcd_barrier_complete(bar, b.x, nloc, nx); b.st[0] = nloc; b.st[1] = nx; }
        const unsigned old = xb_add(&bar[XB_XSUB(b.x)], 1u);
        const unsigned gen = old / nloc;
        if (old + 1u == (gen + 1u) * nloc) {
            __builtin_amdgcn_fence(__ATOMIC_RELEASE, "agent");
            asm volatile("s_waitcnt vmcnt(0)" ::: "memory");
            const unsigned og = xb_add(&bar[XB_TOP], 1u);
            const unsigned tg = og / nx;
            if (og + 1u == (tg + 1u) * nx) xb_add(&bar[XB_TOPGEN], 1u);
            else XB_SPIN(xb_ld(&bar[XB_TOPGEN]) == tg, bar);
            __builtin_amdgcn_fence(__ATOMIC_ACQUIRE, "agent");
            xb_add(&bar[XB_XGEN(b.x)], 1u);
            asm volatile("s_waitcnt vmcnt(0)" ::: "memory");
        } else {
            XB_SPIN(xb_ld(&bar[XB_XGEN(b.x)]) == gen, bar);
            __builtin_amdgcn_fence(__ATOMIC_ACQUIRE, "agent");
            asm volatile("s_waitcnt vmcnt(0)" ::: "memory");
        }
    }
    __syncthreads();
}


namespace cg = cooperative_groups;
constexpr int LDS_BYTES = 147456;
constexpr int N_PHASES = 12;
constexpr size_t CTL_BYTES = 65536;
#ifndef REP_PH
#define REP_PH -1
#endif
#ifndef REP_SYNC
#define REP_SYNC 0
#endif
struct MegaArgs { const float* in[20]; float* out; unsigned char* ws; int ph_lo, ph_hi; };
__global__ void __launch_bounds__(512, 2) hy_mega(MegaArgs a) {
    extern __shared__ __attribute__((aligned(16))) unsigned char lds_raw[];
    LAS unsigned char* lds = (LAS unsigned char*)lds_raw;
    const int bid = blockIdx.x, G = gridDim.x;
#define Q_x (a.in[0])
#define Q_c (a.in[1])
#define Q_ctx (a.in[2])
#define Q_c_ctx (a.in[3])
#define Q_w_mod (a.in[4])
#define Q_b_mod (a.in[5])
#define Q_g_pre (a.in[6])
#define Q_g_post (a.in[7])
#define Q_g_fpre (a.in[8])
#define Q_g_fpost (a.in[9])
#define Q_w_in (a.in[10])
#define Q_rpb (a.in[11])
#define Q_a_up (a.in[12])
#define Q_a_bias (a.in[13])
#define Q_gnorm (a.in[14])
#define Q_w_out (a.in[15])
#define Q_router (a.in[16])
#define Q_w_gate (a.in[17])
#define Q_w_up (a.in[18])
#define Q_w_down (a.in[19])
#define Q_ws (a.ws)
#define Q_out (a.out)
#define Q_mod ((float*)(a.ws + WS_MOD))
#define Q_WTIN ((bf16_t*)(a.ws + WS_WTIN))
#define Q_WTV ((bf16_t*)(a.ws + WS_WTV))
#define Q_WTOUT ((bf16_t*)(a.ws + WS_WTOUT))
#define Q_WTGU ((unsigned char*)(a.ws + WS_WTGU))
#define Q_WTDN ((unsigned char*)(a.ws + WS_WTDN))
#define Q_H ((bf16_t*)(a.ws + WS_H))
#define Q_PROJ ((bf16_t*)(a.ws + WS_PROJ))
#define Q_VT ((bf16_t*)(a.ws + WS_VT))
#define Q_OMIX ((bf16_t*)(a.ws + WS_OMIX))
#define Q_MIX ((bf16_t*)(a.ws + WS_MIX))
#define Q_HID ((unsigned char*)(a.ws + WS_HID))
#define Q_HF ((unsigned char*)(a.ws + WS_HF))
#define Q_XS ((unsigned char*)(a.ws + WS_XS))
#define Q_Y ((bf16_t*)(a.ws + WS_XS))
#define Q_aff ((float*)(a.ws + WS_AFF))
#define Q_idx ((int*)(a.ws + WS_IDX))
#define Q_gate ((float*)(a.ws + WS_GATE))
#define Q_inv ((int*)(a.ws + WS_INV))
#define Q_QF ((bf16_t*)(a.ws + WS_QF))
#define Q_KF ((bf16_t*)(a.ws + WS_KF))
#define Q_KFT ((bf16_t*)(a.ws + WS_KFT))
#define Q_AT ((float*)(a.ws + WS_AT))
#define Q_SB ((bf16_t*)(a.ws + WS_SB))
#define Q_KH ((bf16_t*)(a.ws + WS_KH))
#define Q_UPF ((bf16_t*)(a.ws + WS_UPF))
#define Q_VB ((bf16_t*)(a.ws + WS_VB))
    volatile LAS unsigned* bst = (volatile LAS unsigned*)(lds + LDS_BYTES - 64);
    if (threadIdx.x < 16) bst[threadIdx.x] = 0u;
    __syncthreads();
    XcdBarrier bar = xcd_barrier_post((unsigned*)a.ws, bst);
    if (a.ph_hi < 0) cg::this_grid().sync();
    const int lo = a.ph_lo, hi = a.ph_hi;
#define IN(k) (lo <= (k) && (k) < hi)
#define SEAM(k) do { if (IN(k) && IN((k) + 1)) xcd_barrier(bar); } while (0)
#define MKP PrepArgs p; p.x = Q_x; p.ctx = Q_ctx; p.g_pre = Q_g_pre; p.mod = Q_mod; p.w_in = Q_w_in; p.w_out = Q_w_out; p.w_gate = Q_w_gate; p.w_up = Q_w_up; p.w_down = Q_w_down; p.WTIN = Q_WTIN; p.WTV = Q_WTV; p.WTOUT = Q_WTOUT; p.WTGU = Q_WTGU; p.WTDN = Q_WTDN; p.H = Q_H;
#define PH0 if (IN(0)) { MKP ph_mod(Q_c, Q_c_ctx, Q_w_mod, Q_b_mod, Q_mod, lds, bid, G); ph_upf(Q_a_up, Q_UPF, bid, G); ph_convert(p, lds, bid, G); }
#define PH1 if (IN(1)) { MKP ph_modulate(p, bid, G); }
#define PH2 if (IN(2)) { pg8::Gemm g{Q_H, Q_WTIN, M_ALL, PROJ_LD, DM}; InOrder S{G, bid, (const char*)Q_H, (const char*)Q_WTIN, (const char*)Q_WTV}; EpiIn E{EpiProj{Q_PROJ, PROJ_LD, Q_KH}, EpiVal{Q_VT, VT_LD, Q_VB}}; \
        pg8::gemm_phase<EpiIn, InOrder, true, true>(lds, g, S, E); }
#define PH3 if (IN(3)) { ph_gla_prep2(Q_PROJ, Q_UPF, Q_a_bias, Q_QF, Q_KF, Q_KFT, Q_AT, lds, bid, G); ph_na(Q_PROJ, Q_KH, Q_VB, Q_rpb, Q_OMIX, lds, bid, G); }
#define PH4 if (IN(4)) { MKP ph_gla_state(Q_KFT, Q_VT, Q_AT, Q_SB, bid, G); \
        { const int wv_ = threadIdx.x >> 6; const int nst_ = G < 128 ? G : 128; const int pid_ = bid < nst_ ? (wv_ == 0 ? -1 : bid * 7 + wv_ - 1) : nst_ * 7 + (bid - nst_) * 8 + wv_; \
          ph_convert_bg(p, CVT_Q0, CVT_Q1, pid_, nst_ * 7 + (G - nst_) * 8, lds); } }
#define PH5 if (IN(5)) ph_gla_out(Q_PROJ, Q_QF, Q_KF, Q_VT, Q_SB, Q_gnorm, Q_OMIX, lds, bid, G);
#define PH6 if (IN(6)) { pg8::Gemm g{Q_OMIX, Q_WTOUT, M_LAT, DM, DM}; pg8::StaticOrder S; S.init(g.M, g.N, G, bid); S.bind(g); pg8::EpiBf16<0> E{Q_MIX, DM, nullptr, 0, 0, 1.f}; \
        pg8::gemm_phase<pg8::EpiBf16<0>, pg8::StaticOrder, true, true>(lds, g, S, E); }
#define PH7 if (IN(7)) ph_post_mix(Q_x, Q_MIX, Q_mod, Q_g_post, Q_g_fpre, Q_router, Q_out, Q_HF, Q_aff, lds, bid, G);
#define PH8 if (IN(8)) { MKP ph_topk(Q_aff, Q_HF, Q_idx, Q_gate, Q_inv, Q_XS, lds, bid, G); \
        { const int nb_ = G < 64 ? G : 64; const int pid_ = (G > 64) ? (bid < 64 ? -1 : (bid - 64) * 8 + (int)(threadIdx.x >> 6)) : bid * 8 + (int)(threadIdx.x >> 6); \
          ph_convert_bg(p, CVT_Q1, IT8, pid_, (G > 64 ? (G - 64) : G) * 8, lds); } }
#define PH9 if (IN(9)) { pg8::Gemm g{(const bf16_t*)Q_XS, (const bf16_t*)Q_WTGU, NSLOT, 2 * DE, DM / 2}; ExpertOrder S{22, G, bid, (const char*)g.A, (const char*)g.Bt, (size_t)256 * g.K * 2}; EpiSwiGLU E{Q_HID, DE}; \
        pg8::gemm_phase<EpiSwiGLU, ExpertOrder, true, true, true>(lds, g, S, E); }
#define PH10 if (IN(10)) { pg8::Gemm g{(const bf16_t*)Q_HID, (const bf16_t*)Q_WTDN, NSLOT, DM, DE / 2}; ExpertOrder S{4, G, bid, (const char*)g.A, (const char*)g.Bt, (size_t)256 * g.K * 2}; EpiRowScale E{Q_Y, DM, Q_gate}; \
        pg8::gemm_phase<EpiRowScale, ExpertOrder, true, true, true>(lds, g, S, E); }
#define PH11 if (IN(11)) ph_combine(Q_Y, Q_inv, Q_mod, Q_g_fpost, Q_out, bid, G);
#define RUN(k, PH) PH
    PH0
#if REP_PH == 0
    PH0
#endif
    SEAM(0);
    for (int rs_ = 0; rs_ < REP_SYNC; ++rs_) xcd_barrier(bar);
    PH1
#if REP_PH == 1
    PH1
#endif
    SEAM(1);
    PH2
#if REP_PH == 2
    PH2
#endif
    SEAM(2);
    PH3
#if REP_PH == 3
    PH3
#endif
    SEAM(3);
    PH4
#if REP_PH == 4
    PH4
#endif
    SEAM(4);
    PH5
#if REP_PH == 5
    PH5
#endif
    SEAM(5);
    PH6
#if REP_PH == 6
    PH6
#endif
    SEAM(6);
    PH7
#if REP_PH == 7
    PH7
#endif
    SEAM(7);
    PH8
#if REP_PH == 8
    PH8
#endif
    SEAM(8);
    PH9
#if REP_PH == 9
    PH9
#endif
    SEAM(9);
    PH10
#if REP_PH == 10
    PH10
#endif
    SEAM(10);
    PH11
#undef IN
#undef SEAM
}
}

extern "C" void kernel_launch(void* const* d_in, const int* in_sizes, int n_in, void* d_out, int out_size, void* d_ws, size_t ws_size, hipStream_t stream) {
    using namespace hy;
    static int grid = 0;
    if (grid == 0) {
        if (n_in != 20 || in_sizes[0] != M_LAT * DM || out_size != M_LAT * DM || ws_size < WS_END) { fprintf(stderr, "kernel_launch: unexpected shapes / workspace (n_in %d, ws %zu)\n", n_in, ws_size); grid = -1; return; }
        int dev = 0, cus = 0, per_cu = 0;
        if (hipGetDevice(&dev) != hipSuccess || hipDeviceGetAttribute(&cus, hipDeviceAttributeMultiprocessorCount, dev) != hipSuccess) { grid = -1; return; }
        if (hipFuncSetAttribute((const void*)hy_mega, hipFuncAttributeMaxDynamicSharedMemorySize, LDS_BYTES) != hipSuccess) { fprintf(stderr, "kernel_launch: hipFuncSetAttribute failed\n"); grid = -1; return; }
        if (hipOccupancyMaxActiveBlocksPerMultiprocessor(&per_cu, (const void*)hy_mega, 512, LDS_BYTES) != hipSuccess || per_cu < 1) { fprintf(stderr, "kernel_launch: occupancy query says %d\n", per_cu); per_cu = 1; }
        (void)hipGetLastError();
        grid = cus;
    }
    if (grid < 0) return;
    (void)hipMemsetAsync(d_ws, 0, CTL_BYTES, stream);
    MegaArgs a{};
    for (int i = 0; i < 20; ++i) a.in[i] = (const float*)d_in[i];
    a.out = (float*)d_out; a.ws = (unsigned char*)d_ws;
    a.ph_lo = 0; a.ph_hi = N_PHASES;
    void* args[] = {&a};
    hipError_t e = hipLaunchCooperativeKernel((const void*)hy_mega, dim3(grid), dim3(512), args, LDS_BYTES, stream);
    if (e != hipSuccess) fprintf(stderr, "cooperative launch failed: %s (grid %d)\n", hipGetErrorString(e), grid);
}
```

```cpp
#define CVT_Q0 0
#define CVT_Q1 19000
#include <hip/hip_runtime.h>
#include <hip/hip_cooperative_groups.h>
#include <cstdio>
#include <cstdint>
namespace pg8 {
#define PG8_LAS __attribute__((address_space(3)))
typedef unsigned short bf16_t;
typedef short bf16x8 __attribute__((ext_vector_type(8)));
typedef float f32x4 __attribute__((ext_vector_type(4)));
typedef unsigned u32x4 __attribute__((ext_vector_type(4)));
constexpr int BM = 256, BK = 64, HALF = 128, HTB = HALF * BK * 2  , STAGE_BYTES = 8 * HTB, NXCD = 8, WGM = 8;

__host__ __device__ __forceinline__ int lds_byte(int r, int c) { const int st = (r >> 4) * 2 + (c >> 5), rr = r & 15, cc = c & 31, ob = rr * 64 + cc * 2; return st * 1024 + (ob ^ (((ob >> 9) & 1) << 5)); }
__host__ __device__ __forceinline__ void stage_rc(int b, int& R, int& C) { const int st = b / 1024, sb = b % 1024, swz = sb ^ (((sb >> 9) & 1) << 5); R = (st >> 1) * 16 + swz / 64; C = (st & 1) * 32 + (swz % 64) / 2; }
__host__ __device__ __forceinline__ int perm32(int rho) { const int n = rho >> 4, i = rho & 15; return 8 * (i >> 2) + 4 * n + (i & 3); }

struct Unit { int pm, pn, bt, kind; const char* a; const char* b; };
struct Gemm { const bf16_t* A; const bf16_t* Bt; int M, N, K; };

struct StaticOrder {
    int nM, nN, nwg, G, c; const char* A; const char* B; size_t ts;
    __host__ __device__ void init(int M, int N, int G_, int c_) { nM = M / BM; nN = N / BM; nwg = nM * nN; G = G_; c = c_; }
    __host__ __device__ void bind(const Gemm& g) { A = (const char*)g.A; B = (const char*)g.Bt; ts = (size_t)BM * g.K * 2; }
    __host__ __device__ bool next(int i, Unit& u) const {
        const long L = (long)i * G + c; if (L >= nwg) return false;
        int wgid = (int)L; { const int q = nwg / NXCD, r = nwg % NXCD, xcd = wgid % NXCD, off = wgid / NXCD; wgid = (xcd < r ? xcd * (q + 1) : r * (q + 1) + (xcd - r) * q) + off; }
        const int nig = WGM * nN, gid = wgid / nig, fm = gid * WGM, gsz = (nM - fm) < WGM ? (nM - fm) : WGM;
        u.pm = fm + ((wgid % nig) % gsz); u.pn = (wgid % nig) / gsz; u.bt = u.pn; u.kind = 0; u.a = A + (size_t)u.pm * ts; u.b = B + (size_t)u.bt * ts; return true;
    }
    __device__ __forceinline__ void a_ready(const Unit&) const {}
    __device__ __forceinline__ void done(const Unit&) const {}
};

__device__ __forceinline__ unsigned cvt_pk_bf16(float lo, float hi) { unsigned r; asm volatile("v_cvt_pk_bf16_f32 %0, %1, %2" : "=v"(r) : "v"(lo), "v"(hi)); return r; }
typedef float f32x2 __attribute__((ext_vector_type(2)));
__device__ __forceinline__ f32x2 gelu_pk(f32x2 v) {
    const f32x2 av = __builtin_elementwise_abs(v), d = av * 0.2316418882f + 1.0f;
    f32x2 t; t.x = __builtin_amdgcn_rcpf(d.x); t.y = __builtin_amdgcn_rcpf(d.y);
    f32x2 q = t * 0.5307027145f + (-0.7265760135f); q = q * t + 0.7107068705f; q = q * t + (-0.142248368f); q = q * t + 0.127414796f; q = q * t;
    const f32x2 s = (v * v) * (-0.72134752044f);
    f32x2 e; e.x = __builtin_amdgcn_exp2f(s.x); e.y = __builtin_amdgcn_exp2f(s.y);
    const f32x2 m = v * (q * e), r = v - m;
    f32x2 o; o.x = v.x < 0.f ? m.x : r.x; o.y = v.y < 0.f ? m.y : r.y; return o;
}

template <int ACT  > struct EpiBf16 {
    static constexpr bool PERM = true, AFTER_DRAIN = false; static_assert(ACT == 0 || ACT == 1, "EpiBf16: ACT is 0 (none) or 1 (gelu_pk)");
    bf16_t* O; int ldc; const float* bias; int split_cols; size_t split_stride; float scale0;
    __device__ __forceinline__ void operator()(const f32x4 (&acc)[2][2][4][2], const Unit& u, int wr, int wc, int fr, int fq) const {
        const int row0 = u.pm * BM + wr * 64 + fr; int colt = u.pn * BM; bf16_t* base = O;
        float sc = 1.f; if (split_cols) { const int t = colt / split_cols; base += (size_t)t * split_stride; colt -= t * split_cols; if (t == 0) sc = scale0; }
        const int col0 = colt + wc * 32 + 8 * fq, bcol0 = u.pn * BM + wc * 32 + 8 * fq;
        f32x4 bv[2][2];
#pragma unroll
        for (int bj = 0; bj < 2; ++bj)
#pragma unroll
            for (int n = 0; n < 2; ++n) bv[bj][n] = bias ? *(const f32x4*)(bias + bcol0 + bj * HALF + 4 * n) : (f32x4){0.f, 0.f, 0.f, 0.f};
#pragma unroll
        for (int ai = 0; ai < 2; ++ai)
#pragma unroll
            for (int m = 0; m < 4; ++m) { bf16_t* rowp = base + (size_t)(row0 + ai * HALF + m * 16) * ldc + col0;
#pragma unroll
                for (int bj = 0; bj < 2; ++bj) { f32x4 v0 = acc[ai][bj][m][0] + bv[bj][0], v1 = acc[ai][bj][m][1] + bv[bj][1];
                    if (ACT == 1) { f32x2 a = gelu_pk((f32x2){v0[0], v0[1]}), b = gelu_pk((f32x2){v0[2], v0[3]}), c = gelu_pk((f32x2){v1[0], v1[1]}), d = gelu_pk((f32x2){v1[2], v1[3]});
                        v0 = (f32x4){a.x, a.y, b.x, b.y}; v1 = (f32x4){c.x, c.y, d.x, d.y}; }
                    v0 = v0 * sc; v1 = v1 * sc; u32x4 w; w.x = cvt_pk_bf16(v0[0], v0[1]); w.y = cvt_pk_bf16(v0[2], v0[3]); w.z = cvt_pk_bf16(v1[0], v1[1]); w.w = cvt_pk_bf16(v1[2], v1[3]);
                    *(u32x4*)(rowp + bj * HALF) = w; } }
    }
};
typedef int i32x8 __attribute__((ext_vector_type(8)));
typedef int i32x4v __attribute__((ext_vector_type(4)));
__device__ __forceinline__ f32x4 mfma_f8(bf16x8 b0, bf16x8 b1, bf16x8 a0, bf16x8 a1, f32x4 c) {
    const i32x8 bv = __builtin_shufflevector(__builtin_bit_cast(i32x4v, b0), __builtin_bit_cast(i32x4v, b1), 0, 1, 2, 3, 4, 5, 6, 7);
    const i32x8 av = __builtin_shufflevector(__builtin_bit_cast(i32x4v, a0), __builtin_bit_cast(i32x4v, a1), 0, 1, 2, 3, 4, 5, 6, 7);
    return __builtin_amdgcn_mfma_scale_f32_16x16x128_f8f6f4(bv, av, c, 0, 0, 0, 0x7f7f7f7f, 0, 0x7f7f7f7f);
}
struct Frag16 { bf16x8 k[2]; };
template <bool F8> struct FragSel { typedef Frag16 A; };
template <> struct FragSel<true> { typedef i32x8 A; };
__device__ __forceinline__ void frag_load(Frag16& d, const PG8_LAS unsigned char* p) { d.k[0] = *(const PG8_LAS bf16x8*)p; d.k[1] = *(const PG8_LAS bf16x8*)(p + 1024); }
__device__ __forceinline__ void frag_load(i32x8& d, const PG8_LAS unsigned char* p) { const i32x4v lo = *(const PG8_LAS i32x4v*)p, hi = *(const PG8_LAS i32x4v*)(p + 1024); d = __builtin_shufflevector(lo, hi, 0, 1, 2, 3, 4, 5, 6, 7); }
__device__ __forceinline__ f32x4 frag_mma(const Frag16& b, const Frag16& a, f32x4 c) { c = __builtin_amdgcn_mfma_f32_16x16x32_bf16(b.k[0], a.k[0], c, 0, 0, 0); return __builtin_amdgcn_mfma_f32_16x16x32_bf16(b.k[1], a.k[1], c, 0, 0, 0); }
__device__ __forceinline__ f32x4 frag_mma(const i32x8& b, const i32x8& a, f32x4 c) {
    const int sc = 0x7f7f7f7f;
    asm volatile("s_nop 1\n\tv_mfma_scale_f32_16x16x128_f8f6f4 %0, %1, %2, %0, %3, %3 op_sel_hi:[0,0,0]" : "+v"(c) : "v"(b), "v"(a), "v"(sc));
    return c; }
template <class Epi, class Sched, bool ALIGN_EPI = false, bool SP2 = false, bool F8 = false>
__device__ __forceinline__ void gemm_phase(PG8_LAS unsigned char* lds, const Gemm g, const Sched& S, const Epi& E) {
    const int tid = threadIdx.x, wid = __builtin_amdgcn_readfirstlane(tid >> 6), lane = tid & 63, wr = wid >> 2, wc = wid & 3, fr = lane & 15, fq = lane >> 4;
    const int K = g.K, nt = K / BK;
    unsigned voffA[2], voffB[2];
#pragma unroll
    for (int i = 0; i < 2; ++i) { int R, C; stage_rc(tid * 16 + i * 8192, R, C); const int Rb = Epi::PERM ? ((R & ~31) + perm32(R & 31)) : R;
        voffA[i] = (unsigned)(R * K + C) * 2u; voffB[i] = (unsigned)(Rb * K + C) * 2u; }
    const size_t kstep = (size_t)(BK * 2);
    const size_t hstep = (size_t)HALF * K * 2;
    const size_t tstep = 2 * hstep;
    const unsigned ldsw = (unsigned)wid * 1024u;
    const int aoff = lds_byte(wr * 64 + fr, fq * 8), boff = lds_byte(wc * 32 + fr, fq * 8);
#define PG8_SA(b, h) (((b) * 2 + (h)) * HTB)
#define PG8_SB(b, h) ((4 + (b) * 2 + (h)) * HTB)
#define PG8_STAGE(bufoff, gbase, voff) do { _Pragma("unroll") for (int _i = 0; _i < 2; ++_i) \
        __builtin_amdgcn_global_load_lds((const unsigned*)((const char*)(gbase) + (voff)[_i]), (PG8_LAS unsigned*)(lds + (bufoff) + ldsw + _i * 8192), 16, 0, 0); } while (0)
#define PG8_LDA(dst, b, h) do { _Pragma("unroll") for (int m = 0; m < 4; ++m) frag_load(dst[m], lds + PG8_SA(b, h) + aoff + m * 2048); } while (0)
#define PG8_LDB(dst, b, h) do { _Pragma("unroll") for (int n = 0; n < 2; ++n) frag_load(dst[n], lds + PG8_SB(b, h) + boff + n * 2048); } while (0)
#define PG8_MMA(ai, bj, At, Bt) do { __builtin_amdgcn_s_setprio(1); _Pragma("unroll") for (int m = 0; m < 4; ++m) _Pragma("unroll") for (int n = 0; n < 2; ++n) \
        acc[ai][bj][m][n] = frag_mma(Bt[n], At[m], acc[ai][bj][m][n]); __builtin_amdgcn_s_setprio(0); } while (0)
#define PG8_WAIT_V(n) asm volatile("s_waitcnt vmcnt(" #n ")" ::: "memory")
#define PG8_WAIT_L(n) asm volatile("s_waitcnt lgkmcnt(" #n ")" ::: "memory")
#define PG8_BAR __builtin_amdgcn_s_barrier()
#define PG8_SCHED __builtin_amdgcn_sched_barrier(0)
    Unit cur, nxt; int ui = 0;
    if (!S.next(0, cur)) return;
    f32x4 acc[2][2][4][2];
#pragma unroll
    for (int a = 0; a < 2; ++a)
#pragma unroll
        for (int b = 0; b < 2; ++b)
#pragma unroll
            for (int m = 0; m < 4; ++m)
#pragma unroll
                for (int n = 0; n < 2; ++n) acc[a][b][m][n] = (f32x4){0.f, 0.f, 0.f, 0.f};
    typename FragSel<F8>::A At[4]; typename FragSel<F8>::A B0[2], B1[2];
    const char* cA = cur.a; const char* cB = cur.b;
    S.a_ready(cur);
    if constexpr (SP2) {
        PG8_STAGE(PG8_SB(0, 0), cB, voffB); PG8_STAGE(PG8_SB(0, 1), cB + hstep, voffB); PG8_STAGE(PG8_SA(0, 0), cA, voffA); PG8_STAGE(PG8_SA(0, 1), cA + hstep, voffA);
        if (wr == 1) PG8_BAR;
        PG8_WAIT_V(2); PG8_BAR;
        PG8_STAGE(PG8_SB(1, 0), cB + kstep, voffB); PG8_STAGE(PG8_SA(1, 0), cA + kstep, voffA); PG8_STAGE(PG8_SB(1, 1), cB + hstep + kstep, voffB);
        PG8_WAIT_V(6); PG8_BAR;
    } else {
        PG8_STAGE(PG8_SB(0, 0), cB, voffB); PG8_STAGE(PG8_SA(0, 0), cA, voffA); PG8_STAGE(PG8_SB(0, 1), cB + hstep, voffB); PG8_STAGE(PG8_SA(0, 1), cA + hstep, voffA);
        if (wr == 1) PG8_BAR;
        PG8_WAIT_V(4); PG8_BAR;
        PG8_STAGE(PG8_SB(1, 0), cB + kstep, voffB); PG8_STAGE(PG8_SA(1, 0), cA + kstep, voffA); PG8_STAGE(PG8_SB(1, 1), cB + hstep + kstep, voffB);
        PG8_WAIT_V(6); PG8_BAR;
    }
    for (;;) {
        const bool has_next = S.next(ui + 1, nxt);
        const char* nA = has_next ? nxt.a : cA; const char* nB = has_next ? nxt.b : cB;
        for (int t = 0; t < nt; t += 2) {
            const bool last = (t == nt - 2);
            const char* a1 = cA + (size_t)(t + 1) * kstep;
            const char* a2 = last ? nA : cA + (size_t)(t + 2) * kstep; const char* b2 = last ? nB : cB + (size_t)(t + 2) * kstep;
            const char* a3 = a2 + kstep; const char* b3 = b2 + kstep;
            if (last && has_next) S.a_ready(nxt);
            if constexpr (SP2) {
            PG8_LDB(B0, 0, 0); PG8_LDB(B1, 0, 1); PG8_SCHED; PG8_LDA(At, 0, 0); PG8_STAGE(PG8_SA(1, 1), a1 + hstep, voffA);
            PG8_WAIT_V(8); PG8_WAIT_L(0); PG8_BAR; PG8_MMA(0, 0, At, B0); PG8_MMA(0, 1, At, B1); PG8_BAR; PG8_SCHED;
            PG8_LDA(At, 0, 1); PG8_STAGE(PG8_SB(0, 0), b2, voffB); PG8_STAGE(PG8_SB(0, 1), b2 + hstep, voffB); PG8_STAGE(PG8_SA(0, 0), a2, voffA);
            PG8_WAIT_V(8); PG8_WAIT_L(0); PG8_BAR; PG8_MMA(1, 0, At, B0); PG8_MMA(1, 1, At, B1); PG8_BAR; PG8_SCHED;
            PG8_LDB(B0, 1, 0); PG8_LDB(B1, 1, 1); PG8_SCHED; PG8_LDA(At, 1, 0); PG8_STAGE(PG8_SA(0, 1), a2 + hstep, voffA);
            PG8_WAIT_V(8); PG8_WAIT_L(0); PG8_BAR; PG8_MMA(0, 0, At, B0); PG8_MMA(0, 1, At, B1); PG8_BAR; PG8_SCHED;
            PG8_LDA(At, 1, 1); PG8_STAGE(PG8_SB(1, 0), b3, voffB); PG8_STAGE(PG8_SB(1, 1), b3 + hstep, voffB); PG8_STAGE(PG8_SA(1, 0), a3, voffA);
            PG8_WAIT_V(8); PG8_WAIT_L(0); PG8_BAR; PG8_MMA(1, 0, At, B0); PG8_MMA(1, 1, At, B1); PG8_BAR; PG8_SCHED;
            } else {
            PG8_LDB(B0, 0, 0); PG8_SCHED; PG8_LDA(At, 0, 0); PG8_STAGE(PG8_SA(1, 1), a1 + hstep, voffA);
            PG8_WAIT_L(8); PG8_BAR; PG8_WAIT_L(0); PG8_MMA(0, 0, At, B0); PG8_BAR; PG8_SCHED;
            PG8_LDB(B1, 0, 1); PG8_STAGE(PG8_SB(0, 0), b2, voffB);
            PG8_BAR; PG8_WAIT_L(0); PG8_MMA(0, 1, At, B1); PG8_BAR;
            PG8_LDA(At, 0, 1); PG8_STAGE(PG8_SA(0, 0), a2, voffA);
            PG8_BAR; PG8_WAIT_L(0); PG8_MMA(1, 0, At, B0); PG8_BAR; PG8_SCHED;
            PG8_STAGE(PG8_SB(0, 1), b2 + hstep, voffB);
            PG8_WAIT_V(6); PG8_BAR; PG8_MMA(1, 1, At, B1); PG8_BAR;
            PG8_LDB(B0, 1, 0); PG8_SCHED; PG8_LDA(At, 1, 0); PG8_STAGE(PG8_SA(0, 1), a2 + hstep, voffA);
            PG8_WAIT_L(8); PG8_BAR; PG8_WAIT_L(0); PG8_MMA(0, 0, At, B0); PG8_BAR; PG8_SCHED;
            PG8_LDB(B1, 1, 1); PG8_STAGE(PG8_SB(1, 0), b3, voffB);
            PG8_BAR; PG8_WAIT_L(0); PG8_MMA(0, 1, At, B1); PG8_BAR;
            PG8_LDA(At, 1, 1); PG8_STAGE(PG8_SA(1, 0), a3, voffA);
            PG8_BAR; PG8_WAIT_L(0); PG8_MMA(1, 0, At, B0); PG8_BAR; PG8_SCHED;
            PG8_STAGE(PG8_SB(1, 1), b3 + hstep, voffB);
            PG8_WAIT_V(6); PG8_BAR; PG8_MMA(1, 1, At, B1); PG8_BAR;
            }
        }
        if constexpr (ALIGN_EPI) { if (wr == 0) PG8_BAR; }
        if constexpr (F8) {
            asm volatile("s_nop 15\n\ts_nop 15" ::: "memory");
#pragma unroll
            for (int a = 0; a < 2; ++a)
#pragma unroll
                for (int b = 0; b < 2; ++b)
#pragma unroll
                    for (int m = 0; m < 4; ++m) asm volatile("" : "+v"(acc[a][b][m][0]), "+v"(acc[a][b][m][1]));
        }
        if constexpr (!Epi::AFTER_DRAIN) { E(acc, cur, wr, wc, fr, fq); S.done(cur); }
        if (!has_next) break;
#pragma unroll
        for (int a = 0; a < 2; ++a)
#pragma unroll
            for (int b = 0; b < 2; ++b)
#pragma unroll
                for (int m = 0; m < 4; ++m)
#pragma unroll
                    for (int n = 0; n < 2; ++n) acc[a][b][m][n] = (f32x4){0.f, 0.f, 0.f, 0.f};
        cur = nxt; cA = nA; cB = nB; ++ui;
        if constexpr (ALIGN_EPI) { if (wr == 1) PG8_BAR; }
    }
    PG8_WAIT_V(0);
    if constexpr (!ALIGN_EPI) { if (wr == 0) PG8_BAR; }
    PG8_BAR;
    if constexpr (Epi::AFTER_DRAIN) { E.fused(acc, cur, wr, wc, fr, fq, lds, wid, lane); S.done(cur); }
#undef PG8_SA
#undef PG8_SB
#undef PG8_STAGE
#undef PG8_LDA
#undef PG8_LDB
#undef PG8_MMA
#undef PG8_WAIT_V
#undef PG8_WAIT_L
#undef PG8_BAR
#undef PG8_SCHED
}
}
namespace hy {
using pg8::bf16_t; using pg8::f32x4; using pg8::u32x4; using pg8::bf16x8;
#define LAS __attribute__((address_space(3)))
constexpr int NB = 4, SEQ = 4096, DM = 1024, CTXL = 256;
constexpr int M_LAT = NB * SEQ, M_CTX = NB * CTXL, M_ALL = M_LAT + M_CTX;
constexpr int IN_COLS = 3104, NE = 16, CAP = 512, DE = 2816, NSLOT = NE * NB * CAP;
constexpr int PROJ_LD = 2304, PC_NAK = 0, PC_GK = 512, PC_NAQ = 768, PC_GQ = 1280, PC_GG = 1536, PC_AD = 2048;
constexpr int VT_LD = M_ALL;
constexpr float EPS = 1e-6f;
constexpr int TKB = SEQ + CTXL;
constexpr size_t MiB = 1u << 20;
constexpr size_t WS_MODP = 1 * MiB, WS_MOD = 3 * MiB, WS_WTIN = 4 * MiB, WS_WTV = 9 * MiB, WS_WTOUT = 11 * MiB, WS_AFF = 13 * MiB, WS_IDX = 14 * MiB, WS_GATE = 14 * MiB + 256 * 1024, WS_INV = 15 * MiB;
constexpr size_t WS_WTGU = 16 * MiB, WS_WTDN = 192 * MiB, WS_H = 280 * MiB, WS_PROJ = 314 * MiB, WS_VT = 391 * MiB, WS_OMIX = 425 * MiB, WS_MIX = 457 * MiB, WS_HID = 280 * MiB;
constexpr size_t WS_HF = 489 * MiB, WS_XS = 521 * MiB, WS_GLAT = 590 * MiB, WS_QF = 590 * MiB, WS_KF = 606 * MiB, WS_KFT = 622 * MiB, WS_AT = 639 * MiB, WS_SB = 640 * MiB, WS_UPF = 639 * MiB + 768 * 1024, WS_KH = 521 * MiB, WS_VB = 538 * MiB, WS_END = 672 * MiB;
static_assert(WS_WTIN + (size_t)PROJ_LD * DM * 2 <= WS_WTV && WS_WTGU + (size_t)NE * 2 * DE * DM * 2 <= WS_WTDN && WS_WTDN + (size_t)NE * DM * DE * 2 <= WS_H, "ws map 1");
static_assert(WS_H + (size_t)M_ALL * DM * 2 <= WS_PROJ && WS_PROJ + (size_t)M_ALL * PROJ_LD * 2 <= WS_VT && WS_VT + (size_t)1024 * VT_LD * 2 <= WS_OMIX, "ws map 2");
static_assert(WS_HID + (size_t)NSLOT * DE * 2 <= WS_MIX && WS_XS + (size_t)NSLOT * DM * 2 <= WS_GLAT && WS_SB + (size_t)2 * NB * 4 * 64 * 128 * 64 * 2 <= WS_END && WS_KFT + (size_t)2 * 256 * M_ALL * 2 <= WS_AT, "ws map 3");

__device__ __forceinline__ float bf2f(bf16_t x) { return __uint_as_float((unsigned)x << 16); }
__device__ __forceinline__ unsigned f2bf(float f) { unsigned u = __float_as_uint(f); return (u + 0x7fffu + ((u >> 16) & 1u)) >> 16; }
__device__ __forceinline__ unsigned pk2(float lo, float hi) { return f2bf(lo) | (f2bf(hi) << 16); }
__device__ __forceinline__ float wave_sum(float v) {
#pragma unroll
    for (int o = 1; o < 64; o <<= 1) v += __shfl_xor(v, o);
    return v;
}
__device__ __forceinline__ float silu_f(float x) { return x * __builtin_amdgcn_rcpf(1.f + __builtin_amdgcn_exp2f(x * -1.4426950408889634f)); }

__device__ __forceinline__ void ph_mod(const float* __restrict__ c, const float* __restrict__ c_ctx, const float* __restrict__ w_mod, const float* __restrict__ b_mod, float* __restrict__ mod, LAS unsigned char* lds, int bid, int G) {
    LAS float* s = (LAS float*)lds;
    LAS float* red = s + 5 * 1024;
    const int tid = threadIdx.x;
    __syncthreads();
    for (int i = tid; i < 5 * 1024; i += 512) { const int v = i >> 10, k = i & 1023; const float x = v < 4 ? c[v * 1024 + k] : c_ctx[k]; s[i] = x / (1.f + expf(-x)); }
    __syncthreads();
    for (int cg = bid; cg < 256; cg += G) {
        const int ks = tid / 24, cj = tid % 24, j = cg * 24 + cj;
        if (tid < 504) {
            float acc[5] = {0.f, 0.f, 0.f, 0.f, 0.f};
            const int k0 = ks * 49, k1 = min(k0 + 49, 1024);
#pragma unroll 7
            for (int k = k0; k < k1; ++k) { const float w = w_mod[(size_t)k * 6144 + j];
#pragma unroll
                for (int v = 0; v < 5; ++v) acc[v] += s[v * 1024 + k] * w; }
#pragma unroll
            for (int v = 0; v < 5; ++v) red[(v * 21 + ks) * 24 + cj] = acc[v];
        }
        __syncthreads();
        if (tid < 120) { const int v = tid / 24, cc = tid % 24; float a = b_mod[cg * 24 + cc];
            for (int q = 0; q < 21; ++q) a += red[(v * 21 + q) * 24 + cc];
            mod[(size_t)v * 6144 + cg * 24 + cc] = a; }
        __syncthreads();
    }
}

__device__ __forceinline__ void transpose_item(const float* __restrict__ W, int N, int k0, int n0, bf16_t* dst, int K, float scale, LAS float* scr, int lane) {
    float wv[32];
#pragma unroll
    for (int i = 0; i < 32; ++i) wv[i] = W[(size_t)(k0 + 2 * i + (lane >> 5)) * N + n0 + (lane & 31)];
#pragma unroll
    for (int i = 0; i < 32; ++i) scr[(2 * i + (lane >> 5)) * 33 + (lane & 31)] = wv[i];
    asm volatile("s_waitcnt lgkmcnt(0)" ::: "memory");
    const int c = lane & 7;
#pragma unroll
    for (int j = 0; j < 4; ++j) { const int n = (lane >> 3) + 8 * j; const LAS float* s = scr + (8 * c) * 33 + n;
        u32x4 o; o.x = pk2(s[0 * 33] * scale, s[1 * 33] * scale); o.y = pk2(s[2 * 33] * scale, s[3 * 33] * scale); o.z = pk2(s[4 * 33] * scale, s[5 * 33] * scale); o.w = pk2(s[6 * 33] * scale, s[7 * 33] * scale);
        *(u32x4*)(dst + (size_t)n * K + k0 + 8 * c) = o; }
    asm volatile("s_waitcnt lgkmcnt(0)" ::: "memory");
}
constexpr float SX8 = 16.f, SW1 = 64.f, SH8 = 8.f, SW2 = 128.f;
__device__ __forceinline__ float clamp448(float v) { return fminf(fmaxf(v, -448.f), 448.f); }
__device__ __forceinline__ unsigned pk4_fp8(float a, float b, float c, float d) {
    int w = 0; w = __builtin_amdgcn_cvt_pk_fp8_f32(clamp448(a), clamp448(b), w, false); w = __builtin_amdgcn_cvt_pk_fp8_f32(clamp448(c), clamp448(d), w, true); return (unsigned)w; }
__device__ __forceinline__ void transpose_item_f8(const float* __restrict__ W, int N, int k0, int n0, unsigned char* dst, int Kb, float scale, LAS float* scr, int lane) {
    float wv[32];
#pragma unroll
    for (int i = 0; i < 32; ++i) wv[i] = W[(size_t)(k0 + 2 * i + (lane >> 5)) * N + n0 + (lane & 31)];
#pragma unroll
    for (int i = 0; i < 32; ++i) scr[(2 * i + (lane >> 5)) * 33 + (lane & 31)] = wv[i];
    asm volatile("s_waitcnt lgkmcnt(0)" ::: "memory");
    const int c = lane & 3;
#pragma unroll
    for (int j = 0; j < 2; ++j) { const int n = (lane >> 2) + 16 * j; const LAS float* s = scr + (16 * c) * 33 + n;
        u32x4 o; o.x = pk4_fp8(s[0 * 33] * scale, s[1 * 33] * scale, s[2 * 33] * scale, s[3 * 33] * scale); o.y = pk4_fp8(s[4 * 33] * scale, s[5 * 33] * scale, s[6 * 33] * scale, s[7 * 33] * scale);
        o.z = pk4_fp8(s[8 * 33] * scale, s[9 * 33] * scale, s[10 * 33] * scale, s[11 * 33] * scale); o.w = pk4_fp8(s[12 * 33] * scale, s[13 * 33] * scale, s[14 * 33] * scale, s[15 * 33] * scale);
        *(u32x4*)(dst + (size_t)n * Kb + k0 + 16 * c) = o; }
    asm volatile("s_waitcnt lgkmcnt(0)" ::: "memory");
}
struct PrepArgs { const float *x, *ctx, *g_pre, *mod, *w_in, *w_out, *w_gate, *w_up, *w_down; bf16_t *WTIN, *WTV, *WTOUT; unsigned char *WTGU, *WTDN; bf16_t* H; };
constexpr int IT_IN = 16 * 97, IT_OUT = 16 * 32, IT_GU1 = 16 * 16 * 88, IT_DN = 16 * 44 * 32, IT_ALL = IT_IN + IT_OUT + 2 * IT_GU1 + IT_DN;
struct CvtItem { const float* W; unsigned char* dst; int N, Kb; float scale; };
constexpr int IT16 = IT_IN + IT_OUT;
constexpr int IT8_GU1 = 16 * 8 * 88, IT8_DN = 16 * 22 * 32, IT8 = 2 * IT8_GU1 + IT8_DN;
#ifndef CVT_Q0
#define CVT_Q0 0
#endif
#ifndef CVT_Q1
#define CVT_Q1 23000
#endif
__device__ __forceinline__ CvtItem cvt_decode16(const PrepArgs& a, int it) {
    CvtItem c; int r = it;
    if (r < IT_IN) { const int kb = r / 97, n0 = (r % 97) * 32; bf16_t* dst; float sc = 1.f;
        if (n0 < 512) dst = a.WTIN + (size_t)(PC_NAK + n0) * DM;
        else if (n0 < 1024) dst = a.WTV + (size_t)(n0 - 512) * DM;
        else if (n0 < 1280) dst = a.WTIN + (size_t)(PC_GK + n0 - 1024) * DM;
        else if (n0 < 1792) dst = a.WTV + (size_t)(512 + n0 - 1280) * DM;
        else if (n0 < 1824) dst = a.WTIN + (size_t)(PC_AD + n0 - 1792) * DM;
        else if (n0 < 2336) { dst = a.WTIN + (size_t)(PC_NAQ + n0 - 1824) * DM; sc = 0.125f; }
        else if (n0 < 2592) { dst = a.WTIN + (size_t)(PC_GQ + n0 - 2336) * DM; sc = 0.125f; }
        else dst = a.WTIN + (size_t)(PC_GG + n0 - 2592) * DM;
        c.W = a.w_in + (size_t)(kb * 64) * IN_COLS + n0; c.N = IN_COLS; c.dst = (unsigned char*)(dst + kb * 64); c.Kb = DM * 2; c.scale = sc; return c; }
    r -= IT_IN;
    { const int kb = r / 32, n0 = (r % 32) * 32; c.W = a.w_out + (size_t)(kb * 64) * DM + n0; c.N = DM; c.dst = (unsigned char*)(a.WTOUT + (size_t)n0 * DM + kb * 64); c.Kb = DM * 2; c.scale = 1.f; return c; }
}
__device__ __forceinline__ CvtItem cvt_decode8(const PrepArgs& a, int it) {
    CvtItem c; int r = it;
    if (r < 2 * IT8_GU1) { const int which = r / IT8_GU1; r %= IT8_GU1; const int e = r / (8 * 88); r %= (8 * 88); const int kb = r / 88, n0 = (r % 88) * 32;
        c.W = (which ? a.w_up : a.w_gate) + (size_t)e * DM * DE + (size_t)(kb * 128) * DE + n0; c.N = DE;
        c.dst = a.WTGU + ((size_t)e * 2 * DE + (n0 / 128) * 256 + (n0 % 128) + which * 128) * DM + kb * 128; c.Kb = DM; c.scale = SW1; return c; }
    r -= 2 * IT8_GU1;
    { const int e = r / (22 * 32); r %= (22 * 32); const int kb = r / 32, n0 = (r % 32) * 32;
      c.W = a.w_down + (size_t)e * DE * DM + (size_t)(kb * 128) * DM + n0; c.N = DM; c.dst = a.WTDN + ((size_t)e * DM + n0) * DE + kb * 128; c.Kb = DE; c.scale = SW2; return c; }
}
__device__ __forceinline__ void cvt_load(const CvtItem& c, int half, float (&wv)[32], int lane) {
    const float* W = c.W + (size_t)(64 * half) * c.N;
#pragma unroll
    for (int i = 0; i < 32; ++i) wv[i] = __builtin_nontemporal_load(&W[(size_t)(2 * i + (lane >> 5)) * c.N + (lane & 31)]);
}
template <bool F8> __device__ __forceinline__ void cvt_store(const CvtItem& c, int half, const float (&wv)[32], LAS float* scr, int lane) {
#pragma unroll
    for (int i = 0; i < 32; ++i) scr[(2 * i + (lane >> 5)) * 33 + (lane & 31)] = wv[i];
    asm volatile("s_waitcnt lgkmcnt(0)" ::: "memory");
    const float scale = c.scale;
    if constexpr (F8) {
        const int cc = lane & 3; unsigned char* dst = c.dst + 64 * half;
#pragma unroll
        for (int j = 0; j < 2; ++j) { const int n = (lane >> 2) + 16 * j; const LAS float* s = scr + (16 * cc) * 33 + n;
            u32x4 o; o.x = pk4_fp8(s[0 * 33] * scale, s[1 * 33] * scale, s[2 * 33] * scale, s[3 * 33] * scale); o.y = pk4_fp8(s[4 * 33] * scale, s[5 * 33] * scale, s[6 * 33] * scale, s[7 * 33] * scale);
            o.z = pk4_fp8(s[8 * 33] * scale, s[9 * 33] * scale, s[10 * 33] * scale, s[11 * 33] * scale); o.w = pk4_fp8(s[12 * 33] * scale, s[13 * 33] * scale, s[14 * 33] * scale, s[15 * 33] * scale);
            __builtin_nontemporal_store(o, (u32x4*)(dst + (size_t)n * c.Kb + 16 * cc)); }
    } else {
        const int cc = lane & 7;
#pragma unroll
        for (int j = 0; j < 4; ++j) { const int n = (lane >> 3) + 8 * j; const LAS float* s = scr + (8 * cc) * 33 + n;
            u32x4 o; o.x = pk2(s[0 * 33] * scale, s[1 * 33] * scale); o.y = pk2(s[2 * 33] * scale, s[3 * 33] * scale); o.z = pk2(s[4 * 33] * scale, s[5 * 33] * scale); o.w = pk2(s[6 * 33] * scale, s[7 * 33] * scale);
            *(u32x4*)(c.dst + (size_t)n * c.Kb + 16 * cc) = o; }
    }
    asm volatile("s_waitcnt lgkmcnt(0)" ::: "memory");
}
template <bool F8> __device__ __forceinline__ void cvt_run(const PrepArgs& a, int it_lo, int it_hi, int wv0, int nwv, LAS float* scr, int lane) {
    int it = it_lo + wv0; if (it >= it_hi) return;
    float wa[32], wb[32];
    if constexpr (F8) {
        CvtItem c = cvt_decode8(a, it); cvt_load(c, 0, wa, lane);
        for (;;) {
            cvt_load(c, 1, wb, lane);
            cvt_store<true>(c, 0, wa, scr, lane);
            const int itn = it + nwv; const bool hn = itn < it_hi;
            const CvtItem cn = cvt_decode8(a, hn ? itn : it); cvt_load(cn, 0, wa, lane);
            cvt_store<true>(c, 1, wb, scr, lane);
            if (!hn) break;
            c = cn; it = itn;
        }
    } else {
        CvtItem ca = cvt_decode16(a, it), cb;  cvt_load(ca, 0, wa, lane);
        for (;;) {
            int itn = it + nwv; bool hn = itn < it_hi;
            cb = cvt_decode16(a, hn ? itn : it); cvt_load(cb, 0, wb, lane);
            cvt_store<false>(ca, 0, wa, scr, lane);
            if (!hn) break;
            it = itn; itn = it + nwv; hn = itn < it_hi;
            ca = cvt_decode16(a, hn ? itn : it); cvt_load(ca, 0, wa, lane);
            cvt_store<false>(cb, 0, wb, scr, lane);
            if (!hn) break;
            it = itn;
        }
    }
}
__device__ __forceinline__ void ph_convert(const PrepArgs& a, LAS unsigned char* lds, int bid, int G) {
    const int tid = threadIdx.x, lane = tid & 63, wave = tid >> 6;
    LAS float* scr = (LAS float*)(lds + wave * 8448);
    { u32x4* z = (u32x4*)(a.WTIN + (size_t)(PC_AD + 32) * DM); const int nz = (PROJ_LD - PC_AD - 32) * DM * 2 / 16;
      for (int i = bid * 512 + tid; i < nz; i += G * 512) z[i] = (u32x4){0u, 0u, 0u, 0u}; }
    cvt_run<false>(a, 0, IT16, bid * 8 + wave, G * 8, scr, lane);
    cvt_run<true>(a, 0, CVT_Q0, bid * 8 + wave, G * 8, scr, lane);
}
__device__ __forceinline__ void ph_convert_bg(const PrepArgs& a, int lo, int hi, int pid, int npid, LAS unsigned char* lds) {
    const int lane = threadIdx.x & 63, wave = threadIdx.x >> 6;
    if (pid < 0) return;
    cvt_run<true>(a, lo, hi, pid, npid, (LAS float*)(lds + 32768 + wave * 8448), lane);
}
__device__ __forceinline__ void ph_modulate(const PrepArgs& a, int bid, int G) {
    const int tid = threadIdx.x, lane = tid & 63, wave = tid >> 6;
    const int gw = bid * 8 + wave, NGW = G * 8;
    for (int m0 = gw; m0 < M_ALL; m0 += 2 * NGW) {
        const float* src[2]; int v[2]; int mm[2]; bool ok[2];
#pragma unroll
        for (int r = 0; r < 2; ++r) { const int m = m0 + r * NGW; ok[r] = m < M_ALL; mm[r] = ok[r] ? m : m0;
            if (mm[r] < M_LAT) { src[r] = a.x + (size_t)mm[r] * DM; v[r] = mm[r] / SEQ; } else { src[r] = a.ctx + (size_t)(mm[r] - M_LAT) * DM; v[r] = 4; } }
        f32x4 xv[2][4]; float ss[2] = {0.f, 0.f};
#pragma unroll
        for (int r = 0; r < 2; ++r)
#pragma unroll
            for (int j = 0; j < 4; ++j) xv[r][j] = ((const f32x4*)src[r])[lane + 64 * j];
#pragma unroll
        for (int r = 0; r < 2; ++r)
#pragma unroll
            for (int j = 0; j < 4; ++j) ss[r] += (xv[r][j].x * xv[r][j].x + xv[r][j].y * xv[r][j].y) + (xv[r][j].z * xv[r][j].z + xv[r][j].w * xv[r][j].w);
#pragma unroll
        for (int o = 1; o < 64; o <<= 1) { ss[0] += __shfl_xor(ss[0], o); ss[1] += __shfl_xor(ss[1], o); }
#pragma unroll
        for (int r = 0; r < 2; ++r) { if (!ok[r]) continue;
            const float rstd = rsqrtf(ss[r] * (1.f / DM) + EPS);
            const float* mv = a.mod + (size_t)v[r] * 6144;
            unsigned long long* o8 = (unsigned long long*)(a.H + (size_t)mm[r] * DM) + lane;
#pragma unroll
            for (int j = 0; j < 4; ++j) { const int col = 4 * lane + 256 * j;
                const f32x4 g = *(const f32x4*)(a.g_pre + col), sh = *(const f32x4*)(mv + col), sc = *(const f32x4*)(mv + 1024 + col);
                const f32x4 hv = xv[r][j] * rstd * g * (sc + 1.f) + sh;
                o8[64 * j] = (unsigned long long)pk2(hv.x, hv.y) | ((unsigned long long)pk2(hv.z, hv.w) << 32); } }
    }
}


__device__ __forceinline__ void tok_of_row(int row, int& bb, int& tk) { if (row < M_LAT) { bb = row >> 12; tk = row & (SEQ - 1); } else { const int r2 = row - M_LAT; bb = r2 >> 8; tk = SEQ + (r2 & (CTXL - 1)); } }
struct EpiProj {
    static constexpr bool PERM = true, AFTER_DRAIN = false;
    bf16_t* O; int ldc; bf16_t* KH;
    __device__ __forceinline__ void operator()(const f32x4 (&acc)[2][2][4][2], const pg8::Unit& u, int wr, int wc, int fr, int fq) const {
        const int row0 = u.pm * 256 + wr * 64 + fr, col0 = u.pn * 256 + wc * 32 + 8 * fq;
#pragma unroll
        for (int ai = 0; ai < 2; ++ai)
#pragma unroll
            for (int m = 0; m < 4; ++m) { const int row = row0 + ai * 128 + m * 16; int bb, tk; tok_of_row(row, bb, tk);
#pragma unroll
                for (int bj = 0; bj < 2; ++bj) { const f32x4 v0 = acc[ai][bj][m][0], v1 = acc[ai][bj][m][1];
                    u32x4 w; w.x = pg8::cvt_pk_bf16(v0[0], v0[1]); w.y = pg8::cvt_pk_bf16(v0[2], v0[3]); w.z = pg8::cvt_pk_bf16(v1[0], v1[1]); w.w = pg8::cvt_pk_bf16(v1[2], v1[3]);
                    const int col = col0 + bj * 128;
                    if (u.pn < 2) { const int hh = col >> 6, ks = (col >> 5) & 1; *(u32x4*)(KH + ((size_t)((bb * 8 + hh) * 2 + ks) * TKB + tk) * 32 + (col & 31)) = w; }
                    else *(u32x4*)(O + (size_t)row * ldc + col) = w; } }
    }
};
struct EpiVal {
    static constexpr bool PERM = true, AFTER_DRAIN = false;
    bf16_t* VT; int ldc; bf16_t* VB;
    __device__ __forceinline__ void operator()(const f32x4 (&acc)[2][2][4][2], const pg8::Unit& u, int wr, int wc, int fr, int fq) const {
        const int row0 = u.pm * 256 + wr * 64 + fr, col0 = u.pn * 256 + wc * 32 + 8 * fq;
#pragma unroll
        for (int ai = 0; ai < 2; ++ai)
#pragma unroll
            for (int m = 0; m < 4; ++m) { const int vr = row0 + ai * 128 + m * 16;
#pragma unroll
                for (int bj = 0; bj < 2; ++bj) { const f32x4 v0 = acc[ai][bj][m][0], v1 = acc[ai][bj][m][1];
                    u32x4 w; w.x = pg8::cvt_pk_bf16(v0[0], v0[1]); w.y = pg8::cvt_pk_bf16(v0[2], v0[3]); w.z = pg8::cvt_pk_bf16(v1[0], v1[1]); w.w = pg8::cvt_pk_bf16(v1[2], v1[3]);
                    const int col = col0 + bj * 128;
                    if (u.pm < 2) { int bb, tk; tok_of_row(col, bb, tk); const int hh = vr >> 6, dt = (vr >> 4) & 3, dd = vr & 15;
                        *(u32x4*)(VB + ((size_t)(((bb * 8 + hh) * 4 + dt) * (TKB / 8) + (tk >> 3)) * 16 + dd) * 8) = w; }
                    else *(u32x4*)(VT + (size_t)vr * ldc + col) = w; } }
    }
};
struct InOrder {
    int G, c; const char* H; const char* WTIN; const char* WTV;
    static constexpr int NLAT = 64 * 9, NCTX = 16, NV = 4 * 68, NALL = NLAT + NCTX + NV;
    __device__ __forceinline__ bool next(int i, pg8::Unit& u) const {
        const int L = i * G + c; if (L >= NALL) return false;
        constexpr size_t ts = (size_t)256 * DM * 2;
        if (L < NLAT) { pg8::StaticOrder S; S.nM = 64; S.nN = 9; S.nwg = NLAT; S.G = NLAT; S.c = L; S.A = H; S.B = WTIN; S.ts = ts; S.next(0, u); return true; }
        if (L < NLAT + NCTX) { const int j = L - NLAT, q = j & 3; u.pm = 64 + (j >> 2); u.pn = q == 3 ? 8 : q; u.bt = u.pn; u.kind = 0; u.a = H + (size_t)u.pm * ts; u.b = WTIN + (size_t)u.bt * ts; return true; }
        const int j = L - NLAT - NCTX; u.pm = j & 3; u.pn = j >> 2; u.bt = u.pn; u.kind = 1; u.a = WTV + (size_t)u.pm * ts; u.b = H + (size_t)u.bt * ts; return true;
    }
    __device__ __forceinline__ void a_ready(const pg8::Unit&) const {}
    __device__ __forceinline__ void done(const pg8::Unit&) const {}
};
struct EpiIn {
    static constexpr bool PERM = true, AFTER_DRAIN = false;
    EpiProj P; EpiVal V;
    __device__ __forceinline__ void operator()(const f32x4 (&acc)[2][2][4][2], const pg8::Unit& u, int wr, int wc, int fr, int fq) const { if (u.kind == 0) P(acc, u, wr, wc, fr, fq); else V(acc, u, wr, wc, fr, fq); }
};
struct EpiSwiGLU {
    static constexpr bool PERM = true, AFTER_DRAIN = false;
    unsigned char* O; int ldc;
    __device__ __forceinline__ void operator()(const f32x4 (&acc)[2][2][4][2], const pg8::Unit& u, int wr, int wc, int fr, int fq) const {
        const int row0 = u.pm * 256 + wr * 64 + fr, col0 = u.pn * 128 + wc * 32 + 8 * fq;
        constexpr float DS = 1.f / (SX8 * SW1);
#pragma unroll
        for (int ai = 0; ai < 2; ++ai)
#pragma unroll
            for (int m = 0; m < 4; ++m) { unsigned char* rowp = O + (size_t)(row0 + ai * 128 + m * 16) * ldc + col0;
                const f32x4 g0 = acc[ai][0][m][0] * DS, g1 = acc[ai][0][m][1] * DS, u0 = acc[ai][1][m][0] * (DS * SH8), u1 = acc[ai][1][m][1] * (DS * SH8);
                uint2 w; w.x = pk4_fp8(silu_f(g0[0]) * u0[0], silu_f(g0[1]) * u0[1], silu_f(g0[2]) * u0[2], silu_f(g0[3]) * u0[3]);
                w.y = pk4_fp8(silu_f(g1[0]) * u1[0], silu_f(g1[1]) * u1[1], silu_f(g1[2]) * u1[2], silu_f(g1[3]) * u1[3]);
                *(uint2*)rowp = w; }
    }
};
struct EpiRowScale {
    static constexpr bool PERM = true, AFTER_DRAIN = false;
    bf16_t* O; int ldc; const float* rowscale;
    __device__ __forceinline__ void operator()(const f32x4 (&acc)[2][2][4][2], const pg8::Unit& u, int wr, int wc, int fr, int fq) const {
        const int row0 = u.pm * 256 + wr * 64 + fr, col0 = u.pn * 256 + wc * 32 + 8 * fq;
#pragma unroll
        for (int ai = 0; ai < 2; ++ai)
#pragma unroll
            for (int m = 0; m < 4; ++m) { const int row = row0 + ai * 128 + m * 16; const float sc = rowscale[row] * (1.f / (SH8 * SW2)); bf16_t* rowp = O + (size_t)row * ldc + col0;
#pragma unroll
                for (int bj = 0; bj < 2; ++bj) { const f32x4 v0 = acc[ai][bj][m][0] * sc, v1 = acc[ai][bj][m][1] * sc;
                    u32x4 w; w.x = pg8::cvt_pk_bf16(v0[0], v0[1]); w.y = pg8::cvt_pk_bf16(v0[2], v0[3]); w.z = pg8::cvt_pk_bf16(v1[0], v1[1]); w.w = pg8::cvt_pk_bf16(v1[2], v1[3]);
                    *(u32x4*)(rowp + bj * 128) = w; } }
    }
};
struct ExpertOrder {
    int nT, G, c; const char* A; const char* B; size_t ts;
    __device__ __forceinline__ bool next(int i, pg8::Unit& u) const {
        if (G == 256) { const int x = c & 7, j = c >> 3, mt = j & 7, q = j >> 3;
            int e, pn;
            if (nT == 4) { if (i >= 2) return false; e = 2 * x + i; pn = q; }
            else { if (i >= 11) return false;
                if (i < 5) { e = 2 * x; pn = 4 * i + q; } else if (i == 5) { e = 2 * x + (q >> 1); pn = 20 + (q & 1); } else { e = 2 * x + 1; pn = 4 * (i - 6) + q; } }
            u.pm = e * 8 + mt; u.pn = pn; u.bt = e * nT + pn; u.kind = 0; u.a = A + (size_t)u.pm * ts; u.b = B + (size_t)u.bt * ts; return true; }
        const long L = (long)i * G + c; if (L >= (long)128 * nT) return false;
        const int e = (int)(L / (8 * nT)), r = (int)(L % (8 * nT)); u.pm = e * 8 + (r % 8); u.pn = r / 8; u.bt = e * nT + u.pn; u.kind = 0; u.a = A + (size_t)u.pm * ts; u.b = B + (size_t)u.bt * ts; return true;
    }
    __device__ __forceinline__ void a_ready(const pg8::Unit&) const {}
    __device__ __forceinline__ void done(const pg8::Unit&) const {}
};
__device__ __forceinline__ void ph_na_naive(const bf16_t* __restrict__ PROJ, const bf16_t* __restrict__ VT, const float* __restrict__ rpb, bf16_t* __restrict__ OMIX, int bid, int G) {
  for (int vb = bid * 8 + (threadIdx.x >> 6); vb < NB * 8 * 64; vb += G * 8) {
    const int r = vb % 64, h = (vb / 64) % 8, b = vb / 512, c = threadIdx.x & 63;
    const size_t mq = (size_t)b * SEQ + r * 64 + c;
    float q[64], acc[64];
    { const u32x4* qp = (const u32x4*)(PROJ + mq * PROJ_LD + PC_NAQ + h * 64);
#pragma unroll
      for (int i = 0; i < 8; ++i) { const u32x4 w = qp[i]; q[8 * i + 0] = __uint_as_float(w.x << 16); q[8 * i + 1] = __uint_as_float(w.x & 0xffff0000u); q[8 * i + 2] = __uint_as_float(w.y << 16); q[8 * i + 3] = __uint_as_float(w.y & 0xffff0000u);
          q[8 * i + 4] = __uint_as_float(w.z << 16); q[8 * i + 5] = __uint_as_float(w.z & 0xffff0000u); q[8 * i + 6] = __uint_as_float(w.w << 16); q[8 * i + 7] = __uint_as_float(w.w & 0xffff0000u); } }
#pragma unroll
    for (int d = 0; d < 64; ++d) acc[d] = 0.f;
    float mx = -INFINITY, l = 0.f;
    const int rs = min(max(r - 4, 0), 56), cs = min(max(c - 8, 0), 48);
    for (int kk = 0; kk < 128 + CTXL; ++kk) {
        size_t mk; float bias = 0.f;
        if (kk < 128) { const int krow = rs + (kk >> 4), kcol = cs + (kk & 15); mk = (size_t)b * SEQ + krow * 64 + kcol; bias = rpb[(h * 15 + (krow - r + 7)) * 31 + (kcol - c + 15)]; }
        else mk = (size_t)M_LAT + b * CTXL + (kk - 128);
        const u32x4* kp = (const u32x4*)(PROJ + mk * PROJ_LD + PC_NAK + h * 64);
        float s = 0.f;
#pragma unroll
        for (int i = 0; i < 8; ++i) { const u32x4 w = kp[i];
            s += q[8 * i + 0] * __uint_as_float(w.x << 16) + q[8 * i + 1] * __uint_as_float(w.x & 0xffff0000u) + q[8 * i + 2] * __uint_as_float(w.y << 16) + q[8 * i + 3] * __uint_as_float(w.y & 0xffff0000u)
               + q[8 * i + 4] * __uint_as_float(w.z << 16) + q[8 * i + 5] * __uint_as_float(w.z & 0xffff0000u) + q[8 * i + 6] * __uint_as_float(w.w << 16) + q[8 * i + 7] * __uint_as_float(w.w & 0xffff0000u); }
        s += bias;
        const float mn = fmaxf(mx, s), al = __expf(mx - mn), p = __expf(s - mn);
        l = l * al + p; mx = mn;
        const bf16_t* vp = VT + (size_t)(h * 64) * VT_LD + mk;
#pragma unroll
        for (int d = 0; d < 64; ++d) acc[d] = acc[d] * al + p * bf2f(vp[(size_t)d * VT_LD]);
    }
    const float inv = 1.f / l;
    unsigned* op = (unsigned*)(OMIX + mq * DM + h * 64);
#pragma unroll
    for (int i = 0; i < 32; ++i) op[i] = pk2(acc[2 * i] * inv, acc[2 * i + 1] * inv);
  }
}

__device__ __forceinline__ f32x4 mfma16(bf16x8 a, bf16x8 b, f32x4 c) { return __builtin_amdgcn_mfma_f32_16x16x32_bf16(a, b, c, 0, 0, 0); }
__device__ __forceinline__ void na_unit(int u, const bf16_t* __restrict__ PROJ, const bf16_t* __restrict__ KH, const bf16_t* __restrict__ VB, const LAS float* rb, const LAS unsigned char* ck, const LAS unsigned char* cv, bf16_t* __restrict__ OMIX, int lane) {
    const int q = lane & 15, g = lane >> 4;
    const int bh = u >> 8, b = bh >> 3, h = bh & 7, r = (u & 255) >> 2, qt = u & 3;
    const int c0 = (qt == 0) ? 0 : (qt == 3 ? 32 : 16 * qt - 8);
    const int rs = min(max(r - 4, 0), 56);
    const int cq = 16 * qt + q, cs = min(max(cq - 8, 0), 48);
    const size_t mq = (size_t)b * SEQ + r * 64 + cq;
    const bf16_t* qp = PROJ + mq * PROJ_LD + PC_NAQ + h * 64 + 8 * g;
    const bf16x8 qf0 = *(const bf16x8*)qp, qf1 = *(const bf16x8*)(qp + 32);
    const bf16_t* kb0 = KH + ((size_t)(bh * 2) * TKB + 8 * (q >> 2) + (q & 3)) * 32 + 8 * g;
    const bf16_t* kb1 = kb0 + (size_t)TKB * 32;
    f32x4 S[32];
#pragma unroll
    for (int p = 0; p < 8; ++p) {
        const int s = (rs + p) * 64 + c0;
#pragma unroll
        for (int half = 0; half < 2; ++half) {
            const size_t off = (size_t)(s + 4 * half) * 32;
            f32x4 acc = (f32x4){0.f, 0.f, 0.f, 0.f};
            acc = mfma16(*(const bf16x8*)(kb0 + off), qf0, acc); acc = mfma16(*(const bf16x8*)(kb1 + off), qf1, acc);
            const LAS float* rbr = rb + (h * 15 + (rs + p - r + 7)) * 31;
#pragma unroll
            for (int i = 0; i < 4; ++i) { const int kcol = c0 + 8 * g + 4 * half + i; const bool valid = (kcol >= cs) && (kcol < cs + 16);
                const float bias = rbr[min(max(kcol - cq + 15, 0), 30)];
                acc[i] = valid ? acc[i] + bias : -INFINITY; }
            S[2 * p + half] = acc;
        }
    }
#pragma unroll
    for (int p = 0; p < 8; ++p)
#pragma unroll
        for (int half = 0; half < 2; ++half) { const LAS unsigned char* kp = ck + ((p * 2 + half) * 2) * 1024 + lane * 16;
            f32x4 acc = (f32x4){0.f, 0.f, 0.f, 0.f};
            acc = mfma16(*(const LAS bf16x8*)kp, qf0, acc); acc = mfma16(*(const LAS bf16x8*)(kp + 1024), qf1, acc);
            S[16 + 2 * p + half] = acc; }
    float mx4[4] = {-INFINITY, -INFINITY, -INFINITY, -INFINITY};
#pragma unroll
    for (int T = 0; T < 32; ++T) mx4[T & 3] = fmaxf(fmaxf(mx4[T & 3], fmaxf(S[T][0], S[T][1])), fmaxf(S[T][2], S[T][3]));
    float mx = fmaxf(fmaxf(mx4[0], mx4[1]), fmaxf(mx4[2], mx4[3]));
    mx = fmaxf(mx, __shfl_xor(mx, 16)); mx = fmaxf(mx, __shfl_xor(mx, 32));
    float l4[4] = {0.f, 0.f, 0.f, 0.f};
#pragma unroll
    for (int T = 0; T < 32; ++T) {
#pragma unroll
        for (int i = 0; i < 4; ++i) { const float p = __expf(S[T][i] - mx); S[T][i] = p; l4[i] += p; } }
    float l = (l4[0] + l4[1]) + (l4[2] + l4[3]);
    l += __shfl_xor(l, 16); l += __shfl_xor(l, 32);
    f32x4 O[4];
#pragma unroll
    for (int dt = 0; dt < 4; ++dt) O[dt] = (f32x4){0.f, 0.f, 0.f, 0.f};
    const bf16_t* vb0 = VB + ((size_t)(bh * 4) * (TKB / 8) * 16 + (size_t)g * 16 + q) * 8;
#pragma unroll
    for (int p = 0; p < 16; ++p) {
        u32x4 pw; pw.x = pg8::cvt_pk_bf16(S[2 * p][0], S[2 * p][1]); pw.y = pg8::cvt_pk_bf16(S[2 * p][2], S[2 * p][3]); pw.z = pg8::cvt_pk_bf16(S[2 * p + 1][0], S[2 * p + 1][1]); pw.w = pg8::cvt_pk_bf16(S[2 * p + 1][2], S[2 * p + 1][3]);
        const bf16x8 pb = __builtin_bit_cast(bf16x8, pw);
        if (p < 8) { const int s = (rs + p) * 64 + c0;
#pragma unroll
            for (int dt = 0; dt < 4; ++dt) O[dt] = mfma16(*(const bf16x8*)(vb0 + ((size_t)dt * (TKB / 8) + (s >> 3)) * 128), pb, O[dt]);
        } else {
#pragma unroll
            for (int dt = 0; dt < 4; ++dt) O[dt] = mfma16(*(const LAS bf16x8*)(cv + ((p - 8) * 4 + dt) * 1024 + lane * 16), pb, O[dt]);
        }
    }
    const float inv = 1.f / l;
    bf16_t* op = OMIX + mq * DM + h * 64 + 4 * g;
#pragma unroll
    for (int dt = 0; dt < 4; ++dt) { uint2 w; w.x = pg8::cvt_pk_bf16(O[dt][0] * inv, O[dt][1] * inv); w.y = pg8::cvt_pk_bf16(O[dt][2] * inv, O[dt][3] * inv); *(uint2*)(op + dt * 16) = w; }
}
__device__ __forceinline__ void ph_na(const bf16_t* __restrict__ PROJ, const bf16_t* __restrict__ KH, const bf16_t* __restrict__ VB, const float* __restrict__ rpb, bf16_t* __restrict__ OMIX, LAS unsigned char* lds, int bid, int G) {
    LAS float* rb = (LAS float*)lds;
    LAS unsigned char* ck = lds + 16384; LAS unsigned char* cv = lds + 49152;
    const int lane = threadIdx.x & 63, wave = threadIdx.x >> 6;
    __syncthreads();
    for (int i = threadIdx.x; i < 8 * 15 * 31; i += 512) rb[i] = rpb[i];
    for (int u0 = bid * 32; u0 < NB * 8 * 64 * 4; u0 += G * 32) {
        const int bh = u0 >> 8;
        __syncthreads();
        for (int i = threadIdx.x; i < 2048; i += 512) { const int ln = i & 63, ks = (i >> 6) & 1, half = (i >> 7) & 1, p = i >> 8, q = ln & 15, g = ln >> 4;
            *(LAS u32x4*)(ck + i * 16) = *(const u32x4*)(KH + ((size_t)(bh * 2 + ks) * TKB + SEQ + 32 * p + 8 * (q >> 2) + (q & 3) + 4 * half) * 32 + 8 * g); }
        for (int i = threadIdx.x; i < 2048; i += 512) { const int ln = i & 63, dt = (i >> 6) & 3, p = i >> 8;
            *(LAS u32x4*)(cv + i * 16) = *(const u32x4*)(VB + ((size_t)((bh * 4 + dt) * (TKB / 8) + SEQ / 8 + 4 * p) * 16) * 8 + ln * 8); }
        __syncthreads();
#pragma unroll 1
        for (int it = 0; it < 4; ++it) na_unit(u0 + it * 8 + wave, PROJ, KH, VB, rb, ck, cv, OMIX, lane);
    }
}

typedef float f32x16 __attribute__((ext_vector_type(16)));
__device__ __forceinline__ f32x16 mfma32(bf16x8 a, bf16x8 b, f32x16 c) { return __builtin_amdgcn_mfma_f32_32x32x16_bf16(a, b, c, 0, 0, 0); }
constexpr int NCHUNK = 272;
__device__ __forceinline__ float logsig16(float z) { return (fminf(z, 0.f) - log1pf(__expf(-fabsf(z)))) * (1.f / 16.f); }
__device__ __forceinline__ void ph_upf(const float* __restrict__ a_up, bf16_t* __restrict__ UPF, int bid, int G) {
    for (int e = bid * 512 + threadIdx.x; e < 1024; e += G * 512) { const int dir = e >> 9, h = (e >> 7) & 3, dd = (e >> 6) & 1, ln = e & 63, d5 = ln & 31, h2 = ln >> 5;
        float v[8];
#pragma unroll
        for (int j = 0; j < 8; ++j) v[j] = a_up[(size_t)(dir * 16 + 8 * h2 + j) * 256 + h * 64 + 32 * dd + d5];
        *(u32x4*)(UPF + (size_t)e * 8) = (u32x4){pk2(v[0], v[1]), pk2(v[2], v[3]), pk2(v[4], v[5]), pk2(v[6], v[7])}; }
}
__device__ __forceinline__ float scan32(float v) {
    v += __int_as_float(__builtin_amdgcn_update_dpp(0, __float_as_int(v), 0x111, 0xf, 0xf, true));
    v += __int_as_float(__builtin_amdgcn_update_dpp(0, __float_as_int(v), 0x112, 0xf, 0xf, true));
    v += __int_as_float(__builtin_amdgcn_update_dpp(0, __float_as_int(v), 0x114, 0xf, 0xf, true));
    v += __int_as_float(__builtin_amdgcn_update_dpp(0, __float_as_int(v), 0x118, 0xf, 0xf, true));
    v += __int_as_float(__builtin_amdgcn_update_dpp(0, __float_as_int(v), 0x142, 0xa, 0xf, false));
    return v;
}
__device__ __forceinline__ void gla_prep_unit(int uu, const bf16_t* __restrict__ PROJ, const bf16_t* __restrict__ UPF, const float* __restrict__ a_bias, bf16_t* __restrict__ QF, bf16_t* __restrict__ KF, bf16_t* __restrict__ KFT, float* __restrict__ AT,
                                              const LAS float* tab, const LAS float* lbias, const LAS unsigned char* lupf, LAS unsigned char* tile, int lane) {
    const int h = uu & 3, ci = uu >> 2;
    const bool lat = ci < 256;
    const int crow = ci & 63;
    const int m0 = lat ? ((ci >> 6) * SEQ + crow * 64) : (M_LAT + (ci - 256) * 64);
    const int l31 = lane & 31, hh = lane >> 5;
    constexpr int TS2 = 144;
    bf16x8 adf[2][2];
#pragma unroll
    for (int dir = 0; dir < 2; ++dir)
#pragma unroll
        for (int tt = 0; tt < 2; ++tt) adf[dir][tt] = *(const bf16x8*)(PROJ + (unsigned)((m0 + 32 * tt + l31) * PROJ_LD + PC_AD + dir * 16 + 8 * hh));
#pragma unroll 1
    for (int dd = 0; dd < 2; ++dd) {
        const int dbase = h * 64 + 32 * dd + 4 * hh;
        float kv[2][16], qv[2][16];
#pragma unroll
        for (int tt = 0; tt < 2; ++tt)
#pragma unroll
            for (int rr = 0; rr < 4; ++rr) { const unsigned ro = (unsigned)((m0 + 32 * tt + l31) * PROJ_LD + dbase + 8 * rr);
                const uint2 kw = *(const uint2*)(PROJ + ro + PC_GK);
                kv[tt][4 * rr] = __uint_as_float(kw.x << 16); kv[tt][4 * rr + 1] = __uint_as_float(kw.x & 0xffff0000u); kv[tt][4 * rr + 2] = __uint_as_float(kw.y << 16); kv[tt][4 * rr + 3] = __uint_as_float(kw.y & 0xffff0000u);
                if (lat) { const uint2 qw = *(const uint2*)(PROJ + ro + PC_GQ);
                    qv[tt][4 * rr] = __uint_as_float(qw.x << 16); qv[tt][4 * rr + 1] = __uint_as_float(qw.x & 0xffff0000u); qv[tt][4 * rr + 2] = __uint_as_float(qw.y << 16); qv[tt][4 * rr + 3] = __uint_as_float(qw.y & 0xffff0000u); }
                else { qv[tt][4 * rr] = 0.f; qv[tt][4 * rr + 1] = 0.f; qv[tt][4 * rr + 2] = 0.f; qv[tt][4 * rr + 3] = 0.f; } }
        if (lat) {
#pragma unroll
            for (int tt = 0; tt < 2; ++tt) { const int pos = dd ? (32 * tt + l31) : crow;
#pragma unroll
                for (int r2 = 0; r2 < 2; ++r2) {
                    const LAS float* tp = tab + 2 * (pos * 16 + 8 * r2 + 4 * hh);
                    const f32x4 c01 = *(const LAS f32x4*)tp, c23 = *(const LAS f32x4*)(tp + 4);
                    const float cs[4] = {c01[0], c01[2], c23[0], c23[2]}, sn[4] = {c01[1], c01[3], c23[1], c23[3]};
#pragma unroll
                    for (int k = 0; k < 4; ++k) { const int lo = 4 * r2 + k, hi = lo + 8;
                        const float k1 = kv[tt][lo], k2 = kv[tt][hi], q1 = qv[tt][lo], q2 = qv[tt][hi];
                        kv[tt][lo] = k1 * cs[k] - k2 * sn[k]; kv[tt][hi] = k1 * sn[k] + k2 * cs[k];
                        qv[tt][lo] = q1 * cs[k] - q2 * sn[k]; qv[tt][hi] = q1 * sn[k] + q2 * cs[k]; } } }
        }
#pragma unroll
        for (int dir = 0; dir < 2; ++dir) {
            const bf16x8 upf = *(const LAS bf16x8*)(lupf + (((dir * 4 + h) * 2 + dd) * 64 + lane) * 16);
            float lam[2][16], la1[16];
            float tot0[16];
            f32x4 zb[4];
#pragma unroll
            for (int rr = 0; rr < 4; ++rr) zb[rr] = *(const LAS f32x4*)(lbias + dir * 256 + dbase + 8 * rr);
#pragma unroll
            for (int tt = 0; tt < 2; ++tt) { f32x16 Z;
#pragma unroll
                for (int i = 0; i < 16; ++i) Z[i] = 0.f;
                Z = mfma32(upf, adf[dir][tt], Z);
                float la[16], p[16];
#pragma unroll
                for (int i = 0; i < 16; ++i) { const float z = Z[i] + zb[i >> 2][i & 3]; la[i] = (fminf(z, 0.f) - __logf(1.f + __expf(-fabsf(z)))) * (1.f / 16.f); p[i] = la[i]; }
#pragma unroll
                for (int i = 0; i < 16; ++i) p[i] += __int_as_float(__builtin_amdgcn_update_dpp(0, __float_as_int(p[i]), 0x111, 0xf, 0xf, true));
#pragma unroll
                for (int i = 0; i < 16; ++i) p[i] += __int_as_float(__builtin_amdgcn_update_dpp(0, __float_as_int(p[i]), 0x112, 0xf, 0xf, true));
#pragma unroll
                for (int i = 0; i < 16; ++i) p[i] += __int_as_float(__builtin_amdgcn_update_dpp(0, __float_as_int(p[i]), 0x114, 0xf, 0xf, true));
#pragma unroll
                for (int i = 0; i < 16; ++i) p[i] += __int_as_float(__builtin_amdgcn_update_dpp(0, __float_as_int(p[i]), 0x118, 0xf, 0xf, true));
#pragma unroll
                for (int i = 0; i < 16; ++i) p[i] += __int_as_float(__builtin_amdgcn_update_dpp(0, __float_as_int(p[i]), 0x142, 0xa, 0xf, false));
#pragma unroll
                for (int i = 0; i < 16; ++i) {
                    if (tt == 1) p[i] += tot0[i];
                    const float t31 = __int_as_float(__builtin_amdgcn_readlane(__float_as_int(p[i]), 31)), t63 = __int_as_float(__builtin_amdgcn_readlane(__float_as_int(p[i]), 63));
                    const float tl = hh ? t63 : t31;
                    if (tt == 0) { la1[i] = la[i]; lam[0][i] = p[i]; tot0[i] = tl; }
                    else { tot0[i] = tl; lam[1][i] = dir ? (tl - p[i] + la[i]) : p[i]; }
                }
                if (tt == 1 && dir) {
#pragma unroll
                    for (int i = 0; i < 16; ++i) lam[0][i] = tot0[i] - lam[0][i] + la1[i];
                }
            }
            if (l31 == 0) {
#pragma unroll
                for (int rr = 0; rr < 4; ++rr) *(f32x4*)(AT + (unsigned)((dir * NCHUNK + ci) * 256 + dbase + 8 * rr)) = (f32x4){__expf(tot0[4 * rr]), __expf(tot0[4 * rr + 1]), __expf(tot0[4 * rr + 2]), __expf(tot0[4 * rr + 3])};
            }
#pragma unroll
            for (int tt = 0; tt < 2; ++tt) { const int t = 32 * tt + l31;
#pragma unroll
                for (int rr = 0; rr < 4; ++rr) { unsigned kb[4], qb[4];
#pragma unroll
                    for (int k = 0; k < 4; ++k) { const int i = 4 * rr + k; const float el = __expf(lam[tt][i]);
                        kb[k] = f2bf(kv[tt][i] * __expf(-lam[tt][i])); qb[k] = f2bf(qv[tt][i] * el);
                        *(LAS bf16_t*)(tile + (8 * rr + 4 * hh + k) * TS2 + t * 2) = (bf16_t)kb[k]; }
                    if (lat) { const unsigned mo = (unsigned)((dir * M_LAT + m0 + t) * 256 + dbase + 8 * rr);
                        *(uint2*)(QF + mo) = make_uint2(qb[0] | (qb[1] << 16), qb[2] | (qb[3] << 16)); *(uint2*)(KF + mo) = make_uint2(kb[0] | (kb[1] << 16), kb[2] | (kb[3] << 16)); } } }
            asm volatile("s_waitcnt lgkmcnt(0)" ::: "memory");
#pragma unroll
            for (int j = 0; j < 4; ++j) { const int ch = lane + 64 * j, dl = ch >> 3, c8 = ch & 7;
                *(u32x4*)(KFT + (unsigned)((dir * 256 + h * 64 + 32 * dd + dl) * M_ALL + m0 + 8 * c8)) = *(const LAS u32x4*)(tile + dl * TS2 + c8 * 16); }
            asm volatile("s_waitcnt lgkmcnt(0)" ::: "memory");
        }
    }
}
__device__ __forceinline__ void ph_gla_prep2(const bf16_t* __restrict__ PROJ, const bf16_t* __restrict__ UPF, const float* __restrict__ a_bias, bf16_t* __restrict__ QF, bf16_t* __restrict__ KF, bf16_t* __restrict__ KFT, float* __restrict__ AT,
                                             LAS unsigned char* lds, int bid, int G) {
    LAS float* tab = (LAS float*)(lds + 16384);
    LAS float* lbias = (LAS float*)(lds + 24576);
    LAS unsigned char* lupf = lds + 26624;
    __syncthreads();
    lbias[threadIdx.x] = a_bias[threadIdx.x];
    for (int i = threadIdx.x; i < 1024; i += 512) *(LAS u32x4*)(lupf + i * 16) = *(const u32x4*)(UPF + (size_t)i * 8);
    for (int i = threadIdx.x; i < 1024; i += 512) { const int pos = i >> 4, fi = i & 15; const float ang = (float)pos * powf(10000.f, -(float)fi / 16.f); tab[2 * i] = cosf(ang); tab[2 * i + 1] = sinf(ang); }
    __syncthreads();
    const int lane = threadIdx.x & 63, wave = threadIdx.x >> 6;
#ifndef REP_GP
#define REP_GP 1
#endif
    for (int rep_ = 0; rep_ < REP_GP; ++rep_)
    for (int u = bid * 8 + wave; u < NCHUNK * 4; u += G * 8) gla_prep_unit(__builtin_amdgcn_readfirstlane(u), PROJ, UPF, a_bias, QF, KF, KFT, AT, tab, lbias, lupf, lds + 49152 + wave * 4608, lane);
}
constexpr size_t SB_CH = 128 * 64;
__device__ __forceinline__ void gla_state_unit(int u, const bf16_t* __restrict__ KFT, const bf16_t* __restrict__ VT, const float* __restrict__ AT, bf16_t* __restrict__ SB, int lane) {
    const int es = u & 3, dir = (u >> 2) & 1, h = (u >> 3) & 3, b = u >> 5;
    const int l31 = lane & 31, hh = lane >> 5;
    f32x16 acc[2];
#pragma unroll
    for (int dt = 0; dt < 2; ++dt)
#pragma unroll
        for (int i = 0; i < 16; ++i) acc[dt][i] = 0.f;
    const bf16_t* kft0 = KFT + ((size_t)dir * 256 + h * 64 + l31) * M_ALL + 8 * hh;
    const bf16_t* vt0 = VT + (size_t)(512 + h * 128 + es * 32 + l31) * VT_LD + 8 * hh;
    bf16_t* sb0 = SB + ((size_t)((dir * NB + b) * 4 + h) * 64) * SB_CH + (size_t)(es * 32 + l31) * 64 + 4 * hh;
    for (int s = 0; s < 68; ++s) {
        int ci, m0, c = 0;
        if (s < 4) { const int cc = dir ? 3 - s : s; ci = 256 + b * 4 + cc; m0 = M_LAT + b * CTXL + cc * 64; }
        else { c = dir ? 67 - s : s - 4; ci = b * 64 + c; m0 = b * SEQ + c * 64; }
        bf16x8 af[2][4], bfr[4]; f32x4 av[2][4];
#pragma unroll
        for (int ks = 0; ks < 4; ++ks) { bfr[ks] = *(const bf16x8*)(vt0 + m0 + 16 * ks);
#pragma unroll
            for (int dt = 0; dt < 2; ++dt) af[dt][ks] = *(const bf16x8*)(kft0 + (size_t)dt * 32 * M_ALL + m0 + 16 * ks); }
#pragma unroll
        for (int dt = 0; dt < 2; ++dt)
#pragma unroll
            for (int rr = 0; rr < 4; ++rr) av[dt][rr] = *(const f32x4*)(AT + ((size_t)dir * NCHUNK + ci) * 256 + h * 64 + dt * 32 + 8 * rr + 4 * hh);
        if (s >= 4) {
            bf16_t* sp = sb0 + (size_t)c * SB_CH;
#pragma unroll
            for (int dt = 0; dt < 2; ++dt)
#pragma unroll
                for (int rr = 0; rr < 4; ++rr) { uint2 w; w.x = pg8::cvt_pk_bf16(acc[dt][4 * rr], acc[dt][4 * rr + 1]); w.y = pg8::cvt_pk_bf16(acc[dt][4 * rr + 2], acc[dt][4 * rr + 3]); *(uint2*)(sp + dt * 32 + 8 * rr) = w; }
        }
#pragma unroll
        for (int dt = 0; dt < 2; ++dt) {
#pragma unroll
            for (int ks = 0; ks < 4; ++ks) acc[dt] = mfma32(af[dt][ks], bfr[ks], acc[dt]);
#pragma unroll
            for (int rr = 0; rr < 4; ++rr) { acc[dt][4 * rr] *= av[dt][rr][0]; acc[dt][4 * rr + 1] *= av[dt][rr][1]; acc[dt][4 * rr + 2] *= av[dt][rr][2]; acc[dt][4 * rr + 3] *= av[dt][rr][3]; }
        }
    }
}
__device__ __forceinline__ void gla_out_unit(int u, const bf16_t* __restrict__ PROJ, const bf16_t* __restrict__ QF, const bf16_t* __restrict__ KF, const bf16_t* __restrict__ VT, const bf16_t* __restrict__ SB, const float* __restrict__ gnorm,
                                             bf16_t* __restrict__ OMIX, LAS unsigned char* tile, int lane) {
    const int it = u & 1, c = (u >> 1) & 63, h = (u >> 7) & 3, b = u >> 9;
    const int l31 = lane & 31, hh = lane >> 5;
    const int m0 = b * SEQ + c * 64;
    f32x16 o[4];
#pragma unroll
    for (int et = 0; et < 4; ++et)
#pragma unroll
        for (int i = 0; i < 16; ++i) o[et][i] = 0.f;
#pragma unroll
    for (int dir = 0; dir < 2; ++dir) {
        bf16x8 qf[4];
        const bf16_t* qp = QF + ((size_t)dir * M_LAT + m0 + 32 * it + l31) * 256 + h * 64 + 8 * hh;
#pragma unroll
        for (int ks = 0; ks < 4; ++ks) qf[ks] = *(const bf16x8*)(qp + 16 * ks);
#pragma unroll
        for (int jt = 0; jt < 2; ++jt) {
            const bool need = dir ? (jt >= it) : (jt <= it);
            if (!need) continue;
            f32x16 X;
#pragma unroll
            for (int i = 0; i < 16; ++i) X[i] = 0.f;
            const bf16_t* kp = KF + ((size_t)dir * M_LAT + m0 + 32 * jt + l31) * 256 + h * 64 + 8 * hh;
#pragma unroll
            for (int ks = 0; ks < 4; ++ks) X = mfma32(*(const bf16x8*)(kp + 16 * ks), qf[ks], X);
            if (jt == it) {
#pragma unroll
                for (int i = 0; i < 16; ++i) { const int jr = (i & 3) + 8 * (i >> 2) + 4 * hh; const bool keep = dir ? (jr >= l31) : (jr <= l31); X[i] = keep ? X[i] : 0.f; }
            }
#pragma unroll
            for (int s = 0; s < 2; ++s) {
                u32x4 xw; xw.x = pg8::cvt_pk_bf16(X[8 * s], X[8 * s + 1]); xw.y = pg8::cvt_pk_bf16(X[8 * s + 2], X[8 * s + 3]); xw.z = pg8::cvt_pk_bf16(X[8 * s + 4], X[8 * s + 5]); xw.w = pg8::cvt_pk_bf16(X[8 * s + 6], X[8 * s + 7]);
                const bf16x8 xa = __builtin_bit_cast(bf16x8, xw);
#pragma unroll
                for (int et = 0; et < 4; ++et) {
                    const bf16_t* vp = VT + (size_t)(512 + h * 128 + et * 32 + l31) * VT_LD + m0 + 32 * jt + 16 * s + 4 * hh;
                    const uint2 lo = *(const uint2*)vp, hi = *(const uint2*)(vp + 8);
                    const u32x4 vw = (u32x4){lo.x, lo.y, hi.x, hi.y};
                    o[et] = mfma32(xa, __builtin_bit_cast(bf16x8, vw), o[et]); }
            }
        }
        const bf16_t* sp = SB + ((size_t)(((dir * NB + b) * 4 + h) * 64 + c)) * SB_CH + (size_t)l31 * 64 + 8 * hh;
#pragma unroll
        for (int et = 0; et < 4; ++et)
#pragma unroll
            for (int ks = 0; ks < 4; ++ks) o[et] = mfma32(qf[ks], *(const bf16x8*)(sp + (size_t)et * 32 * 64 + 16 * ks), o[et]);
    }
    float ss[16];
#pragma unroll
    for (int i = 0; i < 16; ++i) { float a = 0.f;
#pragma unroll
        for (int et = 0; et < 4; ++et) a += o[et][i] * o[et][i];
        a += __shfl_xor(a, 1); a += __shfl_xor(a, 2); a += __shfl_xor(a, 4); a += __shfl_xor(a, 8); a += __shfl_xor(a, 16);
        ss[i] = rsqrtf(a * (1.f / 128.f) + EPS); }
    constexpr int TS = 272;
    const size_t mrow0 = (size_t)(m0 + 32 * it);
#pragma unroll
    for (int j = 0; j < 8; ++j) { const int ch = lane + 64 * j, t = ch >> 4, c16 = ch & 15;
        *(LAS u32x4*)(tile + t * TS + c16 * 16) = *(const u32x4*)(PROJ + (mrow0 + t) * PROJ_LD + PC_GG + h * 128 + c16 * 8); }
    asm volatile("s_waitcnt vmcnt(0) lgkmcnt(0)" ::: "memory");
#pragma unroll
    for (int et = 0; et < 4; ++et) { const float gn = gnorm[et * 32 + l31];
#pragma unroll
        for (int i = 0; i < 16; ++i) { const int t = (i & 3) + 8 * (i >> 2) + 4 * hh;
            LAS bf16_t* p = (LAS bf16_t*)(tile + t * TS) + et * 32 + l31;
            const float g = bf2f(*p);
            *p = (bf16_t)f2bf(o[et][i] * ss[i] * gn * silu_f(g)); } }
    asm volatile("s_waitcnt lgkmcnt(0)" ::: "memory");
#pragma unroll
    for (int j = 0; j < 8; ++j) { const int ch = lane + 64 * j, t = ch >> 4, c16 = ch & 15;
        *(u32x4*)(OMIX + (mrow0 + t) * DM + 512 + h * 128 + c16 * 8) = *(const LAS u32x4*)(tile + t * TS + c16 * 16); }
    asm volatile("s_waitcnt lgkmcnt(0)" ::: "memory");
}
__device__ __forceinline__ void ph_gla_state(const bf16_t* KFT, const bf16_t* VT, const float* AT, bf16_t* SB, int bid, int G) {
    const int lane = threadIdx.x & 63, wave = threadIdx.x >> 6;
    for (int u = wave * G + bid; u < NB * 4 * 2 * 4; u += 8 * G) gla_state_unit(u, KFT, VT, AT, SB, lane);
}
__device__ __forceinline__ void ph_gla_out(const bf16_t* PROJ, const bf16_t* QF, const bf16_t* KF, const bf16_t* VT, const bf16_t* SB, const float* gnorm, bf16_t* OMIX, LAS unsigned char* lds, int bid, int G) {
    const int lane = threadIdx.x & 63, wave = threadIdx.x >> 6;
    for (int u = bid * 8 + wave; u < NB * 4 * 64 * 2; u += G * 8) gla_out_unit(u, PROJ, QF, KF, VT, SB, gnorm, OMIX, lds + wave * (32 * 272), lane);
}

__device__ __forceinline__ void ph_post_mix(const float* __restrict__ x, const bf16_t* __restrict__ MIX, const float* __restrict__ mod, const float* __restrict__ g_post, const float* __restrict__ g_fpre, const float* __restrict__ router,
                                                  float* __restrict__ xnew, unsigned char* __restrict__ HF, float* __restrict__ aff, LAS unsigned char* lds, int bid, int G) {
    LAS float* rt = (LAS float*)lds;
    __syncthreads();
    for (int i = threadIdx.x; i < DM * NE; i += 512) rt[(i % NE) * DM + (i / NE)] = router[i];
    __syncthreads();
    const int lane = threadIdx.x & 63, wave = threadIdx.x >> 6;
    const int NGW = G * 8;
    for (int m0 = bid * 8 + wave; m0 < M_LAT; m0 += 2 * NGW) {
        int mm[2]; bool ok[2];
#pragma unroll
        for (int r = 0; r < 2; ++r) { const int m = m0 + r * NGW; ok[r] = m < M_LAT; mm[r] = ok[r] ? m : m0; }
        unsigned long long mw[2][4]; f32x4 xv[2][4];
#pragma unroll
        for (int r = 0; r < 2; ++r)
#pragma unroll
            for (int j = 0; j < 4; ++j) { mw[r][j] = ((const unsigned long long*)(MIX + (size_t)mm[r] * DM))[lane + 64 * j]; xv[r][j] = *(const f32x4*)(x + (size_t)mm[r] * DM + 4 * lane + 256 * j); }
        f32x4 mx[2][4]; float ss[2] = {0.f, 0.f};
#pragma unroll
        for (int r = 0; r < 2; ++r)
#pragma unroll
            for (int j = 0; j < 4; ++j) { const unsigned lo = (unsigned)mw[r][j], hi = (unsigned)(mw[r][j] >> 32);
                mx[r][j] = (f32x4){__uint_as_float(lo << 16), __uint_as_float(lo & 0xffff0000u), __uint_as_float(hi << 16), __uint_as_float(hi & 0xffff0000u)};
                ss[r] += (mx[r][j].x * mx[r][j].x + mx[r][j].y * mx[r][j].y) + (mx[r][j].z * mx[r][j].z + mx[r][j].w * mx[r][j].w); }
#pragma unroll
        for (int o = 1; o < 64; o <<= 1) { ss[0] += __shfl_xor(ss[0], o); ss[1] += __shfl_xor(ss[1], o); }
        f32x4 xn[2][4]; float s2[2] = {0.f, 0.f};
#pragma unroll
        for (int r = 0; r < 2; ++r) { const float rstd = rsqrtf(ss[r] * (1.f / DM) + EPS); const float* mv = mod + (size_t)(mm[r] / SEQ) * 6144;
#pragma unroll
            for (int j = 0; j < 4; ++j) { const int col = 4 * lane + 256 * j;
                const f32x4 gp = *(const f32x4*)(g_post + col), gm = *(const f32x4*)(mv + 2048 + col);
                xn[r][j] = xv[r][j] + gm * (mx[r][j] * rstd * gp);
                if (ok[r]) *(f32x4*)(xnew + (size_t)mm[r] * DM + col) = xn[r][j];
                s2[r] += (xn[r][j].x * xn[r][j].x + xn[r][j].y * xn[r][j].y) + (xn[r][j].z * xn[r][j].z + xn[r][j].w * xn[r][j].w); } }
#pragma unroll
        for (int o = 1; o < 64; o <<= 1) { s2[0] += __shfl_xor(s2[0], o); s2[1] += __shfl_xor(s2[1], o); }
        const bool b5 = lane & 32, b4 = lane & 16, b3 = lane & 8, b2 = lane & 4;
#pragma unroll
        for (int r = 0; r < 2; ++r) { const float rstd2 = rsqrtf(s2[r] * (1.f / DM) + EPS); const float* mv = mod + (size_t)(mm[r] / SEQ) * 6144;
            f32x4 hv4[4]; float lg[NE];
            unsigned* hp = (unsigned*)(HF + (size_t)mm[r] * DM) + lane;
#pragma unroll
            for (int j = 0; j < 4; ++j) { const int col = 4 * lane + 256 * j;
                const f32x4 gf = *(const f32x4*)(g_fpre + col), sh = *(const f32x4*)(mv + 3072 + col), sc = *(const f32x4*)(mv + 4096 + col);
                hv4[j] = xn[r][j] * rstd2 * gf * (sc + 1.f) + sh;
                if (ok[r]) hp[64 * j] = pk4_fp8(hv4[j].x * SX8, hv4[j].y * SX8, hv4[j].z * SX8, hv4[j].w * SX8); }
#pragma unroll
            for (int e = 0; e < NE; ++e) { float sacc = 0.f;
#pragma unroll
                for (int j = 0; j < 4; ++j) { const f32x4 rv = *(const LAS f32x4*)(rt + e * DM + 4 * lane + 256 * j); sacc += (hv4[j].x * rv.x + hv4[j].y * rv.y) + (hv4[j].z * rv.z + hv4[j].w * rv.w); }
                lg[e] = sacc; }
            float w8[8], w4[4], w2[2];
#pragma unroll
            for (int j = 0; j < 8; ++j) { const float keep = b5 ? lg[8 + j] : lg[j], send = b5 ? lg[j] : lg[8 + j]; w8[j] = keep + __shfl_xor(send, 32); }
#pragma unroll
            for (int j = 0; j < 4; ++j) { const float keep = b4 ? w8[4 + j] : w8[j], send = b4 ? w8[j] : w8[4 + j]; w4[j] = keep + __shfl_xor(send, 16); }
#pragma unroll
            for (int j = 0; j < 2; ++j) { const float keep = b3 ? w4[2 + j] : w4[j], send = b3 ? w4[j] : w4[2 + j]; w2[j] = keep + __shfl_xor(send, 8); }
            float z = (b2 ? w2[1] : w2[0]) + __shfl_xor(b2 ? w2[0] : w2[1], 4);
            z += __shfl_xor(z, 2); z += __shfl_xor(z, 1);
            float mxl = z;
            mxl = fmaxf(mxl, __shfl_xor(mxl, 4)); mxl = fmaxf(mxl, __shfl_xor(mxl, 8)); mxl = fmaxf(mxl, __shfl_xor(mxl, 16)); mxl = fmaxf(mxl, __shfl_xor(mxl, 32));
            const float ez = expf(z - mxl); float den = ez;
            den += __shfl_xor(den, 4); den += __shfl_xor(den, 8); den += __shfl_xor(den, 16); den += __shfl_xor(den, 32);
            if (ok[r] && (lane & 3) == 0) aff[((size_t)(mm[r] / SEQ) * NE + (lane >> 2)) * SEQ + (mm[r] % SEQ)] = ez / den;
            asm volatile("" ::: "memory");
        }
    }
}

__device__ __forceinline__ int block_excl_scan(int v, LAS int* sm  , int& total) {
    const int lane = threadIdx.x & 63, w = threadIdx.x >> 6; int x = v;
#pragma unroll
    for (int o = 1; o < 64; o <<= 1) { const int y = __shfl_up(x, o); if (lane >= o) x += y; }
    __syncthreads();
    if (lane == 63) sm[w] = x;
    __syncthreads();
    int base = 0, tot = 0;
#pragma unroll
    for (int i = 0; i < 8; ++i) { const int s = sm[i]; if (i < w) base += s; tot += s; }
    total = tot;
    return base + x - v;
}
__device__ __forceinline__ void ph_topk(const float* __restrict__ aff, const unsigned char* __restrict__ HF, int* __restrict__ idx, float* __restrict__ gate, int* __restrict__ inv, unsigned char* __restrict__ XS, LAS unsigned char* lds, int bid, int G) {
  LAS int* hist = (LAS int*)lds; LAS int* sm = hist + 256; LAS unsigned* sp = (LAS unsigned*)(sm + 16); LAS int* srm = (LAS int*)(sp + 1); LAS int* s_list = srm + 1;
#define s_prefix (*sp)
#define s_remain (*srm)
  for (int be = bid; be < NB * NE; be += G) {
    const int b = be / NE, e = be % NE, tid = threadIdx.x;
    __syncthreads();
    const float* av = aff + ((size_t)b * NE + e) * SEQ;
    unsigned key[8];
#pragma unroll
    for (int j = 0; j < 8; ++j) key[j] = __float_as_uint(av[tid * 8 + j]);
    if (tid == 0) { s_prefix = 0u; s_remain = CAP; }
    for (int pass = 3; pass >= 0; --pass) {
        if (tid < 256) hist[tid] = 0;
        __syncthreads();
        const unsigned prefix = s_prefix; const int shift = pass * 8; const unsigned himask = pass == 3 ? 0u : (0xffffffffu << (shift + 8));
#pragma unroll
        for (int j = 0; j < 8; ++j) if ((key[j] & himask) == prefix) atomicAdd((int*)(hist + ((key[j] >> shift) & 255u)), 1);
        __syncthreads();
        {
            const int rem = s_remain; const int lane_ = tid & 63, w_ = tid >> 6;
            int hcnt = 0, suf = 0;
            if (tid < 256) { hcnt = hist[tid]; suf = hcnt;
#pragma unroll
                for (int o = 1; o < 64; o <<= 1) { const int y = __shfl_down(suf, o); if (lane_ + o < 64) suf += y; }
                if (lane_ == 0) sm[8 + w_] = suf; }
            __syncthreads();
            if (tid < 256) { int above = suf - hcnt; for (int w2 = w_ + 1; w2 < 4; ++w2) above += sm[8 + w2];
                if (hcnt > 0 && above < rem && rem <= above + hcnt) { s_remain = rem - above; s_prefix = prefix | ((unsigned)tid << shift); } }
            __syncthreads();
        }
    }
    const unsigned T = s_prefix; const int remain = s_remain;
    int neq = 0;
#pragma unroll
    for (int j = 0; j < 8; ++j) neq += (key[j] == T);
    int tot; int eqbase = block_excl_scan(neq, sm, tot);
    int flags = 0, nsel = 0;
#pragma unroll
    for (int j = 0; j < 8; ++j) { bool sel = key[j] > T; if (key[j] == T) { sel = eqbase < remain; ++eqbase; } if (sel) { flags |= 1 << j; ++nsel; } }
    int slot = block_excl_scan(nsel, sm, tot);
    const int rowbase = (e * NB + b) * CAP;
#pragma unroll
    for (int j = 0; j < 8; ++j) { const int t = tid * 8 + j; int sl = -1;
        if (flags & (1 << j)) { sl = slot++; idx[rowbase + sl] = t; gate[rowbase + sl] = __uint_as_float(key[j]); s_list[sl] = t; }
        inv[((size_t)b * SEQ + t) * NE + e] = sl; }
    __syncthreads();
    const int lane = tid & 63, wave = tid >> 6;
    for (int s = wave; s < CAP; s += 8) { const u32x4* src = (const u32x4*)(HF + ((size_t)b * SEQ + s_list[s]) * DM); u32x4* dst = (u32x4*)(XS + (size_t)(rowbase + s) * DM);
        dst[lane] = src[lane]; }
  }
#undef s_prefix
#undef s_remain
}

__device__ __forceinline__ void ph_combine(const bf16_t* __restrict__ Y, const int* __restrict__ inv, const float* __restrict__ mod, const float* __restrict__ g_fpost, float* __restrict__ out, int bid, int G) {
    const int lane = threadIdx.x & 63, wave = threadIdx.x >> 6;
    for (int m = bid * 8 + wave; m < M_LAT; m += G * 8) {
        const int b = m / SEQ; const float* mv = mod + (size_t)b * 6144;
        const int sl = (lane < NE) ? inv[(size_t)m * NE + lane] : -1;
        unsigned mask = (unsigned)__ballot(sl >= 0);
        f32x4 xn[4];
#pragma unroll
        for (int j = 0; j < 4; ++j) xn[j] = *(const f32x4*)(out + (size_t)m * DM + 4 * lane + 256 * j);
        f32x4 y[4];
#pragma unroll
        for (int j = 0; j < 4; ++j) y[j] = (f32x4){0.f, 0.f, 0.f, 0.f};
        while (mask) {
            const unsigned long long* yp[4]; float w[4];
#pragma unroll
            for (int k = 0; k < 4; ++k) { const unsigned mm = mask ? mask : 1u; const int e = __builtin_ctz(mm); w[k] = mask ? 1.f : 0.f; mask &= mask - 1u;
                const int s = __builtin_amdgcn_readlane(sl, e); const int s2 = s < 0 ? 0 : s;
                yp[k] = (const unsigned long long*)(Y + (size_t)((e * NB + b) * CAP + s2) * DM) + lane; }
            unsigned long long v[4][4];
#pragma unroll
            for (int k = 0; k < 4; ++k)
#pragma unroll
                for (int j = 0; j < 4; ++j) v[k][j] = yp[k][64 * j];
#pragma unroll
            for (int k = 0; k < 4; ++k)
#pragma unroll
                for (int j = 0; j < 4; ++j) { const unsigned lo = (unsigned)v[k][j], hi = (unsigned)(v[k][j] >> 32);
                    y[j] += (f32x4){__uint_as_float(lo << 16), __uint_as_float(lo & 0xffff0000u), __uint_as_float(hi << 16), __uint_as_float(hi & 0xffff0000u)} * w[k]; }
        }
        float ss = 0.f;
#pragma unroll
        for (int j = 0; j < 4; ++j) ss += (y[j].x * y[j].x + y[j].y * y[j].y) + (y[j].z * y[j].z + y[j].w * y[j].w);
        const float rstd = rsqrtf(wave_sum(ss) * (1.f / DM) + EPS);
#pragma unroll
        for (int j = 0; j < 4; ++j) { const int col = 4 * lane + 256 * j; float* op = out + (size_t)m * DM + col;
            const f32x4 gp = *(const f32x4*)(g_fpost + col), gf = *(const f32x4*)(mv + 5120 + col);
            *(f32x4*)op = xn[j] + gf * (y[j] * rstd * gp); }
    }
}

#define GAS __attribute__((address_space(1)))
#define XB_TMO      128
#define XB_XCNT(j)  (256  + 64 * (j))
#define XB_XSUB(j)  (1280 + 64 * (j))
#define XB_XGEN(j)  (2304 + 64 * (j))
#define XB_TOP      3328
#define XB_TOPGEN   3392
#define XCD_BAR_WORDS 3456
#define XB_SPIN_CAP (1u << 18)

__device__ __forceinline__ unsigned xb_ld(unsigned* p)              { return __hip_atomic_load(p, __ATOMIC_RELAXED, __HIP_MEMORY_SCOPE_AGENT); }
__device__ __forceinline__ unsigned xb_add(unsigned* p, unsigned v) { return __hip_atomic_fetch_add(p, v, __ATOMIC_RELAXED, __HIP_MEMORY_SCOPE_AGENT); }
__device__ __forceinline__ unsigned xb_xcc_id() { return (unsigned)__builtin_amdgcn_s_getreg((3 << 11) | 20) & 0xFu; }
#define XB_SPIN(cond, bar) do { unsigned _sp = 0; while (cond) { __builtin_amdgcn_s_sleep(1); \
    if ((++_sp & 255u) == 0u) { if (xb_ld(&(bar)[XB_TMO])) break; if (_sp > XB_SPIN_CAP) { atomicAdd(&(bar)[XB_TMO], 1u); break; } } } } while (0)

struct XcdBarrier {
    unsigned* bar; unsigned x;
    volatile LAS unsigned* st;
};

__device__ __forceinline__ XcdBarrier xcd_barrier_post(unsigned* bar, volatile LAS unsigned* st) {
    XcdBarrier b; b.bar = bar; b.x = xb_xcc_id(); b.st = st;
    if (threadIdx.x == 0) (void)xb_add(&bar[XB_XCNT(b.x)], 1u);
    return b;
}
__device__ __forceinline__ void xcd_barrier_complete(unsigned* bar, unsigned x, unsigned& nloc, unsigned& nx) {
    const unsigned G = gridDim.x * gridDim.y * gridDim.z;
    unsigned sum, cnt, mine, sp = 0u;
    for (;;) {
        sum = 0u; cnt = 0u; mine = 0u;
#pragma unroll
        for (unsigned j = 0; j < 16; ++j) { const unsigned c = xb_ld(&bar[XB_XCNT(j)]); sum += c; cnt += (c > 0u) ? 1u : 0u; mine = (j == x) ? c : mine; }
        if (sum == G) break;
        __builtin_amdgcn_s_sleep(1);
        if ((++sp & 255u) == 0u) { if (xb_ld(&bar[XB_TMO])) break; if (sp > XB_SPIN_CAP) { atomicAdd(&bar[XB_TMO], 1u); break; } }
    }
    nloc = mine > 0u ? mine : 1u; nx = cnt > 0u ? cnt : 1u;
}

__device__ __forceinline__ void xcd_barrier(const XcdBarrier& b) {
    asm volatile("s_waitcnt vmcnt(0)" ::: "memory");
    __syncthreads();
    if (threadIdx.x == 0) {
        unsigned* bar = b.bar;
        __builtin_amdgcn_s_waitcnt(0);
        unsigned nloc = b.st[0], nx = b.st[1];
        if (nloc == 0u) { xcd_barrier_complete(bar, b.x, nloc, nx); b.st[0] = nloc; b.st[1] = nx; }
        const unsigned old = xb_add(&bar[XB_XSUB(b.x)], 1u);
        const unsigned gen = old / nloc;
        if (old + 1u == (gen + 1u) * nloc) {
            __builtin_amdgcn_fence(__ATOMIC_RELEASE, "agent");
            asm volatile("s_waitcnt vmcnt(0)" ::: "memory");
            const unsigned og = xb_add(&bar[XB_TOP], 1u);
            const unsigned tg = og / nx;
            if (og + 1u == (tg + 1u) * nx) xb_add(&bar[XB_TOPGEN], 1u);
            else XB_SPIN(xb_ld(&bar[XB_TOPGEN]) == tg, bar);
            __builtin_amdgcn_fence(__ATOMIC_ACQUIRE, "agent");
            xb_add(&bar[XB_XGEN(b.x)], 1u);
            asm volatile("s_waitcnt vmcnt(0)" ::: "memory");
        } else {
            XB_SPIN(xb_ld(&bar[XB_XGEN(b.x)]) == gen, bar);
            __builtin_amdgcn_fence(__ATOMIC_ACQUIRE, "agent");
            asm volatile("s_waitcnt vmcnt(0)" ::: "memory");
        }
    }
    __syncthreads();
}


namespace cg = cooperative_groups;
constexpr int LDS_BYTES = 147456;
constexpr int N_PHASES = 12;
constexpr size_t CTL_BYTES = 65536;
#ifndef REP_PH
#define REP_PH -1
#endif
#ifndef REP_SYNC
#define REP_SYNC 0
#endif
struct MegaArgs { const float* in[20]; float* out; unsigned char* ws; int ph_lo, ph_hi; };
__global__ void __launch_bounds__(512, 2) hy_mega(MegaArgs a) {
    extern __shared__ __attribute__((aligned(16))) unsigned char lds_raw[];
    LAS unsigned char* lds = (LAS unsigned char*)lds_raw;
    const int bid = blockIdx.x, G = gridDim.x;
#define Q_x (a.in[0])
#define Q_c (a.in[1])
#define Q_ctx (a.in[2])
#define Q_c_ctx (a.in[3])
#define Q_w_mod (a.in[4])
#define Q_b_mod (a.in[5])
#define Q_g_pre (a.in[6])
#define Q_g_post (a.in[7])
#define Q_g_fpre (a.in[8])
#define Q_g_fpost (a.in[9])
#define Q_w_in (a.in[10])
#define Q_rpb (a.in[11])
#define Q_a_up (a.in[12])
#define Q_a_bias (a.in[13])
#define Q_gnorm (a.in[14])
#define Q_w_out (a.in[15])
#define Q_router (a.in[16])
#define Q_w_gate (a.in[17])
#define Q_w_up (a.in[18])
#define Q_w_down (a.in[19])
#define Q_ws (a.ws)
#define Q_out (a.out)
#define Q_mod ((float*)(a.ws + WS_MOD))
#define Q_WTIN ((bf16_t*)(a.ws + WS_WTIN))
#define Q_WTV ((bf16_t*)(a.ws + WS_WTV))
#define Q_WTOUT ((bf16_t*)(a.ws + WS_WTOUT))
#define Q_WTGU ((unsigned char*)(a.ws + WS_WTGU))
#define Q_WTDN ((unsigned char*)(a.ws + WS_WTDN))
#define Q_H ((bf16_t*)(a.ws + WS_H))
#define Q_PROJ ((bf16_t*)(a.ws + WS_PROJ))
#define Q_VT ((bf16_t*)(a.ws + WS_VT))
#define Q_OMIX ((bf16_t*)(a.ws + WS_OMIX))
#define Q_MIX ((bf16_t*)(a.ws + WS_MIX))
#define Q_HID ((unsigned char*)(a.ws + WS_HID))
#define Q_HF ((unsigned char*)(a.ws + WS_HF))
#define Q_XS ((unsigned char*)(a.ws + WS_XS))
#define Q_Y ((bf16_t*)(a.ws + WS_XS))
#define Q_aff ((float*)(a.ws + WS_AFF))
#define Q_idx ((int*)(a.ws + WS_IDX))
#define Q_gate ((float*)(a.ws + WS_GATE))
#define Q_inv ((int*)(a.ws + WS_INV))
#define Q_QF ((bf16_t*)(a.ws + WS_QF))
#define Q_KF ((bf16_t*)(a.ws + WS_KF))
#define Q_KFT ((bf16_t*)(a.ws + WS_KFT))
#define Q_AT ((float*)(a.ws + WS_AT))
#define Q_SB ((bf16_t*)(a.ws + WS_SB))
#define Q_KH ((bf16_t*)(a.ws + WS_KH))
#define Q_UPF ((bf16_t*)(a.ws + WS_UPF))
#define Q_VB ((bf16_t*)(a.ws + WS_VB))
    volatile LAS unsigned* bst = (volatile LAS unsigned*)(lds + LDS_BYTES - 64);
    if (threadIdx.x < 16) bst[threadIdx.x] = 0u;
    __syncthreads();
    XcdBarrier bar = xcd_barrier_post((unsigned*)a.ws, bst);
    if (a.ph_hi < 0) cg::this_grid().sync();
    const int lo = a.ph_lo, hi = a.ph_hi;
#define IN(k) (lo <= (k) && (k) < hi)
#define SEAM(k) do { if (IN(k) && IN((k) + 1)) xcd_barrier(bar); } while (0)
#define MKP PrepArgs p; p.x = Q_x; p.ctx = Q_ctx; p.g_pre = Q_g_pre; p.mod = Q_mod; p.w_in = Q_w_in; p.w_out = Q_w_out; p.w_gate = Q_w_gate; p.w_up = Q_w_up; p.w_down = Q_w_down; p.WTIN = Q_WTIN; p.WTV = Q_WTV; p.WTOUT = Q_WTOUT; p.WTGU = Q_WTGU; p.WTDN = Q_WTDN; p.H = Q_H;
#define PH0 if (IN(0)) { MKP ph_mod(Q_c, Q_c_ctx, Q_w_mod, Q_b_mod, Q_mod, lds, bid, G); ph_upf(Q_a_up, Q_UPF, bid, G); ph_convert(p, lds, bid, G); }
#define PH1 if (IN(1)) { MKP ph_modulate(p, bid, G); }
#define PH2 if (IN(2)) { pg8::Gemm g{Q_H, Q_WTIN, M_ALL, PROJ_LD, DM}; InOrder S{G, bid, (const char*)Q_H, (const char*)Q_WTIN, (const char*)Q_WTV}; EpiIn E{EpiProj{Q_PROJ, PROJ_LD, Q_KH}, EpiVal{Q_VT, VT_LD, Q_VB}}; \
        pg8::gemm_phase<EpiIn, InOrder, true, true>(lds, g, S, E); }
#define PH3 if (IN(3)) { ph_gla_prep2(Q_PROJ, Q_UPF, Q_a_bias, Q_QF, Q_KF, Q_KFT, Q_AT, lds, bid, G); ph_na(Q_PROJ, Q_KH, Q_VB, Q_rpb, Q_OMIX, lds, bid, G); }
#define PH4 if (IN(4)) { MKP ph_gla_state(Q_KFT, Q_VT, Q_AT, Q_SB, bid, G); \
        { const int wv_ = threadIdx.x >> 6; const int nst_ = G < 128 ? G : 128; const int pid_ = bid < nst_ ? (wv_ == 0 ? -1 : bid * 7 + wv_ - 1) : nst_ * 7 + (bid - nst_) * 8 + wv_; \
          ph_convert_bg(p, CVT_Q0, CVT_Q1, pid_, nst_ * 7 + (G - nst_) * 8, lds); } }
#define PH5 if (IN(5)) ph_gla_out(Q_PROJ, Q_QF, Q_KF, Q_VT, Q_SB, Q_gnorm, Q_OMIX, lds, bid, G);
#define PH6 if (IN(6)) { pg8::Gemm g{Q_OMIX, Q_WTOUT, M_LAT, DM, DM}; pg8::StaticOrder S; S.init(g.M, g.N, G, bid); S.bind(g); pg8::EpiBf16<0> E{Q_MIX, DM, nullptr, 0, 0, 1.f}; \
        pg8::gemm_phase<pg8::EpiBf16<0>, pg8::StaticOrder, true, true>(lds, g, S, E); }
#define PH7 if (IN(7)) ph_post_mix(Q_x, Q_MIX, Q_mod, Q_g_post, Q_g_fpre, Q_router, Q_out, Q_HF, Q_aff, lds, bid, G);
#define PH8 if (IN(8)) { MKP ph_topk(Q_aff, Q_HF, Q_idx, Q_gate, Q_inv, Q_XS, lds, bid, G); \
        { const int nb_ = G < 64 ? G : 64; const int pid_ = (G > 64) ? (bid < 64 ? -1 : (bid - 64) * 8 + (int)(threadIdx.x >> 6)) : bid * 8 + (int)(threadIdx.x >> 6); \
          ph_convert_bg(p, CVT_Q1, IT8, pid_, (G > 64 ? (G - 64) : G) * 8, lds); } }
#define PH9 if (IN(9)) { pg8::Gemm g{(const bf16_t*)Q_XS, (const bf16_t*)Q_WTGU, NSLOT, 2 * DE, DM / 2}; ExpertOrder S{22, G, bid, (const char*)g.A, (const char*)g.Bt, (size_t)256 * g.K * 2}; EpiSwiGLU E{Q_HID, DE}; \
        pg8::gemm_phase<EpiSwiGLU, ExpertOrder, true, true, true>(lds, g, S, E); }
#define PH10 if (IN(10)) { pg8::Gemm g{(const bf16_t*)Q_HID, (const bf16_t*)Q_WTDN, NSLOT, DM, DE / 2}; ExpertOrder S{4, G, bid, (const char*)g.A, (const char*)g.Bt, (size_t)256 * g.K * 2}; EpiRowScale E{Q_Y, DM, Q_gate}; \
        pg8::gemm_phase<EpiRowScale, ExpertOrder, true, true, true>(lds, g, S, E); }
#define PH11 if (IN(11)) ph_combine(Q_Y, Q_inv, Q_mod, Q_g_fpost, Q_out, bid, G);
#define RUN(k, PH) PH
    PH0
#if REP_PH == 0
    PH0
#endif
    SEAM(0);
    for (int rs_ = 0; rs_ < REP_SYNC; ++rs_) xcd_barrier(bar);
    PH1
#if REP_PH == 1
    PH1
#endif
    SEAM(1);
    PH2
#if REP_PH == 2
    PH2
#endif
    SEAM(2);
    PH3
#if REP_PH == 3
    PH3
#endif
    SEAM(3);
    PH4
#if REP_PH == 4
    PH4
#endif
    SEAM(4);
    PH5
#if REP_PH == 5
    PH5
#endif
    SEAM(5);
    PH6
#if REP_PH == 6
    PH6
#endif
    SEAM(6);
    PH7
#if REP_PH == 7
    PH7
#endif
    SEAM(7);
    PH8
#if REP_PH == 8
    PH8
#endif
    SEAM(8);
    PH9
#if REP_PH == 9
    PH9
#endif
    SEAM(9);
    PH10
#if REP_PH == 10
    PH10
#endif
    SEAM(10);
    PH11
#undef IN
#undef SEAM
}
}

extern "C" void kernel_launch(void* const* d_in, const int* in_sizes, int n_in, void* d_out, int out_size, void* d_ws, size_t ws_size, hipStream_t stream) {
    using namespace hy;
    static int grid = 0;
    if (grid == 0) {
        if (n_in != 20 || in_sizes[0] != M_LAT * DM || out_size != M_LAT * DM || ws_size < WS_END) { fprintf(stderr, "kernel_launch: unexpected shapes / workspace (n_in %d, ws %zu)\n", n_in, ws_size); grid = -1; return; }
        int dev = 0, cus = 0, per_cu = 0;
        if (hipGetDevice(&dev) != hipSuccess || hipDeviceGetAttribute(&cus, hipDeviceAttributeMultiprocessorCount, dev) != hipSuccess) { grid = -1; return; }
        if (hipFuncSetAttribute((const void*)hy_mega, hipFuncAttributeMaxDynamicSharedMemorySize, LDS_BYTES) != hipSuccess) { fprintf(stderr, "kernel_launch: hipFuncSetAttribute failed\n"); grid = -1; return; }
        if (hipOccupancyMaxActiveBlocksPerMultiprocessor(&per_cu, (const void*)hy_mega, 512, LDS_BYTES) != hipSuccess || per_cu < 1) { fprintf(stderr, "kernel_launch: occupancy query says %d\n", per_cu); per_cu = 1; }
        (void)hipGetLastError();
        grid = cus;
    }
    if (grid < 0) return;
    (void)hipMemsetAsync(d_ws, 0, CTL_BYTES, stream);
    MegaArgs a{};
    for (int i = 0; i < 20; ++i) a.in[i] = (const float*)d_in[i];
    a.out = (float*)d_out; a.ws = (unsigned char*)d_ws;
    a.ph_lo = 0; a.ph_hi = N_PHASES;
    void* args[] = {&a};
    hipError_t e = hipLaunchCooperativeKernel((const void*)hy_mega, dim3(grid), dim3(512), args, LDS_BYTES, stream);
    if (e != hipSuccess) fprintf(stderr, "cooperative launch failed: %s (grid %d)\n", hipGetErrorString(e), grid);
}
```
